# Optimizing an MI355X kernel written in HIP

```python
import math
import jax, jax.numpy as jnp
from jax import lax
import numpy as np


D_MODEL = 1024
BATCH = 16
SEQ = 2048
DEPTH = 2

N_MIXERS = 2
HEAD_DIM = 64
N_Q_HEADS = D_MODEL // HEAD_DIM
N_KV_HEADS = N_Q_HEADS // 4
GQA_GROUP = N_Q_HEADS // N_KV_HEADS
WINDOW = 128
BLOCK = 128
REL_BUCKETS = 32
REL_MAX_DIST = 128
QKV_DIM = (N_Q_HEADS + 2 * N_KV_HEADS) * HEAD_DIM
CHUNK = 128
D_FFN_SG = 6 * D_MODEL
D_GATE = D_FFN_SG // 2
N_SG_GROUPS = 8
SG_GROUP_DIM = D_GATE // N_SG_GROUPS
N_KEYS = 128
N_EXPERTS = N_KEYS * N_KEYS
PEER_HEADS = 8
PEER_TOPK = 16
D_KEY = 256
D_HALF = D_KEY // 2
TOKEN_CHUNK = 128

NORM_EPS = 1e-6
LN_EPS = 1e-5
N_ATTN_LAYERS = (DEPTH + N_MIXERS - 1) // N_MIXERS
N_SG_LAYERS = DEPTH // N_MIXERS

kernel_name = "hybrid_swa_gmlp_peer_encoder"


def rms_norm(x, g):
    xf = x.astype(jnp.float32)
    y = xf * lax.rsqrt(jnp.mean(xf * xf, axis=-1, keepdims=True) + NORM_EPS)
    return (y * g.astype(jnp.float32)).astype(x.dtype)


def t5_bucket(rel):
    nb = REL_BUCKETS // 2
    max_exact = nb // 2
    ret = jnp.where(rel > 0, nb, 0)
    n = jnp.abs(rel)
    nf = jnp.maximum(n, 1).astype(jnp.float32)
    large = max_exact + (jnp.log(nf / max_exact) / math.log(REL_MAX_DIST / max_exact)
                         * (nb - max_exact)).astype(jnp.int32)
    large = jnp.minimum(large, nb - 1)
    return ret + jnp.where(n < max_exact, n, large)


def windowed_gqa_attention(h, w_in, w_out, sink, rel_table):
    B, S, _ = h.shape
    nb = S // BLOCK
    qkv = h @ w_in
    q, k, v = jnp.split(qkv, [N_Q_HEADS * HEAD_DIM, (N_Q_HEADS + N_KV_HEADS) * HEAD_DIM], axis=-1)
    q = q.reshape(B, nb, BLOCK, N_KV_HEADS, GQA_GROUP, HEAD_DIM) * (HEAD_DIM ** -0.5)
    k = k.reshape(B, S, N_KV_HEADS, HEAD_DIM)
    v = v.reshape(B, S, N_KV_HEADS, HEAD_DIM)
    pad = ((0, 0), (BLOCK, BLOCK), (0, 0), (0, 0))
    kp = jnp.pad(k, pad).reshape(B, nb + 2, BLOCK, N_KV_HEADS, HEAD_DIM)
    vp = jnp.pad(v, pad).reshape(B, nb + 2, BLOCK, N_KV_HEADS, HEAD_DIM)

    def band(t):
        return jnp.concatenate([t[:, :-2], t[:, 1:-1], t[:, 2:]], axis=2)

    kb, vb = band(kp), band(vp)
    qi = jnp.arange(BLOCK)[:, None]
    kj = jnp.arange(3 * BLOCK)[None, :]
    rel = kj - BLOCK - qi
    bias = rel_table[t5_bucket(rel)]
    bias = bias.astype(jnp.float32).transpose(2, 0, 1).reshape(N_KV_HEADS, GQA_GROUP, BLOCK, 3 * BLOCK)
    key_pos = (jnp.arange(nb)[:, None] - 1) * BLOCK + jnp.arange(3 * BLOCK)[None, :]
    valid = (jnp.abs(rel) <= WINDOW)[None] & ((key_pos >= 0) & (key_pos < S))[:, None, :]
    sink_f = sink.astype(jnp.float32).reshape(N_KV_HEADS, GQA_GROUP, 1, 1)

    def attend(args):
        qb, kb_, vb_, m = args
        s = jnp.einsum('bqhgd,bkhd->bhgqk', qb, kb_).astype(jnp.float32) + bias
        s = jnp.where(m, s, -jnp.inf)
        mx = jnp.maximum(jnp.max(s, axis=-1, keepdims=True), sink_f)
        p = jnp.exp(s - mx)
        denom = jnp.sum(p, axis=-1, keepdims=True) + jnp.exp(sink_f - mx)
        p = (p / denom).astype(vb_.dtype)
        return jnp.einsum('bhgqk,bkhd->bqhgd', p, vb_)

    out = lax.map(attend, (q.transpose(1, 0, 2, 3, 4, 5), kb.transpose(1, 0, 2, 3, 4),
                           vb.transpose(1, 0, 2, 3, 4), valid))
    out = out.transpose(1, 0, 2, 3, 4, 5).reshape(B, S, N_Q_HEADS * HEAD_DIM)
    return out @ w_out


def chunked_spatial_gating(h, w_in, ln_g, ln_b, w_sp, b_sp, w_out):
    B, S, _ = h.shape
    nc = S // CHUNK
    z = jax.nn.gelu(h @ w_in)
    u, v = jnp.split(z, 2, axis=-1)
    vf = v.astype(jnp.float32)
    mu = jnp.mean(vf, axis=-1, keepdims=True)
    var = jnp.mean(jnp.square(vf - mu), axis=-1, keepdims=True)
    v = ((vf - mu) * lax.rsqrt(var + LN_EPS) * ln_g.astype(jnp.float32)
         + ln_b.astype(jnp.float32)).astype(h.dtype)
    v = v.reshape(B, nc, CHUNK, N_SG_GROUPS, SG_GROUP_DIM)
    mixed = jnp.einsum('gpq,bcqgd->bcpgd', w_sp, v) + b_sp.T[None, None, :, :, None]
    gated = u * mixed.reshape(B, S, D_GATE)
    return gated @ w_out


def peer(h, w_query, sub_keys, expert_down, expert_up):
    B, S, D = h.shape
    T = B * S
    x = h.reshape(T, D)
    q = (x @ w_query).reshape(T, PEER_HEADS, 2, D_HALF)
    s = jnp.einsum('thcd,hckd->thck', q, sub_keys).astype(jnp.float32)
    s1, i1 = lax.top_k(s[:, :, 0], PEER_TOPK)
    s2, i2 = lax.top_k(s[:, :, 1], PEER_TOPK)
    cand = (s1[..., :, None] + s2[..., None, :]).reshape(T, PEER_HEADS, PEER_TOPK * PEER_TOPK)
    cidx = (i1[..., :, None] * N_KEYS + i2[..., None, :]).reshape(T, PEER_HEADS, PEER_TOPK * PEER_TOPK)
    top_s, pos = lax.top_k(cand, PEER_TOPK)
    idx = jnp.take_along_axis(cidx, pos, axis=-1)
    gate = jax.nn.softmax(top_s, axis=-1).astype(h.dtype)
    nch = T // TOKEN_CHUNK

    def experts(args):
        xc, ic, gc = args
        a = jax.nn.gelu(jnp.einsum('cd,chkd->chk', xc, expert_down[ic]))
        return jnp.einsum('chk,chkd->cd', a * gc, expert_up[ic])

    y = lax.map(experts, (x.reshape(nch, TOKEN_CHUNK, D),
                          idx.reshape(nch, TOKEN_CHUNK, PEER_HEADS, PEER_TOPK),
                          gate.reshape(nch, TOKEN_CHUNK, PEER_HEADS, PEER_TOPK)))
    return y.reshape(B, S, D)


def setup_inputs(seed: int = 0) -> dict:
    key = jax.random.key(seed)
    ks = jax.random.split(key, 20)
    nrm = jax.random.normal
    f32 = jnp.float32
    return {
        "x": nrm(ks[0], (BATCH, SEQ, D_MODEL), f32),
        "rel_table": 0.5 * nrm(ks[1], (REL_BUCKETS, N_Q_HEADS), f32),
        "mix_norm_g": 1.0 + 0.05 * nrm(ks[2], (DEPTH, D_MODEL), f32),
        "attn_w_in": nrm(ks[3], (N_ATTN_LAYERS, D_MODEL, QKV_DIM), f32) * D_MODEL ** -0.5,
        "attn_w_out": nrm(ks[4], (N_ATTN_LAYERS, N_Q_HEADS * HEAD_DIM, D_MODEL), f32) * (N_Q_HEADS * HEAD_DIM) ** -0.5,
        "attn_sink": 0.5 * nrm(ks[5], (N_ATTN_LAYERS, N_Q_HEADS), f32),
        "sg_w_in": nrm(ks[6], (N_SG_LAYERS, D_MODEL, D_FFN_SG), f32) * D_MODEL ** -0.5,
        "sg_ln_g": 1.0 + 0.05 * nrm(ks[7], (N_SG_LAYERS, D_GATE), f32),
        "sg_ln_b": 0.02 * nrm(ks[8], (N_SG_LAYERS, D_GATE), f32),
        "sg_w_spatial": nrm(ks[9], (N_SG_LAYERS, N_SG_GROUPS, CHUNK, CHUNK), f32) * CHUNK ** -0.5,
        "sg_b_spatial": 1.0 + 0.02 * nrm(ks[10], (N_SG_LAYERS, N_SG_GROUPS, CHUNK), f32),
        "sg_w_out": nrm(ks[11], (N_SG_LAYERS, D_GATE, D_MODEL), f32) * D_GATE ** -0.5,
        "ffn_norm_g": 1.0 + 0.05 * nrm(ks[12], (DEPTH, D_MODEL), f32),
        "peer_w_query": nrm(ks[13], (DEPTH, D_MODEL, PEER_HEADS * D_KEY), f32) * D_MODEL ** -0.5,
        "peer_sub_keys": nrm(ks[14], (DEPTH, PEER_HEADS, 2, N_KEYS, D_HALF), f32) * D_HALF ** -0.5,
        "peer_down": nrm(ks[15], (DEPTH, N_EXPERTS, D_MODEL), f32) * D_MODEL ** -0.5,
        "peer_up": nrm(ks[16], (DEPTH, N_EXPERTS, D_MODEL), f32) * PEER_HEADS ** -0.5,
        "final_norm_g": 1.0 + 0.05 * nrm(ks[17], (D_MODEL,), f32),
    }


def reference(x, rel_table, mix_norm_g, attn_w_in, attn_w_out, attn_sink, sg_w_in, sg_ln_g,
              sg_ln_b, sg_w_spatial, sg_b_spatial, sg_w_out, ffn_norm_g, peer_w_query,
              peer_sub_keys, peer_down, peer_up, final_norm_g):
    h = x
    for i in range(DEPTH):
        j = i // N_MIXERS
        hn = rms_norm(h, mix_norm_g[i])
        if i % N_MIXERS == 0:
            h = h + windowed_gqa_attention(hn, attn_w_in[j], attn_w_out[j], attn_sink[j], rel_table)
        else:
            h = h + chunked_spatial_gating(hn, sg_w_in[j], sg_ln_g[j], sg_ln_b[j],
                                           sg_w_spatial[j], sg_b_spatial[j], sg_w_out[j])
        h = h + peer(rms_norm(h, ffn_norm_g[i]), peer_w_query[i], peer_sub_keys[i],
                     peer_down[i], peer_up[i])
    return rms_norm(h, final_norm_g)
```

```cpp
#include <hip/hip_runtime.h>
#include <cstdio>

#ifndef MK_ONE_LAUNCH
#define MK_ONE_LAUNCH 1
#endif

#define LAS __attribute__((address_space(3)))
#define GAS __attribute__((address_space(1)))
typedef unsigned short bf16_t;
typedef short bf16x8 __attribute__((ext_vector_type(8)));
typedef float f32x4 __attribute__((ext_vector_type(4)));
typedef float f32x2 __attribute__((ext_vector_type(2)));
typedef unsigned u32x4 __attribute__((ext_vector_type(4)));
typedef unsigned u32x2 __attribute__((ext_vector_type(2)));
typedef int i32x8 __attribute__((ext_vector_type(8)));
typedef int i32x2 __attribute__((ext_vector_type(2)));
typedef int i32x4 __attribute__((ext_vector_type(4)));

constexpr int T = 32768, D = 1024, SEQ = 2048;
constexpr int DG = 3072;
constexpr int NQK = 1280;
constexpr int NPH = 22;

constexpr size_t MiB = 1u << 20;
constexpr size_t WS_CTL = 0, CTL_ZERO_BYTES = 1 * MiB;
constexpr size_t WS_BIAS = 1 * MiB;
constexpr size_t WS_WQK = 2 * MiB;
constexpr size_t WS_WV = WS_WQK + (size_t)1280 * 1024 * 2;
constexpr size_t WS_WO = 5 * MiB;
constexpr size_t WS_WSGV = 7 * MiB;
constexpr size_t WS_WSGU = 13 * MiB;
constexpr size_t WS_WSGO = 19 * MiB;
constexpr size_t WS_WQKP = 25 * MiB;
constexpr size_t WS_HN = 34 * MiB;
constexpr size_t WS_SCL = 1 * MiB + 64 * 1024;
constexpr size_t WS_TAB = 98 * MiB;
constexpr size_t WS_IDX = 162 * MiB;
constexpr size_t WS_GATE = 178 * MiB;
constexpr size_t WS_SCR = 194 * MiB;
constexpr size_t WS_Q = WS_SCR, WS_K = WS_SCR + 64 * MiB, WS_VT = WS_SCR + 80 * MiB, WS_AO = WS_SCR + 96 * MiB;
constexpr size_t WS_S = WS_SCR;
constexpr size_t WS_SG = WS_SCR;
constexpr size_t WS_PART = WS_SCR;
constexpr size_t WS_AB = WS_SCR + 128 * MiB;
constexpr size_t WS_HN8 = WS_SCR + 200 * MiB;
constexpr size_t WS_END = WS_SCR + 298 * MiB;
constexpr int CW_BAR = 4096;
constexpr int CW_COLMAX = 16384;
constexpr int CW_WSCL = 32768;
constexpr int CW_COLMAX2 = 20480;
constexpr int CW_WSCL2 = 40960;
constexpr size_t WS_SGW8 = WS_SCR + 292 * MiB;
constexpr size_t WS_WQ8 = WS_SCR + 288 * MiB;
constexpr size_t WS_HNI8 = 34 * MiB;
constexpr size_t WS_HSC = 34 * MiB + 32 * MiB;
constexpr size_t WS_H2 = WS_SCR + 32 * MiB;
constexpr float AO8_SCALE = 8.0f;
constexpr float W8_SCALE = 256.0f;
constexpr size_t WS_HN8B = WS_IDX;
constexpr size_t WS_SG8 = WS_SCR + 192 * MiB;

constexpr int LDS_BYTES = 163840;
constexpr int MISC_OFF = LDS_BYTES - 256;

typedef __bf16 bfx2 __attribute__((ext_vector_type(2)));
__device__ __forceinline__ unsigned pk2(float lo, float hi) { const bfx2 v = {(__bf16)lo, (__bf16)hi}; return __builtin_bit_cast(unsigned, v); }
__device__ __forceinline__ unsigned f2bf(float f) { return pk2(f, 0.f) & 0xffffu; }
typedef _Float16 h16x2 __attribute__((ext_vector_type(2)));
__device__ __forceinline__ unsigned pkh2(float lo, float hi) { const h16x2 h = {(_Float16)lo, (_Float16)hi}; return __builtin_bit_cast(unsigned, h); }
__device__ __forceinline__ float hlo(unsigned w) { return (float)__builtin_bit_cast(h16x2, w).x; }
__device__ __forceinline__ float hhi(unsigned w) { return (float)__builtin_bit_cast(h16x2, w).y; }
__device__ __forceinline__ float bflo(unsigned w) { return __builtin_bit_cast(float, w << 16); }
__device__ __forceinline__ float bfhi(unsigned w) { return __builtin_bit_cast(float, w & 0xffff0000u); }
__device__ __forceinline__ float bf2f(bf16_t b) { return __builtin_bit_cast(float, ((unsigned)b) << 16); }
__device__ __forceinline__ float wave_sum(float v) {
#pragma unroll
    for (int o = 1; o < 64; o <<= 1) v += __shfl_xor(v, o);
    return v;
}
__device__ __forceinline__ float wave_max(float v) {
#pragma unroll
    for (int o = 1; o < 64; o <<= 1) v = fmaxf(v, __shfl_xor(v, o));
    return v;
}
__device__ __forceinline__ unsigned wave_max_u(unsigned v) {
#pragma unroll
    for (int o = 1; o < 64; o <<= 1) { const unsigned w = (unsigned)__shfl_xor((int)v, o); v = w > v ? w : v; }
    return v;
}
__device__ __forceinline__ float gelu_tanh(float x) {
    const float u = x * (-2.302208198144325f) * (1.0f + 0.044715f * x * x);
    return x * __builtin_amdgcn_rcpf(1.0f + __builtin_amdgcn_exp2f(u));
}
#define LDS_WAIT() asm volatile("s_waitcnt lgkmcnt(0)" ::: "memory")
#define VM_WAIT() asm volatile("s_waitcnt vmcnt(0)" ::: "memory")

namespace pg8 {
#define PG8_LAS __attribute__((address_space(3)))
constexpr int BM = 256, BK = 64, HALF = 128, HTB = HALF * BK * 2, STAGE_BYTES = 8 * HTB, NXCD = 8, WGM = 8;
__host__ __device__ __forceinline__ int lds_byte(int r, int c) { const int st = (r >> 4) * 2 + (c >> 5), rr = r & 15, cc = c & 31, ob = rr * 64 + cc * 2; return st * 1024 + (ob ^ (((ob >> 9) & 1) << 5)); }
__host__ __device__ __forceinline__ void stage_rc(int b, int& R, int& C) { const int st = b / 1024, sb = b % 1024, swz = sb ^ (((sb >> 9) & 1) << 5); R = (st >> 1) * 16 + swz / 64; C = (st & 1) * 32 + (swz % 64) / 2; }
__host__ __device__ __forceinline__ int perm32(int rho) { const int n = rho >> 4, i = rho & 15; return 8 * (i >> 2) + 4 * n + (i & 3); }
struct Unit { int pm, pn; };
struct Gemm { const bf16_t* A; const bf16_t* Bt; int M, N, K; };
struct StaticOrder {
    int nM, nN, nwg, G, c;
    __host__ __device__ void init(int M, int N, int G_, int c_) { nM = M / BM; nN = N / BM; nwg = nM * nN; G = G_; c = c_; }
    __host__ __device__ bool next(int i, Unit& u) const {
        const long L = (long)i * G + c; if (L >= nwg) return false;
        int wgid = (int)L; { const int q = nwg / NXCD, r = nwg % NXCD, xcd = wgid % NXCD, off = wgid / NXCD; wgid = (xcd < r ? xcd * (q + 1) : r * (q + 1) + (xcd - r) * q) + off; }
        const int nig = WGM * nN, gid = wgid / nig, fm = gid * WGM, gsz = (nM - fm) < WGM ? (nM - fm) : WGM;
        u.pm = fm + ((wgid % nig) % gsz); u.pn = (wgid % nig) / gsz; return true;
    }
    __device__ __forceinline__ void a_ready(const Unit&) const {}
    __device__ __forceinline__ void done(const Unit&) const {}
};

template <int MODE, bool I8 = false> struct EpiBf {
    static constexpr bool PERM = true, AFTER_DRAIN = false;
    bf16_t* O; int ldc; bf16_t* O2; float sc = 1.0f; const float* rsc = nullptr; const float* csc = nullptr;
    __device__ __forceinline__ void operator()(const f32x4 (&acc)[2][2][4][2], const Unit& u, int wr, int wc, int fr, int fq) const {
        const int row0 = u.pm * BM + wr * 64 + fr; int colt = u.pn * BM; bf16_t* base = O; int ld = ldc;
        if (MODE == 3) { if (u.pn >= 4) { base = O2; ld = 256; colt = 0; } else { ld = 1024; } }
        const int col0 = colt + wc * 32 + 8 * fq;
#pragma unroll
        for (int ai = 0; ai < 2; ++ai)
#pragma unroll
            for (int m = 0; m < 4; ++m) { bf16_t* rowp = base + (size_t)(row0 + ai * HALF + m * 16) * ld + col0;
#pragma unroll
                for (int bj = 0; bj < 2; ++bj) { f32x4 v0 = acc[ai][bj][m][0], v1 = acc[ai][bj][m][1];
                    if (I8) { const float rs = rsc[row0 + ai * HALF + m * 16]; const f32x4* cp = (const f32x4*)(csc + col0 + bj * HALF); const f32x4 c0 = cp[0] * rs, c1 = cp[1] * rs;
                        const i32x4 i0 = __builtin_bit_cast(i32x4, v0), i1 = __builtin_bit_cast(i32x4, v1);
                        v0 = (f32x4){(float)i0.x, (float)i0.y, (float)i0.z, (float)i0.w} * c0; v1 = (f32x4){(float)i1.x, (float)i1.y, (float)i1.z, (float)i1.w} * c1; }
                    if (MODE == 0 || MODE == 3) {
#pragma unroll
                        for (int j = 0; j < 4; ++j) { v0[j] *= sc; v1[j] *= sc; } }
                    if (MODE == 6) { const f32x4* xp = (const f32x4*)((const float*)O2 + (size_t)(row0 + ai * HALF + m * 16) * ld + col0 + bj * HALF); v0 = xp[0] + v0 * sc; v1 = xp[1] + v1 * sc; }
                    if (MODE == 7) { const u32x4 hv = *(const u32x4*)(rowp + bj * HALF);
                        v0[0] = bflo(hv.x) + v0[0] * sc; v0[1] = bfhi(hv.x) + v0[1] * sc; v0[2] = bflo(hv.y) + v0[2] * sc; v0[3] = bfhi(hv.y) + v0[3] * sc;
                        v1[0] = bflo(hv.z) + v1[0] * sc; v1[1] = bfhi(hv.z) + v1[1] * sc; v1[2] = bflo(hv.w) + v1[2] * sc; v1[3] = bfhi(hv.w) + v1[3] * sc; }
                    if (MODE == 1 || MODE == 2 || MODE == 5) {
#pragma unroll
                        for (int j = 0; j < 4; ++j) { v0[j] = gelu_tanh(v0[j] * sc); v1[j] = gelu_tanh(v1[j] * sc); } }
                    if (MODE == 2 || MODE == 5) { const u32x4 mv = *(const u32x4*)(rowp + bj * HALF);
                        v0[0] *= bflo(mv.x); v0[1] *= bfhi(mv.x); v0[2] *= bflo(mv.y); v0[3] *= bfhi(mv.y);
                        v1[0] *= bflo(mv.z); v1[1] *= bfhi(mv.z); v1[2] *= bflo(mv.w); v1[3] *= bfhi(mv.w); }
                    if (MODE == 5) { int w0 = 0, w1 = 0;
                        w0 = __builtin_amdgcn_cvt_pk_fp8_f32(v0[0], v0[1], w0, false); w0 = __builtin_amdgcn_cvt_pk_fp8_f32(v0[2], v0[3], w0, true);
                        w1 = __builtin_amdgcn_cvt_pk_fp8_f32(v1[0], v1[1], w1, false); w1 = __builtin_amdgcn_cvt_pk_fp8_f32(v1[2], v1[3], w1, true);
                        *(u32x2*)((unsigned char*)O2 + (size_t)(row0 + ai * HALF + m * 16) * ld + col0 + bj * HALF) = (u32x2){(unsigned)w0, (unsigned)w1}; continue; }
                    u32x4 w;
                    if (MODE == 4) { w.x = pkh2(v0[0], v0[1]); w.y = pkh2(v0[2], v0[3]); w.z = pkh2(v1[0], v1[1]); w.w = pkh2(v1[2], v1[3]); }
                    else { w.x = pk2(v0[0], v0[1]); w.y = pk2(v0[2], v0[3]); w.z = pk2(v1[0], v1[1]); w.w = pk2(v1[2], v1[3]); }
                    *(u32x4*)(rowp + bj * HALF) = w; } }
    }
};
template <int MODE> struct EpiF32 {
    static constexpr bool PERM = false, AFTER_DRAIN = false;
    float* C; int ldc; const float* B; float sc = 1.0f;
    __device__ __forceinline__ void operator()(const f32x4 (&acc)[2][2][4][2], const Unit& u, int wr, int wc, int fr, int fq) const {
        const int row0 = u.pm * BM + wr * 64 + fr, col0 = u.pn * BM + wc * 32 + 4 * fq;
#pragma unroll
        for (int ai = 0; ai < 2; ++ai)
#pragma unroll
            for (int m = 0; m < 4; ++m) { float* rowp = C + (size_t)(row0 + ai * HALF + m * 16) * ldc + col0;
#pragma unroll
                for (int bj = 0; bj < 2; ++bj)
#pragma unroll
                    for (int n = 0; n < 2; ++n) { f32x4* p = (f32x4*)(rowp + bj * HALF + n * 16);
                        if (MODE == 1) *p = *p + acc[ai][bj][m][n] * sc;
                        else if (MODE == 2) *p = *(const f32x4*)(B + (p - (f32x4*)C) * 4) + acc[ai][bj][m][n] * sc;
                        else *p = acc[ai][bj][m][n]; } }
    }
};

template <int F8 = 0, class Epi, class Sched>
__device__ __forceinline__ void gemm_phase(PG8_LAS unsigned char* lds, const Gemm g, const Sched& S, const Epi& E) {
    const int tid = threadIdx.x, wid = __builtin_amdgcn_readfirstlane(tid >> 6), lane = tid & 63, wr = wid >> 2, wc = wid & 3, fr = lane & 15, fq = lane >> 4;
    const int K = g.K, nt = K / BK;
    unsigned voffA[2], voffB[2];
#pragma unroll
    for (int i = 0; i < 2; ++i) { int R, C; stage_rc(tid * 16 + i * 8192, R, C); const int Rb = Epi::PERM ? ((R & ~31) + perm32(R & 31)) : R;
        voffA[i] = (unsigned)(R * K + C) * 2u; voffB[i] = (unsigned)(Rb * K + C) * 2u; }
    const size_t kstep = (size_t)(BK * 2);
    const size_t hstep = (size_t)HALF * K * 2;
    const size_t tstep = 2 * hstep;
    const unsigned ldsw = (unsigned)wid * 1024u;
    const int aoff = lds_byte(wr * 64 + fr, fq * 8), boff = lds_byte(wc * 32 + fr, fq * 8);
#define PG8_SA(b, h) (((b) * 2 + (h)) * HTB)
#define PG8_SB(b, h) ((4 + (b) * 2 + (h)) * HTB)
#define PG8_STAGE(bufoff, gbase, voff) do { const char* gb_ = (const char*)(gbase); asm volatile("" : "+s"(gb_));        \
        _Pragma("unroll") for (int _i = 0; _i < 2; ++_i) { unsigned vo_ = (voff)[_i]; asm volatile("" : "+v"(vo_)); \
        __builtin_amdgcn_global_load_lds((const unsigned*)(gb_ + vo_), (PG8_LAS unsigned*)(lds + (bufoff) + ldsw + _i * 8192), 16, 0, 0); } } while (0)
#define PG8_LD8(dst8, cbase_, voff_, cnt_) do { unsigned o_ = (unsigned)(voff_); asm volatile("" : "+v"(o_));        \
        _Pragma("unroll") for (int i_ = 0; i_ < cnt_; ++i_) { const i32x4 lo_ = *(const PG8_LAS i32x4*)(lds + (cbase_) + o_ + i_ * 2048), hi_ = *(const PG8_LAS i32x4*)(lds + (cbase_) + o_ + i_ * 2048 + 1024); \
        dst8[i_] = (i32x8){lo_.x, lo_.y, lo_.z, lo_.w, hi_.x, hi_.y, hi_.z, hi_.w}; } } while (0)
#define PG8_LDA(dst, b, h) do { if (F8 == 1) PG8_LD8(Ah8, PG8_SA(b, h), aoff, 2); else { _Pragma("unroll") for (int m = 0; m < 4; ++m) _Pragma("unroll") for (int k = 0; k < 2; ++k) dst[m][k] = *(const PG8_LAS bf16x8*)(lds + PG8_SA(b, h) + aoff + m * 2048 + k * 1024); } } while (0)
#define PG8_LDB(dst, b, h) do { if (F8 == 1) PG8_LD8(dst##8, PG8_SB(b, h), boff, 2); else { _Pragma("unroll") for (int n = 0; n < 2; ++n) _Pragma("unroll") for (int k = 0; k < 2; ++k) dst[n][k] = *(const PG8_LAS bf16x8*)(lds + PG8_SB(b, h) + boff + n * 2048 + k * 1024); } } while (0)
#define PG8_MM8(ai, bj, mm, Bt, Ax) do { _Pragma("unroll") for (int n = 0; n < 2; ++n) { \
        acc[ai][bj][mm][n] = __builtin_amdgcn_mfma_scale_f32_16x16x128_f8f6f4(Bt##8[n], Ax[0], acc[ai][bj][mm][n], 0, 0, 0, 0, 0, 0); \
        acc[ai][bj][(mm) + 1][n] = __builtin_amdgcn_mfma_scale_f32_16x16x128_f8f6f4(Bt##8[n], Ax[1], acc[ai][bj][(mm) + 1][n], 0, 0, 0, 0, 0, 0); } } while (0)
#define PG8_MMA(ai, bj, At, Bt, bb) do { __builtin_amdgcn_s_setprio(1); \
        if (F8 == 1) { if ((bj) == 0) { PG8_SCHED; PG8_LD8(Bh8, PG8_SA(bb, ai) + 2 * 2048, aoff, 2); PG8_SCHED; PG8_MM8(ai, bj, 0, Bt, Ah8); PG8_SCHED; PG8_MM8(ai, bj, 2, Bt, Bh8); } \
                  else { PG8_MM8(ai, bj, 0, Bt, Ah8); PG8_MM8(ai, bj, 2, Bt, Bh8); } } \
        else if (F8 == 2) { _Pragma("unroll") for (int m = 0; m < 4; ++m) _Pragma("unroll") for (int n = 0; n < 2; ++n) _Pragma("unroll") for (int k = 0; k < 2; ++k) \
            acc[ai][bj][m][n] = __builtin_bit_cast(f32x4, __builtin_amdgcn_mfma_i32_16x16x64_i8(__builtin_bit_cast(i32x4, Bt[n][k]), __builtin_bit_cast(i32x4, At[m][k]), __builtin_bit_cast(i32x4, acc[ai][bj][m][n]), 0, 0, 0)); } \
        else { _Pragma("unroll") for (int m = 0; m < 4; ++m) _Pragma("unroll") for (int n = 0; n < 2; ++n) _Pragma("unroll") for (int k = 0; k < 2; ++k) \
            acc[ai][bj][m][n] = __builtin_amdgcn_mfma_f32_16x16x32_bf16(Bt[n][k], At[m][k], acc[ai][bj][m][n], 0, 0, 0); } \
        __builtin_amdgcn_s_setprio(0); } while (0)
#define PG8_WAIT_V(n) asm volatile("s_waitcnt vmcnt(" #n ")" ::: "memory")
#define PG8_WAIT_L(n) asm volatile("s_waitcnt lgkmcnt(" #n ")" ::: "memory")
#define PG8_BAR __builtin_amdgcn_s_barrier()
#define PG8_SCHED __builtin_amdgcn_sched_barrier(0)
    Unit cur, nxt; int ui = 0;
    if (!S.next(0, cur)) return;
    f32x4 acc[2][2][4][2];
#pragma unroll
    for (int a = 0; a < 2; ++a)
#pragma unroll
        for (int b = 0; b < 2; ++b)
#pragma unroll
            for (int m = 0; m < 4; ++m)
#pragma unroll
                for (int n = 0; n < 2; ++n) acc[a][b][m][n] = (f32x4){0.f, 0.f, 0.f, 0.f};
    bf16x8 At[4][2], B0[2][2], B1[2][2]; i32x8 Ah8[2], Bh8[2], B08[2], B18[2];
    const char* cA = (const char*)g.A + (size_t)cur.pm * tstep; const char* cB = (const char*)g.Bt + (size_t)cur.pn * tstep;
    S.a_ready(cur);
    PG8_STAGE(PG8_SB(0, 0), cB, voffB); PG8_STAGE(PG8_SA(0, 0), cA, voffA); PG8_STAGE(PG8_SB(0, 1), cB + hstep, voffB); PG8_STAGE(PG8_SA(0, 1), cA + hstep, voffA);
    if (wr == 1) PG8_BAR;
    PG8_WAIT_V(4); PG8_BAR;
    PG8_STAGE(PG8_SB(1, 0), cB + kstep, voffB); PG8_STAGE(PG8_SA(1, 0), cA + kstep, voffA); PG8_STAGE(PG8_SB(1, 1), cB + hstep + kstep, voffB);
    PG8_WAIT_V(6); PG8_BAR;
    for (;;) {
        const bool has_next = S.next(ui + 1, nxt);
        const char* nA = has_next ? (const char*)g.A + (size_t)nxt.pm * tstep : cA; const char* nB = has_next ? (const char*)g.Bt + (size_t)nxt.pn * tstep : cB;
        for (int t = 0; t < nt; t += 2) {
            const bool last = (t == nt - 2);
            const char* a1 = cA + (size_t)(t + 1) * kstep;
            const char* a2 = last ? nA : cA + (size_t)(t + 2) * kstep; const char* b2 = last ? nB : cB + (size_t)(t + 2) * kstep;
            const char* a3 = a2 + kstep; const char* b3 = b2 + kstep;
            if (last && has_next) S.a_ready(nxt);
            PG8_LDB(B0, 0, 0); PG8_SCHED; PG8_LDA(At, 0, 0); PG8_STAGE(PG8_SA(1, 1), a1 + hstep, voffA);
            PG8_WAIT_L(8); PG8_BAR; PG8_WAIT_L(0); PG8_MMA(0, 0, At, B0, 0); PG8_BAR; PG8_SCHED;
            PG8_LDB(B1, 0, 1); PG8_STAGE(PG8_SB(0, 0), b2, voffB);
            PG8_BAR; PG8_WAIT_L(0); PG8_MMA(0, 1, At, B1, 0); PG8_BAR; if (F8 == 1) PG8_SCHED;
            PG8_LDA(At, 0, 1); PG8_STAGE(PG8_SA(0, 0), a2, voffA);
            PG8_BAR; PG8_WAIT_L(0); PG8_MMA(1, 0, At, B0, 0); PG8_BAR; PG8_SCHED;
            PG8_STAGE(PG8_SB(0, 1), b2 + hstep, voffB);
            PG8_WAIT_V(6); PG8_BAR; PG8_MMA(1, 1, At, B1, 0); PG8_BAR; if (F8 == 1) PG8_SCHED;
            PG8_LDB(B0, 1, 0); PG8_SCHED; PG8_LDA(At, 1, 0); PG8_STAGE(PG8_SA(0, 1), a2 + hstep, voffA);
            PG8_WAIT_L(8); PG8_BAR; PG8_WAIT_L(0); PG8_MMA(0, 0, At, B0, 1); PG8_BAR; PG8_SCHED;
            PG8_LDB(B1, 1, 1); PG8_STAGE(PG8_SB(1, 0), b3, voffB);
            PG8_BAR; PG8_WAIT_L(0); PG8_MMA(0, 1, At, B1, 1); PG8_BAR; if (F8 == 1) PG8_SCHED;
            PG8_LDA(At, 1, 1); PG8_STAGE(PG8_SA(1, 0), a3, voffA);
            PG8_BAR; PG8_WAIT_L(0); PG8_MMA(1, 0, At, B0, 1); PG8_BAR; PG8_SCHED;
            PG8_STAGE(PG8_SB(1, 1), b3 + hstep, voffB);
            PG8_WAIT_V(6); PG8_BAR; PG8_MMA(1, 1, At, B1, 1); PG8_BAR; if (F8 == 1) PG8_SCHED;
        }
        { int fr_ = fr, fq_ = fq; asm volatile("" : "+v"(fr_), "+v"(fq_));
          E(acc, cur, wr, wc, fr_, fq_); } S.done(cur);
        if (!has_next) break;
#pragma unroll
        for (int a = 0; a < 2; ++a)
#pragma unroll
            for (int b = 0; b < 2; ++b)
#pragma unroll
                for (int m = 0; m < 4; ++m)
#pragma unroll
                    for (int n = 0; n < 2; ++n) acc[a][b][m][n] = (f32x4){0.f, 0.f, 0.f, 0.f};
        cur = nxt; cA = nA; cB = nB; ++ui;
    }
    PG8_WAIT_V(0);
    if (wr == 0) PG8_BAR;
    PG8_BAR;
#undef PG8_SA
#undef PG8_SB
#undef PG8_STAGE
#undef PG8_LDA
#undef PG8_LDB
#undef PG8_MMA
#undef PG8_LD8
#undef PG8_MM8
#undef PG8_WAIT_V
#undef PG8_WAIT_L
#undef PG8_BAR
#undef PG8_SCHED
}
}

#define XB_TMO      128
#define XB_XCNT(j)  (256  + 64 * (j))
#define XB_XSUB(j)  (1280 + 64 * (j))
#define XB_XGEN(j)  (2304 + 64 * (j))
#define XB_TOP      3328
#define XB_TOPGEN   3392
#define XCD_BAR_WORDS 3456
#define XB_SPIN_CAP (1u << 18)
__device__ __forceinline__ unsigned xb_ld(unsigned* p)              { return __hip_atomic_load(p, __ATOMIC_RELAXED, __HIP_MEMORY_SCOPE_AGENT); }
__device__ __forceinline__ unsigned xb_add(unsigned* p, unsigned v) { return __hip_atomic_fetch_add(p, v, __ATOMIC_RELAXED, __HIP_MEMORY_SCOPE_AGENT); }
__device__ __forceinline__ unsigned xb_xcc_id() { return (unsigned)__builtin_amdgcn_s_getreg((3 << 11) | 20) & 0xFu; }
#define XB_SPIN(cond, bar) do { unsigned _sp = 0; while (cond) { __builtin_amdgcn_s_sleep(1); \
    if ((++_sp & 255u) == 0u) { if (xb_ld(&(bar)[XB_TMO])) break; if (_sp > XB_SPIN_CAP) { atomicAdd(&(bar)[XB_TMO], 1u); break; } } } } while (0)
struct XcdBarrier { unsigned* bar; unsigned x; volatile LAS unsigned* st; };
__device__ __forceinline__ XcdBarrier xcd_barrier_post(unsigned* bar, volatile LAS unsigned* st) {
    XcdBarrier b; b.bar = bar; b.x = xb_xcc_id(); b.st = st;
    if (threadIdx.x == 0) (void)xb_add(&bar[XB_XCNT(b.x)], 1u);
    return b;
}
__device__ __forceinline__ void xcd_barrier_complete(unsigned* bar, unsigned x, unsigned& nloc, unsigned& nx) {
    const unsigned G = gridDim.x * gridDim.y * gridDim.z;
    unsigned sum, cnt, mine, sp = 0u;
    for (;;) {
        sum = 0u; cnt = 0u; mine = 0u;
#pragma unroll
        for (unsigned j = 0; j < 16; ++j) { const unsigned c = xb_ld(&bar[XB_XCNT(j)]); sum += c; cnt += (c > 0u) ? 1u : 0u; mine = (j == x) ? c : mine; }
        if (sum == G) break;
        __builtin_amdgcn_s_sleep(1);
        if ((++sp & 255u) == 0u) { if (xb_ld(&bar[XB_TMO])) break; if (sp > XB_SPIN_CAP) { atomicAdd(&bar[XB_TMO], 1u); break; } }
    }
    nloc = mine > 0u ? mine : 1u; nx = cnt > 0u ? cnt : 1u;
}
__device__ __forceinline__ void xcd_barrier(const XcdBarrier& b) {
    asm volatile("s_waitcnt vmcnt(0)" ::: "memory");
    __syncthreads();
    if (threadIdx.x == 0) {
        unsigned* bar = b.bar;
        __builtin_amdgcn_s_waitcnt(0);
        unsigned nloc = b.st[0], nx = b.st[1];
        if (nloc == 0u) { xcd_barrier_complete(bar, b.x, nloc, nx); b.st[0] = nloc; b.st[1] = nx; }
        const unsigned old = xb_add(&bar[XB_XSUB(b.x)], 1u);
        const unsigned gen = old / nloc;
        if (old + 1u == (gen + 1u) * nloc) {
            __builtin_amdgcn_fence(__ATOMIC_RELEASE, "agent");
            asm volatile("s_waitcnt vmcnt(0)" ::: "memory");
            const unsigned og = xb_add(&bar[XB_TOP], 1u);
            const unsigned tg = og / nx;
            if (og + 1u == (tg + 1u) * nx) xb_add(&bar[XB_TOPGEN], 1u);
            else XB_SPIN(xb_ld(&bar[XB_TOPGEN]) == tg, bar);
            __builtin_amdgcn_fence(__ATOMIC_ACQUIRE, "agent");
            xb_add(&bar[XB_XGEN(b.x)], 1u);
            asm volatile("s_waitcnt vmcnt(0)" ::: "memory");
        } else {
            XB_SPIN(xb_ld(&bar[XB_XGEN(b.x)]) == gen, bar);
            __builtin_amdgcn_fence(__ATOMIC_ACQUIRE, "agent");
            asm volatile("s_waitcnt vmcnt(0)" ::: "memory");
        }
    }
    __syncthreads();
}

struct Args { const float* in[18]; float* out; unsigned char* ws; int ph_lo, ph_hi; };
struct Frame {
    LAS unsigned char* lds;
    int tid, lane, wave, G, gw, NGW;
    const float* const* in; float* out; unsigned char* ws;
};

__device__ __forceinline__ void transpose_item(const float* W, int ldw, int col0, bf16_t* WT, int K, int nblk, float scale, LAS float* scr, int item, int lane, bool f8 = false, unsigned* cmax = nullptr) {
    const int kb = item / nblk, nb = item % nblk, k0 = 64 * kb, n0 = 32 * nb;
#pragma unroll 8
    for (int i = 0; i < 32; ++i) { const int kk = 2 * i + (lane >> 5); scr[kk * 33 + (lane & 31)] = W[(size_t)(k0 + kk) * ldw + col0 + n0 + (lane & 31)]; }
    LDS_WAIT();
    const int c = lane & 7;
#pragma unroll
    for (int j = 0; j < 4; ++j) { const int n = (lane >> 3) + 8 * j; const LAS float* s = scr + (8 * c) * 33 + n;
        if (cmax) { float mx = 0.f;
#pragma unroll
            for (int i = 0; i < 8; ++i) mx = fmaxf(mx, fabsf(s[i * 33] * scale));
            mx = fmaxf(mx, __shfl_xor(mx, 1)); mx = fmaxf(mx, __shfl_xor(mx, 2)); mx = fmaxf(mx, __shfl_xor(mx, 4));
            if (c == 0) atomicMax(cmax + n0 + n, __builtin_bit_cast(unsigned, mx)); }
        if (f8) { int w0 = 0, w1 = 0;
            w0 = __builtin_amdgcn_cvt_pk_fp8_f32(s[0 * 33] * scale, s[1 * 33] * scale, w0, false); w0 = __builtin_amdgcn_cvt_pk_fp8_f32(s[2 * 33] * scale, s[3 * 33] * scale, w0, true);
            w1 = __builtin_amdgcn_cvt_pk_fp8_f32(s[4 * 33] * scale, s[5 * 33] * scale, w1, false); w1 = __builtin_amdgcn_cvt_pk_fp8_f32(s[6 * 33] * scale, s[7 * 33] * scale, w1, true);
            *(u32x2*)((unsigned char*)WT + (size_t)(n0 + n) * K + k0 + 8 * c) = (u32x2){(unsigned)w0, (unsigned)w1}; continue; }
        u32x4 o; o.x = pk2(s[0 * 33] * scale, s[1 * 33] * scale); o.y = pk2(s[2 * 33] * scale, s[3 * 33] * scale); o.z = pk2(s[4 * 33] * scale, s[5 * 33] * scale); o.w = pk2(s[6 * 33] * scale, s[7 * 33] * scale);
        *(u32x4*)(WT + (size_t)(n0 + n) * K + k0 + 8 * c) = o; }
    LDS_WAIT();
}
__device__ __forceinline__ void rmsnorm_rows(const Frame& F, const float* src, const float* g, bf16_t* dst, float* cpy, unsigned char* dst8 = nullptr) {
    const f32x4* gp = (const f32x4*)g + F.lane;
    f32x4 gv[4];
#pragma unroll
    for (int j = 0; j < 4; ++j) gv[j] = gp[64 * j];
    for (int m = F.gw; m < T; m += F.NGW) {
        const f32x4* xr = (const f32x4*)(src + (size_t)m * D) + F.lane;
        f32x4 v[4]; float s = 0.f;
#pragma unroll
        for (int j = 0; j < 4; ++j) { v[j] = xr[64 * j]; s += (v[j].x * v[j].x + v[j].y * v[j].y) + (v[j].z * v[j].z + v[j].w * v[j].w); }
        const float rstd = 1.0f / sqrtf(wave_sum(s) * (1.f / D) + 1e-6f);
        if (cpy) { f32x4* cr = (f32x4*)(cpy + (size_t)m * D) + F.lane;
#pragma unroll
            for (int j = 0; j < 4; ++j) cr[64 * j] = v[j]; }
        if (dst) { u32x2* o8 = (u32x2*)(dst + (size_t)m * D) + F.lane;
#pragma unroll
        for (int j = 0; j < 4; ++j) { u32x2 w; w.x = pk2(v[j].x * rstd * gv[j].x, v[j].y * rstd * gv[j].y); w.y = pk2(v[j].z * rstd * gv[j].z, v[j].w * rstd * gv[j].w); o8[64 * j] = w; } }
        if (dst8) { unsigned* o4 = (unsigned*)(dst8 + (size_t)m * D) + F.lane;
#pragma unroll
            for (int j = 0; j < 4; ++j) { int w = 0; w = __builtin_amdgcn_cvt_pk_fp8_f32(v[j].x * rstd * gv[j].x, v[j].y * rstd * gv[j].y, w, false); w = __builtin_amdgcn_cvt_pk_fp8_f32(v[j].z * rstd * gv[j].z, v[j].w * rstd * gv[j].w, w, true); o4[64 * j] = (unsigned)w; } }
    }
}
__device__ __forceinline__ void quant_rows(const Frame& F, const bf16_t* W, unsigned char* Q8, const unsigned* CM, float* WSCL, int nrows) {
    for (int r = F.gw; r < nrows; r += F.NGW) {
        const float cm = __builtin_bit_cast(float, __hip_atomic_load(CM + r, __ATOMIC_RELAXED, __HIP_MEMORY_SCOPE_AGENT));
        const float sc = cm > 0.f ? 127.0f / cm : 0.f;
        const u32x4* wp = (const u32x4*)(W + (size_t)r * 1024 + 16 * F.lane); const u32x4 a = wp[0], b = wp[1];
        const float v[16] = {bflo(a.x), bfhi(a.x), bflo(a.y), bfhi(a.y), bflo(a.z), bfhi(a.z), bflo(a.w), bfhi(a.w), bflo(b.x), bfhi(b.x), bflo(b.y), bfhi(b.y), bflo(b.z), bfhi(b.z), bflo(b.w), bfhi(b.w)};
        unsigned o[4];
#pragma unroll
        for (int j = 0; j < 4; ++j) { unsigned w = 0u;
#pragma unroll
            for (int e = 0; e < 4; ++e) { int q = (int)rintf(v[4 * j + e] * sc); q = q > 127 ? 127 : (q < -127 ? -127 : q); w |= ((unsigned)q & 255u) << (8 * e); }
            o[j] = w; }
        *(u32x4*)(Q8 + (size_t)r * 1024 + 16 * F.lane) = (u32x4){o[0], o[1], o[2], o[3]};
        if (F.lane == 0) WSCL[r] = cm * (1.0f / 127.0f);
    }
}
__device__ __forceinline__ void quant_weights(const Frame& F) {
    unsigned* ctl = (unsigned*)(F.ws + WS_CTL);
    quant_rows(F, (const bf16_t*)(F.ws + WS_WQKP), F.ws + WS_WQ8, ctl + CW_COLMAX, (float*)ctl + CW_WSCL, 4096);
    quant_rows(F, (const bf16_t*)(F.ws + WS_WSGV), F.ws + WS_SGW8, ctl + CW_COLMAX2, (float*)ctl + CW_WSCL2, 6144);
}
__device__ __forceinline__ void rmsnorm_rows_bf(const Frame& F, const bf16_t* src, const float* g, bf16_t* dst, unsigned char* dst8, unsigned char* dsti = nullptr, float* rowsc = nullptr) {
    const f32x4* gp = (const f32x4*)g + F.lane;
    f32x4 gv[4];
#pragma unroll
    for (int j = 0; j < 4; ++j) gv[j] = gp[64 * j];
    for (int m = F.gw; m < T; m += F.NGW) {
        const u32x2* xr = (const u32x2*)(src + (size_t)m * D) + F.lane;
        f32x4 v[4]; float s = 0.f;
#pragma unroll
        for (int j = 0; j < 4; ++j) { const u32x2 w = xr[64 * j]; v[j] = (f32x4){bflo(w.x), bfhi(w.x), bflo(w.y), bfhi(w.y)}; s += (v[j].x * v[j].x + v[j].y * v[j].y) + (v[j].z * v[j].z + v[j].w * v[j].w); }
        const float rstd = 1.0f / sqrtf(wave_sum(s) * (1.f / D) + 1e-6f);
        if (dst) { u32x2* o8 = (u32x2*)(dst + (size_t)m * D) + F.lane;
#pragma unroll
        for (int j = 0; j < 4; ++j) { u32x2 w; w.x = pk2(v[j].x * rstd * gv[j].x, v[j].y * rstd * gv[j].y); w.y = pk2(v[j].z * rstd * gv[j].z, v[j].w * rstd * gv[j].w); o8[64 * j] = w; } }
        if (dst8) { unsigned* o4 = (unsigned*)(dst8 + (size_t)m * D) + F.lane;
#pragma unroll
            for (int j = 0; j < 4; ++j) { int w = 0; w = __builtin_amdgcn_cvt_pk_fp8_f32(v[j].x * rstd * gv[j].x, v[j].y * rstd * gv[j].y, w, false); w = __builtin_amdgcn_cvt_pk_fp8_f32(v[j].z * rstd * gv[j].z, v[j].w * rstd * gv[j].w, w, true); o4[64 * j] = (unsigned)w; } }
        if (dsti) {
            f32x4 y[4]; float am = 0.f;
#pragma unroll
            for (int j = 0; j < 4; ++j) { y[j] = v[j] * rstd * gv[j]; am = fmaxf(am, fmaxf(fmaxf(fabsf(y[j].x), fabsf(y[j].y)), fmaxf(fabsf(y[j].z), fabsf(y[j].w)))); }
            am = wave_max(am);
            const float qs = am > 0.f ? 127.0f / am : 0.f;
            unsigned* oi = (unsigned*)(dsti + (size_t)m * D) + F.lane;
#pragma unroll
            for (int j = 0; j < 4; ++j) { const int q0 = (int)rintf(y[j].x * qs), q1 = (int)rintf(y[j].y * qs), q2 = (int)rintf(y[j].z * qs), q3 = (int)rintf(y[j].w * qs);
                oi[64 * j] = ((unsigned)q0 & 255u) | (((unsigned)q1 & 255u) << 8) | (((unsigned)q2 & 255u) << 16) | ((unsigned)q3 << 24); }
            if (F.lane == 0) rowsc[m] = am * (1.0f / 127.0f);
        }
    }
}
__device__ __forceinline__ void final_norm_bf(const Frame& F, const bf16_t* h, float* out, const float* g) {
    const f32x4* gp = (const f32x4*)g + F.lane;
    f32x4 gv[4];
#pragma unroll
    for (int j = 0; j < 4; ++j) gv[j] = gp[64 * j];
    for (int m = F.gw; m < T; m += F.NGW) {
        const u32x2* xr = (const u32x2*)(h + (size_t)m * D) + F.lane;
        f32x4 v[4]; float s = 0.f;
#pragma unroll
        for (int j = 0; j < 4; ++j) { const u32x2 w = xr[64 * j]; v[j] = (f32x4){bflo(w.x), bfhi(w.x), bflo(w.y), bfhi(w.y)}; s += (v[j].x * v[j].x + v[j].y * v[j].y) + (v[j].z * v[j].z + v[j].w * v[j].w); }
        const float rstd = 1.0f / sqrtf(wave_sum(s) * (1.f / D) + 1e-6f);
        f32x4* orow = (f32x4*)(out + (size_t)m * D) + F.lane;
#pragma unroll
        for (int j = 0; j < 4; ++j) orow[64 * j] = v[j] * rstd * gv[j];
    }
}
__device__ __forceinline__ void final_norm(const Frame& F, float* h, const float* g) {
    const f32x4* gp = (const f32x4*)g + F.lane;
    f32x4 gv[4];
#pragma unroll
    for (int j = 0; j < 4; ++j) gv[j] = gp[64 * j];
    for (int m = F.gw; m < T; m += F.NGW) {
        f32x4* xr = (f32x4*)(h + (size_t)m * D) + F.lane;
        f32x4 v[4]; float s = 0.f;
#pragma unroll
        for (int j = 0; j < 4; ++j) { v[j] = xr[64 * j]; s += (v[j].x * v[j].x + v[j].y * v[j].y) + (v[j].z * v[j].z + v[j].w * v[j].w); }
        const float rstd = 1.0f / sqrtf(wave_sum(s) * (1.f / D) + 1e-6f);
#pragma unroll
        for (int j = 0; j < 4; ++j) xr[64 * j] = v[j] * rstd * gv[j];
    }
}
__device__ __forceinline__ void cvt_fp4_rows(const Frame& F, const float* src, unsigned char* dst, float* inv) {
    for (int r = F.gw; r < 16384; r += F.NGW) {
        const f32x4* p = (const f32x4*)(src + (size_t)r * 1024 + 16 * F.lane);
        const f32x4 v0 = p[0], v1 = p[1], v2 = p[2], v3 = p[3];
        float m = fmaxf(fmaxf(fmaxf(fabsf(v0.x), fabsf(v0.y)), fmaxf(fabsf(v0.z), fabsf(v0.w))), fmaxf(fmaxf(fabsf(v1.x), fabsf(v1.y)), fmaxf(fabsf(v1.z), fabsf(v1.w))));
        m = fmaxf(m, fmaxf(fmaxf(fmaxf(fabsf(v2.x), fabsf(v2.y)), fmaxf(fabsf(v2.z), fabsf(v2.w))), fmaxf(fmaxf(fabsf(v3.x), fabsf(v3.y)), fmaxf(fabsf(v3.z), fabsf(v3.w)))));
        m = wave_max(m);
        const float sc = m > 0.f ? 6.0f / m : 1.0f;
        unsigned w0 = 0u, w1 = 0u;
        w0 = __builtin_amdgcn_cvt_scalef32_pk_fp4_f32(w0, v0.x * sc, v0.y * sc, 1.0f, 0); w0 = __builtin_amdgcn_cvt_scalef32_pk_fp4_f32(w0, v0.z * sc, v0.w * sc, 1.0f, 1);
        w0 = __builtin_amdgcn_cvt_scalef32_pk_fp4_f32(w0, v1.x * sc, v1.y * sc, 1.0f, 2); w0 = __builtin_amdgcn_cvt_scalef32_pk_fp4_f32(w0, v1.z * sc, v1.w * sc, 1.0f, 3);
        w1 = __builtin_amdgcn_cvt_scalef32_pk_fp4_f32(w1, v2.x * sc, v2.y * sc, 1.0f, 0); w1 = __builtin_amdgcn_cvt_scalef32_pk_fp4_f32(w1, v2.z * sc, v2.w * sc, 1.0f, 1);
        w1 = __builtin_amdgcn_cvt_scalef32_pk_fp4_f32(w1, v3.x * sc, v3.y * sc, 1.0f, 2); w1 = __builtin_amdgcn_cvt_scalef32_pk_fp4_f32(w1, v3.z * sc, v3.w * sc, 1.0f, 3);
        *(u32x2*)(dst + (size_t)(F.lane >> 4) * (2 * MiB) + (size_t)r * 128 + 8 * (F.lane & 15)) = (u32x2){w0, w1};
        if (F.lane == 0) inv[2 * r] = m > 0.f ? m * (1.0f / 6.0f) : 1.0f;
    }
}
__device__ __forceinline__ int t5_bucket(int rel) {
    const int ret = rel > 0 ? 16 : 0; const int n = rel < 0 ? -rel : rel;
    int v;
    if (n < 8) v = n; else if (n < 12) v = 8; else if (n < 16) v = 9; else if (n < 23) v = 10; else if (n < 32) v = 11;
    else if (n < 46) v = 12; else if (n < 64) v = 13; else if (n < 91) v = 14; else v = 15;
    return ret + v;
}

__device__ __forceinline__ void p0_prologue(const Frame& F) {
    LAS float* scr = (LAS float*)(F.lds + F.wave * 16384);
    bf16_t* WQK = (bf16_t*)(F.ws + WS_WQK); bf16_t* WV = (bf16_t*)(F.ws + WS_WV); bf16_t* WO = (bf16_t*)(F.ws + WS_WO);
    bf16_t* WSGV = (bf16_t*)(F.ws + WS_WSGV); bf16_t* WSGU = (bf16_t*)(F.ws + WS_WSGU); bf16_t* WSGO = (bf16_t*)(F.ws + WS_WSGO);
    constexpr int I_QK = 16 * 40, I_V = 16 * 8, I_O = 16 * 32, I_SG = 16 * 96, I_SGO = 48 * 32;
    constexpr int NITEMS = I_QK + I_V + I_O + 2 * I_SG + I_SGO;
    for (int it = F.gw; it < NITEMS; it += F.NGW) {
        int r = it;
        if (r < I_QK) { const int nb = r % 40; transpose_item(F.in[3], 1536, 0, WQK, 1024, 40, (nb < 32 ? 0.125f * 1.4426950408889634f : 1.0f) * W8_SCALE, scr, r, F.lane, true); continue; } r -= I_QK;
        if (r < I_V) { transpose_item(F.in[3], 1536, 1280, WV, 1024, 8, W8_SCALE, scr, r, F.lane, true); continue; } r -= I_V;
        if (r < I_O) { transpose_item(F.in[4], 1024, 0, WO, 1024, 32, W8_SCALE, scr, r, F.lane, true); continue; } r -= I_O;
        if (r < I_SG) { transpose_item(F.in[6], 6144, 0, WSGU, 1024, 96, 1.0f, scr, r, F.lane, false, (unsigned*)(F.ws + WS_CTL) + CW_COLMAX2 + 3072); continue; } r -= I_SG;
        if (r < I_SG) { transpose_item(F.in[6], 6144, 3072, WSGV, 1024, 96, 1.0f, scr, r, F.lane, false, (unsigned*)(F.ws + WS_CTL) + CW_COLMAX2); continue; } r -= I_SG;
        transpose_item(F.in[11], 1024, 0, WSGO, 3072, 32, W8_SCALE, scr, r, F.lane, true);
    }
    {
        bf16_t* WQKP = (bf16_t*)(F.ws + WS_WQKP);
        const int fr = F.lane & 15, fq = F.lane >> 4;
        for (int task = F.gw; task < 2 * 16 * 64; task += F.NGW) {
            const int l = task >> 10, hc = (task >> 6) & 15, k0 = (task & 63) * 16;
            const f32x4* ap = (const f32x4*)(F.in[13] + ((size_t)l * 1024 + k0 + fr) * 2048 + hc * 128 + 32 * fq);
            f32x4 av[8];
#pragma unroll
            for (int i = 0; i < 8; ++i) av[i] = ap[i];
#pragma unroll 1
            for (int nt = 0; nt < 8; ++nt) {
                const f32x4* bp = (const f32x4*)(F.in[14] + ((size_t)(l * 16 + hc) * 128 + nt * 16 + fr) * 128 + 32 * fq);
                f32x4 bv[8];
#pragma unroll
                for (int i = 0; i < 8; ++i) bv[i] = bp[i];
                f32x4 acc = {0.f, 0.f, 0.f, 0.f};
#pragma unroll
                for (int i = 0; i < 8; ++i)
#pragma unroll
                    for (int j = 0; j < 4; ++j) acc = __builtin_amdgcn_mfma_f32_16x16x4f32(av[i][j], bv[i][j], acc, 0, 0, 0);
                *(u32x2*)(WQKP + ((size_t)l * 2048 + hc * 128 + nt * 16 + fr) * 1024 + k0 + 4 * fq) = (u32x2){pk2(acc[0], acc[1]), pk2(acc[2], acc[3])};
                { float mx = fmaxf(fmaxf(fabsf(acc[0]), fabsf(acc[1])), fmaxf(fabsf(acc[2]), fabsf(acc[3])));
                  mx = fmaxf(mx, __shfl_xor(mx, 16)); mx = fmaxf(mx, __shfl_xor(mx, 32));
                  if (fq == 0) atomicMax((unsigned*)(F.ws + WS_CTL) + CW_COLMAX + l * 2048 + hc * 128 + nt * 16 + fr, __builtin_bit_cast(unsigned, mx)); }
            }
        }
    }
    if (blockIdx.x == 0) {
        float* bt = (float*)(F.ws + WS_BIAS);
        for (int i = F.tid; i < 16 * 257; i += 512) { const int hq = i / 257, r = i % 257 - 128; bt[hq * 260 + r + 128] = F.in[1][t5_bucket(r) * 16 + hq] * 1.4426950408889634f; }
    }
    rmsnorm_rows(F, F.in[0], F.in[2], nullptr, nullptr, F.ws + WS_HN8B);
    for (int l = 0; l < 2; ++l) {
        cvt_fp4_rows(F, F.in[15] + (size_t)l * 16384 * 1024, F.ws + WS_TAB + (size_t)(2 * l) * 16 * MiB, (float*)(F.ws + WS_SCL) + (size_t)l * 32768);
        cvt_fp4_rows(F, F.in[16] + (size_t)l * 16384 * 1024, F.ws + WS_TAB + (size_t)(2 * l + 1) * 16 * MiB, (float*)(F.ws + WS_SCL) + (size_t)l * 32768 + 1);
    }
}

typedef float f32x16 __attribute__((ext_vector_type(16)));
constexpr int AT_K = 0, AT_KS = 144, AT_V = 384 * AT_KS, AT_VS = 792, AT_B = AT_V + 64 * AT_VS;
__device__ __forceinline__ void attn_phase_v2(const Frame& F) {
    const bf16_t* Q = (const bf16_t*)(F.ws + WS_Q); const bf16_t* Kb = (const bf16_t*)(F.ws + WS_K); const bf16_t* Vt = (const bf16_t*)(F.ws + WS_VT);
    bf16_t* AO = (bf16_t*)(F.ws + WS_AO); const float* bias = (const float*)(F.ws + WS_BIAS); const float* sinkp = F.in[5];
    const int lane = F.lane, tid = F.tid, h5 = lane >> 5, c31 = lane & 31, g = F.wave >> 1, qh = F.wave & 1;
    LAS float* bl = (LAS float*)(F.lds + AT_B) + g * 260;
    for (int unit = blockIdx.x; unit < 1024; unit += F.G) {
        const int hkv = unit & 3, qb = (unit >> 2) & 15, b = unit >> 6;
        const int tok0 = b * 2048 + qb * 128, kbase = tok0 - 128;
        __syncthreads();
#pragma unroll 2
        for (int it = 0; it < 6; ++it) { const int id = it * 512 + tid, row = id >> 3, ch = id & 7, pos = qb * 128 - 128 + row;
            u32x4 v = (u32x4){0u, 0u, 0u, 0u};
            if (pos >= 0 && pos < 2048) v = *(const u32x4*)(Kb + (size_t)(kbase + row) * 256 + hkv * 64 + ch * 8);
            *(LAS u32x4*)(F.lds + AT_K + row * AT_KS + ch * 16) = v; }
#pragma unroll 2
        for (int it = 0; it < 6; ++it) { const int id = it * 512 + tid, d = id / 48, ch = id % 48, pos0 = qb * 128 - 128 + ch * 8;
            u32x4 v = (u32x4){0u, 0u, 0u, 0u};
            if (pos0 >= 0 && pos0 < 2048) v = *(const u32x4*)(Vt + (size_t)(hkv * 64 + d) * T + kbase + ch * 8);
            *(LAS u32x2*)(F.lds + AT_V + d * AT_VS + ch * 16) = (u32x2){v.x, v.y}; *(LAS u32x2*)(F.lds + AT_V + d * AT_VS + ch * 16 + 8) = (u32x2){v.z, v.w}; }
        for (int i = tid; i < 4 * 260; i += 512) ((LAS float*)(F.lds + AT_B))[i] = bias[hkv * 4 * 260 + i];
        __syncthreads();
        const int hq = hkv * 4 + g; const float sinkv = sinkp[hq] * 1.4426950408889634f;
#pragma unroll 1
        for (int qt = 0; qt < 2; ++qt) {
            const int q0 = 64 * qh + 32 * qt;
            const bf16_t* qrow = Q + (size_t)(tok0 + q0 + c31) * 1024 + hq * 64 + 8 * h5;
            bf16x8 qf[4];
#pragma unroll
            for (int s2 = 0; s2 < 4; ++s2) qf[s2] = *(const bf16x8*)(qrow + 16 * s2);
            const int kt0 = q0 >> 5; int kt_lo = kt0, kt_hi = kt0 + 8;
            if (qb == 0 && kt_lo < 4) kt_lo = 4;
            if (qb == 15 && kt_hi > 7) kt_hi = 7;
            const int qi = q0 + c31;
            float mx = sinkv, lsum = h5 == 0 ? 1.0f : 0.f;
            f32x16 o0 = {0.f, 0.f, 0.f, 0.f, 0.f, 0.f, 0.f, 0.f, 0.f, 0.f, 0.f, 0.f, 0.f, 0.f, 0.f, 0.f}, o1 = o0;
#pragma unroll 1
            for (int kt = kt_lo; kt <= kt_hi; ++kt) {
                f32x16 sa = {0.f, 0.f, 0.f, 0.f, 0.f, 0.f, 0.f, 0.f, 0.f, 0.f, 0.f, 0.f, 0.f, 0.f, 0.f, 0.f};
#pragma unroll
                for (int s2 = 0; s2 < 4; ++s2) { const bf16x8 kf = *(const LAS bf16x8*)(F.lds + AT_K + (kt * 32 + c31) * AT_KS + s2 * 32 + h5 * 16); sa = __builtin_amdgcn_mfma_f32_32x32x16_bf16(kf, qf[s2], sa, 0, 0, 0); }
                float sv[16]; float tmax = -INFINITY;
                if (kt > kt0 && kt < kt0 + 8) {
                    const LAS float* bp = bl + (kt * 32 + 4 * h5 - qi);
#pragma unroll
                    for (int r = 0; r < 16; ++r) { sv[r] = sa[r] + bp[(r & 3) + 8 * (r >> 2)]; tmax = fmaxf(tmax, sv[r]); }
                } else {
#pragma unroll
                    for (int r = 0; r < 16; ++r) { const int key = kt * 32 + (r & 3) + 8 * (r >> 2) + 4 * h5, rel = key - 128 - qi; const bool ok = rel >= -128 && rel <= 128;
                        const int bi = rel < -128 ? 0 : (rel > 128 ? 256 : rel + 128);
                        sv[r] = ok ? sa[r] + bl[bi] : -INFINITY; tmax = fmaxf(tmax, sv[r]); }
                }
                tmax = fmaxf(tmax, __shfl_xor(tmax, 32));
                if (__any(tmax > mx)) {
                    const float mn = fmaxf(mx, tmax), scl = __builtin_amdgcn_exp2f(mx - mn); mx = mn; lsum *= scl;
#pragma unroll
                    for (int r = 0; r < 16; ++r) { o0[r] *= scl; o1[r] *= scl; }
                }
                float pr[16];
#pragma unroll
                for (int r = 0; r < 16; ++r) { pr[r] = __builtin_amdgcn_exp2f(sv[r] - mx); lsum += pr[r]; }
#pragma unroll
                for (int s2 = 0; s2 < 2; ++s2) {
                    u32x4 pw; pw.x = pk2(pr[8 * s2 + 0], pr[8 * s2 + 1]); pw.y = pk2(pr[8 * s2 + 2], pr[8 * s2 + 3]); pw.z = pk2(pr[8 * s2 + 4], pr[8 * s2 + 5]); pw.w = pk2(pr[8 * s2 + 6], pr[8 * s2 + 7]);
                    const bf16x8 pb = __builtin_bit_cast(bf16x8, pw);
                    const int koff = (kt * 32 + 16 * s2 + 4 * h5) * 2;
                    { const LAS unsigned char* vb = F.lds + AT_V + c31 * AT_VS + koff; const u32x2 lo = *(const LAS u32x2*)vb, hi = *(const LAS u32x2*)(vb + 16);
                      const bf16x8 vf = __builtin_bit_cast(bf16x8, (u32x4){lo.x, lo.y, hi.x, hi.y}); o0 = __builtin_amdgcn_mfma_f32_32x32x16_bf16(vf, pb, o0, 0, 0, 0); }
                    { const LAS unsigned char* vb = F.lds + AT_V + (32 + c31) * AT_VS + koff; const u32x2 lo = *(const LAS u32x2*)vb, hi = *(const LAS u32x2*)(vb + 16);
                      const bf16x8 vf = __builtin_bit_cast(bf16x8, (u32x4){lo.x, lo.y, hi.x, hi.y}); o1 = __builtin_amdgcn_mfma_f32_32x32x16_bf16(vf, pb, o1, 0, 0, 0); }
                }
            }
            lsum += __shfl_xor(lsum, 32);
            const float linv = 1.0f / lsum;
            unsigned char* op = (unsigned char*)AO + (size_t)(tok0 + qi) * 1024 + hq * 64 + 4 * h5;
            const float ls = linv * AO8_SCALE;
#pragma unroll
            for (int gq = 0; gq < 4; ++gq) {
                int w0 = 0, w1 = 0;
                w0 = __builtin_amdgcn_cvt_pk_fp8_f32(o0[4 * gq] * ls, o0[4 * gq + 1] * ls, w0, false); w0 = __builtin_amdgcn_cvt_pk_fp8_f32(o0[4 * gq + 2] * ls, o0[4 * gq + 3] * ls, w0, true);
                w1 = __builtin_amdgcn_cvt_pk_fp8_f32(o1[4 * gq] * ls, o1[4 * gq + 1] * ls, w1, false); w1 = __builtin_amdgcn_cvt_pk_fp8_f32(o1[4 * gq + 2] * ls, o1[4 * gq + 3] * ls, w1, true);
                *(unsigned*)(op + 8 * gq) = (unsigned)w0; *(unsigned*)(op + 32 + 8 * gq) = (unsigned)w1; }
        }
    }
}

__device__ __forceinline__ unsigned enc_key(float f, unsigned tag, unsigned mask) { unsigned u = __builtin_bit_cast(unsigned, f); u = (u & ~mask) | tag; return (u & 0x80000000u) ? ~u : (u | 0x80000000u); }
__device__ __forceinline__ unsigned dec_key(unsigned m) { return (m & 0x80000000u) ? (m & 0x7fffffffu) : ~m; }
__device__ __forceinline__ unsigned umax(unsigned a, unsigned b) { return a > b ? a : b; }
__device__ __forceinline__ unsigned umin(unsigned a, unsigned b) { return a < b ? a : b; }
#define SORT_CE(i, j) do { const unsigned hi_ = umax(a[i], a[j]), lo_ = umin(a[i], a[j]); a[i] = hi_; a[j] = lo_; } while (0)
__device__ __forceinline__ void sort16_desc(unsigned (&a)[16]) {
    SORT_CE(0, 13); SORT_CE(1, 12); SORT_CE(2, 15); SORT_CE(3, 14); SORT_CE(4, 8); SORT_CE(5, 6); SORT_CE(7, 11); SORT_CE(9, 10);
    SORT_CE(0, 5); SORT_CE(1, 7); SORT_CE(2, 9); SORT_CE(3, 4); SORT_CE(6, 13); SORT_CE(8, 14); SORT_CE(10, 15); SORT_CE(11, 12);
    SORT_CE(0, 1); SORT_CE(2, 3); SORT_CE(4, 5); SORT_CE(6, 8); SORT_CE(7, 9); SORT_CE(10, 11); SORT_CE(12, 13); SORT_CE(14, 15);
    SORT_CE(0, 2); SORT_CE(1, 3); SORT_CE(4, 10); SORT_CE(5, 11); SORT_CE(6, 7); SORT_CE(8, 9); SORT_CE(12, 14); SORT_CE(13, 15);
    SORT_CE(1, 2); SORT_CE(3, 12); SORT_CE(4, 6); SORT_CE(5, 7); SORT_CE(8, 10); SORT_CE(9, 11); SORT_CE(13, 14);
    SORT_CE(1, 4); SORT_CE(2, 6); SORT_CE(5, 8); SORT_CE(7, 10); SORT_CE(9, 13); SORT_CE(11, 14);
    SORT_CE(2, 4); SORT_CE(3, 6); SORT_CE(9, 12); SORT_CE(11, 13);
    SORT_CE(3, 5); SORT_CE(6, 8); SORT_CE(7, 9); SORT_CE(10, 12);
    SORT_CE(3, 4); SORT_CE(5, 6); SORT_CE(7, 8); SORT_CE(9, 10); SORT_CE(11, 12);
    SORT_CE(6, 7); SORT_CE(8, 9);
}
#undef SORT_CE
__device__ __forceinline__ void merge16_desc(unsigned (&a)[16]) {
#pragma unroll
    for (int jj = 3; jj >= 0; --jj)
#pragma unroll
        for (int i = 0; i < 16; ++i) { const int j = 1 << jj, l = i ^ j; if (l > i) { const unsigned hi = umax(a[i], a[l]), lo = umin(a[i], a[l]); a[i] = hi; a[l] = lo; } }
}
template <int CTRL> __device__ __forceinline__ void xmerge16(unsigned (&a)[16]) {
    unsigned p[16];
#pragma unroll
    for (int i = 0; i < 16; ++i) p[i] = (unsigned)__builtin_amdgcn_update_dpp(0, (int)a[i], CTRL, 0xf, 0xf, true);
#pragma unroll
    for (int i = 0; i < 16; ++i) a[i] = umax(a[i], p[15 - i]);
    merge16_desc(a);
}
template <int CTRL> __device__ __forceinline__ unsigned dpp_u(unsigned v) { return (unsigned)__builtin_amdgcn_update_dpp(0, (int)v, CTRL, 0xf, 0xf, true); }
__device__ __forceinline__ void topk_phase_v3(const Frame& F) {
    const bf16_t* S = (const bf16_t*)(F.ws + WS_S); int* IDX = (int*)(F.ws + WS_IDX); float* GATE = (float*)(F.ws + WS_GATE);
    LAS unsigned* L = (LAS unsigned*)F.lds + F.wave * 1024;
    const int lane = F.lane, tk = lane >> 4, hc = lane & 15, h = hc >> 1, c = hc & 1;
    auto step = [&](const u32x4 (&cur)[16], const int tb) __attribute__((always_inline)) {
        const int t = tb + tk;
        unsigned top[16];
#pragma unroll
        for (int ck = 0; ck < 8; ++ck) {
            const u32x4 v = cur[2 * ck], w = cur[2 * ck + 1];
            const float fv[16] = {hlo(v.x), hhi(v.x), hlo(v.y), hhi(v.y), hlo(v.z), hhi(v.z), hlo(v.w), hhi(v.w), hlo(w.x), hhi(w.x), hlo(w.y), hhi(w.y), hlo(w.z), hhi(w.z), hlo(w.w), hhi(w.w)};
            unsigned nw[16];
#pragma unroll
            for (int j = 0; j < 16; ++j) nw[j] = enc_key(fv[j], (unsigned)(16 * ck + j), 127u);
            sort16_desc(nw);
            if (ck == 0) {
#pragma unroll
                for (int j = 0; j < 16; ++j) top[j] = nw[j];
            } else {
#pragma unroll
                for (int j = 0; j < 16; ++j) top[j] = umax(top[j], nw[15 - j]);
                merge16_desc(top);
            }
        }
#pragma unroll
        for (int i = 0; i < 16; ++i) L[lane * 16 + i] = top[i];
        float f1[16], f2[16];
#pragma unroll
        for (int i = 0; i < 16; ++i) { const unsigned o = dpp_u<0xB1>(top[i]); const unsigned u1 = dec_key(c ? o : top[i]) & ~127u, u2 = dec_key(c ? top[i] : o) & ~127u;
            f1[i] = __builtin_bit_cast(float, u1); f2[i] = __builtin_bit_cast(float, u2); }
        unsigned ca[16], cb[16];
#pragma unroll
        for (int i = 0; i < 16; ++i) { ca[i] = 0u; cb[i] = 0u; }
        { int n = 0;
#pragma unroll
          for (int i = 0; i < 16; ++i)
#pragma unroll
            for (int j = 0; j < 16; ++j) if ((i + 1) * (j + 1) <= 16) { const unsigned key = enc_key(f1[i] + f2[j], (unsigned)((i << 4) | j), 255u); const int slot = n >> 1, who = n & 1;
                if (slot < 16) ca[slot] = (c == who) ? key : ca[slot]; else cb[slot - 16] = (c == who) ? key : cb[slot - 16]; ++n; } }
        sort16_desc(ca); sort16_desc(cb);
#pragma unroll
        for (int i = 0; i < 16; ++i) ca[i] = umax(ca[i], cb[15 - i]);
        merge16_desc(ca);
        xmerge16<0xB1>(ca);
        float sc[8]; unsigned ex[8];
#pragma unroll
        for (int k = 0; k < 8; ++k) { unsigned wlo = ca[k], whi = ca[8 + k]; asm volatile("" : "+v"(wlo), "+v"(whi));
            const unsigned w = c ? whi : wlo;
            const unsigned tag = dec_key(w) & 255u; const unsigned u1 = dec_key(L[(lane & ~1) * 16 + (tag >> 4)]), u2 = dec_key(L[(lane | 1) * 16 + (tag & 15u)]);
            sc[k] = __builtin_bit_cast(float, u1 & ~127u) + __builtin_bit_cast(float, u2 & ~127u); ex[k] = ((u1 & 127u) << 7) | (u2 & 127u); }
        const float smax = __builtin_bit_cast(float, __builtin_amdgcn_update_dpp(0, __builtin_bit_cast(int, sc[0]), 0xA0, 0xf, 0xf, true));
        float e[8]; float sum = 0.f;
#pragma unroll
        for (int k = 0; k < 8; ++k) { e[k] = __expf(sc[k] - smax); sum += e[k]; }
        sum += __builtin_bit_cast(float, __builtin_amdgcn_update_dpp(0, __builtin_bit_cast(int, sum), 0xB1, 0xf, 0xf, true));
        const float inv = 1.0f / sum;
        int* ip = IDX + (size_t)t * 128 + h * 16 + 8 * c; float* gp = GATE + (size_t)t * 128 + h * 16 + 8 * c;
        *(u32x4*)ip = (u32x4){ex[0], ex[1], ex[2], ex[3]}; *(u32x4*)(ip + 4) = (u32x4){ex[4], ex[5], ex[6], ex[7]};
        *(f32x4*)gp = (f32x4){e[0] * inv, e[1] * inv, e[2] * inv, e[3] * inv}; *(f32x4*)(gp + 4) = (f32x4){e[4] * inv, e[5] * inv, e[6] * inv, e[7] * inv};
    };
#define TK_LD1(dst, ptr, OFF) asm volatile("global_load_dwordx4 %0, %1, off offset:" #OFF : "=v"(dst) : "v"(ptr) : "memory")
#define TK_LOAD(buf, tb_) do { const u32x4* sp_ = (const u32x4*)(S + (size_t)((tb_) + tk) * 2048 + hc * 128); \
        TK_LD1(buf[0], sp_, 0); TK_LD1(buf[1], sp_, 16); TK_LD1(buf[2], sp_, 32); TK_LD1(buf[3], sp_, 48); TK_LD1(buf[4], sp_, 64); TK_LD1(buf[5], sp_, 80); TK_LD1(buf[6], sp_, 96); TK_LD1(buf[7], sp_, 112); \
        TK_LD1(buf[8], sp_, 128); TK_LD1(buf[9], sp_, 144); TK_LD1(buf[10], sp_, 160); TK_LD1(buf[11], sp_, 176); TK_LD1(buf[12], sp_, 192); TK_LD1(buf[13], sp_, 208); TK_LD1(buf[14], sp_, 224); TK_LD1(buf[15], sp_, 240); } while (0)
#define TK_WAIT(buf, N) asm volatile("s_waitcnt vmcnt(" #N ")" : "+v"(buf[0]), "+v"(buf[1]), "+v"(buf[2]), "+v"(buf[3]), "+v"(buf[4]), "+v"(buf[5]), "+v"(buf[6]), "+v"(buf[7]), \
        "+v"(buf[8]), "+v"(buf[9]), "+v"(buf[10]), "+v"(buf[11]), "+v"(buf[12]), "+v"(buf[13]), "+v"(buf[14]), "+v"(buf[15]) :: "memory")
    const int dstep = 4 * F.NGW; int tb = 4 * F.gw;
    u32x4 bufa[16], bufb[16];
    if (tb >= T) return;
    TK_LOAD(bufa, tb);
    for (;;) {
        const int t1 = tb + dstep; TK_LOAD(bufb, t1 < T ? t1 : tb);
        TK_WAIT(bufa, 16);
        step(bufa, tb);
        if (t1 >= T) break;
        const int t2 = t1 + dstep; TK_LOAD(bufa, t2 < T ? t2 : t1);
        TK_WAIT(bufb, 16);
        step(bufb, t1);
        if (t2 >= T) break;
        tb = t2;
    }
    asm volatile("s_waitcnt vmcnt(0)" ::: "memory");
#undef TK_LOAD
#undef TK_LD1
#undef TK_WAIT
}

template <int S> __device__ __forceinline__ void reduce_scatter16(const float (&v)[16], int lane, float& z0, float& z1) {
    const bool b2 = (lane & (4 * S)) != 0, b1 = (lane & (2 * S)) != 0, b0 = (lane & S) != 0;
    float u[8], w[4];
#pragma unroll
    for (int k = 0; k < 8; ++k) { const float keep = b2 ? v[8 + k] : v[k], send = b2 ? v[k] : v[8 + k]; u[k] = keep + __shfl_xor(send, 4 * S); }
#pragma unroll
    for (int k = 0; k < 4; ++k) { const float keep = b1 ? u[4 + k] : u[k], send = b1 ? u[k] : u[4 + k]; w[k] = keep + __shfl_xor(send, 2 * S); }
    { const float keep = b0 ? w[2] : w[0], send = b0 ? w[0] : w[2]; z0 = keep + __shfl_xor(send, S); }
    { const float keep = b0 ? w[3] : w[1], send = b0 ? w[1] : w[3]; z1 = keep + __shfl_xor(send, S); }
}
__device__ __forceinline__ void ld_off16(const int* IDX, int t, int g, unsigned off, unsigned (&e)[16]) {
    const u32x4* ip = (const u32x4*)((const char*)IDX + (unsigned)(t * 512 + 64 * g)); const u32x4 i0 = ip[0], i1 = ip[1], i2 = ip[2], i3 = ip[3];
    e[0] = i0.x * 128u + off; e[1] = i0.y * 128u + off; e[2] = i0.z * 128u + off; e[3] = i0.w * 128u + off; e[4] = i1.x * 128u + off; e[5] = i1.y * 128u + off; e[6] = i1.z * 128u + off; e[7] = i1.w * 128u + off;
    e[8] = i2.x * 128u + off; e[9] = i2.y * 128u + off; e[10] = i2.z * 128u + off; e[11] = i2.w * 128u + off; e[12] = i3.x * 128u + off; e[13] = i3.y * 128u + off; e[14] = i3.z * 128u + off; e[15] = i3.w * 128u + off;
}
__device__ __forceinline__ void gather16(const unsigned char* tab, const unsigned (&e)[16], u32x4 (&wv)[16]) {
#pragma unroll
    for (int i = 0; i < 16; ++i) wv[i] = *(const u32x4*)(tab + e[i]);
}
#define FP4X32(W_, o) do { const u32x4 _w = (W_); \
    o[0] = __builtin_amdgcn_cvt_scalef32_pk_f32_fp4(_w.x, 1.0f, 0); o[1] = __builtin_amdgcn_cvt_scalef32_pk_f32_fp4(_w.x, 1.0f, 1); o[2] = __builtin_amdgcn_cvt_scalef32_pk_f32_fp4(_w.x, 1.0f, 2); o[3] = __builtin_amdgcn_cvt_scalef32_pk_f32_fp4(_w.x, 1.0f, 3); \
    o[4] = __builtin_amdgcn_cvt_scalef32_pk_f32_fp4(_w.y, 1.0f, 0); o[5] = __builtin_amdgcn_cvt_scalef32_pk_f32_fp4(_w.y, 1.0f, 1); o[6] = __builtin_amdgcn_cvt_scalef32_pk_f32_fp4(_w.y, 1.0f, 2); o[7] = __builtin_amdgcn_cvt_scalef32_pk_f32_fp4(_w.y, 1.0f, 3); \
    o[8] = __builtin_amdgcn_cvt_scalef32_pk_f32_fp4(_w.z, 1.0f, 0); o[9] = __builtin_amdgcn_cvt_scalef32_pk_f32_fp4(_w.z, 1.0f, 1); o[10] = __builtin_amdgcn_cvt_scalef32_pk_f32_fp4(_w.z, 1.0f, 2); o[11] = __builtin_amdgcn_cvt_scalef32_pk_f32_fp4(_w.z, 1.0f, 3); \
    o[12] = __builtin_amdgcn_cvt_scalef32_pk_f32_fp4(_w.w, 1.0f, 0); o[13] = __builtin_amdgcn_cvt_scalef32_pk_f32_fp4(_w.w, 1.0f, 1); o[14] = __builtin_amdgcn_cvt_scalef32_pk_f32_fp4(_w.w, 1.0f, 2); o[15] = __builtin_amdgcn_cvt_scalef32_pk_f32_fp4(_w.w, 1.0f, 3); } while (0)
__device__ __forceinline__ void peer_down_phase4(const Frame& F, int layer) {
    const int bx = blockIdx.x, p4 = bx & 3, par = (bx >> 2) & 1;
    const unsigned char* TD = F.ws + WS_TAB + (size_t)(2 * layer) * 16 * MiB + (size_t)p4 * (2 * MiB); const char* HNb = (const char*)(F.ws + WS_HN);
    const int* IDX = (const int*)(F.ws + WS_IDX); bf16_t* PART = (bf16_t*)(F.ws + WS_PART);
    const int nwp = (F.G - (bx & 7) + 7) >> 3, ww = (bx >> 3) * 8 + F.wave, stride = 2 * nwp * 8, tfirst = 2 * ww + par;
    const int lane = F.lane, r = lane & 7, g = lane >> 3, off = 256 * p4 + 32 * r;
    if (tfirst >= T) return;
    unsigned e1[16]; u32x4 wv[16];
    const unsigned toff = 16u * r;
    ld_off16(IDX, tfirst, g, toff, e1); gather16(TD, e1, wv);
    u32x4 xc[4];
#pragma unroll
    for (int k = 0; k < 4; ++k) xc[k] = *(const u32x4*)(HNb + (unsigned)(tfirst * 2048 + 2 * off + 16 * k));
    { const int t1 = tfirst + stride < T ? tfirst + stride : tfirst; ld_off16(IDX, t1, g, toff, e1); }
    for (int t0 = tfirst; t0 < T; t0 += stride) {
        const int t1 = t0 + stride < T ? t0 + stride : t0, t2 = t0 + 2 * stride < T ? t0 + 2 * stride : t0;
        unsigned e2[16]; ld_off16(IDX, t2, g, toff, e2);
        u32x4 xn[4];
#pragma unroll
        for (int k = 0; k < 4; ++k) xn[k] = *(const u32x4*)(HNb + (unsigned)(t1 * 2048 + 2 * off + 16 * k));
        const unsigned xw[16] = {xc[0].x, xc[0].y, xc[0].z, xc[0].w, xc[1].x, xc[1].y, xc[1].z, xc[1].w, xc[2].x, xc[2].y, xc[2].z, xc[2].w, xc[3].x, xc[3].y, xc[3].z, xc[3].w};
        float acc[16];
#pragma unroll
        for (int i = 0; i < 16; ++i) { const u32x4 w = wv[i]; wv[i] = *(const u32x4*)(TD + e1[i]);
            const unsigned ww4[4] = {w.x, w.y, w.z, w.w}; float sv = 0.f;
#pragma unroll
            for (int k = 0; k < 4; ++k) {
                sv = __builtin_amdgcn_fdot2_f32_bf16(__builtin_amdgcn_cvt_scalef32_pk_bf16_fp4(ww4[k], 1.0f, 0), __builtin_bit_cast(bfx2, xw[4 * k]), sv, false);
                sv = __builtin_amdgcn_fdot2_f32_bf16(__builtin_amdgcn_cvt_scalef32_pk_bf16_fp4(ww4[k], 1.0f, 1), __builtin_bit_cast(bfx2, xw[4 * k + 1]), sv, false);
                sv = __builtin_amdgcn_fdot2_f32_bf16(__builtin_amdgcn_cvt_scalef32_pk_bf16_fp4(ww4[k], 1.0f, 2), __builtin_bit_cast(bfx2, xw[4 * k + 2]), sv, false);
                sv = __builtin_amdgcn_fdot2_f32_bf16(__builtin_amdgcn_cvt_scalef32_pk_bf16_fp4(ww4[k], 1.0f, 3), __builtin_bit_cast(bfx2, xw[4 * k + 3]), sv, false); }
            acc[i] = sv; }
        float z0, z1; reduce_scatter16<1>(acc, lane, z0, z1);
        *(unsigned*)((char*)(PART + (size_t)p4 * T * 128) + (unsigned)(t0 * 256 + 32 * g + 4 * r)) = pk2(z0, z1);
#pragma unroll
        for (int k = 0; k < 4; ++k) xc[k] = xn[k];
#pragma unroll
        for (int i = 0; i < 16; ++i) e1[i] = e2[i];
    }
}
constexpr int D5_AUX = 131072;
#define D5_EL(iv, d) ((iv)[2 * ((d) & 1) + ((d) >> 3)][((d) >> 1) & 3])
#define D5_DMA(iv, d) __builtin_amdgcn_global_load_lds((const unsigned*)(TD + (D5_EL(iv, d) * 128u + (((d) & 1) ? sw1 : sw0))), (LAS unsigned*)(wl + (d) * 1024), 16, 0, 0)
#define D5_DMA_IDX(t, slot) do { __builtin_amdgcn_global_load_lds((const unsigned*)(IDX + (unsigned)((t) * 512) + l4), (LAS unsigned*)(xl + (slot) * 512), 4, 0, 0); \
                                 __builtin_amdgcn_global_load_lds((const unsigned*)(IDX + (unsigned)((t) * 512) + 256u + l4), (LAS unsigned*)(xl + (slot) * 512 + 256), 4, 0, 0); } while (0)
#define D5_DMA_H(t, slot) __builtin_amdgcn_global_load_lds((const unsigned*)(H8 + (unsigned)((t) * 1024) + l4), (LAS unsigned*)(xl + 1024 + (slot) * 256), 4, 0, 0)
#define D5_B(h, c) ((i32x8){(int)h[2 * (c)].x, (int)h[2 * (c)].y, (int)h[2 * (c)].z, (int)h[2 * (c)].w, (int)h[2 * (c) + 1].x, (int)h[2 * (c) + 1].y, (int)h[2 * (c) + 1].z, (int)h[2 * (c) + 1].w})
#define D5_A(a) ((i32x8){(int)(a).x, (int)(a).y, (int)(a).z, (int)(a).w, 0, 0, 0, 0})
__device__ __forceinline__ void peer_down_phase5(const Frame& F, int layer) {
    const int bx = blockIdx.x, p4 = bx & 3, par = (bx >> 2) & 1;
    const unsigned char* TD = F.ws + WS_TAB + (size_t)(2 * layer) * 16 * MiB + (size_t)p4 * (2 * MiB);
    const char* H8 = (const char*)(F.ws + WS_HN8) + 256 * p4; const char* IDX = (const char*)(F.ws + WS_IDX); char* PART = (char*)(F.ws + WS_PART) + (size_t)p4 * T * 256;
    const int nwp = (F.G - (bx & 7) + 7) >> 3, ww = (bx >> 3) * 8 + F.wave, stride = 2 * nwp * 8, tfirst = 2 * ww + par;
    if (tfirst >= T) return;
    const int lane = F.lane, rs = lane >> 3, sg = lane & 7, m = lane & 15, kg = lane >> 4;
    LAS unsigned char* wl = F.lds + F.wave * 16384; LAS unsigned char* xl = F.lds + D5_AUX + F.wave * 1536;
    const unsigned sw0 = (unsigned)((sg ^ kg) * 16), sw1 = (unsigned)((sg ^ (4 + kg)) * 16);
    const unsigned rd0 = (unsigned)(m * 128 + (kg ^ (m >> 1)) * 16), rd1 = (unsigned)(m * 128 + ((4 + kg) ^ (m >> 1)) * 16);
    const unsigned l4 = 4u * lane, ioff = 32u * rs, hoff = 16u * kg;
    { const u32x4* ip = (const u32x4*)(IDX + (unsigned)(tfirst * 512) + ioff); u32x4 i0[4]; i0[0] = ip[0]; i0[1] = ip[1]; i0[2] = ip[16]; i0[3] = ip[17];
      asm volatile("" : "+v"(i0[0]), "+v"(i0[1]), "+v"(i0[2]), "+v"(i0[3]) :: "memory");
      { const int t1 = tfirst + stride < T ? tfirst + stride : tfirst; D5_DMA_IDX(t1, 1); D5_DMA_H(tfirst, 0); }
      asm volatile("" ::: "memory");
#pragma unroll
      for (int d = 0; d < 16; ++d) D5_DMA(i0, d); }
    int sl = 0;
    for (int t0 = tfirst; t0 < T; t0 += stride, sl ^= 1) {
        const int t1 = t0 + stride < T ? t0 + stride : t0, t2 = t0 + 2 * stride < T ? t0 + 2 * stride : t0;
        D5_DMA_IDX(t2, sl); D5_DMA_H(t1, sl ^ 1);
        u32x4 i1[4], hb[4];
        f32x4 acc[8];
#pragma unroll
        for (int q = 0; q < 4; ++q) {
            asm volatile("s_waitcnt vmcnt(15)" ::: "memory");
            u32x4 a00 = *(const LAS u32x4*)(wl + (2 * q) * 2048 + rd0), a01 = *(const LAS u32x4*)(wl + (2 * q) * 2048 + rd1);
            u32x4 a10 = *(const LAS u32x4*)(wl + (2 * q + 1) * 2048 + rd0), a11 = *(const LAS u32x4*)(wl + (2 * q + 1) * 2048 + rd1);
            if (q == 0) {
                const LAS u32x4* ip = (const LAS u32x4*)(xl + (sl ^ 1) * 512 + ioff); i1[0] = ip[0]; i1[1] = ip[1]; i1[2] = ip[16]; i1[3] = ip[17];
                const LAS u32x4* hp = (const LAS u32x4*)(xl + 1024 + sl * 256 + hoff); hb[0] = hp[0]; hb[1] = hp[4]; hb[2] = hp[8]; hb[3] = hp[12];
                asm volatile("s_waitcnt lgkmcnt(0)" : "+v"(i1[0]), "+v"(i1[1]), "+v"(i1[2]), "+v"(i1[3]), "+v"(hb[0]), "+v"(hb[1]), "+v"(hb[2]), "+v"(hb[3]) :: "memory");
            }
            asm volatile("s_waitcnt lgkmcnt(0)" : "+v"(a00), "+v"(a01), "+v"(a10), "+v"(a11) :: "memory");
            D5_DMA(i1, 4 * q); D5_DMA(i1, 4 * q + 1); D5_DMA(i1, 4 * q + 2); D5_DMA(i1, 4 * q + 3);
            asm volatile("" ::: "memory");
            const i32x8 b0 = D5_B(hb, 0), b1 = D5_B(hb, 1);
            const f32x4 z = {0.f, 0.f, 0.f, 0.f};
            acc[2 * q] = __builtin_amdgcn_mfma_scale_f32_16x16x128_f8f6f4(D5_A(a00), b0, z, 4, 0, 0, 0, 0, 0);
            acc[2 * q + 1] = __builtin_amdgcn_mfma_scale_f32_16x16x128_f8f6f4(D5_A(a10), b0, z, 4, 0, 0, 0, 0, 0);
            acc[2 * q] = __builtin_amdgcn_mfma_scale_f32_16x16x128_f8f6f4(D5_A(a01), b1, acc[2 * q], 4, 0, 0, 0, 0, 0);
            acc[2 * q + 1] = __builtin_amdgcn_mfma_scale_f32_16x16x128_f8f6f4(D5_A(a11), b1, acc[2 * q + 1], 4, 0, 0, 0, 0, 0);
        }
        if (m < 4) {
            float v[8];
#pragma unroll
            for (int j = 0; j < 8; ++j) v[j] = m == 0 ? acc[j].x : m == 1 ? acc[j].y : m == 2 ? acc[j].z : acc[j].w;
            *(u32x4*)(PART + (unsigned)(t0 * 256 + 16 * (4 * kg + m))) = (u32x4){pk2(v[0], v[1]), pk2(v[2], v[3]), pk2(v[4], v[5]), pk2(v[6], v[7])};
        }
    }
    asm volatile("s_waitcnt vmcnt(0)" ::: "memory");
}
template <int NS> __device__ __forceinline__ void peer_reduce_phase(const Frame& F, int layer) {
    const u32x2* PART = (const u32x2*)(F.ws + WS_PART); const int* IDX = (const int*)(F.ws + WS_IDX); const float* GATE = (const float*)(F.ws + WS_GATE);
    bf16_t* AB = (bf16_t*)(F.ws + WS_AB);
    const f32x2* scl = (const f32x2*)(F.ws + WS_SCL) + (size_t)layer * 16384;
    const size_t n4 = (size_t)T * 128 / 4, stride = (size_t)F.G * 512;
    for (size_t i = (size_t)blockIdx.x * 512 + F.tid; i < n4; i += stride) {
        u32x2 pw[NS];
#pragma unroll
        for (int p = 0; p < NS; ++p) pw[p] = PART[(size_t)p * T * 32 + i];
        const u32x4 e = ((const u32x4*)IDX)[i]; const f32x4 gt = ((const f32x4*)GATE)[i];
        const f32x2 c0 = scl[e.x], c1 = scl[e.y], c2 = scl[e.z], c3 = scl[e.w];
        f32x4 s = {0.f, 0.f, 0.f, 0.f};
#pragma unroll
        for (int p = 0; p < NS; ++p) { s.x += bflo(pw[p].x); s.y += bfhi(pw[p].x); s.z += bflo(pw[p].y); s.w += bfhi(pw[p].y); }
        f32x4 o;
        o.x = gelu_tanh(s.x * c0.x) * gt.x * c0.y; o.y = gelu_tanh(s.y * c1.x) * gt.y * c1.y;
        o.z = gelu_tanh(s.z * c2.x) * gt.z * c2.y; o.w = gelu_tanh(s.w * c3.x) * gt.w * c3.y;
        ((u32x2*)AB)[i] = (u32x2){pk2(o.x, o.y), pk2(o.z, o.w)};
    }
}
__device__ __forceinline__ void peer_reduce_phase8(const Frame& F, int layer) {
    const u32x2* PART = (const u32x2*)(F.ws + WS_PART); const int* IDX = (const int*)(F.ws + WS_IDX); const float* GATE = (const float*)(F.ws + WS_GATE);
    unsigned char* AB8 = F.ws + WS_AB;
    const f32x2* scl = (const f32x2*)(F.ws + WS_SCL) + (size_t)layer * 16384;
    const size_t n4 = (size_t)T * 128 / 4, stride = (size_t)F.G * 512;
    for (size_t i = (size_t)blockIdx.x * 512 + F.tid; i < n4; i += stride) {
        u32x2 pw[4];
#pragma unroll
        for (int p = 0; p < 4; ++p) pw[p] = PART[(size_t)p * T * 32 + i];
        const u32x4 e = ((const u32x4*)IDX)[i]; const f32x4 gt = ((const f32x4*)GATE)[i];
        const f32x2 c0 = scl[e.x], c1 = scl[e.y], c2 = scl[e.z], c3 = scl[e.w];
        f32x4 s = {0.f, 0.f, 0.f, 0.f};
#pragma unroll
        for (int p = 0; p < 4; ++p) { s.x += bflo(pw[p].x); s.y += bfhi(pw[p].x); s.z += bflo(pw[p].y); s.w += bfhi(pw[p].y); }
        f32x4 o;
        o.x = gelu_tanh(s.x * c0.x) * gt.x * c0.y; o.y = gelu_tanh(s.y * c1.x) * gt.y * c1.y;
        o.z = gelu_tanh(s.z * c2.x) * gt.z * c2.y; o.w = gelu_tanh(s.w * c3.x) * gt.w * c3.y;
        float am = fmaxf(fmaxf(fabsf(o.x), fabsf(o.y)), fmaxf(fabsf(o.z), fabsf(o.w)));
#pragma unroll
        for (int d = 1; d < 32; d <<= 1) am = fmaxf(am, __shfl_xor(am, d));
        const float S = am > 0.f ? 256.0f / am : 1.0f;
        int w = 0; w = __builtin_amdgcn_cvt_pk_fp8_f32(o.x * S, o.y * S, w, false); w = __builtin_amdgcn_cvt_pk_fp8_f32(o.z * S, o.w * S, w, true);
        const size_t t = i >> 5; const unsigned j = (unsigned)i & 31u;
        *(unsigned*)(AB8 + t * 256 + 4 * j) = (unsigned)w;
        if (j == 0) *(float*)(AB8 + t * 256 + 128) = am * (1.0f / 256.0f);
    }
}
__device__ __forceinline__ unsigned hadd2(unsigned a, unsigned b) { const h16x2 r = __builtin_bit_cast(h16x2, a) + __builtin_bit_cast(h16x2, b); return __builtin_bit_cast(unsigned, r); }
__device__ __forceinline__ f32x4 reduce_scatter32h_g(const unsigned (&v)[16], int lane) {
    const bool b2 = (lane & 32) != 0, b1 = (lane & 16) != 0, b0 = (lane & 8) != 0;
    unsigned u[8], w[4], z[2];
#pragma unroll
    for (int k = 0; k < 8; ++k) { const unsigned keep = b2 ? v[8 + k] : v[k], send = b2 ? v[k] : v[8 + k]; u[k] = hadd2(keep, (unsigned)__shfl_xor((int)send, 32)); }
#pragma unroll
    for (int k = 0; k < 4; ++k) { const unsigned keep = b1 ? u[4 + k] : u[k], send = b1 ? u[k] : u[4 + k]; w[k] = hadd2(keep, (unsigned)__shfl_xor((int)send, 16)); }
#pragma unroll
    for (int k = 0; k < 2; ++k) { const unsigned keep = b0 ? w[2 + k] : w[k], send = b0 ? w[k] : w[2 + k]; z[k] = hadd2(keep, (unsigned)__shfl_xor((int)send, 8)); }
    return (f32x4){hlo(z[0]), hhi(z[0]), hlo(z[1]), hhi(z[1])};
}
__device__ __forceinline__ void peer_up_phase4(const Frame& F, int layer) {
    const int bx = blockIdx.x, p4 = bx & 3, par = (bx >> 2) & 1;
    const unsigned char* TU = F.ws + WS_TAB + (size_t)(2 * layer + 1) * 16 * MiB + (size_t)p4 * (2 * MiB);
    const int* IDX = (const int*)(F.ws + WS_IDX); const char* AB = (const char*)(F.ws + WS_AB);
    const int nwp = (F.G - (bx & 7) + 7) >> 3, ww = (bx >> 3) * 8 + F.wave, stride = 2 * nwp * 8, tfirst = 2 * ww + par;
    const int lane = F.lane, r = lane & 7, g = lane >> 3, hoff = 256 * p4 + 32 * r + 4 * g;
    if (tfirst >= T) return;
    unsigned e1[16]; u32x4 wv[16];
    const unsigned toff = 16u * r;
    ld_off16(IDX, tfirst, g, toff, e1); gather16(TU, e1, wv);
    u32x4 a0a = *(const u32x4*)(AB + (unsigned)(tfirst * 256 + 32 * g)), a0b = *(const u32x4*)(AB + (unsigned)(tfirst * 256 + 32 * g + 16));
    { const int t1 = tfirst + stride < T ? tfirst + stride : tfirst; ld_off16(IDX, t1, g, toff, e1); }
    for (int t0 = tfirst; t0 < T; t0 += stride) {
        const int t1 = t0 + stride < T ? t0 + stride : t0, t2 = t0 + 2 * stride < T ? t0 + 2 * stride : t0;
        unsigned e2[16]; ld_off16(IDX, t2, g, toff, e2);
        const u32x4 a1a = *(const u32x4*)(AB + (unsigned)(t1 * 256 + 32 * g)), a1b = *(const u32x4*)(AB + (unsigned)(t1 * 256 + 32 * g + 16));
        f32x4* hp = (f32x4*)((char*)F.out + (unsigned)(t0 * 4096 + 4 * hoff)); const f32x4 h0 = *hp;
        const unsigned aw[8] = {a0a.x, a0a.y, a0a.z, a0a.w, a0b.x, a0b.y, a0b.z, a0b.w};
        unsigned y2[16];
#pragma unroll
        for (int k = 0; k < 16; ++k) y2[k] = 0u;
#pragma unroll
        for (int i = 0; i < 16; ++i) { u32x4 w = wv[i]; wv[i] = *(const u32x4*)(TU + e1[i]);
            if (i > 0) asm volatile("" : "+v"(w.x), "+v"(w.y), "+v"(w.z), "+v"(w.w) : "v"(y2[0]), "v"(y2[15]));
            const float ai = (i & 1) ? bfhi(aw[i >> 1]) : bflo(aw[i >> 1]); const h16x2 av = {(_Float16)ai, (_Float16)ai};
            const unsigned ww4[4] = {w.x, w.y, w.z, w.w};
#pragma unroll
            for (int k = 0; k < 4; ++k) {
                { const h16x2 r = av * __builtin_amdgcn_cvt_scalef32_pk_f16_fp4(ww4[k], 1.0f, 0) + __builtin_bit_cast(h16x2, y2[4 * k]); y2[4 * k] = __builtin_bit_cast(unsigned, r); }
                { const h16x2 r = av * __builtin_amdgcn_cvt_scalef32_pk_f16_fp4(ww4[k], 1.0f, 1) + __builtin_bit_cast(h16x2, y2[4 * k + 1]); y2[4 * k + 1] = __builtin_bit_cast(unsigned, r); }
                { const h16x2 r = av * __builtin_amdgcn_cvt_scalef32_pk_f16_fp4(ww4[k], 1.0f, 2) + __builtin_bit_cast(h16x2, y2[4 * k + 2]); y2[4 * k + 2] = __builtin_bit_cast(unsigned, r); }
                { const h16x2 r = av * __builtin_amdgcn_cvt_scalef32_pk_f16_fp4(ww4[k], 1.0f, 3) + __builtin_bit_cast(h16x2, y2[4 * k + 3]); y2[4 * k + 3] = __builtin_bit_cast(unsigned, r); } } }
        const f32x4 z = reduce_scatter32h_g(y2, lane);
        *hp = h0 + z;
        a0a = a1a; a0b = a1b;
#pragma unroll
        for (int i = 0; i < 16; ++i) e1[i] = e2[i];
    }
}

constexpr int U5_AUX = 131072;
__device__ __forceinline__ void peer_up_phase5(const Frame& F, int layer) {
    const int bx = blockIdx.x, p4 = bx & 3, par = (bx >> 2) & 1;
    const unsigned char* TU = F.ws + WS_TAB + (size_t)(2 * layer + 1) * 16 * MiB + (size_t)p4 * (2 * MiB);
    const char* IDX = (const char*)(F.ws + WS_IDX); const char* AB8 = (const char*)(F.ws + WS_AB);
    const char* HIN = (const char*)F.out + 512 * p4; char* OUT = (layer == 1 ? (char*)(F.ws + WS_H2) : (char*)F.out) + 512 * p4;
    const int nwp = (F.G - (bx & 7) + 7) >> 3, ww = (bx >> 3) * 8 + F.wave, stride = 2 * nwp * 8, tfirst = 2 * ww + par;
    if (tfirst >= T) return;
    const int lane = F.lane, rs = lane >> 3, sg = lane & 7, m = lane & 15, kg = lane >> 4;
    LAS unsigned char* wl = F.lds + F.wave * 16384; LAS unsigned char* xl = F.lds + U5_AUX + F.wave * 3584;
    const unsigned sw0 = (unsigned)((sg ^ kg) * 16), sw1 = (unsigned)((sg ^ (4 + kg)) * 16);
    const unsigned l4 = 4u * lane, l16 = 16u * lane;
    unsigned tb[8];
#pragma unroll
    for (int sgm = 0; sgm < 8; ++sgm) tb[sgm] = (unsigned)((32 * kg + m) * 128 + ((sgm ^ (m >> 1)) * 16));
    const unsigned hrd = (unsigned)(32 * m + 8 * kg);
#define U5_PIECE(ixv, d) __builtin_amdgcn_global_load_lds((const unsigned*)(TU + ((ixv)[d] * 128u + (((d) & 1) ? sw1 : sw0))), (LAS unsigned*)(wl + (d) * 1024), 16, 0, 0)
#define U5_DMA_IDX(t, slot) do { __builtin_amdgcn_global_load_lds((const unsigned*)(IDX + (unsigned)((t) * 512) + l4), (LAS unsigned*)(xl + (slot) * 512), 4, 0, 0); \
                                 __builtin_amdgcn_global_load_lds((const unsigned*)(IDX + (unsigned)((t) * 512) + 256u + l4), (LAS unsigned*)(xl + (slot) * 512 + 256), 4, 0, 0); } while (0)
#define U5_DMA_AB(t, slot) __builtin_amdgcn_global_load_lds((const unsigned*)(AB8 + (unsigned)((t) * 256) + l4), (LAS unsigned*)(xl + 1024 + (slot) * 256), 4, 0, 0)
#define U5_DMA_H(t, slot) do { __builtin_amdgcn_global_load_lds((const unsigned*)(HIN + (unsigned)((t) * 2048) + l4), (LAS unsigned*)(xl + 1536 + (slot) * 1024), 4, 0, 0); \
                               __builtin_amdgcn_global_load_lds((const unsigned*)(HIN + (unsigned)((t) * 2048) + 256u + l4), (LAS unsigned*)(xl + 1536 + (slot) * 1024 + 256), 4, 0, 0); } while (0)
    { unsigned i0[16];
#pragma unroll
      for (int d = 0; d < 16; ++d) i0[d] = *(const unsigned*)(IDX + (unsigned)(tfirst * 512) + (unsigned)(4 * rs + 32 * d));
#pragma unroll
      for (int d = 0; d < 16; ++d) asm volatile("" : "+v"(i0[d]) :: "memory");
      { const int t1 = tfirst + stride < T ? tfirst + stride : tfirst; U5_DMA_IDX(t1, 1); U5_DMA_AB(tfirst, 0); U5_DMA_H(tfirst, 0); }
      asm volatile("" ::: "memory");
#pragma unroll
      for (int d = 0; d < 16; ++d) U5_PIECE(i0, d); }
    int sl = 0, tprev = -1; f32x4 pend = {0.f, 0.f, 0.f, 0.f};
    for (int t0 = tfirst; t0 < T; t0 += stride, sl ^= 1) {
        const int t1 = t0 + stride < T ? t0 + stride : t0, t2 = t0 + 2 * stride < T ? t0 + 2 * stride : t0;
        asm volatile("s_waitcnt vmcnt(0)" ::: "memory");
        unsigned ix[16];
        { const LAS unsigned* ip = (const LAS unsigned*)(xl + (sl ^ 1) * 512 + 4 * rs);
#pragma unroll
          for (int d = 0; d < 16; ++d) ix[d] = ip[8 * d]; }
        const LAS u32x4* bp = (const LAS u32x4*)(xl + 1024 + sl * 256 + 16 * kg); u32x4 bl = bp[0], bh = bp[4];
        float inv = *(const LAS float*)(xl + 1024 + sl * 256 + 128);
        u32x2 hw = *(const LAS u32x2*)(xl + 1536 + sl * 1024 + hrd);
        i32x2 a0[16], a1[16];
#pragma unroll
        for (int cb = 0; cb < 16; ++cb) {
            a0[cb] = __builtin_amdgcn_ds_read_tr4_b64_v2i32((LAS i32x2*)(wl + tb[cb >> 1] + (cb & 1) * 8));
            a1[cb] = __builtin_amdgcn_ds_read_tr4_b64_v2i32((LAS i32x2*)(wl + tb[cb >> 1] + (cb & 1) * 8 + 2048)); }
        asm volatile("s_waitcnt lgkmcnt(0)" : "+v"(bl), "+v"(bh), "+v"(inv), "+v"(hw) :: "memory");
#pragma unroll
        for (int d = 0; d < 16; ++d) asm volatile("" : "+v"(ix[d]), "+v"(a0[d]), "+v"(a1[d]) :: "memory");
        if (tprev >= 0) *(u32x2*)(OUT + (unsigned)(tprev * 2048) + hrd) = (u32x2){pk2(pend.x, pend.y), pk2(pend.z, pend.w)};
        asm volatile("" ::: "memory");
        U5_DMA_IDX(t2, sl); U5_DMA_AB(t1, sl ^ 1); U5_DMA_H(t1, sl ^ 1);
#pragma unroll
        for (int d = 0; d < 16; ++d) U5_PIECE(ix, d);
        asm volatile("" ::: "memory");
        const i32x8 b = {(int)bl.x, (int)bl.y, (int)bl.z, (int)bl.w, (int)bh.x, (int)bh.y, (int)bh.z, (int)bh.w};
        const f32x4 z = {0.f, 0.f, 0.f, 0.f};
        f32x4 v = z;
#pragma unroll
        for (int cb = 0; cb < 16; ++cb) {
            const i32x8 a = {a0[cb].x, a0[cb].y, a1[cb].x, a1[cb].y, 0, 0, 0, 0};
            const f32x4 r = __builtin_amdgcn_mfma_scale_f32_16x16x128_f8f6f4(a, b, z, 4, 0, 0, 0, 0, 0);
            v = (m == cb) ? r : v; }
        pend = (f32x4){bflo(hw.x), bfhi(hw.x), bflo(hw.y), bfhi(hw.y)} + v * inv; tprev = t0;
    }
    asm volatile("s_waitcnt vmcnt(0)" ::: "memory");
    *(u32x2*)(OUT + (unsigned)(tprev * 2048) + hrd) = (u32x2){pk2(pend.x, pend.y), pk2(pend.z, pend.w)};
#undef U5_PIECE
#undef U5_DMA_IDX
#undef U5_DMA_AB
#undef U5_DMA_H
}

constexpr int SGM_VT = 0, SGM_WL = 384 * 272, SGM_STAT = SGM_WL + 128 * 272;
__device__ __forceinline__ void sg_mix_phase(const Frame& F) {
    bf16_t* V = (bf16_t*)(F.ws + WS_SG);
    const float* lng = F.in[7]; const float* lnb = F.in[8]; const float* wsp = F.in[9]; const float* bsp = F.in[10];
    LAS unsigned* VT32 = (LAS unsigned*)(F.lds + SGM_VT); LAS bf16_t* VT = (LAS bf16_t*)(F.lds + SGM_VT); LAS bf16_t* WL = (LAS bf16_t*)(F.lds + SGM_WL);
    LAS float* stat = (LAS float*)(F.lds + SGM_STAT);
    const int lane = F.lane, tid = F.tid, fr = lane & 15, fq = lane >> 4;
    for (int c = blockIdx.x; c < 256; c += F.G) {
#pragma unroll 1
        for (int r = 0; r < 16; ++r) {
            const int q = F.wave * 16 + r; const u32x4* row = (const u32x4*)(V + (size_t)(c * 128 + q) * DG);
            float v[48]; float s = 0.f;
#pragma unroll
            for (int i = 0; i < 6; ++i) { const u32x4 w = row[lane + 64 * i];
                v[8 * i + 0] = bflo(w.x); v[8 * i + 1] = bfhi(w.x); v[8 * i + 2] = bflo(w.y); v[8 * i + 3] = bfhi(w.y); v[8 * i + 4] = bflo(w.z); v[8 * i + 5] = bfhi(w.z); v[8 * i + 6] = bflo(w.w); v[8 * i + 7] = bfhi(w.w); }
#pragma unroll
            for (int i = 0; i < 48; ++i) s += v[i];
            const float mean = wave_sum(s) * (1.f / DG); float s2 = 0.f;
#pragma unroll
            for (int i = 0; i < 48; ++i) { const float d = v[i] - mean; s2 += d * d; }
            const float rstd = 1.0f / sqrtf(wave_sum(s2) * (1.f / DG) + 1e-5f);
            if (lane == 0) { stat[2 * q] = mean; stat[2 * q + 1] = rstd; }
        }
        __syncthreads();
#pragma unroll 1
        for (int g = 0; g < 8; ++g) {
#pragma unroll 1
            for (int it = 0; it < 4; ++it) { const int item = it * 512 + tid, p = item >> 4, q8 = (item & 15) * 8;
                const f32x4* wp = (const f32x4*)(wsp + ((size_t)g * 128 + p) * 128 + q8); const f32x4 a = wp[0], b = wp[1];
                u32x4 w; w.x = pk2(a.x, a.y); w.y = pk2(a.z, a.w); w.z = pk2(b.x, b.y); w.w = pk2(b.z, b.w);
                *(LAS u32x4*)(WL + p * 136 + q8) = w; }
#pragma unroll 1
            for (int it = 0; it < 6; ++it) { const int item = it * 512 + tid, qp = item & 63, dc = item >> 6; const int q0 = 2 * qp, col = g * 384 + 8 * dc;
                const u32x4 w0 = *(const u32x4*)(V + (size_t)(c * 128 + q0) * DG + col), w1 = *(const u32x4*)(V + (size_t)(c * 128 + q0 + 1) * DG + col);
                const float mu0 = stat[2 * q0], rs0 = stat[2 * q0 + 1], mu1 = stat[2 * q0 + 2], rs1 = stat[2 * q0 + 3];
                const f32x4 ga = *(const f32x4*)(lng + col), gb = *(const f32x4*)(lng + col + 4), ba = *(const f32x4*)(lnb + col), bb = *(const f32x4*)(lnb + col + 4);
                const float gm[8] = {ga.x, ga.y, ga.z, ga.w, gb.x, gb.y, gb.z, gb.w}, bt[8] = {ba.x, ba.y, ba.z, ba.w, bb.x, bb.y, bb.z, bb.w};
                const float a0[8] = {bflo(w0.x), bfhi(w0.x), bflo(w0.y), bfhi(w0.y), bflo(w0.z), bfhi(w0.z), bflo(w0.w), bfhi(w0.w)};
                const float a1[8] = {bflo(w1.x), bfhi(w1.x), bflo(w1.y), bfhi(w1.y), bflo(w1.z), bfhi(w1.z), bflo(w1.w), bfhi(w1.w)};
#pragma unroll
                for (int i = 0; i < 8; ++i) VT32[(8 * dc + i) * 68 + qp] = pk2((a0[i] - mu0) * rs0 * gm[i] + bt[i], (a1[i] - mu1) * rs1 * gm[i] + bt[i]); }
            __syncthreads();
            f32x4 acc[3][8];
#pragma unroll
            for (int a = 0; a < 3; ++a)
#pragma unroll
                for (int n = 0; n < 8; ++n) acc[a][n] = (f32x4){0.f, 0.f, 0.f, 0.f};
#pragma unroll 1
            for (int ks = 0; ks < 4; ++ks) { const int k0 = 32 * ks + 8 * fq;
                bf16x8 af[3], bfg[8];
#pragma unroll
                for (int a = 0; a < 3; ++a) af[a] = *(const LAS bf16x8*)(VT + (16 * (3 * F.wave + a) + fr) * 136 + k0);
#pragma unroll
                for (int n = 0; n < 8; ++n) bfg[n] = *(const LAS bf16x8*)(WL + (16 * n + fr) * 136 + k0);
#pragma unroll
                for (int a = 0; a < 3; ++a)
#pragma unroll
                    for (int n = 0; n < 8; ++n) acc[a][n] = __builtin_amdgcn_mfma_f32_16x16x32_bf16(af[a], bfg[n], acc[a][n], 0, 0, 0); }
#pragma unroll
            for (int n = 0; n < 8; ++n) { const int p = 16 * n + fr; const float bs = bsp[g * 128 + p];
#pragma unroll
                for (int a = 0; a < 3; ++a) { const int d0 = 16 * (3 * F.wave + a) + 4 * fq;
                    u32x2 w; w.x = pk2(acc[a][n][0] + bs, acc[a][n][1] + bs); w.y = pk2(acc[a][n][2] + bs, acc[a][n][3] + bs);
                    *(u32x2*)(V + (size_t)(c * 128 + p) * DG + g * 384 + d0) = w; } }
            __syncthreads();
        }
    }
}

__global__ void __launch_bounds__(512, 2) fwd(Args args) {
    extern __shared__ __attribute__((aligned(16))) unsigned char lds_raw[];
    Frame F;
    F.lds = (LAS unsigned char*)lds_raw;
    F.tid = threadIdx.x; F.lane = F.tid & 63; F.wave = __builtin_amdgcn_readfirstlane(F.tid >> 6);
    F.G = gridDim.x; F.gw = blockIdx.x * 8 + F.wave; F.NGW = F.G * 8;
    F.in = args.in; F.out = args.out; F.ws = args.ws;
    volatile LAS unsigned* MISC = (volatile LAS unsigned*)(F.lds + MISC_OFF);
    if (F.tid < 64) MISC[F.tid] = 0u;
    __syncthreads();
    const int lo = args.ph_lo, hi = args.ph_hi;
    unsigned* barw = (unsigned*)(F.ws + WS_CTL) + CW_BAR;
    XcdBarrier bar; bar.bar = barw; bar.x = 0; bar.st = MISC + 8;
    if (hi - lo > 1) bar = xcd_barrier_post(barw, MISC + 8);
#define IN(k) (lo <= (k) && (k) < hi)
#define SEAM(k) do { if (IN(k) && IN((k) + 1)) xcd_barrier(bar); } while (0)
    const int G = F.G, bx = blockIdx.x;
    bf16_t* HN = (bf16_t*)(F.ws + WS_HN); bf16_t* HB = (bf16_t*)F.out;

    if (IN(0)) { p0_prologue(F); } SEAM(0);
    if (IN(1)) {
        const bf16_t* HN8 = (const bf16_t*)(F.ws + WS_HN8B);
        { pg8::Gemm g{HN8, (const bf16_t*)(F.ws + WS_WQK), T, NQK, D / 2}; pg8::StaticOrder S; S.init(T, NQK, G, bx);
          pg8::EpiBf<3> E{(bf16_t*)(F.ws + WS_Q), 1024, (bf16_t*)(F.ws + WS_K), 1.0f / W8_SCALE};
          pg8::gemm_phase<1>(F.lds, g, S, E); }
        __syncthreads();
        { pg8::Gemm g{(const bf16_t*)(F.ws + WS_WV), HN8, 256, T, D / 2}; pg8::StaticOrder S; S.init(256, T, G, (bx + G / 2) % G);
          pg8::EpiBf<0> E{(bf16_t*)(F.ws + WS_VT), T, nullptr, 1.0f / W8_SCALE};
          pg8::gemm_phase<1>(F.lds, g, S, E); }
    } SEAM(1);
    if (IN(2)) { attn_phase_v2(F); } SEAM(2);
    if (IN(3)) {
        pg8::Gemm g{(const bf16_t*)(F.ws + WS_AO), (const bf16_t*)(F.ws + WS_WO), T, D, D / 2}; pg8::StaticOrder S; S.init(T, D, G, bx);
        pg8::EpiBf<6> E{HB, D, (bf16_t*)F.in[0], 1.0f / (W8_SCALE * AO8_SCALE)};
        pg8::gemm_phase<1>(F.lds, g, S, E);
    } SEAM(3);
    if (IN(4)) { quant_weights(F); rmsnorm_rows_bf(F, HB, F.in[12], nullptr, F.ws + WS_HN8, F.ws + WS_HNI8, (float*)(F.ws + WS_HSC)); } SEAM(4);
    if (IN(5)) {
        pg8::Gemm g{(const bf16_t*)(F.ws + WS_HNI8), (const bf16_t*)(F.ws + WS_WQ8), T, 2048, D / 2}; pg8::StaticOrder S; S.init(T, 2048, G, bx);
        pg8::EpiBf<4, true> E{(bf16_t*)(F.ws + WS_S), 2048, nullptr, 1.0f, (const float*)(F.ws + WS_HSC), (const float*)(F.ws + WS_CTL) + CW_WSCL};
        pg8::gemm_phase<2>(F.lds, g, S, E);
    } SEAM(5);
    if (IN(6)) { topk_phase_v3(F); } SEAM(6);
    if (IN(7)) { peer_down_phase5(F, 0); } SEAM(7);
    if (IN(8)) { peer_reduce_phase8(F, 0); } SEAM(8);
    if (IN(9)) { peer_up_phase5(F, 0); } SEAM(9);
    if (IN(10)) { rmsnorm_rows_bf(F, HB, F.in[2] + D, nullptr, nullptr, F.ws + WS_HNI8, (float*)(F.ws + WS_HSC)); } SEAM(10);
    if (IN(11)) {
        pg8::Gemm g{(const bf16_t*)(F.ws + WS_HNI8), (const bf16_t*)(F.ws + WS_SGW8), T, DG, D / 2}; pg8::StaticOrder S; S.init(T, DG, G, bx);
        pg8::EpiBf<1, true> E{(bf16_t*)(F.ws + WS_SG), DG, nullptr, 1.0f, (const float*)(F.ws + WS_HSC), (const float*)(F.ws + WS_CTL) + CW_WSCL2};
        pg8::gemm_phase<2>(F.lds, g, S, E);
    } SEAM(11);
    if (IN(12)) { sg_mix_phase(F); } SEAM(12);
    if (IN(13)) {
        pg8::Gemm g{(const bf16_t*)(F.ws + WS_HNI8), (const bf16_t*)(F.ws + WS_SGW8 + (size_t)3072 * 1024), T, DG, D / 2}; pg8::StaticOrder S; S.init(T, DG, G, bx);
        pg8::EpiBf<5, true> E{(bf16_t*)(F.ws + WS_SG), DG, (bf16_t*)(F.ws + WS_SG8), 1.0f, (const float*)(F.ws + WS_HSC), (const float*)(F.ws + WS_CTL) + CW_WSCL2 + 3072};
        pg8::gemm_phase<2>(F.lds, g, S, E);
    } SEAM(13);
    if (IN(14)) {
        pg8::Gemm g{(const bf16_t*)(F.ws + WS_SG8), (const bf16_t*)(F.ws + WS_WSGO), T, D, DG / 2}; pg8::StaticOrder S; S.init(T, D, G, bx);
        pg8::EpiBf<7> E{HB, D, nullptr, 1.0f / W8_SCALE};
        pg8::gemm_phase<1>(F.lds, g, S, E);
    } SEAM(14);
    if (IN(15)) { rmsnorm_rows_bf(F, HB, F.in[12] + D, nullptr, F.ws + WS_HN8, F.ws + WS_HNI8, (float*)(F.ws + WS_HSC)); } SEAM(15);
    if (IN(16)) {
        pg8::Gemm g{(const bf16_t*)(F.ws + WS_HNI8), (const bf16_t*)(F.ws + WS_WQ8 + (size_t)2048 * 1024), T, 2048, D / 2}; pg8::StaticOrder S; S.init(T, 2048, G, bx);
        pg8::EpiBf<4, true> E{(bf16_t*)(F.ws + WS_S), 2048, nullptr, 1.0f, (const float*)(F.ws + WS_HSC), (const float*)(F.ws + WS_CTL) + CW_WSCL + 2048};
        pg8::gemm_phase<2>(F.lds, g, S, E);
    } SEAM(16);
    if (IN(17)) { topk_phase_v3(F); } SEAM(17);
    if (IN(18)) { peer_down_phase5(F, 1); } SEAM(18);
    if (IN(19)) { peer_reduce_phase8(F, 1); } SEAM(19);
    if (IN(20)) { peer_up_phase5(F, 1); } SEAM(20);
    if (IN(21)) { final_norm_bf(F, (const bf16_t*)(F.ws + WS_H2), F.out, F.in[17]); }
#undef IN
#undef SEAM
}

extern "C" void kernel_launch(void* const* d_in, const int* in_sizes, int n_in, void* d_out, int out_size, void* d_ws, size_t ws_size, hipStream_t stream) {
    static int grid = 0;
    if (grid == 0) {
        if (n_in != 18 || out_size != T * D || ws_size < WS_END) { fprintf(stderr, "kernel_launch: unexpected problem (n_in %d, out %d, ws %zu)\n", n_in, out_size, ws_size); grid = -1; return; }
        int dev = 0, cus = 0, per_cu = 0;
        if (hipGetDevice(&dev) != hipSuccess || hipDeviceGetAttribute(&cus, hipDeviceAttributeMultiprocessorCount, dev) != hipSuccess) { grid = -1; return; }
        if (hipFuncSetAttribute((const void*)fwd, hipFuncAttributeMaxDynamicSharedMemorySize, LDS_BYTES) != hipSuccess) { fprintf(stderr, "kernel_launch: hipFuncSetAttribute failed\n"); grid = -1; return; }
        if (hipOccupancyMaxActiveBlocksPerMultiprocessor(&per_cu, (const void*)fwd, 512, LDS_BYTES) != hipSuccess || per_cu < 1) fprintf(stderr, "kernel_launch: occupancy query says %d\n", per_cu);
        (void)hipGetLastError();
        grid = cus;
    }
    if (grid < 0) return;
    (void)hipMemsetAsync((char*)d_ws + WS_CTL, 0, CTL_ZERO_BYTES, stream);
    Args a{};
    for (int i = 0; i < 18; ++i) a.in[i] = (const float*)d_in[i];
    a.out = (float*)d_out; a.ws = (unsigned char*)d_ws;
#if MK_ONE_LAUNCH
    a.ph_lo = 0; a.ph_hi = NPH;
    hipLaunchKernelGGL(fwd, dim3(grid), dim3(512), LDS_BYTES, stream, a);
#else
    for (int ph = 0; ph < NPH; ++ph) {
        a.ph_lo = ph; a.ph_hi = ph + 1;
        hipLaunchKernelGGL(fwd, dim3(grid), dim3(512), LDS_BYTES, stream, a);
    }
#endif
}
```

```cpp
#include <hip/hip_runtime.h>
#include <cstdio>

#ifndef MK_ONE_LAUNCH
#define MK_ONE_LAUNCH 1
#endif

#define LAS __attribute__((address_space(3)))
#define GAS __attribute__((address_space(1)))
typedef unsigned short bf16_t;
typedef short bf16x8 __attribute__((ext_vector_type(8)));
typedef float f32x4 __attribute__((ext_vector_type(4)));
typedef float f32x2 __attribute__((ext_vector_type(2)));
typedef unsigned u32x4 __attribute__((ext_vector_type(4)));
typedef unsigned u32x2 __attribute__((ext_vector_type(2)));
typedef int i32x8 __attribute__((ext_vector_type(8)));
typedef int i32x2 __attribute__((ext_vector_type(2)));
typedef int i32x4 __attribute__((ext_vector_type(4)));

constexpr int T = 32768, D = 1024, SEQ = 2048;
constexpr int DG = 3072;
constexpr int NQK = 1280;
constexpr int NPH = 22;

constexpr size_t MiB = 1u << 20;
constexpr size_t WS_CTL = 0, CTL_ZERO_BYTES = 1 * MiB;
constexpr size_t WS_BIAS = 1 * MiB;
constexpr size_t WS_WQK = 2 * MiB;
constexpr size_t WS_WV = WS_WQK + (size_t)1280 * 1024 * 2;
constexpr size_t WS_WO = 5 * MiB;
constexpr size_t WS_WSGV = 7 * MiB;
constexpr size_t WS_WSGU = 13 * MiB;
constexpr size_t WS_WSGO = 19 * MiB;
constexpr size_t WS_WQKP = 25 * MiB;
constexpr size_t WS_HN = 34 * MiB;
constexpr size_t WS_SCL = 1 * MiB + 64 * 1024;
constexpr size_t WS_TAB = 98 * MiB;
constexpr size_t WS_IDX = 162 * MiB;
constexpr size_t WS_GATE = 178 * MiB;
constexpr size_t WS_SCR = 194 * MiB;
constexpr size_t WS_Q = WS_SCR, WS_K = WS_SCR + 64 * MiB, WS_VT = WS_SCR + 80 * MiB, WS_AO = WS_SCR + 96 * MiB;
constexpr size_t WS_S = WS_SCR;
constexpr size_t WS_SG = WS_SCR;
constexpr size_t WS_PART = WS_SCR;
constexpr size_t WS_AB = WS_SCR + 128 * MiB;
constexpr size_t WS_HN8 = WS_SCR + 200 * MiB;
constexpr size_t WS_END = WS_SCR + 292 * MiB;
constexpr int CW_BAR = 4096;
constexpr int CW_COLMAX = 16384;
constexpr int CW_WSCL = 32768;
constexpr size_t WS_WQ8 = WS_SCR + 288 * MiB;
constexpr size_t WS_HNI8 = 34 * MiB;
constexpr size_t WS_HSC = 34 * MiB + 32 * MiB;
constexpr size_t WS_H2 = WS_SCR + 32 * MiB;
constexpr float AO8_SCALE = 8.0f;
constexpr float W8_SCALE = 256.0f;
constexpr size_t WS_HN8B = WS_IDX;
constexpr size_t WS_SG8 = WS_SCR + 192 * MiB;

constexpr int LDS_BYTES = 163840;
constexpr int MISC_OFF = LDS_BYTES - 256;

typedef __bf16 bfx2 __attribute__((ext_vector_type(2)));
__device__ __forceinline__ unsigned pk2(float lo, float hi) { const bfx2 v = {(__bf16)lo, (__bf16)hi}; return __builtin_bit_cast(unsigned, v); }
__device__ __forceinline__ unsigned f2bf(float f) { return pk2(f, 0.f) & 0xffffu; }
typedef _Float16 h16x2 __attribute__((ext_vector_type(2)));
__device__ __forceinline__ unsigned pkh2(float lo, float hi) { const h16x2 h = {(_Float16)lo, (_Float16)hi}; return __builtin_bit_cast(unsigned, h); }
__device__ __forceinline__ float hlo(unsigned w) { return (float)__builtin_bit_cast(h16x2, w).x; }
__device__ __forceinline__ float hhi(unsigned w) { return (float)__builtin_bit_cast(h16x2, w).y; }
__device__ __forceinline__ float bflo(unsigned w) { return __builtin_bit_cast(float, w << 16); }
__device__ __forceinline__ float bfhi(unsigned w) { return __builtin_bit_cast(float, w & 0xffff0000u); }
__device__ __forceinline__ float bf2f(bf16_t b) { return __builtin_bit_cast(float, ((unsigned)b) << 16); }
__device__ __forceinline__ float wave_sum(float v) {
#pragma unroll
    for (int o = 1; o < 64; o <<= 1) v += __shfl_xor(v, o);
    return v;
}
__device__ __forceinline__ float wave_max(float v) {
#pragma unroll
    for (int o = 1; o < 64; o <<= 1) v = fmaxf(v, __shfl_xor(v, o));
    return v;
}
__device__ __forceinline__ unsigned wave_max_u(unsigned v) {
#pragma unroll
    for (int o = 1; o < 64; o <<= 1) { const unsigned w = (unsigned)__shfl_xor((int)v, o); v = w > v ? w : v; }
    return v;
}
__device__ __forceinline__ float gelu_tanh(float x) {
    const float u = x * (-2.302208198144325f) * (1.0f + 0.044715f * x * x);
    return x * __builtin_amdgcn_rcpf(1.0f + __builtin_amdgcn_exp2f(u));
}
#define LDS_WAIT() asm volatile("s_waitcnt lgkmcnt(0)" ::: "memory")
#define VM_WAIT() asm volatile("s_waitcnt vmcnt(0)" ::: "memory")

namespace pg8 {
#define PG8_LAS __attribute__((address_space(3)))
constexpr int BM = 256, BK = 64, HALF = 128, HTB = HALF * BK * 2, STAGE_BYTES = 8 * HTB, NXCD = 8, WGM = 8;
__host__ __device__ __forceinline__ int lds_byte(int r, int c) { const int st = (r >> 4) * 2 + (c >> 5), rr = r & 15, cc = c & 31, ob = rr * 64 + cc * 2; return st * 1024 + (ob ^ (((ob >> 9) & 1) << 5)); }
__host__ __device__ __forceinline__ void stage_rc(int b, int& R, int& C) { const int st = b / 1024, sb = b % 1024, swz = sb ^ (((sb >> 9) & 1) << 5); R = (st >> 1) * 16 + swz / 64; C = (st & 1) * 32 + (swz % 64) / 2; }
__host__ __device__ __forceinline__ int perm32(int rho) { const int n = rho >> 4, i = rho & 15; return 8 * (i >> 2) + 4 * n + (i & 3); }
struct Unit { int pm, pn; };
struct Gemm { const bf16_t* A; const bf16_t* Bt; int M, N, K; };
struct StaticOrder {
    int nM, nN, nwg, G, c;
    __host__ __device__ void init(int M, int N, int G_, int c_) { nM = M / BM; nN = N / BM; nwg = nM * nN; G = G_; c = c_; }
    __host__ __device__ bool next(int i, Unit& u) const {
        const long L = (long)i * G + c; if (L >= nwg) return false;
        int wgid = (int)L; { const int q = nwg / NXCD, r = nwg % NXCD, xcd = wgid % NXCD, off = wgid / NXCD; wgid = (xcd < r ? xcd * (q + 1) : r * (q + 1) + (xcd - r) * q) + off; }
        const int nig = WGM * nN, gid = wgid / nig, fm = gid * WGM, gsz = (nM - fm) < WGM ? (nM - fm) : WGM;
        u.pm = fm + ((wgid % nig) % gsz); u.pn = (wgid % nig) / gsz; return true;
    }
    __device__ __forceinline__ void a_ready(const Unit&) const {}
    __device__ __forceinline__ void done(const Unit&) const {}
};

template <int MODE> struct EpiBf {
    static constexpr bool PERM = true, AFTER_DRAIN = false;
    bf16_t* O; int ldc; bf16_t* O2; float sc = 1.0f; const float* aux = nullptr;
    __device__ __forceinline__ void operator()(const f32x4 (&acc)[2][2][4][2], const Unit& u, int wr, int wc, int fr, int fq) const {
        const int row0 = u.pm * BM + wr * 64 + fr; int colt = u.pn * BM; bf16_t* base = O; int ld = ldc;
        if (MODE == 3) { if (u.pn >= 4) { base = O2; ld = 256; colt = 0; } else { ld = 1024; } }
        const int col0 = colt + wc * 32 + 8 * fq;
#pragma unroll
        for (int ai = 0; ai < 2; ++ai)
#pragma unroll
            for (int m = 0; m < 4; ++m) { bf16_t* rowp = base + (size_t)(row0 + ai * HALF + m * 16) * ld + col0;
#pragma unroll
                for (int bj = 0; bj < 2; ++bj) { f32x4 v0 = acc[ai][bj][m][0], v1 = acc[ai][bj][m][1];
                    if (MODE == 8) { const float rs = ((const float*)O2)[row0 + ai * HALF + m * 16]; const f32x4* cp = (const f32x4*)(aux + col0 + bj * HALF); const f32x4 c0 = cp[0] * rs, c1 = cp[1] * rs;
                        const i32x4 i0 = __builtin_bit_cast(i32x4, v0), i1 = __builtin_bit_cast(i32x4, v1);
                        v0 = (f32x4){(float)i0.x, (float)i0.y, (float)i0.z, (float)i0.w} * c0; v1 = (f32x4){(float)i1.x, (float)i1.y, (float)i1.z, (float)i1.w} * c1; }
                    if (MODE == 0 || MODE == 3) {
#pragma unroll
                        for (int j = 0; j < 4; ++j) { v0[j] *= sc; v1[j] *= sc; } }
                    if (MODE == 6) { const f32x4* xp = (const f32x4*)((const float*)O2 + (size_t)(row0 + ai * HALF + m * 16) * ld + col0 + bj * HALF); v0 = xp[0] + v0 * sc; v1 = xp[1] + v1 * sc; }
                    if (MODE == 7) { const u32x4 hv = *(const u32x4*)(rowp + bj * HALF);
                        v0[0] = bflo(hv.x) + v0[0] * sc; v0[1] = bfhi(hv.x) + v0[1] * sc; v0[2] = bflo(hv.y) + v0[2] * sc; v0[3] = bfhi(hv.y) + v0[3] * sc;
                        v1[0] = bflo(hv.z) + v1[0] * sc; v1[1] = bfhi(hv.z) + v1[1] * sc; v1[2] = bflo(hv.w) + v1[2] * sc; v1[3] = bfhi(hv.w) + v1[3] * sc; }
                    if (MODE == 1 || MODE == 2 || MODE == 5) {
#pragma unroll
                        for (int j = 0; j < 4; ++j) { v0[j] = gelu_tanh(v0[j] * sc); v1[j] = gelu_tanh(v1[j] * sc); } }
                    if (MODE == 2 || MODE == 5) { const u32x4 mv = *(const u32x4*)(rowp + bj * HALF);
                        v0[0] *= bflo(mv.x); v0[1] *= bfhi(mv.x); v0[2] *= bflo(mv.y); v0[3] *= bfhi(mv.y);
                        v1[0] *= bflo(mv.z); v1[1] *= bfhi(mv.z); v1[2] *= bflo(mv.w); v1[3] *= bfhi(mv.w); }
                    if (MODE == 5) { int w0 = 0, w1 = 0;
                        w0 = __builtin_amdgcn_cvt_pk_fp8_f32(v0[0], v0[1], w0, false); w0 = __builtin_amdgcn_cvt_pk_fp8_f32(v0[2], v0[3], w0, true);
                        w1 = __builtin_amdgcn_cvt_pk_fp8_f32(v1[0], v1[1], w1, false); w1 = __builtin_amdgcn_cvt_pk_fp8_f32(v1[2], v1[3], w1, true);
                        *(u32x2*)((unsigned char*)O2 + (size_t)(row0 + ai * HALF + m * 16) * ld + col0 + bj * HALF) = (u32x2){(unsigned)w0, (unsigned)w1}; continue; }
                    u32x4 w;
                    if (MODE == 4 || MODE == 8) { w.x = pkh2(v0[0], v0[1]); w.y = pkh2(v0[2], v0[3]); w.z = pkh2(v1[0], v1[1]); w.w = pkh2(v1[2], v1[3]); }
                    else { w.x = pk2(v0[0], v0[1]); w.y = pk2(v0[2], v0[3]); w.z = pk2(v1[0], v1[1]); w.w = pk2(v1[2], v1[3]); }
                    *(u32x4*)(rowp + bj * HALF) = w; } }
    }
};
template <int MODE> struct EpiF32 {
    static constexpr bool PERM = false, AFTER_DRAIN = false;
    float* C; int ldc; const float* B; float sc = 1.0f;
    __device__ __forceinline__ void operator()(const f32x4 (&acc)[2][2][4][2], const Unit& u, int wr, int wc, int fr, int fq) const {
        const int row0 = u.pm * BM + wr * 64 + fr, col0 = u.pn * BM + wc * 32 + 4 * fq;
#pragma unroll
        for (int ai = 0; ai < 2; ++ai)
#pragma unroll
            for (int m = 0; m < 4; ++m) { float* rowp = C + (size_t)(row0 + ai * HALF + m * 16) * ldc + col0;
#pragma unroll
                for (int bj = 0; bj < 2; ++bj)
#pragma unroll
                    for (int n = 0; n < 2; ++n) { f32x4* p = (f32x4*)(rowp + bj * HALF + n * 16);
                        if (MODE == 1) *p = *p + acc[ai][bj][m][n] * sc;
                        else if (MODE == 2) *p = *(const f32x4*)(B + (p - (f32x4*)C) * 4) + acc[ai][bj][m][n] * sc;
                        else *p = acc[ai][bj][m][n]; } }
    }
};

template <int F8 = 0, class Epi, class Sched>
__device__ __forceinline__ void gemm_phase(PG8_LAS unsigned char* lds, const Gemm g, const Sched& S, const Epi& E) {
    const int tid = threadIdx.x, wid = __builtin_amdgcn_readfirstlane(tid >> 6), lane = tid & 63, wr = wid >> 2, wc = wid & 3, fr = lane & 15, fq = lane >> 4;
    const int K = g.K, nt = K / BK;
    unsigned voffA[2], voffB[2];
#pragma unroll
    for (int i = 0; i < 2; ++i) { int R, C; stage_rc(tid * 16 + i * 8192, R, C); const int Rb = Epi::PERM ? ((R & ~31) + perm32(R & 31)) : R;
        voffA[i] = (unsigned)(R * K + C) * 2u; voffB[i] = (unsigned)(Rb * K + C) * 2u; }
    const size_t kstep = (size_t)(BK * 2);
    const size_t hstep = (size_t)HALF * K * 2;
    const size_t tstep = 2 * hstep;
    const unsigned ldsw = (unsigned)wid * 1024u;
    const int aoff = lds_byte(wr * 64 + fr, fq * 8), boff = lds_byte(wc * 32 + fr, fq * 8);
#define PG8_SA(b, h) (((b) * 2 + (h)) * HTB)
#define PG8_SB(b, h) ((4 + (b) * 2 + (h)) * HTB)
#define PG8_STAGE(bufoff, gbase, voff) do { const char* gb_ = (const char*)(gbase); asm volatile("" : "+s"(gb_));        \
        _Pragma("unroll") for (int _i = 0; _i < 2; ++_i) { unsigned vo_ = (voff)[_i]; asm volatile("" : "+v"(vo_)); \
        __builtin_amdgcn_global_load_lds((const unsigned*)(gb_ + vo_), (PG8_LAS unsigned*)(lds + (bufoff) + ldsw + _i * 8192), 16, 0, 0); } } while (0)
#define PG8_LD8(dst8, cbase_, voff_, cnt_) do { unsigned o_ = (unsigned)(voff_); asm volatile("" : "+v"(o_));        \
        _Pragma("unroll") for (int i_ = 0; i_ < cnt_; ++i_) { const i32x4 lo_ = *(const PG8_LAS i32x4*)(lds + (cbase_) + o_ + i_ * 2048), hi_ = *(const PG8_LAS i32x4*)(lds + (cbase_) + o_ + i_ * 2048 + 1024); \
        dst8[i_] = (i32x8){lo_.x, lo_.y, lo_.z, lo_.w, hi_.x, hi_.y, hi_.z, hi_.w}; } } while (0)
#define PG8_LDA(dst, b, h) do { if (F8 == 1) PG8_LD8(Ah8, PG8_SA(b, h), aoff, 2); else { _Pragma("unroll") for (int m = 0; m < 4; ++m) _Pragma("unroll") for (int k = 0; k < 2; ++k) dst[m][k] = *(const PG8_LAS bf16x8*)(lds + PG8_SA(b, h) + aoff + m * 2048 + k * 1024); } } while (0)
#define PG8_LDB(dst, b, h) do { if (F8 == 1) PG8_LD8(dst##8, PG8_SB(b, h), boff, 2); else { _Pragma("unroll") for (int n = 0; n < 2; ++n) _Pragma("unroll") for (int k = 0; k < 2; ++k) dst[n][k] = *(const PG8_LAS bf16x8*)(lds + PG8_SB(b, h) + boff + n * 2048 + k * 1024); } } while (0)
#define PG8_MM8(ai, bj, mm, Bt, Ax) do { _Pragma("unroll") for (int n = 0; n < 2; ++n) { \
        acc[ai][bj][mm][n] = __builtin_amdgcn_mfma_scale_f32_16x16x128_f8f6f4(Bt##8[n], Ax[0], acc[ai][bj][mm][n], 0, 0, 0, 0, 0, 0); \
        acc[ai][bj][(mm) + 1][n] = __builtin_amdgcn_mfma_scale_f32_16x16x128_f8f6f4(Bt##8[n], Ax[1], acc[ai][bj][(mm) + 1][n], 0, 0, 0, 0, 0, 0); } } while (0)
#define PG8_MMA(ai, bj, At, Bt, bb) do { __builtin_amdgcn_s_setprio(1); \
        if (F8 == 1) { if ((bj) == 0) { PG8_SCHED; PG8_LD8(Bh8, PG8_SA(bb, ai) + 2 * 2048, aoff, 2); PG8_SCHED; PG8_MM8(ai, bj, 0, Bt, Ah8); PG8_SCHED; PG8_MM8(ai, bj, 2, Bt, Bh8); } \
                  else { PG8_MM8(ai, bj, 0, Bt, Ah8); PG8_MM8(ai, bj, 2, Bt, Bh8); } } \
        else if (F8 == 2) { _Pragma("unroll") for (int m = 0; m < 4; ++m) _Pragma("unroll") for (int n = 0; n < 2; ++n) _Pragma("unroll") for (int k = 0; k < 2; ++k) \
            acc[ai][bj][m][n] = __builtin_bit_cast(f32x4, __builtin_amdgcn_mfma_i32_16x16x64_i8(__builtin_bit_cast(i32x4, Bt[n][k]), __builtin_bit_cast(i32x4, At[m][k]), __builtin_bit_cast(i32x4, acc[ai][bj][m][n]), 0, 0, 0)); } \
        else { _Pragma("unroll") for (int m = 0; m < 4; ++m) _Pragma("unroll") for (int n = 0; n < 2; ++n) _Pragma("unroll") for (int k = 0; k < 2; ++k) \
            acc[ai][bj][m][n] = __builtin_amdgcn_mfma_f32_16x16x32_bf16(Bt[n][k], At[m][k], acc[ai][bj][m][n], 0, 0, 0); } \
        __builtin_amdgcn_s_setprio(0); } while (0)
#define PG8_WAIT_V(n) asm volatile("s_waitcnt vmcnt(" #n ")" ::: "memory")
#define PG8_WAIT_L(n) asm volatile("s_waitcnt lgkmcnt(" #n ")" ::: "memory")
#define PG8_BAR __builtin_amdgcn_s_barrier()
#define PG8_SCHED __builtin_amdgcn_sched_barrier(0)
    Unit cur, nxt; int ui = 0;
    if (!S.next(0, cur)) return;
    f32x4 acc[2][2][4][2];
#pragma unroll
    for (int a = 0; a < 2; ++a)
#pragma unroll
        for (int b = 0; b < 2; ++b)
#pragma unroll
            for (int m = 0; m < 4; ++m)
#pragma unroll
                for (int n = 0; n < 2; ++n) acc[a][b][m][n] = (f32x4){0.f, 0.f, 0.f, 0.f};
    bf16x8 At[4][2], B0[2][2], B1[2][2]; i32x8 Ah8[2], Bh8[2], B08[2], B18[2];
    const char* cA = (const char*)g.A + (size_t)cur.pm * tstep; const char* cB = (const char*)g.Bt + (size_t)cur.pn * tstep;
    S.a_ready(cur);
    PG8_STAGE(PG8_SB(0, 0), cB, voffB); PG8_STAGE(PG8_SA(0, 0), cA, voffA); PG8_STAGE(PG8_SB(0, 1), cB + hstep, voffB); PG8_STAGE(PG8_SA(0, 1), cA + hstep, voffA);
    if (wr == 1) PG8_BAR;
    PG8_WAIT_V(4); PG8_BAR;
    PG8_STAGE(PG8_SB(1, 0), cB + kstep, voffB); PG8_STAGE(PG8_SA(1, 0), cA + kstep, voffA); PG8_STAGE(PG8_SB(1, 1), cB + hstep + kstep, voffB);
    PG8_WAIT_V(6); PG8_BAR;
    for (;;) {
        const bool has_next = S.next(ui + 1, nxt);
        const char* nA = has_next ? (const char*)g.A + (size_t)nxt.pm * tstep : cA; const char* nB = has_next ? (const char*)g.Bt + (size_t)nxt.pn * tstep : cB;
        for (int t = 0; t < nt; t += 2) {
            const bool last = (t == nt - 2);
            const char* a1 = cA + (size_t)(t + 1) * kstep;
            const char* a2 = last ? nA : cA + (size_t)(t + 2) * kstep; const char* b2 = last ? nB : cB + (size_t)(t + 2) * kstep;
            const char* a3 = a2 + kstep; const char* b3 = b2 + kstep;
            if (last && has_next) S.a_ready(nxt);
            PG8_LDB(B0, 0, 0); PG8_SCHED; PG8_LDA(At, 0, 0); PG8_STAGE(PG8_SA(1, 1), a1 + hstep, voffA);
            PG8_WAIT_L(8); PG8_BAR; PG8_WAIT_L(0); PG8_MMA(0, 0, At, B0, 0); PG8_BAR; PG8_SCHED;
            PG8_LDB(B1, 0, 1); PG8_STAGE(PG8_SB(0, 0), b2, voffB);
            PG8_BAR; PG8_WAIT_L(0); PG8_MMA(0, 1, At, B1, 0); PG8_BAR; if (F8 == 1) PG8_SCHED;
            PG8_LDA(At, 0, 1); PG8_STAGE(PG8_SA(0, 0), a2, voffA);
            PG8_BAR; PG8_WAIT_L(0); PG8_MMA(1, 0, At, B0, 0); PG8_BAR; PG8_SCHED;
            PG8_STAGE(PG8_SB(0, 1), b2 + hstep, voffB);
            PG8_WAIT_V(6); PG8_BAR; PG8_MMA(1, 1, At, B1, 0); PG8_BAR; if (F8 == 1) PG8_SCHED;
            PG8_LDB(B0, 1, 0); PG8_SCHED; PG8_LDA(At, 1, 0); PG8_STAGE(PG8_SA(0, 1), a2 + hstep, voffA);
            PG8_WAIT_L(8); PG8_BAR; PG8_WAIT_L(0); PG8_MMA(0, 0, At, B0, 1); PG8_BAR; PG8_SCHED;
            PG8_LDB(B1, 1, 1); PG8_STAGE(PG8_SB(1, 0), b3, voffB);
            PG8_BAR; PG8_WAIT_L(0); PG8_MMA(0, 1, At, B1, 1); PG8_BAR; if (F8 == 1) PG8_SCHED;
            PG8_LDA(At, 1, 1); PG8_STAGE(PG8_SA(1, 0), a3, voffA);
            PG8_BAR; PG8_WAIT_L(0); PG8_MMA(1, 0, At, B0, 1); PG8_BAR; PG8_SCHED;
            PG8_STAGE(PG8_SB(1, 1), b3 + hstep, voffB);
            PG8_WAIT_V(6); PG8_BAR; PG8_MMA(1, 1, At, B1, 1); PG8_BAR; if (F8 == 1) PG8_SCHED;
        }
        { int fr_ = fr, fq_ = fq; asm volatile("" : "+v"(fr_), "+v"(fq_));
          E(acc, cur, wr, wc, fr_, fq_); } S.done(cur);
        if (!has_next) break;
#pragma unroll
        for (int a = 0; a < 2; ++a)
#pragma unroll
            for (int b = 0; b < 2; ++b)
#pragma unroll
                for (int m = 0; m < 4; ++m)
#pragma unroll
                    for (int n = 0; n < 2; ++n) acc[a][b][m][n] = (f32x4){0.f, 0.f, 0.f, 0.f};
        cur = nxt; cA = nA; cB = nB; ++ui;
    }
    PG8_WAIT_V(0);
    if (wr == 0) PG8_BAR;
    PG8_BAR;
#undef PG8_SA
#undef PG8_SB
#undef PG8_STAGE
#undef PG8_LDA
#undef PG8_LDB
#undef PG8_MMA
#undef PG8_LD8
#undef PG8_MM8
#undef PG8_WAIT_V
#undef PG8_WAIT_L
#undef PG8_BAR
#undef PG8_SCHED
}
}

#define XB_TMO      128
#define XB_XCNT(j)  (256  + 64 * (j))
#define XB_XSUB(j)  (1280 + 64 * (j))
#define XB_XGEN(j)  (2304 + 64 * (j))
#define XB_TOP      3328
#define XB_TOPGEN   3392
#define XCD_BAR_WORDS 3456
#define XB_SPIN_CAP (1u << 18)
__device__ __forceinline__ unsigned xb_ld(unsigned* p)              { return __hip_atomic_load(p, __ATOMIC_RELAXED, __HIP_MEMORY_SCOPE_AGENT); }
__device__ __forceinline__ unsigned xb_add(unsigned* p, unsigned v) { return __hip_atomic_fetch_add(p, v, __ATOMIC_RELAXED, __HIP_MEMORY_SCOPE_AGENT); }
__device__ __forceinline__ unsigned xb_xcc_id() { return (unsigned)__builtin_amdgcn_s_getreg((3 << 11) | 20) & 0xFu; }
#define XB_SPIN(cond, bar) do { unsigned _sp = 0; while (cond) { __builtin_amdgcn_s_sleep(1); \
    if ((++_sp & 255u) == 0u) { if (xb_ld(&(bar)[XB_TMO])) break; if (_sp > XB_SPIN_CAP) { atomicAdd(&(bar)[XB_TMO], 1u); break; } } } } while (0)
struct XcdBarrier { unsigned* bar; unsigned x; volatile LAS unsigned* st; };
__device__ __forceinline__ XcdBarrier xcd_barrier_post(unsigned* bar, volatile LAS unsigned* st) {
    XcdBarrier b; b.bar = bar; b.x = xb_xcc_id(); b.st = st;
    if (threadIdx.x == 0) (void)xb_add(&bar[XB_XCNT(b.x)], 1u);
    return b;
}
__device__ __forceinline__ void xcd_barrier_complete(unsigned* bar, unsigned x, unsigned& nloc, unsigned& nx) {
    const unsigned G = gridDim.x * gridDim.y * gridDim.z;
    unsigned sum, cnt, mine, sp = 0u;
    for (;;) {
        sum = 0u; cnt = 0u; mine = 0u;
#pragma unroll
        for (unsigned j = 0; j < 16; ++j) { const unsigned c = xb_ld(&bar[XB_XCNT(j)]); sum += c; cnt += (c > 0u) ? 1u : 0u; mine = (j == x) ? c : mine; }
        if (sum == G) break;
        __builtin_amdgcn_s_sleep(1);
        if ((++sp & 255u) == 0u) { if (xb_ld(&bar[XB_TMO])) break; if (sp > XB_SPIN_CAP) { atomicAdd(&bar[XB_TMO], 1u); break; } }
    }
    nloc = mine > 0u ? mine : 1u; nx = cnt > 0u ? cnt : 1u;
}
__device__ __forceinline__ void xcd_barrier(const XcdBarrier& b) {
    asm volatile("s_waitcnt vmcnt(0)" ::: "memory");
    __syncthreads();
    if (threadIdx.x == 0) {
        unsigned* bar = b.bar;
        __builtin_amdgcn_s_waitcnt(0);
        unsigned nloc = b.st[0], nx = b.st[1];
        if (nloc == 0u) { xcd_barrier_complete(bar, b.x, nloc, nx); b.st[0] = nloc; b.st[1] = nx; }
        const unsigned old = xb_add(&bar[XB_XSUB(b.x)], 1u);
        const unsigned gen = old / nloc;
        if (old + 1u == (gen + 1u) * nloc) {
            __builtin_amdgcn_fence(__ATOMIC_RELEASE, "agent");
            asm volatile("s_waitcnt vmcnt(0)" ::: "memory");
            const unsigned og = xb_add(&bar[XB_TOP], 1u);
            const unsigned tg = og / nx;
            if (og + 1u == (tg + 1u) * nx) xb_add(&bar[XB_TOPGEN], 1u);
            else XB_SPIN(xb_ld(&bar[XB_TOPGEN]) == tg, bar);
            __builtin_amdgcn_fence(__ATOMIC_ACQUIRE, "agent");
            xb_add(&bar[XB_XGEN(b.x)], 1u);
            asm volatile("s_waitcnt vmcnt(0)" ::: "memory");
        } else {
            XB_SPIN(xb_ld(&bar[XB_XGEN(b.x)]) == gen, bar);
            __builtin_amdgcn_fence(__ATOMIC_ACQUIRE, "agent");
            asm volatile("s_waitcnt vmcnt(0)" ::: "memory");
        }
    }
    __syncthreads();
}

struct Args { const float* in[18]; float* out; unsigned char* ws; int ph_lo, ph_hi; };
struct Frame {
    LAS unsigned char* lds;
    int tid, lane, wave, G, gw, NGW;
    const float* const* in; float* out; unsigned char* ws;
};

__device__ __forceinline__ void transpose_item(const float* W, int ldw, int col0, bf16_t* WT, int K, int nblk, float scale, LAS float* scr, int item, int lane, bool f8 = false) {
    const int kb = item / nblk, nb = item % nblk, k0 = 64 * kb, n0 = 32 * nb;
#pragma unroll 8
    for (int i = 0; i < 32; ++i) { const int kk = 2 * i + (lane >> 5); scr[kk * 33 + (lane & 31)] = W[(size_t)(k0 + kk) * ldw + col0 + n0 + (lane & 31)]; }
    LDS_WAIT();
    const int c = lane & 7;
#pragma unroll
    for (int j = 0; j < 4; ++j) { const int n = (lane >> 3) + 8 * j; const LAS float* s = scr + (8 * c) * 33 + n;
        if (f8) { int w0 = 0, w1 = 0;
            w0 = __builtin_amdgcn_cvt_pk_fp8_f32(s[0 * 33] * scale, s[1 * 33] * scale, w0, false); w0 = __builtin_amdgcn_cvt_pk_fp8_f32(s[2 * 33] * scale, s[3 * 33] * scale, w0, true);
            w1 = __builtin_amdgcn_cvt_pk_fp8_f32(s[4 * 33] * scale, s[5 * 33] * scale, w1, false); w1 = __builtin_amdgcn_cvt_pk_fp8_f32(s[6 * 33] * scale, s[7 * 33] * scale, w1, true);
            *(u32x2*)((unsigned char*)WT + (size_t)(n0 + n) * K + k0 + 8 * c) = (u32x2){(unsigned)w0, (unsigned)w1}; continue; }
        u32x4 o; o.x = pk2(s[0 * 33] * scale, s[1 * 33] * scale); o.y = pk2(s[2 * 33] * scale, s[3 * 33] * scale); o.z = pk2(s[4 * 33] * scale, s[5 * 33] * scale); o.w = pk2(s[6 * 33] * scale, s[7 * 33] * scale);
        *(u32x4*)(WT + (size_t)(n0 + n) * K + k0 + 8 * c) = o; }
    LDS_WAIT();
}
__device__ __forceinline__ void rmsnorm_rows(const Frame& F, const float* src, const float* g, bf16_t* dst, float* cpy, unsigned char* dst8 = nullptr) {
    const f32x4* gp = (const f32x4*)g + F.lane;
    f32x4 gv[4];
#pragma unroll
    for (int j = 0; j < 4; ++j) gv[j] = gp[64 * j];
    for (int m = F.gw; m < T; m += F.NGW) {
        const f32x4* xr = (const f32x4*)(src + (size_t)m * D) + F.lane;
        f32x4 v[4]; float s = 0.f;
#pragma unroll
        for (int j = 0; j < 4; ++j) { v[j] = xr[64 * j]; s += (v[j].x * v[j].x + v[j].y * v[j].y) + (v[j].z * v[j].z + v[j].w * v[j].w); }
        const float rstd = 1.0f / sqrtf(wave_sum(s) * (1.f / D) + 1e-6f);
        if (cpy) { f32x4* cr = (f32x4*)(cpy + (size_t)m * D) + F.lane;
#pragma unroll
            for (int j = 0; j < 4; ++j) cr[64 * j] = v[j]; }
        if (dst) { u32x2* o8 = (u32x2*)(dst + (size_t)m * D) + F.lane;
#pragma unroll
        for (int j = 0; j < 4; ++j) { u32x2 w; w.x = pk2(v[j].x * rstd * gv[j].x, v[j].y * rstd * gv[j].y); w.y = pk2(v[j].z * rstd * gv[j].z, v[j].w * rstd * gv[j].w); o8[64 * j] = w; } }
        if (dst8) { unsigned* o4 = (unsigned*)(dst8 + (size_t)m * D) + F.lane;
#pragma unroll
            for (int j = 0; j < 4; ++j) { int w = 0; w = __builtin_amdgcn_cvt_pk_fp8_f32(v[j].x * rstd * gv[j].x, v[j].y * rstd * gv[j].y, w, false); w = __builtin_amdgcn_cvt_pk_fp8_f32(v[j].z * rstd * gv[j].z, v[j].w * rstd * gv[j].w, w, true); o4[64 * j] = (unsigned)w; } }
    }
}
__device__ __forceinline__ void quant_wqk(const Frame& F) {
    const bf16_t* W = (const bf16_t*)(F.ws + WS_WQKP); unsigned char* Q8 = F.ws + WS_WQ8;
    const unsigned* CM = (const unsigned*)(F.ws + WS_CTL) + CW_COLMAX; float* WSCL = (float*)(F.ws + WS_CTL) + CW_WSCL;
    for (int r = F.gw; r < 4096; r += F.NGW) {
        const float cm = __builtin_bit_cast(float, __hip_atomic_load(CM + r, __ATOMIC_RELAXED, __HIP_MEMORY_SCOPE_AGENT));
        const float sc = cm > 0.f ? 127.0f / cm : 0.f;
        const u32x4* wp = (const u32x4*)(W + (size_t)r * 1024 + 16 * F.lane); const u32x4 a = wp[0], b = wp[1];
        const float v[16] = {bflo(a.x), bfhi(a.x), bflo(a.y), bfhi(a.y), bflo(a.z), bfhi(a.z), bflo(a.w), bfhi(a.w), bflo(b.x), bfhi(b.x), bflo(b.y), bfhi(b.y), bflo(b.z), bfhi(b.z), bflo(b.w), bfhi(b.w)};
        unsigned o[4];
#pragma unroll
        for (int j = 0; j < 4; ++j) { unsigned w = 0u;
#pragma unroll
            for (int e = 0; e < 4; ++e) { int q = (int)rintf(v[4 * j + e] * sc); q = q > 127 ? 127 : (q < -127 ? -127 : q); w |= ((unsigned)q & 255u) << (8 * e); }
            o[j] = w; }
        *(u32x4*)(Q8 + (size_t)r * 1024 + 16 * F.lane) = (u32x4){o[0], o[1], o[2], o[3]};
        if (F.lane == 0) WSCL[r] = cm * (1.0f / 127.0f);
    }
}
__device__ __forceinline__ void rmsnorm_rows_bf(const Frame& F, const bf16_t* src, const float* g, bf16_t* dst, unsigned char* dst8, unsigned char* dsti = nullptr, float* rowsc = nullptr) {
    const f32x4* gp = (const f32x4*)g + F.lane;
    f32x4 gv[4];
#pragma unroll
    for (int j = 0; j < 4; ++j) gv[j] = gp[64 * j];
    for (int m = F.gw; m < T; m += F.NGW) {
        const u32x2* xr = (const u32x2*)(src + (size_t)m * D) + F.lane;
        f32x4 v[4]; float s = 0.f;
#pragma unroll
        for (int j = 0; j < 4; ++j) { const u32x2 w = xr[64 * j]; v[j] = (f32x4){bflo(w.x), bfhi(w.x), bflo(w.y), bfhi(w.y)}; s += (v[j].x * v[j].x + v[j].y * v[j].y) + (v[j].z * v[j].z + v[j].w * v[j].w); }
        const float rstd = 1.0f / sqrtf(wave_sum(s) * (1.f / D) + 1e-6f);
        if (dst) { u32x2* o8 = (u32x2*)(dst + (size_t)m * D) + F.lane;
#pragma unroll
        for (int j = 0; j < 4; ++j) { u32x2 w; w.x = pk2(v[j].x * rstd * gv[j].x, v[j].y * rstd * gv[j].y); w.y = pk2(v[j].z * rstd * gv[j].z, v[j].w * rstd * gv[j].w); o8[64 * j] = w; } }
        if (dst8) { unsigned* o4 = (unsigned*)(dst8 + (size_t)m * D) + F.lane;
#pragma unroll
            for (int j = 0; j < 4; ++j) { int w = 0; w = __builtin_amdgcn_cvt_pk_fp8_f32(v[j].x * rstd * gv[j].x, v[j].y * rstd * gv[j].y, w, false); w = __builtin_amdgcn_cvt_pk_fp8_f32(v[j].z * rstd * gv[j].z, v[j].w * rstd * gv[j].w, w, true); o4[64 * j] = (unsigned)w; } }
        if (dsti) {
            f32x4 y[4]; float am = 0.f;
#pragma unroll
            for (int j = 0; j < 4; ++j) { y[j] = v[j] * rstd * gv[j]; am = fmaxf(am, fmaxf(fmaxf(fabsf(y[j].x), fabsf(y[j].y)), fmaxf(fabsf(y[j].z), fabsf(y[j].w)))); }
            am = wave_max(am);
            const float qs = am > 0.f ? 127.0f / am : 0.f;
            unsigned* oi = (unsigned*)(dsti + (size_t)m * D) + F.lane;
#pragma unroll
            for (int j = 0; j < 4; ++j) { const int q0 = (int)rintf(y[j].x * qs), q1 = (int)rintf(y[j].y * qs), q2 = (int)rintf(y[j].z * qs), q3 = (int)rintf(y[j].w * qs);
                oi[64 * j] = ((unsigned)q0 & 255u) | (((unsigned)q1 & 255u) << 8) | (((unsigned)q2 & 255u) << 16) | ((unsigned)q3 << 24); }
            if (F.lane == 0) rowsc[m] = am * (1.0f / 127.0f);
        }
    }
}
__device__ __forceinline__ void final_norm_bf(const Frame& F, const bf16_t* h, float* out, const float* g) {
    const f32x4* gp = (const f32x4*)g + F.lane;
    f32x4 gv[4];
#pragma unroll
    for (int j = 0; j < 4; ++j) gv[j] = gp[64 * j];
    for (int m = F.gw; m < T; m += F.NGW) {
        const u32x2* xr = (const u32x2*)(h + (size_t)m * D) + F.lane;
        f32x4 v[4]; float s = 0.f;
#pragma unroll
        for (int j = 0; j < 4; ++j) { const u32x2 w = xr[64 * j]; v[j] = (f32x4){bflo(w.x), bfhi(w.x), bflo(w.y), bfhi(w.y)}; s += (v[j].x * v[j].x + v[j].y * v[j].y) + (v[j].z * v[j].z + v[j].w * v[j].w); }
        const float rstd = 1.0f / sqrtf(wave_sum(s) * (1.f / D) + 1e-6f);
        f32x4* orow = (f32x4*)(out + (size_t)m * D) + F.lane;
#pragma unroll
        for (int j = 0; j < 4; ++j) orow[64 * j] = v[j] * rstd * gv[j];
    }
}
__device__ __forceinline__ void final_norm(const Frame& F, float* h, const float* g) {
    const f32x4* gp = (const f32x4*)g + F.lane;
    f32x4 gv[4];
#pragma unroll
    for (int j = 0; j < 4; ++j) gv[j] = gp[64 * j];
    for (int m = F.gw; m < T; m += F.NGW) {
        f32x4* xr = (f32x4*)(h + (size_t)m * D) + F.lane;
        f32x4 v[4]; float s = 0.f;
#pragma unroll
        for (int j = 0; j < 4; ++j) { v[j] = xr[64 * j]; s += (v[j].x * v[j].x + v[j].y * v[j].y) + (v[j].z * v[j].z + v[j].w * v[j].w); }
        const float rstd = 1.0f / sqrtf(wave_sum(s) * (1.f / D) + 1e-6f);
#pragma unroll
        for (int j = 0; j < 4; ++j) xr[64 * j] = v[j] * rstd * gv[j];
    }
}
__device__ __forceinline__ void cvt_fp4_rows(const Frame& F, const float* src, unsigned char* dst, float* inv) {
    for (int r = F.gw; r < 16384; r += F.NGW) {
        const f32x4* p = (const f32x4*)(src + (size_t)r * 1024 + 16 * F.lane);
        const f32x4 v0 = p[0], v1 = p[1], v2 = p[2], v3 = p[3];
        float m = fmaxf(fmaxf(fmaxf(fabsf(v0.x), fabsf(v0.y)), fmaxf(fabsf(v0.z), fabsf(v0.w))), fmaxf(fmaxf(fabsf(v1.x), fabsf(v1.y)), fmaxf(fabsf(v1.z), fabsf(v1.w))));
        m = fmaxf(m, fmaxf(fmaxf(fmaxf(fabsf(v2.x), fabsf(v2.y)), fmaxf(fabsf(v2.z), fabsf(v2.w))), fmaxf(fmaxf(fabsf(v3.x), fabsf(v3.y)), fmaxf(fabsf(v3.z), fabsf(v3.w)))));
        m = wave_max(m);
        const float sc = m > 0.f ? 6.0f / m : 1.0f;
        unsigned w0 = 0u, w1 = 0u;
        w0 = __builtin_amdgcn_cvt_scalef32_pk_fp4_f32(w0, v0.x * sc, v0.y * sc, 1.0f, 0); w0 = __builtin_amdgcn_cvt_scalef32_pk_fp4_f32(w0, v0.z * sc, v0.w * sc, 1.0f, 1);
        w0 = __builtin_amdgcn_cvt_scalef32_pk_fp4_f32(w0, v1.x * sc, v1.y * sc, 1.0f, 2); w0 = __builtin_amdgcn_cvt_scalef32_pk_fp4_f32(w0, v1.z * sc, v1.w * sc, 1.0f, 3);
        w1 = __builtin_amdgcn_cvt_scalef32_pk_fp4_f32(w1, v2.x * sc, v2.y * sc, 1.0f, 0); w1 = __builtin_amdgcn_cvt_scalef32_pk_fp4_f32(w1, v2.z * sc, v2.w * sc, 1.0f, 1);
        w1 = __builtin_amdgcn_cvt_scalef32_pk_fp4_f32(w1, v3.x * sc, v3.y * sc, 1.0f, 2); w1 = __builtin_amdgcn_cvt_scalef32_pk_fp4_f32(w1, v3.z * sc, v3.w * sc, 1.0f, 3);
        *(u32x2*)(dst + (size_t)(F.lane >> 4) * (2 * MiB) + (size_t)r * 128 + 8 * (F.lane & 15)) = (u32x2){w0, w1};
        if (F.lane == 0) inv[2 * r] = m > 0.f ? m * (1.0f / 6.0f) : 1.0f;
    }
}
__device__ __forceinline__ int t5_bucket(int rel) {
    const int ret = rel > 0 ? 16 : 0; const int n = rel < 0 ? -rel : rel;
    int v;
    if (n < 8) v = n; else if (n < 12) v = 8; else if (n < 16) v = 9; else if (n < 23) v = 10; else if (n < 32) v = 11;
    else if (n < 46) v = 12; else if (n < 64) v = 13; else if (n < 91) v = 14; else v = 15;
    return ret + v;
}

__device__ __forceinline__ void p0_prologue(const Frame& F) {
    LAS float* scr = (LAS float*)(F.lds + F.wave * 16384);
    bf16_t* WQK = (bf16_t*)(F.ws + WS_WQK); bf16_t* WV = (bf16_t*)(F.ws + WS_WV); bf16_t* WO = (bf16_t*)(F.ws + WS_WO);
    bf16_t* WSGV = (bf16_t*)(F.ws + WS_WSGV); bf16_t* WSGU = (bf16_t*)(F.ws + WS_WSGU); bf16_t* WSGO = (bf16_t*)(F.ws + WS_WSGO);
    constexpr int I_QK = 16 * 40, I_V = 16 * 8, I_O = 16 * 32, I_SG = 16 * 96, I_SGO = 48 * 32;
    constexpr int NITEMS = I_QK + I_V + I_O + 2 * I_SG + I_SGO;
    for (int it = F.gw; it < NITEMS; it += F.NGW) {
        int r = it;
        if (r < I_QK) { const int nb = r % 40; transpose_item(F.in[3], 1536, 0, WQK, 1024, 40, (nb < 32 ? 0.125f * 1.4426950408889634f : 1.0f) * W8_SCALE, scr, r, F.lane, true); continue; } r -= I_QK;
        if (r < I_V) { transpose_item(F.in[3], 1536, 1280, WV, 1024, 8, W8_SCALE, scr, r, F.lane, true); continue; } r -= I_V;
        if (r < I_O) { transpose_item(F.in[4], 1024, 0, WO, 1024, 32, W8_SCALE, scr, r, F.lane, true); continue; } r -= I_O;
        if (r < I_SG) { transpose_item(F.in[6], 6144, 0, WSGU, 1024, 96, W8_SCALE, scr, r, F.lane, true); continue; } r -= I_SG;
        if (r < I_SG) { transpose_item(F.in[6], 6144, 3072, WSGV, 1024, 96, W8_SCALE, scr, r, F.lane, true); continue; } r -= I_SG;
        transpose_item(F.in[11], 1024, 0, WSGO, 3072, 32, W8_SCALE, scr, r, F.lane, true);
    }
    {
        bf16_t* WQKP = (bf16_t*)(F.ws + WS_WQKP);
        const int fr = F.lane & 15, fq = F.lane >> 4;
        for (int task = F.gw; task < 2 * 16 * 64; task += F.NGW) {
            const int l = task >> 10, hc = (task >> 6) & 15, k0 = (task & 63) * 16;
            const f32x4* ap = (const f32x4*)(F.in[13] + ((size_t)l * 1024 + k0 + fr) * 2048 + hc * 128 + 32 * fq);
            f32x4 av[8];
#pragma unroll
            for (int i = 0; i < 8; ++i) av[i] = ap[i];
#pragma unroll 1
            for (int nt = 0; nt < 8; ++nt) {
                const f32x4* bp = (const f32x4*)(F.in[14] + ((size_t)(l * 16 + hc) * 128 + nt * 16 + fr) * 128 + 32 * fq);
                f32x4 bv[8];
#pragma unroll
                for (int i = 0; i < 8; ++i) bv[i] = bp[i];
                f32x4 acc = {0.f, 0.f, 0.f, 0.f};
#pragma unroll
                for (int i = 0; i < 8; ++i)
#pragma unroll
                    for (int j = 0; j < 4; ++j) acc = __builtin_amdgcn_mfma_f32_16x16x4f32(av[i][j], bv[i][j], acc, 0, 0, 0);
                *(u32x2*)(WQKP + ((size_t)l * 2048 + hc * 128 + nt * 16 + fr) * 1024 + k0 + 4 * fq) = (u32x2){pk2(acc[0], acc[1]), pk2(acc[2], acc[3])};
                { float mx = fmaxf(fmaxf(fabsf(acc[0]), fabsf(acc[1])), fmaxf(fabsf(acc[2]), fabsf(acc[3])));
                  mx = fmaxf(mx, __shfl_xor(mx, 16)); mx = fmaxf(mx, __shfl_xor(mx, 32));
                  if (fq == 0) atomicMax((unsigned*)(F.ws + WS_CTL) + CW_COLMAX + l * 2048 + hc * 128 + nt * 16 + fr, __builtin_bit_cast(unsigned, mx)); }
            }
        }
    }
    if (blockIdx.x == 0) {
        float* bt = (float*)(F.ws + WS_BIAS);
        for (int i = F.tid; i < 16 * 257; i += 512) { const int hq = i / 257, r = i % 257 - 128; bt[hq * 260 + r + 128] = F.in[1][t5_bucket(r) * 16 + hq] * 1.4426950408889634f; }
    }
    rmsnorm_rows(F, F.in[0], F.in[2], nullptr, nullptr, F.ws + WS_HN8B);
    for (int l = 0; l < 2; ++l) {
        cvt_fp4_rows(F, F.in[15] + (size_t)l * 16384 * 1024, F.ws + WS_TAB + (size_t)(2 * l) * 16 * MiB, (float*)(F.ws + WS_SCL) + (size_t)l * 32768);
        cvt_fp4_rows(F, F.in[16] + (size_t)l * 16384 * 1024, F.ws + WS_TAB + (size_t)(2 * l + 1) * 16 * MiB, (float*)(F.ws + WS_SCL) + (size_t)l * 32768 + 1);
    }
}

typedef float f32x16 __attribute__((ext_vector_type(16)));
constexpr int AT_K = 0, AT_KS = 144, AT_V = 384 * AT_KS, AT_VS = 792, AT_B = AT_V + 64 * AT_VS;
__device__ __forceinline__ void attn_phase_v2(const Frame& F) {
    const bf16_t* Q = (const bf16_t*)(F.ws + WS_Q); const bf16_t* Kb = (const bf16_t*)(F.ws + WS_K); const bf16_t* Vt = (const bf16_t*)(F.ws + WS_VT);
    bf16_t* AO = (bf16_t*)(F.ws + WS_AO); const float* bias = (const float*)(F.ws + WS_BIAS); const float* sinkp = F.in[5];
    const int lane = F.lane, tid = F.tid, h5 = lane >> 5, c31 = lane & 31, g = F.wave >> 1, qh = F.wave & 1;
    LAS float* bl = (LAS float*)(F.lds + AT_B) + g * 260;
    for (int unit = blockIdx.x; unit < 1024; unit += F.G) {
        const int hkv = unit & 3, qb = (unit >> 2) & 15, b = unit >> 6;
        const int tok0 = b * 2048 + qb * 128, kbase = tok0 - 128;
        __syncthreads();
#pragma unroll 2
        for (int it = 0; it < 6; ++it) { const int id = it * 512 + tid, row = id >> 3, ch = id & 7, pos = qb * 128 - 128 + row;
            u32x4 v = (u32x4){0u, 0u, 0u, 0u};
            if (pos >= 0 && pos < 2048) v = *(const u32x4*)(Kb + (size_t)(kbase + row) * 256 + hkv * 64 + ch * 8);
            *(LAS u32x4*)(F.lds + AT_K + row * AT_KS + ch * 16) = v; }
#pragma unroll 2
        for (int it = 0; it < 6; ++it) { const int id = it * 512 + tid, d = id / 48, ch = id % 48, pos0 = qb * 128 - 128 + ch * 8;
            u32x4 v = (u32x4){0u, 0u, 0u, 0u};
            if (pos0 >= 0 && pos0 < 2048) v = *(const u32x4*)(Vt + (size_t)(hkv * 64 + d) * T + kbase + ch * 8);
            *(LAS u32x2*)(F.lds + AT_V + d * AT_VS + ch * 16) = (u32x2){v.x, v.y}; *(LAS u32x2*)(F.lds + AT_V + d * AT_VS + ch * 16 + 8) = (u32x2){v.z, v.w}; }
        for (int i = tid; i < 4 * 260; i += 512) ((LAS float*)(F.lds + AT_B))[i] = bias[hkv * 4 * 260 + i];
        __syncthreads();
        const int hq = hkv * 4 + g; const float sinkv = sinkp[hq] * 1.4426950408889634f;
#pragma unroll 1
        for (int qt = 0; qt < 2; ++qt) {
            const int q0 = 64 * qh + 32 * qt;
            const bf16_t* qrow = Q + (size_t)(tok0 + q0 + c31) * 1024 + hq * 64 + 8 * h5;
            bf16x8 qf[4];
#pragma unroll
            for (int s2 = 0; s2 < 4; ++s2) qf[s2] = *(const bf16x8*)(qrow + 16 * s2);
            const int kt0 = q0 >> 5; int kt_lo = kt0, kt_hi = kt0 + 8;
            if (qb == 0 && kt_lo < 4) kt_lo = 4;
            if (qb == 15 && kt_hi > 7) kt_hi = 7;
            const int qi = q0 + c31;
            float mx = sinkv, lsum = h5 == 0 ? 1.0f : 0.f;
            f32x16 o0 = {0.f, 0.f, 0.f, 0.f, 0.f, 0.f, 0.f, 0.f, 0.f, 0.f, 0.f, 0.f, 0.f, 0.f, 0.f, 0.f}, o1 = o0;
#pragma unroll 1
            for (int kt = kt_lo; kt <= kt_hi; ++kt) {
                f32x16 sa = {0.f, 0.f, 0.f, 0.f, 0.f, 0.f, 0.f, 0.f, 0.f, 0.f, 0.f, 0.f, 0.f, 0.f, 0.f, 0.f};
#pragma unroll
                for (int s2 = 0; s2 < 4; ++s2) { const bf16x8 kf = *(const LAS bf16x8*)(F.lds + AT_K + (kt * 32 + c31) * AT_KS + s2 * 32 + h5 * 16); sa = __builtin_amdgcn_mfma_f32_32x32x16_bf16(kf, qf[s2], sa, 0, 0, 0); }
                float sv[16]; float tmax = -INFINITY;
                if (kt > kt0 && kt < kt0 + 8) {
                    const LAS float* bp = bl + (kt * 32 + 4 * h5 - qi);
#pragma unroll
                    for (int r = 0; r < 16; ++r) { sv[r] = sa[r] + bp[(r & 3) + 8 * (r >> 2)]; tmax = fmaxf(tmax, sv[r]); }
                } else {
#pragma unroll
                    for (int r = 0; r < 16; ++r) { const int key = kt * 32 + (r & 3) + 8 * (r >> 2) + 4 * h5, rel = key - 128 - qi; const bool ok = rel >= -128 && rel <= 128;
                        const int bi = rel < -128 ? 0 : (rel > 128 ? 256 : rel + 128);
                        sv[r] = ok ? sa[r] + bl[bi] : -INFINITY; tmax = fmaxf(tmax, sv[r]); }
                }
                tmax = fmaxf(tmax, __shfl_xor(tmax, 32));
                if (__any(tmax > mx)) {
                    const float mn = fmaxf(mx, tmax), scl = __builtin_amdgcn_exp2f(mx - mn); mx = mn; lsum *= scl;
#pragma unroll
                    for (int r = 0; r < 16; ++r) { o0[r] *= scl; o1[r] *= scl; }
                }
                float pr[16];
#pragma unroll
                for (int r = 0; r < 16; ++r) { pr[r] = __builtin_amdgcn_exp2f(sv[r] - mx); lsum += pr[r]; }
#pragma unroll
                for (int s2 = 0; s2 < 2; ++s2) {
                    u32x4 pw; pw.x = pk2(pr[8 * s2 + 0], pr[8 * s2 + 1]); pw.y = pk2(pr[8 * s2 + 2], pr[8 * s2 + 3]); pw.z = pk2(pr[8 * s2 + 4], pr[8 * s2 + 5]); pw.w = pk2(pr[8 * s2 + 6], pr[8 * s2 + 7]);
                    const bf16x8 pb = __builtin_bit_cast(bf16x8, pw);
                    const int koff = (kt * 32 + 16 * s2 + 4 * h5) * 2;
                    { const LAS unsigned char* vb = F.lds + AT_V + c31 * AT_VS + koff; const u32x2 lo = *(const LAS u32x2*)vb, hi = *(const LAS u32x2*)(vb + 16);
                      const bf16x8 vf = __builtin_bit_cast(bf16x8, (u32x4){lo.x, lo.y, hi.x, hi.y}); o0 = __builtin_amdgcn_mfma_f32_32x32x16_bf16(vf, pb, o0, 0, 0, 0); }
                    { const LAS unsigned char* vb = F.lds + AT_V + (32 + c31) * AT_VS + koff; const u32x2 lo = *(const LAS u32x2*)vb, hi = *(const LAS u32x2*)(vb + 16);
                      const bf16x8 vf = __builtin_bit_cast(bf16x8, (u32x4){lo.x, lo.y, hi.x, hi.y}); o1 = __builtin_amdgcn_mfma_f32_32x32x16_bf16(vf, pb, o1, 0, 0, 0); }
                }
            }
            lsum += __shfl_xor(lsum, 32);
            const float linv = 1.0f / lsum;
            unsigned char* op = (unsigned char*)AO + (size_t)(tok0 + qi) * 1024 + hq * 64 + 4 * h5;
            const float ls = linv * AO8_SCALE;
#pragma unroll
            for (int gq = 0; gq < 4; ++gq) {
                int w0 = 0, w1 = 0;
                w0 = __builtin_amdgcn_cvt_pk_fp8_f32(o0[4 * gq] * ls, o0[4 * gq + 1] * ls, w0, false); w0 = __builtin_amdgcn_cvt_pk_fp8_f32(o0[4 * gq + 2] * ls, o0[4 * gq + 3] * ls, w0, true);
                w1 = __builtin_amdgcn_cvt_pk_fp8_f32(o1[4 * gq] * ls, o1[4 * gq + 1] * ls, w1, false); w1 = __builtin_amdgcn_cvt_pk_fp8_f32(o1[4 * gq + 2] * ls, o1[4 * gq + 3] * ls, w1, true);
                *(unsigned*)(op + 8 * gq) = (unsigned)w0; *(unsigned*)(op + 32 + 8 * gq) = (unsigned)w1; }
        }
    }
}

__device__ __forceinline__ unsigned enc_key(float f, unsigned tag, unsigned mask) { unsigned u = __builtin_bit_cast(unsigned, f); u = (u & ~mask) | tag; return (u & 0x80000000u) ? ~u : (u | 0x80000000u); }
__device__ __forceinline__ unsigned dec_key(unsigned m) { return (m & 0x80000000u) ? (m & 0x7fffffffu) : ~m; }
__device__ __forceinline__ unsigned umax(unsigned a, unsigned b) { return a > b ? a : b; }
__device__ __forceinline__ unsigned umin(unsigned a, unsigned b) { return a < b ? a : b; }
#define SORT_CE(i, j) do { const unsigned hi_ = umax(a[i], a[j]), lo_ = umin(a[i], a[j]); a[i] = hi_; a[j] = lo_; } while (0)
__device__ __forceinline__ void sort16_desc(unsigned (&a)[16]) {
    SORT_CE(0, 13); SORT_CE(1, 12); SORT_CE(2, 15); SORT_CE(3, 14); SORT_CE(4, 8); SORT_CE(5, 6); SORT_CE(7, 11); SORT_CE(9, 10);
    SORT_CE(0, 5); SORT_CE(1, 7); SORT_CE(2, 9); SORT_CE(3, 4); SORT_CE(6, 13); SORT_CE(8, 14); SORT_CE(10, 15); SORT_CE(11, 12);
    SORT_CE(0, 1); SORT_CE(2, 3); SORT_CE(4, 5); SORT_CE(6, 8); SORT_CE(7, 9); SORT_CE(10, 11); SORT_CE(12, 13); SORT_CE(14, 15);
    SORT_CE(0, 2); SORT_CE(1, 3); SORT_CE(4, 10); SORT_CE(5, 11); SORT_CE(6, 7); SORT_CE(8, 9); SORT_CE(12, 14); SORT_CE(13, 15);
    SORT_CE(1, 2); SORT_CE(3, 12); SORT_CE(4, 6); SORT_CE(5, 7); SORT_CE(8, 10); SORT_CE(9, 11); SORT_CE(13, 14);
    SORT_CE(1, 4); SORT_CE(2, 6); SORT_CE(5, 8); SORT_CE(7, 10); SORT_CE(9, 13); SORT_CE(11, 14);
    SORT_CE(2, 4); SORT_CE(3, 6); SORT_CE(9, 12); SORT_CE(11, 13);
    SORT_CE(3, 5); SORT_CE(6, 8); SORT_CE(7, 9); SORT_CE(10, 12);
    SORT_CE(3, 4); SORT_CE(5, 6); SORT_CE(7, 8); SORT_CE(9, 10); SORT_CE(11, 12);
    SORT_CE(6, 7); SORT_CE(8, 9);
}
#undef SORT_CE
__device__ __forceinline__ void merge16_desc(unsigned (&a)[16]) {
#pragma unroll
    for (int jj = 3; jj >= 0; --jj)
#pragma unroll
        for (int i = 0; i < 16; ++i) { const int j = 1 << jj, l = i ^ j; if (l > i) { const unsigned hi = umax(a[i], a[l]), lo = umin(a[i], a[l]); a[i] = hi; a[l] = lo; } }
}
template <int CTRL> __device__ __forceinline__ void xmerge16(unsigned (&a)[16]) {
    unsigned p[16];
#pragma unroll
    for (int i = 0; i < 16; ++i) p[i] = (unsigned)__builtin_amdgcn_update_dpp(0, (int)a[i], CTRL, 0xf, 0xf, true);
#pragma unroll
    for (int i = 0; i < 16; ++i) a[i] = umax(a[i], p[15 - i]);
    merge16_desc(a);
}
template <int CTRL> __device__ __forceinline__ unsigned dpp_u(unsigned v) { return (unsigned)__builtin_amdgcn_update_dpp(0, (int)v, CTRL, 0xf, 0xf, true); }
__device__ __forceinline__ void topk_phase_v3(const Frame& F) {
    const bf16_t* S = (const bf16_t*)(F.ws + WS_S); int* IDX = (int*)(F.ws + WS_IDX); float* GATE = (float*)(F.ws + WS_GATE);
    LAS unsigned* L = (LAS unsigned*)F.lds + F.wave * 1024;
    const int lane = F.lane, tk = lane >> 4, hc = lane & 15, h = hc >> 1, c = hc & 1;
    auto step = [&](const u32x4 (&cur)[16], const int tb) __attribute__((always_inline)) {
        const int t = tb + tk;
        unsigned top[16];
#pragma unroll
        for (int ck = 0; ck < 8; ++ck) {
            const u32x4 v = cur[2 * ck], w = cur[2 * ck + 1];
            const float fv[16] = {hlo(v.x), hhi(v.x), hlo(v.y), hhi(v.y), hlo(v.z), hhi(v.z), hlo(v.w), hhi(v.w), hlo(w.x), hhi(w.x), hlo(w.y), hhi(w.y), hlo(w.z), hhi(w.z), hlo(w.w), hhi(w.w)};
            unsigned nw[16];
#pragma unroll
            for (int j = 0; j < 16; ++j) nw[j] = enc_key(fv[j], (unsigned)(16 * ck + j), 127u);
            sort16_desc(nw);
            if (ck == 0) {
#pragma unroll
                for (int j = 0; j < 16; ++j) top[j] = nw[j];
            } else {
#pragma unroll
                for (int j = 0; j < 16; ++j) top[j] = umax(top[j], nw[15 - j]);
                merge16_desc(top);
            }
        }
#pragma unroll
        for (int i = 0; i < 16; ++i) L[lane * 16 + i] = top[i];
        float f1[16], f2[16];
#pragma unroll
        for (int i = 0; i < 16; ++i) { const unsigned o = dpp_u<0xB1>(top[i]); const unsigned u1 = dec_key(c ? o : top[i]) & ~127u, u2 = dec_key(c ? top[i] : o) & ~127u;
            f1[i] = __builtin_bit_cast(float, u1); f2[i] = __builtin_bit_cast(float, u2); }
        unsigned ca[16], cb[16];
#pragma unroll
        for (int i = 0; i < 16; ++i) { ca[i] = 0u; cb[i] = 0u; }
        { int n = 0;
#pragma unroll
          for (int i = 0; i < 16; ++i)
#pragma unroll
            for (int j = 0; j < 16; ++j) if ((i + 1) * (j + 1) <= 16) { const unsigned key = enc_key(f1[i] + f2[j], (unsigned)((i << 4) | j), 255u); const int slot = n >> 1, who = n & 1;
                if (slot < 16) ca[slot] = (c == who) ? key : ca[slot]; else cb[slot - 16] = (c == who) ? key : cb[slot - 16]; ++n; } }
        sort16_desc(ca); sort16_desc(cb);
#pragma unroll
        for (int i = 0; i < 16; ++i) ca[i] = umax(ca[i], cb[15 - i]);
        merge16_desc(ca);
        xmerge16<0xB1>(ca);
        float sc[8]; unsigned ex[8];
#pragma unroll
        for (int k = 0; k < 8; ++k) { unsigned wlo = ca[k], whi = ca[8 + k]; asm volatile("" : "+v"(wlo), "+v"(whi));
            const unsigned w = c ? whi : wlo;
            const unsigned tag = dec_key(w) & 255u; const unsigned u1 = dec_key(L[(lane & ~1) * 16 + (tag >> 4)]), u2 = dec_key(L[(lane | 1) * 16 + (tag & 15u)]);
            sc[k] = __builtin_bit_cast(float, u1 & ~127u) + __builtin_bit_cast(float, u2 & ~127u); ex[k] = ((u1 & 127u) << 7) | (u2 & 127u); }
        const float smax = __builtin_bit_cast(float, __builtin_amdgcn_update_dpp(0, __builtin_bit_cast(int, sc[0]), 0xA0, 0xf, 0xf, true));
        float e[8]; float sum = 0.f;
#pragma unroll
        for (int k = 0; k < 8; ++k) { e[k] = __expf(sc[k] - smax); sum += e[k]; }
        sum += __builtin_bit_cast(float, __builtin_amdgcn_update_dpp(0, __builtin_bit_cast(int, sum), 0xB1, 0xf, 0xf, true));
        const float inv = 1.0f / sum;
        int* ip = IDX + (size_t)t * 128 + h * 16 + 8 * c; float* gp = GATE + (size_t)t * 128 + h * 16 + 8 * c;
        *(u32x4*)ip = (u32x4){ex[0], ex[1], ex[2], ex[3]}; *(u32x4*)(ip + 4) = (u32x4){ex[4], ex[5], ex[6], ex[7]};
        *(f32x4*)gp = (f32x4){e[0] * inv, e[1] * inv, e[2] * inv, e[3] * inv}; *(f32x4*)(gp + 4) = (f32x4){e[4] * inv, e[5] * inv, e[6] * inv, e[7] * inv};
    };
#define TK_LD1(dst, ptr, OFF) asm volatile("global_load_dwordx4 %0, %1, off offset:" #OFF : "=v"(dst) : "v"(ptr) : "memory")
#define TK_LOAD(buf, tb_) do { const u32x4* sp_ = (const u32x4*)(S + (size_t)((tb_) + tk) * 2048 + hc * 128); \
        TK_LD1(buf[0], sp_, 0); TK_LD1(buf[1], sp_, 16); TK_LD1(buf[2], sp_, 32); TK_LD1(buf[3], sp_, 48); TK_LD1(buf[4], sp_, 64); TK_LD1(buf[5], sp_, 80); TK_LD1(buf[6], sp_, 96); TK_LD1(buf[7], sp_, 112); \
        TK_LD1(buf[8], sp_, 128); TK_LD1(buf[9], sp_, 144); TK_LD1(buf[10], sp_, 160); TK_LD1(buf[11], sp_, 176); TK_LD1(buf[12], sp_, 192); TK_LD1(buf[13], sp_, 208); TK_LD1(buf[14], sp_, 224); TK_LD1(buf[15], sp_, 240); } while (0)
#define TK_WAIT(buf, N) asm volatile("s_waitcnt vmcnt(" #N ")" : "+v"(buf[0]), "+v"(buf[1]), "+v"(buf[2]), "+v"(buf[3]), "+v"(buf[4]), "+v"(buf[5]), "+v"(buf[6]), "+v"(buf[7]), \
        "+v"(buf[8]), "+v"(buf[9]), "+v"(buf[10]), "+v"(buf[11]), "+v"(buf[12]), "+v"(buf[13]), "+v"(buf[14]), "+v"(buf[15]) :: "memory")
    const int dstep = 4 * F.NGW; int tb = 4 * F.gw;
    u32x4 bufa[16], bufb[16];
    if (tb >= T) return;
    TK_LOAD(bufa, tb);
    for (;;) {
        const int t1 = tb + dstep; TK_LOAD(bufb, t1 < T ? t1 : tb);
        TK_WAIT(bufa, 16);
        step(bufa, tb);
        if (t1 >= T) break;
        const int t2 = t1 + dstep; TK_LOAD(bufa, t2 < T ? t2 : t1);
        TK_WAIT(bufb, 16);
        step(bufb, t1);
        if (t2 >= T) break;
        tb = t2;
    }
    asm volatile("s_waitcnt vmcnt(0)" ::: "memory");
#undef TK_LOAD
#undef TK_LD1
#undef TK_WAIT
}

template <int S> __device__ __forceinline__ void reduce_scatter16(const float (&v)[16], int lane, float& z0, float& z1) {
    const bool b2 = (lane & (4 * S)) != 0, b1 = (lane & (2 * S)) != 0, b0 = (lane & S) != 0;
    float u[8], w[4];
#pragma unroll
    for (int k = 0; k < 8; ++k) { const float keep = b2 ? v[8 + k] : v[k], send = b2 ? v[k] : v[8 + k]; u[k] = keep + __shfl_xor(send, 4 * S); }
#pragma unroll
    for (int k = 0; k < 4; ++k) { const float keep = b1 ? u[4 + k] : u[k], send = b1 ? u[k] : u[4 + k]; w[k] = keep + __shfl_xor(send, 2 * S); }
    { const float keep = b0 ? w[2] : w[0], send = b0 ? w[0] : w[2]; z0 = keep + __shfl_xor(send, S); }
    { const float keep = b0 ? w[3] : w[1], send = b0 ? w[1] : w[3]; z1 = keep + __shfl_xor(send, S); }
}
__device__ __forceinline__ void ld_off16(const int* IDX, int t, int g, unsigned off, unsigned (&e)[16]) {
    const u32x4* ip = (const u32x4*)((const char*)IDX + (unsigned)(t * 512 + 64 * g)); const u32x4 i0 = ip[0], i1 = ip[1], i2 = ip[2], i3 = ip[3];
    e[0] = i0.x * 128u + off; e[1] = i0.y * 128u + off; e[2] = i0.z * 128u + off; e[3] = i0.w * 128u + off; e[4] = i1.x * 128u + off; e[5] = i1.y * 128u + off; e[6] = i1.z * 128u + off; e[7] = i1.w * 128u + off;
    e[8] = i2.x * 128u + off; e[9] = i2.y * 128u + off; e[10] = i2.z * 128u + off; e[11] = i2.w * 128u + off; e[12] = i3.x * 128u + off; e[13] = i3.y * 128u + off; e[14] = i3.z * 128u + off; e[15] = i3.w * 128u + off;
}
__device__ __forceinline__ void gather16(const unsigned char* tab, const unsigned (&e)[16], u32x4 (&wv)[16]) {
#pragma unroll
    for (int i = 0; i < 16; ++i) wv[i] = *(const u32x4*)(tab + e[i]);
}
#define FP4X32(W_, o) do { const u32x4 _w = (W_); \
    o[0] = __builtin_amdgcn_cvt_scalef32_pk_f32_fp4(_w.x, 1.0f, 0); o[1] = __builtin_amdgcn_cvt_scalef32_pk_f32_fp4(_w.x, 1.0f, 1); o[2] = __builtin_amdgcn_cvt_scalef32_pk_f32_fp4(_w.x, 1.0f, 2); o[3] = __builtin_amdgcn_cvt_scalef32_pk_f32_fp4(_w.x, 1.0f, 3); \
    o[4] = __builtin_amdgcn_cvt_scalef32_pk_f32_fp4(_w.y, 1.0f, 0); o[5] = __builtin_amdgcn_cvt_scalef32_pk_f32_fp4(_w.y, 1.0f, 1); o[6] = __builtin_amdgcn_cvt_scalef32_pk_f32_fp4(_w.y, 1.0f, 2); o[7] = __builtin_amdgcn_cvt_scalef32_pk_f32_fp4(_w.y, 1.0f, 3); \
    o[8] = __builtin_amdgcn_cvt_scalef32_pk_f32_fp4(_w.z, 1.0f, 0); o[9] = __builtin_amdgcn_cvt_scalef32_pk_f32_fp4(_w.z, 1.0f, 1); o[10] = __builtin_amdgcn_cvt_scalef32_pk_f32_fp4(_w.z, 1.0f, 2); o[11] = __builtin_amdgcn_cvt_scalef32_pk_f32_fp4(_w.z, 1.0f, 3); \
    o[12] = __builtin_amdgcn_cvt_scalef32_pk_f32_fp4(_w.w, 1.0f, 0); o[13] = __builtin_amdgcn_cvt_scalef32_pk_f32_fp4(_w.w, 1.0f, 1); o[14] = __builtin_amdgcn_cvt_scalef32_pk_f32_fp4(_w.w, 1.0f, 2); o[15] = __builtin_amdgcn_cvt_scalef32_pk_f32_fp4(_w.w, 1.0f, 3); } while (0)
__device__ __forceinline__ void peer_down_phase4(const Frame& F, int layer) {
    const int bx = blockIdx.x, p4 = bx & 3, par = (bx >> 2) & 1;
    const unsigned char* TD = F.ws + WS_TAB + (size_t)(2 * layer) * 16 * MiB + (size_t)p4 * (2 * MiB); const char* HNb = (const char*)(F.ws + WS_HN);
    const int* IDX = (const int*)(F.ws + WS_IDX); bf16_t* PART = (bf16_t*)(F.ws + WS_PART);
    const int nwp = (F.G - (bx & 7) + 7) >> 3, ww = (bx >> 3) * 8 + F.wave, stride = 2 * nwp * 8, tfirst = 2 * ww + par;
    const int lane = F.lane, r = lane & 7, g = lane >> 3, off = 256 * p4 + 32 * r;
    if (tfirst >= T) return;
    unsigned e1[16]; u32x4 wv[16];
    const unsigned toff = 16u * r;
    ld_off16(IDX, tfirst, g, toff, e1); gather16(TD, e1, wv);
    u32x4 xc[4];
#pragma unroll
    for (int k = 0; k < 4; ++k) xc[k] = *(const u32x4*)(HNb + (unsigned)(tfirst * 2048 + 2 * off + 16 * k));
    { const int t1 = tfirst + stride < T ? tfirst + stride : tfirst; ld_off16(IDX, t1, g, toff, e1); }
    for (int t0 = tfirst; t0 < T; t0 += stride) {
        const int t1 = t0 + stride < T ? t0 + stride : t0, t2 = t0 + 2 * stride < T ? t0 + 2 * stride : t0;
        unsigned e2[16]; ld_off16(IDX, t2, g, toff, e2);
        u32x4 xn[4];
#pragma unroll
        for (int k = 0; k < 4; ++k) xn[k] = *(const u32x4*)(HNb + (unsigned)(t1 * 2048 + 2 * off + 16 * k));
        const unsigned xw[16] = {xc[0].x, xc[0].y, xc[0].z, xc[0].w, xc[1].x, xc[1].y, xc[1].z, xc[1].w, xc[2].x, xc[2].y, xc[2].z, xc[2].w, xc[3].x, xc[3].y, xc[3].z, xc[3].w};
        float acc[16];
#pragma unroll
        for (int i = 0; i < 16; ++i) { const u32x4 w = wv[i]; wv[i] = *(const u32x4*)(TD + e1[i]);
            const unsigned ww4[4] = {w.x, w.y, w.z, w.w}; float sv = 0.f;
#pragma unroll
            for (int k = 0; k < 4; ++k) {
                sv = __builtin_amdgcn_fdot2_f32_bf16(__builtin_amdgcn_cvt_scalef32_pk_bf16_fp4(ww4[k], 1.0f, 0), __builtin_bit_cast(bfx2, xw[4 * k]), sv, false);
                sv = __builtin_amdgcn_fdot2_f32_bf16(__builtin_amdgcn_cvt_scalef32_pk_bf16_fp4(ww4[k], 1.0f, 1), __builtin_bit_cast(bfx2, xw[4 * k + 1]), sv, false);
                sv = __builtin_amdgcn_fdot2_f32_bf16(__builtin_amdgcn_cvt_scalef32_pk_bf16_fp4(ww4[k], 1.0f, 2), __builtin_bit_cast(bfx2, xw[4 * k + 2]), sv, false);
                sv = __builtin_amdgcn_fdot2_f32_bf16(__builtin_amdgcn_cvt_scalef32_pk_bf16_fp4(ww4[k], 1.0f, 3), __builtin_bit_cast(bfx2, xw[4 * k + 3]), sv, false); }
            acc[i] = sv; }
        float z0, z1; reduce_scatter16<1>(acc, lane, z0, z1);
        *(unsigned*)((char*)(PART + (size_t)p4 * T * 128) + (unsigned)(t0 * 256 + 32 * g + 4 * r)) = pk2(z0, z1);
#pragma unroll
        for (int k = 0; k < 4; ++k) xc[k] = xn[k];
#pragma unroll
        for (int i = 0; i < 16; ++i) e1[i] = e2[i];
    }
}
constexpr int D5_AUX = 131072;
#define D5_EL(iv, d) ((iv)[2 * ((d) & 1) + ((d) >> 3)][((d) >> 1) & 3])
#define D5_DMA(iv, d) __builtin_amdgcn_global_load_lds((const unsigned*)(TD + (D5_EL(iv, d) * 128u + (((d) & 1) ? sw1 : sw0))), (LAS unsigned*)(wl + (d) * 1024), 16, 0, 0)
#define D5_DMA_IDX(t, slot) do { __builtin_amdgcn_global_load_lds((const unsigned*)(IDX + (unsigned)((t) * 512) + l4), (LAS unsigned*)(xl + (slot) * 512), 4, 0, 0); \
                                 __builtin_amdgcn_global_load_lds((const unsigned*)(IDX + (unsigned)((t) * 512) + 256u + l4), (LAS unsigned*)(xl + (slot) * 512 + 256), 4, 0, 0); } while (0)
#define D5_DMA_H(t, slot) __builtin_amdgcn_global_load_lds((const unsigned*)(H8 + (unsigned)((t) * 1024) + l4), (LAS unsigned*)(xl + 1024 + (slot) * 256), 4, 0, 0)
#define D5_B(h, c) ((i32x8){(int)h[2 * (c)].x, (int)h[2 * (c)].y, (int)h[2 * (c)].z, (int)h[2 * (c)].w, (int)h[2 * (c) + 1].x, (int)h[2 * (c) + 1].y, (int)h[2 * (c) + 1].z, (int)h[2 * (c) + 1].w})
#define D5_A(a) ((i32x8){(int)(a).x, (int)(a).y, (int)(a).z, (int)(a).w, 0, 0, 0, 0})
__device__ __forceinline__ void peer_down_phase5(const Frame& F, int layer) {
    const int bx = blockIdx.x, p4 = bx & 3, par = (bx >> 2) & 1;
    const unsigned char* TD = F.ws + WS_TAB + (size_t)(2 * layer) * 16 * MiB + (size_t)p4 * (2 * MiB);
    const char* H8 = (const char*)(F.ws + WS_HN8) + 256 * p4; const char* IDX = (const char*)(F.ws + WS_IDX); char* PART = (char*)(F.ws + WS_PART) + (size_t)p4 * T * 256;
    const int nwp = (F.G - (bx & 7) + 7) >> 3, ww = (bx >> 3) * 8 + F.wave, stride = 2 * nwp * 8, tfirst = 2 * ww + par;
    if (tfirst >= T) return;
    const int lane = F.lane, rs = lane >> 3, sg = lane & 7, m = lane & 15, kg = lane >> 4;
    LAS unsigned char* wl = F.lds + F.wave * 16384; LAS unsigned char* xl = F.lds + D5_AUX + F.wave * 1536;
    const unsigned sw0 = (unsigned)((sg ^ kg) * 16), sw1 = (unsigned)((sg ^ (4 + kg)) * 16);
    const unsigned rd0 = (unsigned)(m * 128 + (kg ^ (m >> 1)) * 16), rd1 = (unsigned)(m * 128 + ((4 + kg) ^ (m >> 1)) * 16);
    const unsigned l4 = 4u * lane, ioff = 32u * rs, hoff = 16u * kg;
    { const u32x4* ip = (const u32x4*)(IDX + (unsigned)(tfirst * 512) + ioff); u32x4 i0[4]; i0[0] = ip[0]; i0[1] = ip[1]; i0[2] = ip[16]; i0[3] = ip[17];
      asm volatile("" : "+v"(i0[0]), "+v"(i0[1]), "+v"(i0[2]), "+v"(i0[3]) :: "memory");
      { const int t1 = tfirst + stride < T ? tfirst + stride : tfirst; D5_DMA_IDX(t1, 1); D5_DMA_H(tfirst, 0); }
      asm volatile("" ::: "memory");
#pragma unroll
      for (int d = 0; d < 16; ++d) D5_DMA(i0, d); }
    int sl = 0;
    for (int t0 = tfirst; t0 < T; t0 += stride, sl ^= 1) {
        const int t1 = t0 + stride < T ? t0 + stride : t0, t2 = t0 + 2 * stride < T ? t0 + 2 * stride : t0;
        D5_DMA_IDX(t2, sl); D5_DMA_H(t1, sl ^ 1);
        u32x4 i1[4], hb[4];
        f32x4 acc[8];
#pragma unroll
        for (int q = 0; q < 4; ++q) {
            asm volatile("s_waitcnt vmcnt(15)" ::: "memory");
            u32x4 a00 = *(const LAS u32x4*)(wl + (2 * q) * 2048 + rd0), a01 = *(const LAS u32x4*)(wl + (2 * q) * 2048 + rd1);
            u32x4 a10 = *(const LAS u32x4*)(wl + (2 * q + 1) * 2048 + rd0), a11 = *(const LAS u32x4*)(wl + (2 * q + 1) * 2048 + rd1);
            if (q == 0) {
                const LAS u32x4* ip = (const LAS u32x4*)(xl + (sl ^ 1) * 512 + ioff); i1[0] = ip[0]; i1[1] = ip[1]; i1[2] = ip[16]; i1[3] = ip[17];
                const LAS u32x4* hp = (const LAS u32x4*)(xl + 1024 + sl * 256 + hoff); hb[0] = hp[0]; hb[1] = hp[4]; hb[2] = hp[8]; hb[3] = hp[12];
                asm volatile("s_waitcnt lgkmcnt(0)" : "+v"(i1[0]), "+v"(i1[1]), "+v"(i1[2]), "+v"(i1[3]), "+v"(hb[0]), "+v"(hb[1]), "+v"(hb[2]), "+v"(hb[3]) :: "memory");
            }
            asm volatile("s_waitcnt lgkmcnt(0)" : "+v"(a00), "+v"(a01), "+v"(a10), "+v"(a11) :: "memory");
            D5_DMA(i1, 4 * q); D5_DMA(i1, 4 * q + 1); D5_DMA(i1, 4 * q + 2); D5_DMA(i1, 4 * q + 3);
            asm volatile("" ::: "memory");
            const i32x8 b0 = D5_B(hb, 0), b1 = D5_B(hb, 1);
            const f32x4 z = {0.f, 0.f, 0.f, 0.f};
            acc[2 * q] = __builtin_amdgcn_mfma_scale_f32_16x16x128_f8f6f4(D5_A(a00), b0, z, 4, 0, 0, 0, 0, 0);
            acc[2 * q + 1] = __builtin_amdgcn_mfma_scale_f32_16x16x128_f8f6f4(D5_A(a10), b0, z, 4, 0, 0, 0, 0, 0);
            acc[2 * q] = __builtin_amdgcn_mfma_scale_f32_16x16x128_f8f6f4(D5_A(a01), b1, acc[2 * q], 4, 0, 0, 0, 0, 0);
            acc[2 * q + 1] = __builtin_amdgcn_mfma_scale_f32_16x16x128_f8f6f4(D5_A(a11), b1, acc[2 * q + 1], 4, 0, 0, 0, 0, 0);
        }
        if (m < 4) {
            float v[8];
#pragma unroll
            for (int j = 0; j < 8; ++j) v[j] = m == 0 ? acc[j].x : m == 1 ? acc[j].y : m == 2 ? acc[j].z : acc[j].w;
            *(u32x4*)(PART + (unsigned)(t0 * 256 + 16 * (4 * kg + m))) = (u32x4){pk2(v[0], v[1]), pk2(v[2], v[3]), pk2(v[4], v[5]), pk2(v[6], v[7])};
        }
    }
    asm volatile("s_waitcnt vmcnt(0)" ::: "memory");
}
template <int NS> __device__ __forceinline__ void peer_reduce_phase(const Frame& F, int layer) {
    const u32x2* PART = (const u32x2*)(F.ws + WS_PART); const int* IDX = (const int*)(F.ws + WS_IDX); const float* GATE = (const float*)(F.ws + WS_GATE);
    bf16_t* AB = (bf16_t*)(F.ws + WS_AB);
    const f32x2* scl = (const f32x2*)(F.ws + WS_SCL) + (size_t)layer * 16384;
    const size_t n4 = (size_t)T * 128 / 4, stride = (size_t)F.G * 512;
    for (size_t i = (size_t)blockIdx.x * 512 + F.tid; i < n4; i += stride) {
        u32x2 pw[NS];
#pragma unroll
        for (int p = 0; p < NS; ++p) pw[p] = PART[(size_t)p * T * 32 + i];
        const u32x4 e = ((const u32x4*)IDX)[i]; const f32x4 gt = ((const f32x4*)GATE)[i];
        const f32x2 c0 = scl[e.x], c1 = scl[e.y], c2 = scl[e.z], c3 = scl[e.w];
        f32x4 s = {0.f, 0.f, 0.f, 0.f};
#pragma unroll
        for (int p = 0; p < NS; ++p) { s.x += bflo(pw[p].x); s.y += bfhi(pw[p].x); s.z += bflo(pw[p].y); s.w += bfhi(pw[p].y); }
        f32x4 o;
        o.x = gelu_tanh(s.x * c0.x) * gt.x * c0.y; o.y = gelu_tanh(s.y * c1.x) * gt.y * c1.y;
        o.z = gelu_tanh(s.z * c2.x) * gt.z * c2.y; o.w = gelu_tanh(s.w * c3.x) * gt.w * c3.y;
        ((u32x2*)AB)[i] = (u32x2){pk2(o.x, o.y), pk2(o.z, o.w)};
    }
}
__device__ __forceinline__ void peer_reduce_phase8(const Frame& F, int layer) {
    const u32x2* PART = (const u32x2*)(F.ws + WS_PART); const int* IDX = (const int*)(F.ws + WS_IDX); const float* GATE = (const float*)(F.ws + WS_GATE);
    unsigned char* AB8 = F.ws + WS_AB;
    const f32x2* scl = (const f32x2*)(F.ws + WS_SCL) + (size_t)layer * 16384;
    const size_t n4 = (size_t)T * 128 / 4, stride = (size_t)F.G * 512;
    for (size_t i = (size_t)blockIdx.x * 512 + F.tid; i < n4; i += stride) {
        u32x2 pw[4];
#pragma unroll
        for (int p = 0; p < 4; ++p) pw[p] = PART[(size_t)p * T * 32 + i];
        const u32x4 e = ((const u32x4*)IDX)[i]; const f32x4 gt = ((const f32x4*)GATE)[i];
        const f32x2 c0 = scl[e.x], c1 = scl[e.y], c2 = scl[e.z], c3 = scl[e.w];
        f32x4 s = {0.f, 0.f, 0.f, 0.f};
#pragma unroll
        for (int p = 0; p < 4; ++p) { s.x += bflo(pw[p].x); s.y += bfhi(pw[p].x); s.z += bflo(pw[p].y); s.w += bfhi(pw[p].y); }
        f32x4 o;
        o.x = gelu_tanh(s.x * c0.x) * gt.x * c0.y; o.y = gelu_tanh(s.y * c1.x) * gt.y * c1.y;
        o.z = gelu_tanh(s.z * c2.x) * gt.z * c2.y; o.w = gelu_tanh(s.w * c3.x) * gt.w * c3.y;
        float am = fmaxf(fmaxf(fabsf(o.x), fabsf(o.y)), fmaxf(fabsf(o.z), fabsf(o.w)));
#pragma unroll
        for (int d = 1; d < 32; d <<= 1) am = fmaxf(am, __shfl_xor(am, d));
        const float S = am > 0.f ? 256.0f / am : 1.0f;
        int w = 0; w = __builtin_amdgcn_cvt_pk_fp8_f32(o.x * S, o.y * S, w, false); w = __builtin_amdgcn_cvt_pk_fp8_f32(o.z * S, o.w * S, w, true);
        const size_t t = i >> 5; const unsigned j = (unsigned)i & 31u;
        *(unsigned*)(AB8 + t * 256 + 4 * j) = (unsigned)w;
        if (j == 0) *(float*)(AB8 + t * 256 + 128) = am * (1.0f / 256.0f);
    }
}
__device__ __forceinline__ unsigned hadd2(unsigned a, unsigned b) { const h16x2 r = __builtin_bit_cast(h16x2, a) + __builtin_bit_cast(h16x2, b); return __builtin_bit_cast(unsigned, r); }
__device__ __forceinline__ f32x4 reduce_scatter32h_g(const unsigned (&v)[16], int lane) {
    const bool b2 = (lane & 32) != 0, b1 = (lane & 16) != 0, b0 = (lane & 8) != 0;
    unsigned u[8], w[4], z[2];
#pragma unroll
    for (int k = 0; k < 8; ++k) { const unsigned keep = b2 ? v[8 + k] : v[k], send = b2 ? v[k] : v[8 + k]; u[k] = hadd2(keep, (unsigned)__shfl_xor((int)send, 32)); }
#pragma unroll
    for (int k = 0; k < 4; ++k) { const unsigned keep = b1 ? u[4 + k] : u[k], send = b1 ? u[k] : u[4 + k]; w[k] = hadd2(keep, (unsigned)__shfl_xor((int)send, 16)); }
#pragma unroll
    for (int k = 0; k < 2; ++k) { const unsigned keep = b0 ? w[2 + k] : w[k], send = b0 ? w[k] : w[2 + k]; z[k] = hadd2(keep, (unsigned)__shfl_xor((int)send, 8)); }
    return (f32x4){hlo(z[0]), hhi(z[0]), hlo(z[1]), hhi(z[1])};
}
__device__ __forceinline__ void peer_up_phase4(const Frame& F, int layer) {
    const int bx = blockIdx.x, p4 = bx & 3, par = (bx >> 2) & 1;
    const unsigned char* TU = F.ws + WS_TAB + (size_t)(2 * layer + 1) * 16 * MiB + (size_t)p4 * (2 * MiB);
    const int* IDX = (const int*)(F.ws + WS_IDX); const char* AB = (const char*)(F.ws + WS_AB);
    const int nwp = (F.G - (bx & 7) + 7) >> 3, ww = (bx >> 3) * 8 + F.wave, stride = 2 * nwp * 8, tfirst = 2 * ww + par;
    const int lane = F.lane, r = lane & 7, g = lane >> 3, hoff = 256 * p4 + 32 * r + 4 * g;
    if (tfirst >= T) return;
    unsigned e1[16]; u32x4 wv[16];
    const unsigned toff = 16u * r;
    ld_off16(IDX, tfirst, g, toff, e1); gather16(TU, e1, wv);
    u32x4 a0a = *(const u32x4*)(AB + (unsigned)(tfirst * 256 + 32 * g)), a0b = *(const u32x4*)(AB + (unsigned)(tfirst * 256 + 32 * g + 16));
    { const int t1 = tfirst + stride < T ? tfirst + stride : tfirst; ld_off16(IDX, t1, g, toff, e1); }
    for (int t0 = tfirst; t0 < T; t0 += stride) {
        const int t1 = t0 + stride < T ? t0 + stride : t0, t2 = t0 + 2 * stride < T ? t0 + 2 * stride : t0;
        unsigned e2[16]; ld_off16(IDX, t2, g, toff, e2);
        const u32x4 a1a = *(const u32x4*)(AB + (unsigned)(t1 * 256 + 32 * g)), a1b = *(const u32x4*)(AB + (unsigned)(t1 * 256 + 32 * g + 16));
        f32x4* hp = (f32x4*)((char*)F.out + (unsigned)(t0 * 4096 + 4 * hoff)); const f32x4 h0 = *hp;
        const unsigned aw[8] = {a0a.x, a0a.y, a0a.z, a0a.w, a0b.x, a0b.y, a0b.z, a0b.w};
        unsigned y2[16];
#pragma unroll
        for (int k = 0; k < 16; ++k) y2[k] = 0u;
#pragma unroll
        for (int i = 0; i < 16; ++i) { u32x4 w = wv[i]; wv[i] = *(const u32x4*)(TU + e1[i]);
            if (i > 0) asm volatile("" : "+v"(w.x), "+v"(w.y), "+v"(w.z), "+v"(w.w) : "v"(y2[0]), "v"(y2[15]));
            const float ai = (i & 1) ? bfhi(aw[i >> 1]) : bflo(aw[i >> 1]); const h16x2 av = {(_Float16)ai, (_Float16)ai};
            const unsigned ww4[4] = {w.x, w.y, w.z, w.w};
#pragma unroll
            for (int k = 0; k < 4; ++k) {
                { const h16x2 r = av * __builtin_amdgcn_cvt_scalef32_pk_f16_fp4(ww4[k], 1.0f, 0) + __builtin_bit_cast(h16x2, y2[4 * k]); y2[4 * k] = __builtin_bit_cast(unsigned, r); }
                { const h16x2 r = av * __builtin_amdgcn_cvt_scalef32_pk_f16_fp4(ww4[k], 1.0f, 1) + __builtin_bit_cast(h16x2, y2[4 * k + 1]); y2[4 * k + 1] = __builtin_bit_cast(unsigned, r); }
                { const h16x2 r = av * __builtin_amdgcn_cvt_scalef32_pk_f16_fp4(ww4[k], 1.0f, 2) + __builtin_bit_cast(h16x2, y2[4 * k + 2]); y2[4 * k + 2] = __builtin_bit_cast(unsigned, r); }
                { const h16x2 r = av * __builtin_amdgcn_cvt_scalef32_pk_f16_fp4(ww4[k], 1.0f, 3) + __builtin_bit_cast(h16x2, y2[4 * k + 3]); y2[4 * k + 3] = __builtin_bit_cast(unsigned, r); } } }
        const f32x4 z = reduce_scatter32h_g(y2, lane);
        *hp = h0 + z;
        a0a = a1a; a0b = a1b;
#pragma unroll
        for (int i = 0; i < 16; ++i) e1[i] = e2[i];
    }
}

constexpr int U5_AUX = 131072;
__device__ __forceinline__ void peer_up_phase5(const Frame& F, int layer) {
    const int bx = blockIdx.x, p4 = bx & 3, par = (bx >> 2) & 1;
    const unsigned char* TU = F.ws + WS_TAB + (size_t)(2 * layer + 1) * 16 * MiB + (size_t)p4 * (2 * MiB);
    const char* IDX = (const char*)(F.ws + WS_IDX); const char* AB8 = (const char*)(F.ws + WS_AB);
    const char* HIN = (const char*)F.out + 512 * p4; char* OUT = (layer == 1 ? (char*)(F.ws + WS_H2) : (char*)F.out) + 512 * p4;
    const int nwp = (F.G - (bx & 7) + 7) >> 3, ww = (bx >> 3) * 8 + F.wave, stride = 2 * nwp * 8, tfirst = 2 * ww + par;
    if (tfirst >= T) return;
    const int lane = F.lane, rs = lane >> 3, sg = lane & 7, m = lane & 15, kg = lane >> 4;
    LAS unsigned char* wl = F.lds + F.wave * 16384; LAS unsigned char* xl = F.lds + U5_AUX + F.wave * 3584;
    const unsigned sw0 = (unsigned)((sg ^ kg) * 16), sw1 = (unsigned)((sg ^ (4 + kg)) * 16);
    const unsigned l4 = 4u * lane, l16 = 16u * lane;
    unsigned tb[8];
#pragma unroll
    for (int sgm = 0; sgm < 8; ++sgm) tb[sgm] = (unsigned)((32 * kg + m) * 128 + ((sgm ^ (m >> 1)) * 16));
    const unsigned hrd = (unsigned)(32 * m + 8 * kg);
#define U5_PIECE(ixv, d) __builtin_amdgcn_global_load_lds((const unsigned*)(TU + ((ixv)[d] * 128u + (((d) & 1) ? sw1 : sw0))), (LAS unsigned*)(wl + (d) * 1024), 16, 0, 0)
#define U5_DMA_IDX(t, slot) do { __builtin_amdgcn_global_load_lds((const unsigned*)(IDX + (unsigned)((t) * 512) + l4), (LAS unsigned*)(xl + (slot) * 512), 4, 0, 0); \
                                 __builtin_amdgcn_global_load_lds((const unsigned*)(IDX + (unsigned)((t) * 512) + 256u + l4), (LAS unsigned*)(xl + (slot) * 512 + 256), 4, 0, 0); } while (0)
#define U5_DMA_AB(t, slot) __builtin_amdgcn_global_load_lds((const unsigned*)(AB8 + (unsigned)((t) * 256) + l4), (LAS unsigned*)(xl + 1024 + (slot) * 256), 4, 0, 0)
#define U5_DMA_H(t, slot) do { __builtin_amdgcn_global_load_lds((const unsigned*)(HIN + (unsigned)((t) * 2048) + l4), (LAS unsigned*)(xl + 1536 + (slot) * 1024), 4, 0, 0); \
                               __builtin_amdgcn_global_load_lds((const unsigned*)(HIN + (unsigned)((t) * 2048) + 256u + l4), (LAS unsigned*)(xl + 1536 + (slot) * 1024 + 256), 4, 0, 0); } while (0)
    { unsigned i0[16];
#pragma unroll
      for (int d = 0; d < 16; ++d) i0[d] = *(const unsigned*)(IDX + (unsigned)(tfirst * 512) + (unsigned)(4 * rs + 32 * d));
#pragma unroll
      for (int d = 0; d < 16; ++d) asm volatile("" : "+v"(i0[d]) :: "memory");
      { const int t1 = tfirst + stride < T ? tfirst + stride : tfirst; U5_DMA_IDX(t1, 1); U5_DMA_AB(tfirst, 0); U5_DMA_H(tfirst, 0); }
      asm volatile("" ::: "memory");
#pragma unroll
      for (int d = 0; d < 16; ++d) U5_PIECE(i0, d); }
    int sl = 0, tprev = -1; f32x4 pend = {0.f, 0.f, 0.f, 0.f};
    for (int t0 = tfirst; t0 < T; t0 += stride, sl ^= 1) {
        const int t1 = t0 + stride < T ? t0 + stride : t0, t2 = t0 + 2 * stride < T ? t0 + 2 * stride : t0;
        asm volatile("s_waitcnt vmcnt(0)" ::: "memory");
        unsigned ix[16];
        { const LAS unsigned* ip = (const LAS unsigned*)(xl + (sl ^ 1) * 512 + 4 * rs);
#pragma unroll
          for (int d = 0; d < 16; ++d) ix[d] = ip[8 * d]; }
        const LAS u32x4* bp = (const LAS u32x4*)(xl + 1024 + sl * 256 + 16 * kg); u32x4 bl = bp[0], bh = bp[4];
        float inv = *(const LAS float*)(xl + 1024 + sl * 256 + 128);
        u32x2 hw = *(const LAS u32x2*)(xl + 1536 + sl * 1024 + hrd);
        i32x2 a0[16], a1[16];
#pragma unroll
        for (int cb = 0; cb < 16; ++cb) {
            a0[cb] = __builtin_amdgcn_ds_read_tr4_b64_v2i32((LAS i32x2*)(wl + tb[cb >> 1] + (cb & 1) * 8));
            a1[cb] = __builtin_amdgcn_ds_read_tr4_b64_v2i32((LAS i32x2*)(wl + tb[cb >> 1] + (cb & 1) * 8 + 2048)); }
        asm volatile("s_waitcnt lgkmcnt(0)" : "+v"(bl), "+v"(bh), "+v"(inv), "+v"(hw) :: "memory");
#pragma unroll
        for (int d = 0; d < 16; ++d) asm volatile("" : "+v"(ix[d]), "+v"(a0[d]), "+v"(a1[d]) :: "memory");
        if (tprev >= 0) *(u32x2*)(OUT + (unsigned)(tprev * 2048) + hrd) = (u32x2){pk2(pend.x, pend.y), pk2(pend.z, pend.w)};
        asm volatile("" ::: "memory");
        U5_DMA_IDX(t2, sl); U5_DMA_AB(t1, sl ^ 1); U5_DMA_H(t1, sl ^ 1);
#pragma unroll
        for (int d = 0; d < 16; ++d) U5_PIECE(ix, d);
        asm volatile("" ::: "memory");
        const i32x8 b = {(int)bl.x, (int)bl.y, (int)bl.z, (int)bl.w, (int)bh.x, (int)bh.y, (int)bh.z, (int)bh.w};
        const f32x4 z = {0.f, 0.f, 0.f, 0.f};
        f32x4 v = z;
#pragma unroll
        for (int cb = 0; cb < 16; ++cb) {
            const i32x8 a = {a0[cb].x, a0[cb].y, a1[cb].x, a1[cb].y, 0, 0, 0, 0};
            const f32x4 r = __builtin_amdgcn_mfma_scale_f32_16x16x128_f8f6f4(a, b, z, 4, 0, 0, 0, 0, 0);
            v = (m == cb) ? r : v; }
        pend = (f32x4){bflo(hw.x), bfhi(hw.x), bflo(hw.y), bfhi(hw.y)} + v * inv; tprev = t0;
    }
    asm volatile("s_waitcnt vmcnt(0)" ::: "memory");
    *(u32x2*)(OUT + (unsigned)(tprev * 2048) + hrd) = (u32x2){pk2(pend.x, pend.y), pk2(pend.z, pend.w)};
#undef U5_PIECE
#undef U5_DMA_IDX
#undef U5_DMA_AB
#undef U5_DMA_H
}

constexpr int SGM_VT = 0, SGM_WL = 384 * 272, SGM_STAT = SGM_WL + 128 * 272;
__device__ __forceinline__ void sg_mix_phase(const Frame& F) {
    bf16_t* V = (bf16_t*)(F.ws + WS_SG);
    const float* lng = F.in[7]; const float* lnb = F.in[8]; const float* wsp = F.in[9]; const float* bsp = F.in[10];
    LAS unsigned* VT32 = (LAS unsigned*)(F.lds + SGM_VT); LAS bf16_t* VT = (LAS bf16_t*)(F.lds + SGM_VT); LAS bf16_t* WL = (LAS bf16_t*)(F.lds + SGM_WL);
    LAS float* stat = (LAS float*)(F.lds + SGM_STAT);
    const int lane = F.lane, tid = F.tid, fr = lane & 15, fq = lane >> 4;
    for (int c = blockIdx.x; c < 256; c += F.G) {
#pragma unroll 1
        for (int r = 0; r < 16; ++r) {
            const int q = F.wave * 16 + r; const u32x4* row = (const u32x4*)(V + (size_t)(c * 128 + q) * DG);
            float v[48]; float s = 0.f;
#pragma unroll
            for (int i = 0; i < 6; ++i) { const u32x4 w = row[lane + 64 * i];
                v[8 * i + 0] = bflo(w.x); v[8 * i + 1] = bfhi(w.x); v[8 * i + 2] = bflo(w.y); v[8 * i + 3] = bfhi(w.y); v[8 * i + 4] = bflo(w.z); v[8 * i + 5] = bfhi(w.z); v[8 * i + 6] = bflo(w.w); v[8 * i + 7] = bfhi(w.w); }
#pragma unroll
            for (int i = 0; i < 48; ++i) s += v[i];
            const float mean = wave_sum(s) * (1.f / DG); float s2 = 0.f;
#pragma unroll
            for (int i = 0; i < 48; ++i) { const float d = v[i] - mean; s2 += d * d; }
            const float rstd = 1.0f / sqrtf(wave_sum(s2) * (1.f / DG) + 1e-5f);
            if (lane == 0) { stat[2 * q] = mean; stat[2 * q + 1] = rstd; }
        }
        __syncthreads();
#pragma unroll 1
        for (int g = 0; g < 8; ++g) {
#pragma unroll 1
            for (int it = 0; it < 4; ++it) { const int item = it * 512 + tid, p = item >> 4, q8 = (item & 15) * 8;
                const f32x4* wp = (const f32x4*)(wsp + ((size_t)g * 128 + p) * 128 + q8); const f32x4 a = wp[0], b = wp[1];
                u32x4 w; w.x = pk2(a.x, a.y); w.y = pk2(a.z, a.w); w.z = pk2(b.x, b.y); w.w = pk2(b.z, b.w);
                *(LAS u32x4*)(WL + p * 136 + q8) = w; }
#pragma unroll 1
            for (int it = 0; it < 6; ++it) { const int item = it * 512 + tid, qp = item & 63, dc = item >> 6; const int q0 = 2 * qp, col = g * 384 + 8 * dc;
                const u32x4 w0 = *(const u32x4*)(V + (size_t)(c * 128 + q0) * DG + col), w1 = *(const u32x4*)(V + (size_t)(c * 128 + q0 + 1) * DG + col);
                const float mu0 = stat[2 * q0], rs0 = stat[2 * q0 + 1], mu1 = stat[2 * q0 + 2], rs1 = stat[2 * q0 + 3];
                const f32x4 ga = *(const f32x4*)(lng + col), gb = *(const f32x4*)(lng + col + 4), ba = *(const f32x4*)(lnb + col), bb = *(const f32x4*)(lnb + col + 4);
                const float gm[8] = {ga.x, ga.y, ga.z, ga.w, gb.x, gb.y, gb.z, gb.w}, bt[8] = {ba.x, ba.y, ba.z, ba.w, bb.x, bb.y, bb.z, bb.w};
                const float a0[8] = {bflo(w0.x), bfhi(w0.x), bflo(w0.y), bfhi(w0.y), bflo(w0.z), bfhi(w0.z), bflo(w0.w), bfhi(w0.w)};
                const float a1[8] = {bflo(w1.x), bfhi(w1.x), bflo(w1.y), bfhi(w1.y), bflo(w1.z), bfhi(w1.z), bflo(w1.w), bfhi(w1.w)};
#pragma unroll
                for (int i = 0; i < 8; ++i) VT32[(8 * dc + i) * 68 + qp] = pk2((a0[i] - mu0) * rs0 * gm[i] + bt[i], (a1[i] - mu1) * rs1 * gm[i] + bt[i]); }
            __syncthreads();
            f32x4 acc[3][8];
#pragma unroll
            for (int a = 0; a < 3; ++a)
#pragma unroll
                for (int n = 0; n < 8; ++n) acc[a][n] = (f32x4){0.f, 0.f, 0.f, 0.f};
#pragma unroll 1
            for (int ks = 0; ks < 4; ++ks) { const int k0 = 32 * ks + 8 * fq;
                bf16x8 af[3], bfg[8];
#pragma unroll
                for (int a = 0; a < 3; ++a) af[a] = *(const LAS bf16x8*)(VT + (16 * (3 * F.wave + a) + fr) * 136 + k0);
#pragma unroll
                for (int n = 0; n < 8; ++n) bfg[n] = *(const LAS bf16x8*)(WL + (16 * n + fr) * 136 + k0);
#pragma unroll
                for (int a = 0; a < 3; ++a)
#pragma unroll
                    for (int n = 0; n < 8; ++n) acc[a][n] = __builtin_amdgcn_mfma_f32_16x16x32_bf16(af[a], bfg[n], acc[a][n], 0, 0, 0); }
#pragma unroll
            for (int n = 0; n < 8; ++n) { const int p = 16 * n + fr; const float bs = bsp[g * 128 + p];
#pragma unroll
                for (int a = 0; a < 3; ++a) { const int d0 = 16 * (3 * F.wave + a) + 4 * fq;
                    u32x2 w; w.x = pk2(acc[a][n][0] + bs, acc[a][n][1] + bs); w.y = pk2(acc[a][n][2] + bs, acc[a][n][3] + bs);
                    *(u32x2*)(V + (size_t)(c * 128 + p) * DG + g * 384 + d0) = w; } }
            __syncthreads();
        }
    }
}

__global__ void __launch_bounds__(512, 2) fwd(Args args) {
    extern __shared__ __attribute__((aligned(16))) unsigned char lds_raw[];
    Frame F;
    F.lds = (LAS unsigned char*)lds_raw;
    F.tid = threadIdx.x; F.lane = F.tid & 63; F.wave = __builtin_amdgcn_readfirstlane(F.tid >> 6);
    F.G = gridDim.x; F.gw = blockIdx.x * 8 + F.wave; F.NGW = F.G * 8;
    F.in = args.in; F.out = args.out; F.ws = args.ws;
    volatile LAS unsigned* MISC = (volatile LAS unsigned*)(F.lds + MISC_OFF);
    if (F.tid < 64) MISC[F.tid] = 0u;
    __syncthreads();
    const int lo = args.ph_lo, hi = args.ph_hi;
    unsigned* barw = (unsigned*)(F.ws + WS_CTL) + CW_BAR;
    XcdBarrier bar; bar.bar = barw; bar.x = 0; bar.st = MISC + 8;
    if (hi - lo > 1) bar = xcd_barrier_post(barw, MISC + 8);
#define IN(k) (lo <= (k) && (k) < hi)
#define SEAM(k) do { if (IN(k) && IN((k) + 1)) xcd_barrier(bar); } while (0)
    const int G = F.G, bx = blockIdx.x;
    bf16_t* HN = (bf16_t*)(F.ws + WS_HN); bf16_t* HB = (bf16_t*)F.out;

    if (IN(0)) { p0_prologue(F); } SEAM(0);
    if (IN(1)) {
        const bf16_t* HN8 = (const bf16_t*)(F.ws + WS_HN8B);
        { pg8::Gemm g{HN8, (const bf16_t*)(F.ws + WS_WQK), T, NQK, D / 2}; pg8::StaticOrder S; S.init(T, NQK, G, bx);
          pg8::EpiBf<3> E{(bf16_t*)(F.ws + WS_Q), 1024, (bf16_t*)(F.ws + WS_K), 1.0f / W8_SCALE};
          pg8::gemm_phase<1>(F.lds, g, S, E); }
        __syncthreads();
        { pg8::Gemm g{(const bf16_t*)(F.ws + WS_WV), HN8, 256, T, D / 2}; pg8::StaticOrder S; S.init(256, T, G, (bx + G / 2) % G);
          pg8::EpiBf<0> E{(bf16_t*)(F.ws + WS_VT), T, nullptr, 1.0f / W8_SCALE};
          pg8::gemm_phase<1>(F.lds, g, S, E); }
    } SEAM(1);
    if (IN(2)) { attn_phase_v2(F); } SEAM(2);
    if (IN(3)) {
        pg8::Gemm g{(const bf16_t*)(F.ws + WS_AO), (const bf16_t*)(F.ws + WS_WO), T, D, D / 2}; pg8::StaticOrder S; S.init(T, D, G, bx);
        pg8::EpiBf<6> E{HB, D, (bf16_t*)F.in[0], 1.0f / (W8_SCALE * AO8_SCALE)};
        pg8::gemm_phase<1>(F.lds, g, S, E);
    } SEAM(3);
    if (IN(4)) { quant_wqk(F); rmsnorm_rows_bf(F, HB, F.in[12], nullptr, F.ws + WS_HN8, F.ws + WS_HNI8, (float*)(F.ws + WS_HSC)); } SEAM(4);
    if (IN(5)) {
        pg8::Gemm g{(const bf16_t*)(F.ws + WS_HNI8), (const bf16_t*)(F.ws + WS_WQ8), T, 2048, D / 2}; pg8::StaticOrder S; S.init(T, 2048, G, bx);
        pg8::EpiBf<8> E{(bf16_t*)(F.ws + WS_S), 2048, (bf16_t*)(F.ws + WS_HSC), 1.0f, (const float*)(F.ws + WS_CTL) + CW_WSCL};
        pg8::gemm_phase<2>(F.lds, g, S, E);
    } SEAM(5);
    if (IN(6)) { topk_phase_v3(F); } SEAM(6);
    if (IN(7)) { peer_down_phase5(F, 0); } SEAM(7);
    if (IN(8)) { peer_reduce_phase8(F, 0); } SEAM(8);
    if (IN(9)) { peer_up_phase5(F, 0); } SEAM(9);
    if (IN(10)) { rmsnorm_rows_bf(F, HB, F.in[2] + D, nullptr, F.ws + WS_HN8B); } SEAM(10);
    if (IN(11)) {
        pg8::Gemm g{(const bf16_t*)(F.ws + WS_HN8B), (const bf16_t*)(F.ws + WS_WSGV), T, DG, D / 2}; pg8::StaticOrder S; S.init(T, DG, G, bx);
        pg8::EpiBf<1> E{(bf16_t*)(F.ws + WS_SG), DG, nullptr, 1.0f / W8_SCALE};
        pg8::gemm_phase<1>(F.lds, g, S, E);
    } SEAM(11);
    if (IN(12)) { sg_mix_phase(F); } SEAM(12);
    if (IN(13)) {
        pg8::Gemm g{(const bf16_t*)(F.ws + WS_HN8B), (const bf16_t*)(F.ws + WS_WSGU), T, DG, D / 2}; pg8::StaticOrder S; S.init(T, DG, G, bx);
        pg8::EpiBf<5> E{(bf16_t*)(F.ws + WS_SG), DG, (bf16_t*)(F.ws + WS_SG8), 1.0f / W8_SCALE};
        pg8::gemm_phase<1>(F.lds, g, S, E);
    } SEAM(13);
    if (IN(14)) {
        pg8::Gemm g{(const bf16_t*)(F.ws + WS_SG8), (const bf16_t*)(F.ws + WS_WSGO), T, D, DG / 2}; pg8::StaticOrder S; S.init(T, D, G, bx);
        pg8::EpiBf<7> E{HB, D, nullptr, 1.0f / W8_SCALE};
        pg8::gemm_phase<1>(F.lds, g, S, E);
    } SEAM(14);
    if (IN(15)) { rmsnorm_rows_bf(F, HB, F.in[12] + D, nullptr, F.ws + WS_HN8, F.ws + WS_HNI8, (float*)(F.ws + WS_HSC)); } SEAM(15);
    if (IN(16)) {
        pg8::Gemm g{(const bf16_t*)(F.ws + WS_HNI8), (const bf16_t*)(F.ws + WS_WQ8 + (size_t)2048 * 1024), T, 2048, D / 2}; pg8::StaticOrder S; S.init(T, 2048, G, bx);
        pg8::EpiBf<8> E{(bf16_t*)(F.ws + WS_S), 2048, (bf16_t*)(F.ws + WS_HSC), 1.0f, (const float*)(F.ws + WS_CTL) + CW_WSCL + 2048};
        pg8::gemm_phase<2>(F.lds, g, S, E);
    } SEAM(16);
    if (IN(17)) { topk_phase_v3(F); } SEAM(17);
    if (IN(18)) { peer_down_phase5(F, 1); } SEAM(18);
    if (IN(19)) { peer_reduce_phase8(F, 1); } SEAM(19);
    if (IN(20)) { peer_up_phase5(F, 1); } SEAM(20);
    if (IN(21)) { final_norm_bf(F, (const bf16_t*)(F.ws + WS_H2), F.out, F.in[17]); }
#undef IN
#undef SEAM
}

extern "C" void kernel_launch(void* const* d_in, const int* in_sizes, int n_in, void* d_out, int out_size, void* d_ws, size_t ws_size, hipStream_t stream) {
    static int grid = 0;
    if (grid == 0) {
        if (n_in != 18 || out_size != T * D || ws_size < WS_END) { fprintf(stderr, "kernel_launch: unexpected problem (n_in %d, out %d, ws %zu)\n", n_in, out_size, ws_size); grid = -1; return; }
        int dev = 0, cus = 0, per_cu = 0;
        if (hipGetDevice(&dev) != hipSuccess || hipDeviceGetAttribute(&cus, hipDeviceAttributeMultiprocessorCount, dev) != hipSuccess) { grid = -1; return; }
        if (hipFuncSetAttribute((const void*)fwd, hipFuncAttributeMaxDynamicSharedMemorySize, LDS_BYTES) != hipSuccess) { fprintf(stderr, "kernel_launch: hipFuncSetAttribute failed\n"); grid = -1; return; }
        if (hipOccupancyMaxActiveBlocksPerMultiprocessor(&per_cu, (const void*)fwd, 512, LDS_BYTES) != hipSuccess || per_cu < 1) fprintf(stderr, "kernel_launch: occupancy query says %d\n", per_cu);
        (void)hipGetLastError();
        grid = cus;
    }
    if (grid < 0) return;
    (void)hipMemsetAsync((char*)d_ws + WS_CTL, 0, CTL_ZERO_BYTES, stream);
    Args a{};
    for (int i = 0; i < 18; ++i) a.in[i] = (const float*)d_in[i];
    a.out = (float*)d_out; a.ws = (unsigned char*)d_ws;
#if MK_ONE_LAUNCH
    a.ph_lo = 0; a.ph_hi = NPH;
    hipLaunchKernelGGL(fwd, dim3(grid), dim3(512), LDS_BYTES, stream, a);
#else
    for (int ph = 0; ph < NPH; ++ph) {
        a.ph_lo = ph; a.ph_hi = ph + 1;
        hipLaunchKernelGGL(fwd, dim3(grid), dim3(512), LDS_BYTES, stream, a);
    }
#endif
}
```

```cpp
#include <hip/hip_runtime.h>
#include <cstdio>

#ifndef MK_ONE_LAUNCH
#define MK_ONE_LAUNCH 1
#endif

#define LAS __attribute__((address_space(3)))
#define GAS __attribute__((address_space(1)))
typedef unsigned short bf16_t;
typedef short bf16x8 __attribute__((ext_vector_type(8)));
typedef float f32x4 __attribute__((ext_vector_type(4)));
typedef float f32x2 __attribute__((ext_vector_type(2)));
typedef unsigned u32x4 __attribute__((ext_vector_type(4)));
typedef unsigned u32x2 __attribute__((ext_vector_type(2)));
typedef int i32x8 __attribute__((ext_vector_type(8)));
typedef int i32x2 __attribute__((ext_vector_type(2)));
typedef int i32x4 __attribute__((ext_vector_type(4)));

constexpr int T = 32768, D = 1024, SEQ = 2048;
constexpr int DG = 3072;
constexpr int NQK = 1280;
constexpr int NPH = 22;

constexpr size_t MiB = 1u << 20;
constexpr size_t WS_CTL = 0, CTL_ZERO_BYTES = 1 * MiB;
constexpr size_t WS_BIAS = 1 * MiB;
constexpr size_t WS_WQK = 2 * MiB;
constexpr size_t WS_WV = WS_WQK + (size_t)1280 * 1024 * 2;
constexpr size_t WS_WO = 5 * MiB;
constexpr size_t WS_WSGV = 7 * MiB;
constexpr size_t WS_WSGU = 13 * MiB;
constexpr size_t WS_WSGO = 19 * MiB;
constexpr size_t WS_WQKP = 25 * MiB;
constexpr size_t WS_HN = 34 * MiB;
constexpr size_t WS_SCL = 1 * MiB + 64 * 1024;
constexpr size_t WS_TAB = 98 * MiB;
constexpr size_t WS_IDX = 162 * MiB;
constexpr size_t WS_GATE = 178 * MiB;
constexpr size_t WS_SCR = 194 * MiB;
constexpr size_t WS_Q = WS_SCR, WS_K = WS_SCR + 64 * MiB, WS_VT = WS_SCR + 80 * MiB, WS_AO = WS_SCR + 96 * MiB;
constexpr size_t WS_S = WS_SCR;
constexpr size_t WS_SG = WS_SCR;
constexpr size_t WS_PART = WS_SCR;
constexpr size_t WS_AB = WS_SCR + 128 * MiB;
constexpr size_t WS_HN8 = WS_SCR + 200 * MiB;
constexpr size_t WS_H8 = 34 * MiB;
constexpr size_t WS_HSQ = 34 * MiB + 40 * MiB;
constexpr size_t WS_END = WS_SCR + 292 * MiB;
constexpr int CW_BAR = 4096;
constexpr int CW_COLMAX = 16384;
constexpr int CW_WSCL = 32768;
constexpr size_t WS_WQ8 = WS_SCR + 288 * MiB;
constexpr size_t WS_HNI8 = 34 * MiB;
constexpr size_t WS_HSC = 34 * MiB + 32 * MiB;
constexpr size_t WS_H2 = WS_SCR + 32 * MiB;
constexpr float AO8_SCALE = 8.0f;
constexpr float W8_SCALE = 256.0f;
constexpr size_t WS_HN8B = WS_IDX;
constexpr size_t WS_SG8 = WS_SCR + 192 * MiB;

constexpr int LDS_BYTES = 163840;
constexpr int MISC_OFF = LDS_BYTES - 256;

typedef __bf16 bfx2 __attribute__((ext_vector_type(2)));
__device__ __forceinline__ unsigned pk2(float lo, float hi) { const bfx2 v = {(__bf16)lo, (__bf16)hi}; return __builtin_bit_cast(unsigned, v); }
__device__ __forceinline__ unsigned f2bf(float f) { return pk2(f, 0.f) & 0xffffu; }
typedef _Float16 h16x2 __attribute__((ext_vector_type(2)));
__device__ __forceinline__ unsigned pkh2(float lo, float hi) { const h16x2 h = {(_Float16)lo, (_Float16)hi}; return __builtin_bit_cast(unsigned, h); }
__device__ __forceinline__ float hlo(unsigned w) { return (float)__builtin_bit_cast(h16x2, w).x; }
__device__ __forceinline__ float hhi(unsigned w) { return (float)__builtin_bit_cast(h16x2, w).y; }
__device__ __forceinline__ float bflo(unsigned w) { return __builtin_bit_cast(float, w << 16); }
__device__ __forceinline__ float bfhi(unsigned w) { return __builtin_bit_cast(float, w & 0xffff0000u); }
__device__ __forceinline__ float bf2f(bf16_t b) { return __builtin_bit_cast(float, ((unsigned)b) << 16); }
__device__ __forceinline__ float wave_sum(float v) {
#pragma unroll
    for (int o = 1; o < 64; o <<= 1) v += __shfl_xor(v, o);
    return v;
}
__device__ __forceinline__ float wave_max(float v) {
#pragma unroll
    for (int o = 1; o < 64; o <<= 1) v = fmaxf(v, __shfl_xor(v, o));
    return v;
}
__device__ __forceinline__ unsigned wave_max_u(unsigned v) {
#pragma unroll
    for (int o = 1; o < 64; o <<= 1) { const unsigned w = (unsigned)__shfl_xor((int)v, o); v = w > v ? w : v; }
    return v;
}
__device__ __forceinline__ float gelu_tanh(float x) {
    const float u = x * (-2.302208198144325f) * (1.0f + 0.044715f * x * x);
    return x * __builtin_amdgcn_rcpf(1.0f + __builtin_amdgcn_exp2f(u));
}
#define LDS_WAIT() asm volatile("s_waitcnt lgkmcnt(0)" ::: "memory")
#define VM_WAIT() asm volatile("s_waitcnt vmcnt(0)" ::: "memory")

namespace pg8 {
#define PG8_LAS __attribute__((address_space(3)))
constexpr int BM = 256, BK = 64, HALF = 128, HTB = HALF * BK * 2, STAGE_BYTES = 8 * HTB, NXCD = 8, WGM = 8;
__host__ __device__ __forceinline__ int lds_byte(int r, int c) { const int st = (r >> 4) * 2 + (c >> 5), rr = r & 15, cc = c & 31, ob = rr * 64 + cc * 2; return st * 1024 + (ob ^ (((ob >> 9) & 1) << 5)); }
__host__ __device__ __forceinline__ void stage_rc(int b, int& R, int& C) { const int st = b / 1024, sb = b % 1024, swz = sb ^ (((sb >> 9) & 1) << 5); R = (st >> 1) * 16 + swz / 64; C = (st & 1) * 32 + (swz % 64) / 2; }
__host__ __device__ __forceinline__ int perm32(int rho) { const int n = rho >> 4, i = rho & 15; return 8 * (i >> 2) + 4 * n + (i & 3); }
struct Unit { int pm, pn; };
struct Gemm { const bf16_t* A; const bf16_t* Bt; int M, N, K; };
struct StaticOrder {
    int nM, nN, nwg, G, c;
    __host__ __device__ void init(int M, int N, int G_, int c_) { nM = M / BM; nN = N / BM; nwg = nM * nN; G = G_; c = c_; }
    __host__ __device__ bool next(int i, Unit& u) const {
        const long L = (long)i * G + c; if (L >= nwg) return false;
        int wgid = (int)L; { const int q = nwg / NXCD, r = nwg % NXCD, xcd = wgid % NXCD, off = wgid / NXCD; wgid = (xcd < r ? xcd * (q + 1) : r * (q + 1) + (xcd - r) * q) + off; }
        const int nig = WGM * nN, gid = wgid / nig, fm = gid * WGM, gsz = (nM - fm) < WGM ? (nM - fm) : WGM;
        u.pm = fm + ((wgid % nig) % gsz); u.pn = (wgid % nig) / gsz; return true;
    }
    __device__ __forceinline__ void a_ready(const Unit&) const {}
    __device__ __forceinline__ void done(const Unit&) const {}
};

template <int MODE, bool RSQ = false> struct EpiBf {
    static constexpr bool PERM = true, AFTER_DRAIN = false;
    bf16_t* O; int ldc; bf16_t* O2; float sc = 1.0f; const float* aux = nullptr; const float* rsq = nullptr;
    __device__ __forceinline__ void operator()(const f32x4 (&acc)[2][2][4][2], const Unit& u, int wr, int wc, int fr, int fq) const {
        const int row0 = u.pm * BM + wr * 64 + fr; int colt = u.pn * BM; bf16_t* base = O; int ld = ldc;
        if (MODE == 3) { if (u.pn >= 4) { base = O2; ld = 256; colt = 0; } else { ld = 1024; } }
        const int col0 = colt + wc * 32 + 8 * fq;
        float rrow[2][4]; f32x4 ccol[2][2];
        if (RSQ || MODE == 8) {
#pragma unroll
            for (int ai = 0; ai < 2; ++ai)
#pragma unroll
                for (int m = 0; m < 4; ++m) { const int row = row0 + ai * HALF + m * 16;
                    if (RSQ) { const f32x4 q4 = *(const f32x4*)(rsq + (size_t)row * 4); rrow[ai][m] = ((q4.x + q4.y) + (q4.z + q4.w)) * (1.f / 1024.f) + 1e-6f; }
                    else rrow[ai][m] = ((const float*)O2)[row]; }
            if (MODE == 8) {
#pragma unroll
                for (int bj = 0; bj < 2; ++bj) { const f32x4* cp = (const f32x4*)(aux + col0 + bj * HALF); ccol[bj][0] = cp[0]; ccol[bj][1] = cp[1]; } }
            if (RSQ) {
#pragma unroll
                for (int ai = 0; ai < 2; ++ai)
#pragma unroll
                    for (int m = 0; m < 4; ++m) rrow[ai][m] = __builtin_amdgcn_rsqf(rrow[ai][m]); }
        }
#pragma unroll
        for (int ai = 0; ai < 2; ++ai) {
          u32x4 pre[4][2]; f32x4 prex[4][2][2];
          if (MODE == 2 || MODE == 5 || MODE == 7) {
#pragma unroll
            for (int m = 0; m < 4; ++m)
#pragma unroll
                for (int bj = 0; bj < 2; ++bj) pre[m][bj] = *(const u32x4*)(base + (size_t)(row0 + ai * HALF + m * 16) * ld + col0 + bj * HALF); }
          if (MODE == 6) {
#pragma unroll
            for (int m = 0; m < 4; ++m)
#pragma unroll
                for (int bj = 0; bj < 2; ++bj) { const f32x4* xp = (const f32x4*)((const float*)O2 + (size_t)(row0 + ai * HALF + m * 16) * ld + col0 + bj * HALF); prex[m][bj][0] = xp[0]; prex[m][bj][1] = xp[1]; } }
#pragma unroll
            for (int m = 0; m < 4; ++m) { bf16_t* rowp = base + (size_t)(row0 + ai * HALF + m * 16) * ld + col0;
#pragma unroll
                for (int bj = 0; bj < 2; ++bj) { f32x4 v0 = acc[ai][bj][m][0], v1 = acc[ai][bj][m][1];
                    if (RSQ) { const float rr = rrow[ai][m]; v0 = v0 * rr; v1 = v1 * rr; }
                    if (MODE == 8) { const float rs = rrow[ai][m]; const f32x4 c0 = ccol[bj][0] * rs, c1 = ccol[bj][1] * rs;
                        const i32x4 i0 = __builtin_bit_cast(i32x4, v0), i1 = __builtin_bit_cast(i32x4, v1);
                        v0 = (f32x4){(float)i0.x, (float)i0.y, (float)i0.z, (float)i0.w} * c0; v1 = (f32x4){(float)i1.x, (float)i1.y, (float)i1.z, (float)i1.w} * c1; }
                    if (MODE == 0 || MODE == 3) {
#pragma unroll
                        for (int j = 0; j < 4; ++j) { v0[j] *= sc; v1[j] *= sc; } }
                    if (MODE == 6) { v0 = prex[m][bj][0] + v0 * sc; v1 = prex[m][bj][1] + v1 * sc; }
                    if (MODE == 7) { const u32x4 hv = pre[m][bj];
                        v0[0] = bflo(hv.x) + v0[0] * sc; v0[1] = bfhi(hv.x) + v0[1] * sc; v0[2] = bflo(hv.y) + v0[2] * sc; v0[3] = bfhi(hv.y) + v0[3] * sc;
                        v1[0] = bflo(hv.z) + v1[0] * sc; v1[1] = bfhi(hv.z) + v1[1] * sc; v1[2] = bflo(hv.w) + v1[2] * sc; v1[3] = bfhi(hv.w) + v1[3] * sc; }
                    if (MODE == 1 || MODE == 2 || MODE == 5) {
#pragma unroll
                        for (int j = 0; j < 4; ++j) { v0[j] = gelu_tanh(v0[j] * sc); v1[j] = gelu_tanh(v1[j] * sc); } }
                    if (MODE == 2 || MODE == 5) { const u32x4 mv = pre[m][bj];
                        v0[0] *= bflo(mv.x); v0[1] *= bfhi(mv.x); v0[2] *= bflo(mv.y); v0[3] *= bfhi(mv.y);
                        v1[0] *= bflo(mv.z); v1[1] *= bfhi(mv.z); v1[2] *= bflo(mv.w); v1[3] *= bfhi(mv.w); }
                    if (MODE == 5) { int w0 = 0, w1 = 0;
                        w0 = __builtin_amdgcn_cvt_pk_fp8_f32(v0[0], v0[1], w0, false); w0 = __builtin_amdgcn_cvt_pk_fp8_f32(v0[2], v0[3], w0, true);
                        w1 = __builtin_amdgcn_cvt_pk_fp8_f32(v1[0], v1[1], w1, false); w1 = __builtin_amdgcn_cvt_pk_fp8_f32(v1[2], v1[3], w1, true);
                        *(u32x2*)((unsigned char*)O2 + (size_t)(row0 + ai * HALF + m * 16) * ld + col0 + bj * HALF) = (u32x2){(unsigned)w0, (unsigned)w1}; continue; }
                    u32x4 w;
                    if (MODE == 4 || MODE == 8) { w.x = pkh2(v0[0], v0[1]); w.y = pkh2(v0[2], v0[3]); w.z = pkh2(v1[0], v1[1]); w.w = pkh2(v1[2], v1[3]); }
                    else { w.x = pk2(v0[0], v0[1]); w.y = pk2(v0[2], v0[3]); w.z = pk2(v1[0], v1[1]); w.w = pk2(v1[2], v1[3]); }
                    *(u32x4*)(rowp + bj * HALF) = w; } } }
    }
};
template <int MODE> struct EpiF32 {
    static constexpr bool PERM = false, AFTER_DRAIN = false;
    float* C; int ldc; const float* B; float sc = 1.0f;
    __device__ __forceinline__ void operator()(const f32x4 (&acc)[2][2][4][2], const Unit& u, int wr, int wc, int fr, int fq) const {
        const int row0 = u.pm * BM + wr * 64 + fr, col0 = u.pn * BM + wc * 32 + 4 * fq;
#pragma unroll
        for (int ai = 0; ai < 2; ++ai)
#pragma unroll
            for (int m = 0; m < 4; ++m) { float* rowp = C + (size_t)(row0 + ai * HALF + m * 16) * ldc + col0;
#pragma unroll
                for (int bj = 0; bj < 2; ++bj)
#pragma unroll
                    for (int n = 0; n < 2; ++n) { f32x4* p = (f32x4*)(rowp + bj * HALF + n * 16);
                        if (MODE == 1) *p = *p + acc[ai][bj][m][n] * sc;
                        else if (MODE == 2) *p = *(const f32x4*)(B + (p - (f32x4*)C) * 4) + acc[ai][bj][m][n] * sc;
                        else *p = acc[ai][bj][m][n]; } }
    }
};

template <int F8 = 0, class Epi, class Sched>
__device__ __forceinline__ void gemm_phase(PG8_LAS unsigned char* lds, const Gemm g, const Sched& S, const Epi& E) {
    const int tid = threadIdx.x, wid = __builtin_amdgcn_readfirstlane(tid >> 6), lane = tid & 63, wr = wid >> 2, wc = wid & 3, fr = lane & 15, fq = lane >> 4;
    const int K = g.K, nt = K / BK;
    unsigned voffA[2], voffB[2];
#pragma unroll
    for (int i = 0; i < 2; ++i) { int R, C; stage_rc(tid * 16 + i * 8192, R, C); const int Rb = Epi::PERM ? ((R & ~31) + perm32(R & 31)) : R;
        voffA[i] = (unsigned)(R * K + C) * 2u; voffB[i] = (unsigned)(Rb * K + C) * 2u; }
    const size_t kstep = (size_t)(BK * 2);
    const size_t hstep = (size_t)HALF * K * 2;
    const size_t tstep = 2 * hstep;
    const unsigned ldsw = (unsigned)wid * 1024u;
    const int aoff = lds_byte(wr * 64 + fr, fq * 8), boff = lds_byte(wc * 32 + fr, fq * 8);
#define PG8_SA(b, h) (((b) * 2 + (h)) * HTB)
#define PG8_SB(b, h) ((4 + (b) * 2 + (h)) * HTB)
#define PG8_STAGE(bufoff, gbase, voff) do { const char* gb_ = (const char*)(gbase); asm volatile("" : "+s"(gb_));        \
        _Pragma("unroll") for (int _i = 0; _i < 2; ++_i) { unsigned vo_ = (voff)[_i]; asm volatile("" : "+v"(vo_)); \
        __builtin_amdgcn_global_load_lds((const unsigned*)(gb_ + vo_), (PG8_LAS unsigned*)(lds + (bufoff) + ldsw + _i * 8192), 16, 0, 0); } } while (0)
#define PG8_LD8(dst8, cbase_, voff_, cnt_) do { unsigned o_ = (unsigned)(voff_); asm volatile("" : "+v"(o_));        \
        _Pragma("unroll") for (int i_ = 0; i_ < cnt_; ++i_) { const i32x4 lo_ = *(const PG8_LAS i32x4*)(lds + (cbase_) + o_ + i_ * 2048), hi_ = *(const PG8_LAS i32x4*)(lds + (cbase_) + o_ + i_ * 2048 + 1024); \
        dst8[i_] = (i32x8){lo_.x, lo_.y, lo_.z, lo_.w, hi_.x, hi_.y, hi_.z, hi_.w}; } } while (0)
#define PG8_LDA(dst, b, h) do { if (F8 == 1) PG8_LD8(Ah8, PG8_SA(b, h), aoff, 2); else { _Pragma("unroll") for (int m = 0; m < 4; ++m) _Pragma("unroll") for (int k = 0; k < 2; ++k) dst[m][k] = *(const PG8_LAS bf16x8*)(lds + PG8_SA(b, h) + aoff + m * 2048 + k * 1024); } } while (0)
#define PG8_LDB(dst, b, h) do { if (F8 == 1) PG8_LD8(dst##8, PG8_SB(b, h), boff, 2); else { _Pragma("unroll") for (int n = 0; n < 2; ++n) _Pragma("unroll") for (int k = 0; k < 2; ++k) dst[n][k] = *(const PG8_LAS bf16x8*)(lds + PG8_SB(b, h) + boff + n * 2048 + k * 1024); } } while (0)
#define PG8_MM8(ai, bj, mm, Bt, Ax) do { _Pragma("unroll") for (int n = 0; n < 2; ++n) { \
        acc[ai][bj][mm][n] = __builtin_amdgcn_mfma_scale_f32_16x16x128_f8f6f4(Bt##8[n], Ax[0], acc[ai][bj][mm][n], 0, 0, 0, 0, 0, 0); \
        acc[ai][bj][(mm) + 1][n] = __builtin_amdgcn_mfma_scale_f32_16x16x128_f8f6f4(Bt##8[n], Ax[1], acc[ai][bj][(mm) + 1][n], 0, 0, 0, 0, 0, 0); } } while (0)
#define PG8_MMA(ai, bj, At, Bt, bb) do { __builtin_amdgcn_s_setprio(1); \
        if (F8 == 1) { if ((bj) == 0) { PG8_SCHED; PG8_LD8(Bh8, PG8_SA(bb, ai) + 2 * 2048, aoff, 2); PG8_SCHED; PG8_MM8(ai, bj, 0, Bt, Ah8); PG8_SCHED; PG8_MM8(ai, bj, 2, Bt, Bh8); } \
                  else { PG8_MM8(ai, bj, 0, Bt, Ah8); PG8_MM8(ai, bj, 2, Bt, Bh8); } } \
        else if (F8 == 2) { _Pragma("unroll") for (int m = 0; m < 4; ++m) _Pragma("unroll") for (int n = 0; n < 2; ++n) _Pragma("unroll") for (int k = 0; k < 2; ++k) \
            acc[ai][bj][m][n] = __builtin_bit_cast(f32x4, __builtin_amdgcn_mfma_i32_16x16x64_i8(__builtin_bit_cast(i32x4, Bt[n][k]), __builtin_bit_cast(i32x4, At[m][k]), __builtin_bit_cast(i32x4, acc[ai][bj][m][n]), 0, 0, 0)); } \
        else { _Pragma("unroll") for (int m = 0; m < 4; ++m) _Pragma("unroll") for (int n = 0; n < 2; ++n) _Pragma("unroll") for (int k = 0; k < 2; ++k) \
            acc[ai][bj][m][n] = __builtin_amdgcn_mfma_f32_16x16x32_bf16(Bt[n][k], At[m][k], acc[ai][bj][m][n], 0, 0, 0); } \
        __builtin_amdgcn_s_setprio(0); } while (0)
#define PG8_WAIT_V(n) asm volatile("s_waitcnt vmcnt(" #n ")" ::: "memory")
#define PG8_WAIT_L(n) asm volatile("s_waitcnt lgkmcnt(" #n ")" ::: "memory")
#define PG8_BAR __builtin_amdgcn_s_barrier()
#define PG8_SCHED __builtin_amdgcn_sched_barrier(0)
    Unit cur, nxt; int ui = 0;
    if (!S.next(0, cur)) return;
    f32x4 acc[2][2][4][2];
#pragma unroll
    for (int a = 0; a < 2; ++a)
#pragma unroll
        for (int b = 0; b < 2; ++b)
#pragma unroll
            for (int m = 0; m < 4; ++m)
#pragma unroll
                for (int n = 0; n < 2; ++n) acc[a][b][m][n] = (f32x4){0.f, 0.f, 0.f, 0.f};
    bf16x8 At[4][2], B0[2][2], B1[2][2]; i32x8 Ah8[2], Bh8[2], B08[2], B18[2];
    const char* cA = (const char*)g.A + (size_t)cur.pm * tstep; const char* cB = (const char*)g.Bt + (size_t)cur.pn * tstep;
    S.a_ready(cur);
    PG8_STAGE(PG8_SB(0, 0), cB, voffB); PG8_STAGE(PG8_SA(0, 0), cA, voffA); PG8_STAGE(PG8_SB(0, 1), cB + hstep, voffB); PG8_STAGE(PG8_SA(0, 1), cA + hstep, voffA);
    if (wr == 1) PG8_BAR;
    PG8_WAIT_V(4); PG8_BAR;
    PG8_STAGE(PG8_SB(1, 0), cB + kstep, voffB); PG8_STAGE(PG8_SA(1, 0), cA + kstep, voffA); PG8_STAGE(PG8_SB(1, 1), cB + hstep + kstep, voffB);
    PG8_WAIT_V(6); PG8_BAR;
    for (;;) {
        const bool has_next = S.next(ui + 1, nxt);
        const char* nA = has_next ? (const char*)g.A + (size_t)nxt.pm * tstep : cA; const char* nB = has_next ? (const char*)g.Bt + (size_t)nxt.pn * tstep : cB;
        for (int t = 0; t < nt; t += 2) {
            const bool last = (t == nt - 2);
            const char* a1 = cA + (size_t)(t + 1) * kstep;
            const char* a2 = last ? nA : cA + (size_t)(t + 2) * kstep; const char* b2 = last ? nB : cB + (size_t)(t + 2) * kstep;
            const char* a3 = a2 + kstep; const char* b3 = b2 + kstep;
            if (last && has_next) S.a_ready(nxt);
            PG8_LDB(B0, 0, 0); PG8_SCHED; PG8_LDA(At, 0, 0); PG8_STAGE(PG8_SA(1, 1), a1 + hstep, voffA);
            PG8_WAIT_L(8); PG8_BAR; PG8_WAIT_L(0); PG8_MMA(0, 0, At, B0, 0); PG8_BAR; PG8_SCHED;
            PG8_LDB(B1, 0, 1); PG8_STAGE(PG8_SB(0, 0), b2, voffB);
            PG8_BAR; PG8_WAIT_L(0); PG8_MMA(0, 1, At, B1, 0); PG8_BAR; if (F8 == 1) PG8_SCHED;
            PG8_LDA(At, 0, 1); PG8_STAGE(PG8_SA(0, 0), a2, voffA);
            PG8_BAR; PG8_WAIT_L(0); PG8_MMA(1, 0, At, B0, 0); PG8_BAR; PG8_SCHED;
            PG8_STAGE(PG8_SB(0, 1), b2 + hstep, voffB);
            PG8_WAIT_V(6); PG8_BAR; PG8_MMA(1, 1, At, B1, 0); PG8_BAR; if (F8 == 1) PG8_SCHED;
            PG8_LDB(B0, 1, 0); PG8_SCHED; PG8_LDA(At, 1, 0); PG8_STAGE(PG8_SA(0, 1), a2 + hstep, voffA);
            PG8_WAIT_L(8); PG8_BAR; PG8_WAIT_L(0); PG8_MMA(0, 0, At, B0, 1); PG8_BAR; PG8_SCHED;
            PG8_LDB(B1, 1, 1); PG8_STAGE(PG8_SB(1, 0), b3, voffB);
            PG8_BAR; PG8_WAIT_L(0); PG8_MMA(0, 1, At, B1, 1); PG8_BAR; if (F8 == 1) PG8_SCHED;
            PG8_LDA(At, 1, 1); PG8_STAGE(PG8_SA(1, 0), a3, voffA);
            PG8_BAR; PG8_WAIT_L(0); PG8_MMA(1, 0, At, B0, 1); PG8_BAR; PG8_SCHED;
            PG8_STAGE(PG8_SB(1, 1), b3 + hstep, voffB);
            PG8_WAIT_V(6); PG8_BAR; PG8_MMA(1, 1, At, B1, 1); PG8_BAR; if (F8 == 1) PG8_SCHED;
        }
        { int fr_ = fr, fq_ = fq; asm volatile("" : "+v"(fr_), "+v"(fq_));
          E(acc, cur, wr, wc, fr_, fq_); } S.done(cur);
        if (!has_next) break;
#pragma unroll
        for (int a = 0; a < 2; ++a)
#pragma unroll
            for (int b = 0; b < 2; ++b)
#pragma unroll
                for (int m = 0; m < 4; ++m)
#pragma unroll
                    for (int n = 0; n < 2; ++n) acc[a][b][m][n] = (f32x4){0.f, 0.f, 0.f, 0.f};
        cur = nxt; cA = nA; cB = nB; ++ui;
    }
    PG8_WAIT_V(0);
    if (wr == 0) PG8_BAR;
    PG8_BAR;
#undef PG8_SA
#undef PG8_SB
#undef PG8_STAGE
#undef PG8_LDA
#undef PG8_LDB
#undef PG8_MMA
#undef PG8_LD8
#undef PG8_MM8
#undef PG8_WAIT_V
#undef PG8_WAIT_L
#undef PG8_BAR
#undef PG8_SCHED
}
}

#define XB_TMO      128
#define XB_XCNT(j)  (256  + 64 * (j))
#define XB_XSUB(j)  (1280 + 64 * (j))
#define XB_XGEN(j)  (2304 + 64 * (j))
#define XB_TOP      3328
#define XB_TOPGEN   3392
#define XCD_BAR_WORDS 3456
#define XB_SPIN_CAP (1u << 18)
__device__ __forceinline__ unsigned xb_ld(unsigned* p)              { return __hip_atomic_load(p, __ATOMIC_RELAXED, __HIP_MEMORY_SCOPE_AGENT); }
__device__ __forceinline__ unsigned xb_add(unsigned* p, unsigned v) { return __hip_atomic_fetch_add(p, v, __ATOMIC_RELAXED, __HIP_MEMORY_SCOPE_AGENT); }
__device__ __forceinline__ unsigned xb_xcc_id() { return (unsigned)__builtin_amdgcn_s_getreg((3 << 11) | 20) & 0xFu; }
#define XB_SPIN(cond, bar) do { unsigned _sp = 0; while (cond) { __builtin_amdgcn_s_sleep(1); \
    if ((++_sp & 255u) == 0u) { if (xb_ld(&(bar)[XB_TMO])) break; if (_sp > XB_SPIN_CAP) { atomicAdd(&(bar)[XB_TMO], 1u); break; } } } } while (0)
struct XcdBarrier { unsigned* bar; unsigned x; volatile LAS unsigned* st; };
__device__ __forceinline__ XcdBarrier xcd_barrier_post(unsigned* bar, volatile LAS unsigned* st) {
    XcdBarrier b; b.bar = bar; b.x = xb_xcc_id(); b.st = st;
    if (threadIdx.x == 0) (void)xb_add(&bar[XB_XCNT(b.x)], 1u);
    return b;
}
__device__ __forceinline__ void xcd_barrier_complete(unsigned* bar, unsigned x, unsigned& nloc, unsigned& nx) {
    const unsigned G = gridDim.x * gridDim.y * gridDim.z;
    unsigned sum, cnt, mine, sp = 0u;
    for (;;) {
        sum = 0u; cnt = 0u; mine = 0u;
#pragma unroll
        for (unsigned j = 0; j < 16; ++j) { const unsigned c = xb_ld(&bar[XB_XCNT(j)]); sum += c; cnt += (c > 0u) ? 1u : 0u; mine = (j == x) ? c : mine; }
        if (sum == G) break;
        __builtin_amdgcn_s_sleep(1);
        if ((++sp & 255u) == 0u) { if (xb_ld(&bar[XB_TMO])) break; if (sp > XB_SPIN_CAP) { atomicAdd(&bar[XB_TMO], 1u); break; } }
    }
    nloc = mine > 0u ? mine : 1u; nx = cnt > 0u ? cnt : 1u;
}
__device__ __forceinline__ void xcd_barrier(const XcdBarrier& b) {
    asm volatile("s_waitcnt vmcnt(0)" ::: "memory");
    __syncthreads();
    if (threadIdx.x == 0) {
        unsigned* bar = b.bar;
        __builtin_amdgcn_s_waitcnt(0);
        unsigned nloc = b.st[0], nx = b.st[1];
        if (nloc == 0u) { xcd_barrier_complete(bar, b.x, nloc, nx); b.st[0] = nloc; b.st[1] = nx; }
        const unsigned old = xb_add(&bar[XB_XSUB(b.x)], 1u);
        const unsigned gen = old / nloc;
        if (old + 1u == (gen + 1u) * nloc) {
            __builtin_amdgcn_fence(__ATOMIC_RELEASE, "agent");
            asm volatile("s_waitcnt vmcnt(0)" ::: "memory");
            const unsigned og = xb_add(&bar[XB_TOP], 1u);
            const unsigned tg = og / nx;
            if (og + 1u == (tg + 1u) * nx) xb_add(&bar[XB_TOPGEN], 1u);
            else XB_SPIN(xb_ld(&bar[XB_TOPGEN]) == tg, bar);
            __builtin_amdgcn_fence(__ATOMIC_ACQUIRE, "agent");
            xb_add(&bar[XB_XGEN(b.x)], 1u);
            asm volatile("s_waitcnt vmcnt(0)" ::: "memory");
        } else {
            XB_SPIN(xb_ld(&bar[XB_XGEN(b.x)]) == gen, bar);
            __builtin_amdgcn_fence(__ATOMIC_ACQUIRE, "agent");
            asm volatile("s_waitcnt vmcnt(0)" ::: "memory");
        }
    }
    __syncthreads();
}

struct Args { const float* in[18]; float* out; unsigned char* ws; int ph_lo, ph_hi; };
struct Frame {
    LAS unsigned char* lds;
    int tid, lane, wave, G, gw, NGW;
    const float* const* in; float* out; unsigned char* ws;
};

__device__ __forceinline__ void transpose_item(const float* W, int ldw, int col0, bf16_t* WT, int K, int nblk, float scale, LAS float* scr, int item, int lane, bool f8 = false, const float* kgain = nullptr) {
    const int kb = item / nblk, nb = item % nblk, k0 = 64 * kb, n0 = 32 * nb;
#pragma unroll 8
    for (int i = 0; i < 32; ++i) { const int kk = 2 * i + (lane >> 5); scr[kk * 33 + (lane & 31)] = W[(size_t)(k0 + kk) * ldw + col0 + n0 + (lane & 31)] * (kgain ? kgain[k0 + kk] : 1.0f); }
    LDS_WAIT();
    const int c = lane & 7;
#pragma unroll
    for (int j = 0; j < 4; ++j) { const int n = (lane >> 3) + 8 * j; const LAS float* s = scr + (8 * c) * 33 + n;
        if (f8) { int w0 = 0, w1 = 0;
            w0 = __builtin_amdgcn_cvt_pk_fp8_f32(s[0 * 33] * scale, s[1 * 33] * scale, w0, false); w0 = __builtin_amdgcn_cvt_pk_fp8_f32(s[2 * 33] * scale, s[3 * 33] * scale, w0, true);
            w1 = __builtin_amdgcn_cvt_pk_fp8_f32(s[4 * 33] * scale, s[5 * 33] * scale, w1, false); w1 = __builtin_amdgcn_cvt_pk_fp8_f32(s[6 * 33] * scale, s[7 * 33] * scale, w1, true);
            *(u32x2*)((unsigned char*)WT + (size_t)(n0 + n) * K + k0 + 8 * c) = (u32x2){(unsigned)w0, (unsigned)w1}; continue; }
        u32x4 o; o.x = pk2(s[0 * 33] * scale, s[1 * 33] * scale); o.y = pk2(s[2 * 33] * scale, s[3 * 33] * scale); o.z = pk2(s[4 * 33] * scale, s[5 * 33] * scale); o.w = pk2(s[6 * 33] * scale, s[7 * 33] * scale);
        *(u32x4*)(WT + (size_t)(n0 + n) * K + k0 + 8 * c) = o; }
    LDS_WAIT();
}
__device__ __forceinline__ void rmsnorm_rows(const Frame& F, const float* src, const float* g, bf16_t* dst, float* cpy, unsigned char* dst8 = nullptr) {
    const f32x4* gp = (const f32x4*)g + F.lane;
    f32x4 gv[4];
#pragma unroll
    for (int j = 0; j < 4; ++j) gv[j] = gp[64 * j];
    for (int m = F.gw; m < T; m += F.NGW) {
        const f32x4* xr = (const f32x4*)(src + (size_t)m * D) + F.lane;
        f32x4 v[4]; float s = 0.f;
#pragma unroll
        for (int j = 0; j < 4; ++j) { v[j] = xr[64 * j]; s += (v[j].x * v[j].x + v[j].y * v[j].y) + (v[j].z * v[j].z + v[j].w * v[j].w); }
        const float rstd = 1.0f / sqrtf(wave_sum(s) * (1.f / D) + 1e-6f);
        if (cpy) { f32x4* cr = (f32x4*)(cpy + (size_t)m * D) + F.lane;
#pragma unroll
            for (int j = 0; j < 4; ++j) cr[64 * j] = v[j]; }
        if (dst) { u32x2* o8 = (u32x2*)(dst + (size_t)m * D) + F.lane;
#pragma unroll
        for (int j = 0; j < 4; ++j) { u32x2 w; w.x = pk2(v[j].x * rstd * gv[j].x, v[j].y * rstd * gv[j].y); w.y = pk2(v[j].z * rstd * gv[j].z, v[j].w * rstd * gv[j].w); o8[64 * j] = w; } }
        if (dst8) { unsigned* o4 = (unsigned*)(dst8 + (size_t)m * D) + F.lane;
#pragma unroll
            for (int j = 0; j < 4; ++j) { int w = 0; w = __builtin_amdgcn_cvt_pk_fp8_f32(v[j].x * rstd * gv[j].x, v[j].y * rstd * gv[j].y, w, false); w = __builtin_amdgcn_cvt_pk_fp8_f32(v[j].z * rstd * gv[j].z, v[j].w * rstd * gv[j].w, w, true); o4[64 * j] = (unsigned)w; } }
    }
}
__device__ __forceinline__ void quant_wqk(const Frame& F) {
    const bf16_t* W = (const bf16_t*)(F.ws + WS_WQKP); unsigned char* Q8 = F.ws + WS_WQ8;
    const unsigned* CM = (const unsigned*)(F.ws + WS_CTL) + CW_COLMAX; float* WSCL = (float*)(F.ws + WS_CTL) + CW_WSCL;
    for (int r = F.gw; r < 4096; r += F.NGW) {
        const float cm = __builtin_bit_cast(float, __hip_atomic_load(CM + r, __ATOMIC_RELAXED, __HIP_MEMORY_SCOPE_AGENT));
        const float sc = cm > 0.f ? 127.0f / cm : 0.f;
        const u32x4* wp = (const u32x4*)(W + (size_t)r * 1024 + 16 * F.lane); const u32x4 a = wp[0], b = wp[1];
        const float v[16] = {bflo(a.x), bfhi(a.x), bflo(a.y), bfhi(a.y), bflo(a.z), bfhi(a.z), bflo(a.w), bfhi(a.w), bflo(b.x), bfhi(b.x), bflo(b.y), bfhi(b.y), bflo(b.z), bfhi(b.z), bflo(b.w), bfhi(b.w)};
        unsigned o[4];
#pragma unroll
        for (int j = 0; j < 4; ++j) { unsigned w = 0u;
#pragma unroll
            for (int e = 0; e < 4; ++e) { int q = (int)rintf(v[4 * j + e] * sc); q = q > 127 ? 127 : (q < -127 ? -127 : q); w |= ((unsigned)q & 255u) << (8 * e); }
            o[j] = w; }
        *(u32x4*)(Q8 + (size_t)r * 1024 + 16 * F.lane) = (u32x4){o[0], o[1], o[2], o[3]};
        if (F.lane == 0) WSCL[r] = cm * (1.0f / 127.0f);
    }
}
__device__ __forceinline__ void rmsnorm_rows_bf(const Frame& F, const bf16_t* src, const float* g, bf16_t* dst, unsigned char* dst8, unsigned char* dsti = nullptr, float* rowsc = nullptr) {
    const f32x4* gp = (const f32x4*)g + F.lane;
    f32x4 gv[4];
#pragma unroll
    for (int j = 0; j < 4; ++j) gv[j] = gp[64 * j];
    for (int m = F.gw; m < T; m += F.NGW) {
        const u32x2* xr = (const u32x2*)(src + (size_t)m * D) + F.lane;
        f32x4 v[4]; float s = 0.f;
#pragma unroll
        for (int j = 0; j < 4; ++j) { const u32x2 w = xr[64 * j]; v[j] = (f32x4){bflo(w.x), bfhi(w.x), bflo(w.y), bfhi(w.y)}; s += (v[j].x * v[j].x + v[j].y * v[j].y) + (v[j].z * v[j].z + v[j].w * v[j].w); }
        const float rstd = 1.0f / sqrtf(wave_sum(s) * (1.f / D) + 1e-6f);
        if (dst) { u32x2* o8 = (u32x2*)(dst + (size_t)m * D) + F.lane;
#pragma unroll
        for (int j = 0; j < 4; ++j) { u32x2 w; w.x = pk2(v[j].x * rstd * gv[j].x, v[j].y * rstd * gv[j].y); w.y = pk2(v[j].z * rstd * gv[j].z, v[j].w * rstd * gv[j].w); o8[64 * j] = w; } }
        if (dst8) { unsigned* o4 = (unsigned*)(dst8 + (size_t)m * D) + F.lane;
#pragma unroll
            for (int j = 0; j < 4; ++j) { int w = 0; w = __builtin_amdgcn_cvt_pk_fp8_f32(v[j].x * rstd * gv[j].x, v[j].y * rstd * gv[j].y, w, false); w = __builtin_amdgcn_cvt_pk_fp8_f32(v[j].z * rstd * gv[j].z, v[j].w * rstd * gv[j].w, w, true); o4[64 * j] = (unsigned)w; } }
        if (dsti) {
            f32x4 y[4]; float am = 0.f;
#pragma unroll
            for (int j = 0; j < 4; ++j) { y[j] = v[j] * rstd * gv[j]; am = fmaxf(am, fmaxf(fmaxf(fabsf(y[j].x), fabsf(y[j].y)), fmaxf(fabsf(y[j].z), fabsf(y[j].w)))); }
            am = wave_max(am);
            const float qs = am > 0.f ? 127.0f / am : 0.f;
            unsigned* oi = (unsigned*)(dsti + (size_t)m * D) + F.lane;
#pragma unroll
            for (int j = 0; j < 4; ++j) { const int q0 = (int)rintf(y[j].x * qs), q1 = (int)rintf(y[j].y * qs), q2 = (int)rintf(y[j].z * qs), q3 = (int)rintf(y[j].w * qs);
                oi[64 * j] = ((unsigned)q0 & 255u) | (((unsigned)q1 & 255u) << 8) | (((unsigned)q2 & 255u) << 16) | ((unsigned)q3 << 24); }
            if (F.lane == 0) rowsc[m] = am * (1.0f / 127.0f);
        }
    }
}
__device__ __forceinline__ void final_norm_bf(const Frame& F, const bf16_t* h, float* out, const float* g) {
    const f32x4* gp = (const f32x4*)g + F.lane;
    f32x4 gv[4];
#pragma unroll
    for (int j = 0; j < 4; ++j) gv[j] = gp[64 * j];
    for (int m = F.gw; m < T; m += F.NGW) {
        const u32x2* xr = (const u32x2*)(h + (size_t)m * D) + F.lane;
        f32x4 v[4]; float s = 0.f;
#pragma unroll
        for (int j = 0; j < 4; ++j) { const u32x2 w = xr[64 * j]; v[j] = (f32x4){bflo(w.x), bfhi(w.x), bflo(w.y), bfhi(w.y)}; s += (v[j].x * v[j].x + v[j].y * v[j].y) + (v[j].z * v[j].z + v[j].w * v[j].w); }
        const float rstd = 1.0f / sqrtf(wave_sum(s) * (1.f / D) + 1e-6f);
        f32x4* orow = (f32x4*)(out + (size_t)m * D) + F.lane;
#pragma unroll
        for (int j = 0; j < 4; ++j) orow[64 * j] = v[j] * rstd * gv[j];
    }
}
__device__ __forceinline__ void final_norm(const Frame& F, float* h, const float* g) {
    const f32x4* gp = (const f32x4*)g + F.lane;
    f32x4 gv[4];
#pragma unroll
    for (int j = 0; j < 4; ++j) gv[j] = gp[64 * j];
    for (int m = F.gw; m < T; m += F.NGW) {
        f32x4* xr = (f32x4*)(h + (size_t)m * D) + F.lane;
        f32x4 v[4]; float s = 0.f;
#pragma unroll
        for (int j = 0; j < 4; ++j) { v[j] = xr[64 * j]; s += (v[j].x * v[j].x + v[j].y * v[j].y) + (v[j].z * v[j].z + v[j].w * v[j].w); }
        const float rstd = 1.0f / sqrtf(wave_sum(s) * (1.f / D) + 1e-6f);
#pragma unroll
        for (int j = 0; j < 4; ++j) xr[64 * j] = v[j] * rstd * gv[j];
    }
}
__device__ __forceinline__ void cvt_fp4_rows(const Frame& F, const float* src, unsigned char* dst, float* inv) {
    for (int r = F.gw; r < 16384; r += F.NGW) {
        const f32x4* p = (const f32x4*)(src + (size_t)r * 1024 + 16 * F.lane);
        const f32x4 v0 = p[0], v1 = p[1], v2 = p[2], v3 = p[3];
        float m = fmaxf(fmaxf(fmaxf(fabsf(v0.x), fabsf(v0.y)), fmaxf(fabsf(v0.z), fabsf(v0.w))), fmaxf(fmaxf(fabsf(v1.x), fabsf(v1.y)), fmaxf(fabsf(v1.z), fabsf(v1.w))));
        m = fmaxf(m, fmaxf(fmaxf(fmaxf(fabsf(v2.x), fabsf(v2.y)), fmaxf(fabsf(v2.z), fabsf(v2.w))), fmaxf(fmaxf(fabsf(v3.x), fabsf(v3.y)), fmaxf(fabsf(v3.z), fabsf(v3.w)))));
        m = wave_max(m);
        const float sc = m > 0.f ? 6.0f / m : 1.0f;
        unsigned w0 = 0u, w1 = 0u;
        w0 = __builtin_amdgcn_cvt_scalef32_pk_fp4_f32(w0, v0.x * sc, v0.y * sc, 1.0f, 0); w0 = __builtin_amdgcn_cvt_scalef32_pk_fp4_f32(w0, v0.z * sc, v0.w * sc, 1.0f, 1);
        w0 = __builtin_amdgcn_cvt_scalef32_pk_fp4_f32(w0, v1.x * sc, v1.y * sc, 1.0f, 2); w0 = __builtin_amdgcn_cvt_scalef32_pk_fp4_f32(w0, v1.z * sc, v1.w * sc, 1.0f, 3);
        w1 = __builtin_amdgcn_cvt_scalef32_pk_fp4_f32(w1, v2.x * sc, v2.y * sc, 1.0f, 0); w1 = __builtin_amdgcn_cvt_scalef32_pk_fp4_f32(w1, v2.z * sc, v2.w * sc, 1.0f, 1);
        w1 = __builtin_amdgcn_cvt_scalef32_pk_fp4_f32(w1, v3.x * sc, v3.y * sc, 1.0f, 2); w1 = __builtin_amdgcn_cvt_scalef32_pk_fp4_f32(w1, v3.z * sc, v3.w * sc, 1.0f, 3);
        *(u32x2*)(dst + (size_t)(F.lane >> 4) * (2 * MiB) + (size_t)r * 128 + 8 * (F.lane & 15)) = (u32x2){w0, w1};
        if (F.lane == 0) inv[2 * r] = m > 0.f ? m * (1.0f / 6.0f) : 1.0f;
    }
}
__device__ __forceinline__ int t5_bucket(int rel) {
    const int ret = rel > 0 ? 16 : 0; const int n = rel < 0 ? -rel : rel;
    int v;
    if (n < 8) v = n; else if (n < 12) v = 8; else if (n < 16) v = 9; else if (n < 23) v = 10; else if (n < 32) v = 11;
    else if (n < 46) v = 12; else if (n < 64) v = 13; else if (n < 91) v = 14; else v = 15;
    return ret + v;
}

__device__ __forceinline__ void p0_prologue(const Frame& F) {
    LAS float* scr = (LAS float*)(F.lds + F.wave * 16384);
    bf16_t* WQK = (bf16_t*)(F.ws + WS_WQK); bf16_t* WV = (bf16_t*)(F.ws + WS_WV); bf16_t* WO = (bf16_t*)(F.ws + WS_WO);
    bf16_t* WSGV = (bf16_t*)(F.ws + WS_WSGV); bf16_t* WSGU = (bf16_t*)(F.ws + WS_WSGU); bf16_t* WSGO = (bf16_t*)(F.ws + WS_WSGO);
    constexpr int I_QK = 16 * 40, I_V = 16 * 8, I_O = 16 * 32, I_SG = 16 * 96, I_SGO = 48 * 32;
    constexpr int NITEMS = I_QK + I_V + I_O + 2 * I_SG + I_SGO;
    for (int it = F.gw; it < NITEMS; it += F.NGW) {
        int r = it;
        if (r < I_QK) { const int nb = r % 40; transpose_item(F.in[3], 1536, 0, WQK, 1024, 40, (nb < 32 ? 0.125f * 1.4426950408889634f : 1.0f) * W8_SCALE, scr, r, F.lane, true); continue; } r -= I_QK;
        if (r < I_V) { transpose_item(F.in[3], 1536, 1280, WV, 1024, 8, W8_SCALE, scr, r, F.lane, true); continue; } r -= I_V;
        if (r < I_O) { transpose_item(F.in[4], 1024, 0, WO, 1024, 32, W8_SCALE, scr, r, F.lane, true); continue; } r -= I_O;
        if (r < I_SG) { transpose_item(F.in[6], 6144, 0, WSGU, 1024, 96, W8_SCALE, scr, r, F.lane, true, F.in[2] + D); continue; } r -= I_SG;
        if (r < I_SG) { transpose_item(F.in[6], 6144, 3072, WSGV, 1024, 96, W8_SCALE, scr, r, F.lane, true, F.in[2] + D); continue; } r -= I_SG;
        transpose_item(F.in[11], 1024, 0, WSGO, 3072, 32, W8_SCALE, scr, r, F.lane, true);
    }
    {
        bf16_t* WQKP = (bf16_t*)(F.ws + WS_WQKP);
        const int fr = F.lane & 15, fq = F.lane >> 4;
        for (int task = F.gw; task < 2 * 16 * 64; task += F.NGW) {
            const int l = task >> 10, hc = (task >> 6) & 15, k0 = (task & 63) * 16;
            const f32x4* ap = (const f32x4*)(F.in[13] + ((size_t)l * 1024 + k0 + fr) * 2048 + hc * 128 + 32 * fq);
            f32x4 av[8];
#pragma unroll
            for (int i = 0; i < 8; ++i) av[i] = ap[i];
#pragma unroll 1
            for (int nt = 0; nt < 8; ++nt) {
                const f32x4* bp = (const f32x4*)(F.in[14] + ((size_t)(l * 16 + hc) * 128 + nt * 16 + fr) * 128 + 32 * fq);
                f32x4 bv[8];
#pragma unroll
                for (int i = 0; i < 8; ++i) bv[i] = bp[i];
                f32x4 acc = {0.f, 0.f, 0.f, 0.f};
#pragma unroll
                for (int i = 0; i < 8; ++i)
#pragma unroll
                    for (int j = 0; j < 4; ++j) acc = __builtin_amdgcn_mfma_f32_16x16x4f32(av[i][j], bv[i][j], acc, 0, 0, 0);
                *(u32x2*)(WQKP + ((size_t)l * 2048 + hc * 128 + nt * 16 + fr) * 1024 + k0 + 4 * fq) = (u32x2){pk2(acc[0], acc[1]), pk2(acc[2], acc[3])};
                { float mx = fmaxf(fmaxf(fabsf(acc[0]), fabsf(acc[1])), fmaxf(fabsf(acc[2]), fabsf(acc[3])));
                  mx = fmaxf(mx, __shfl_xor(mx, 16)); mx = fmaxf(mx, __shfl_xor(mx, 32));
                  if (fq == 0) atomicMax((unsigned*)(F.ws + WS_CTL) + CW_COLMAX + l * 2048 + hc * 128 + nt * 16 + fr, __builtin_bit_cast(unsigned, mx)); }
            }
        }
    }
    if (blockIdx.x == 0) {
        float* bt = (float*)(F.ws + WS_BIAS);
        for (int i = F.tid; i < 16 * 257; i += 512) { const int hq = i / 257, r = i % 257 - 128; bt[hq * 260 + r + 128] = F.in[1][t5_bucket(r) * 16 + hq] * 1.4426950408889634f; }
    }
    rmsnorm_rows(F, F.in[0], F.in[2], nullptr, nullptr, F.ws + WS_HN8B);
    for (int l = 0; l < 2; ++l) {
        cvt_fp4_rows(F, F.in[15] + (size_t)l * 16384 * 1024, F.ws + WS_TAB + (size_t)(2 * l) * 16 * MiB, (float*)(F.ws + WS_SCL) + (size_t)l * 32768);
        cvt_fp4_rows(F, F.in[16] + (size_t)l * 16384 * 1024, F.ws + WS_TAB + (size_t)(2 * l + 1) * 16 * MiB, (float*)(F.ws + WS_SCL) + (size_t)l * 32768 + 1);
    }
}

typedef float f32x16 __attribute__((ext_vector_type(16)));
constexpr int AT_K = 0, AT_KS = 144, AT_V = 384 * AT_KS, AT_VS = 792, AT_B = AT_V + 64 * AT_VS;
__device__ __forceinline__ void attn_phase_v2(const Frame& F) {
    const bf16_t* Q = (const bf16_t*)(F.ws + WS_Q); const bf16_t* Kb = (const bf16_t*)(F.ws + WS_K); const bf16_t* Vt = (const bf16_t*)(F.ws + WS_VT);
    bf16_t* AO = (bf16_t*)(F.ws + WS_AO); const float* bias = (const float*)(F.ws + WS_BIAS); const float* sinkp = F.in[5];
    const int lane = F.lane, tid = F.tid, h5 = lane >> 5, c31 = lane & 31, g = F.wave >> 1, qh = F.wave & 1;
    LAS float* bl = (LAS float*)(F.lds + AT_B) + g * 260;
    for (int unit = blockIdx.x; unit < 1024; unit += F.G) {
        const int hkv = unit & 3, qb = (unit >> 2) & 15, b = unit >> 6;
        const int tok0 = b * 2048 + qb * 128, kbase = tok0 - 128;
        __syncthreads();
#pragma unroll 2
        for (int it = 0; it < 6; ++it) { const int id = it * 512 + tid, row = id >> 3, ch = id & 7, pos = qb * 128 - 128 + row;
            u32x4 v = (u32x4){0u, 0u, 0u, 0u};
            if (pos >= 0 && pos < 2048) v = *(const u32x4*)(Kb + (size_t)(kbase + row) * 256 + hkv * 64 + ch * 8);
            *(LAS u32x4*)(F.lds + AT_K + row * AT_KS + ch * 16) = v; }
#pragma unroll 2
        for (int it = 0; it < 6; ++it) { const int id = it * 512 + tid, d = id / 48, ch = id % 48, pos0 = qb * 128 - 128 + ch * 8;
            u32x4 v = (u32x4){0u, 0u, 0u, 0u};
            if (pos0 >= 0 && pos0 < 2048) v = *(const u32x4*)(Vt + (size_t)(hkv * 64 + d) * T + kbase + ch * 8);
            *(LAS u32x2*)(F.lds + AT_V + d * AT_VS + ch * 16) = (u32x2){v.x, v.y}; *(LAS u32x2*)(F.lds + AT_V + d * AT_VS + ch * 16 + 8) = (u32x2){v.z, v.w}; }
        for (int i = tid; i < 4 * 260; i += 512) ((LAS float*)(F.lds + AT_B))[i] = bias[hkv * 4 * 260 + i];
        __syncthreads();
        const int hq = hkv * 4 + g; const float sinkv = sinkp[hq] * 1.4426950408889634f;
#pragma unroll 1
        for (int qt = 0; qt < 2; ++qt) {
            const int q0 = 64 * qh + 32 * qt;
            const bf16_t* qrow = Q + (size_t)(tok0 + q0 + c31) * 1024 + hq * 64 + 8 * h5;
            bf16x8 qf[4];
#pragma unroll
            for (int s2 = 0; s2 < 4; ++s2) qf[s2] = *(const bf16x8*)(qrow + 16 * s2);
            const int kt0 = q0 >> 5; int kt_lo = kt0, kt_hi = kt0 + 8;
            if (qb == 0 && kt_lo < 4) kt_lo = 4;
            if (qb == 15 && kt_hi > 7) kt_hi = 7;
            const int qi = q0 + c31;
            float mx = sinkv, lsum = h5 == 0 ? 1.0f : 0.f;
            f32x16 o0 = {0.f, 0.f, 0.f, 0.f, 0.f, 0.f, 0.f, 0.f, 0.f, 0.f, 0.f, 0.f, 0.f, 0.f, 0.f, 0.f}, o1 = o0;
#pragma unroll 1
            for (int kt = kt_lo; kt <= kt_hi; ++kt) {
                f32x16 sa = {0.f, 0.f, 0.f, 0.f, 0.f, 0.f, 0.f, 0.f, 0.f, 0.f, 0.f, 0.f, 0.f, 0.f, 0.f, 0.f};
#pragma unroll
                for (int s2 = 0; s2 < 4; ++s2) { const bf16x8 kf = *(const LAS bf16x8*)(F.lds + AT_K + (kt * 32 + c31) * AT_KS + s2 * 32 + h5 * 16); sa = __builtin_amdgcn_mfma_f32_32x32x16_bf16(kf, qf[s2], sa, 0, 0, 0); }
                float sv[16]; float tmax = -INFINITY;
                if (kt > kt0 && kt < kt0 + 8) {
                    const LAS float* bp = bl + (kt * 32 + 4 * h5 - qi);
#pragma unroll
                    for (int r = 0; r < 16; ++r) { sv[r] = sa[r] + bp[(r & 3) + 8 * (r >> 2)]; tmax = fmaxf(tmax, sv[r]); }
                } else {
#pragma unroll
                    for (int r = 0; r < 16; ++r) { const int key = kt * 32 + (r & 3) + 8 * (r >> 2) + 4 * h5, rel = key - 128 - qi; const bool ok = rel >= -128 && rel <= 128;
                        const int bi = rel < -128 ? 0 : (rel > 128 ? 256 : rel + 128);
                        sv[r] = ok ? sa[r] + bl[bi] : -INFINITY; tmax = fmaxf(tmax, sv[r]); }
                }
                tmax = fmaxf(tmax, __shfl_xor(tmax, 32));
                if (__any(tmax > mx)) {
                    const float mn = fmaxf(mx, tmax), scl = __builtin_amdgcn_exp2f(mx - mn); mx = mn; lsum *= scl;
#pragma unroll
                    for (int r = 0; r < 16; ++r) { o0[r] *= scl; o1[r] *= scl; }
                }
                float pr[16];
#pragma unroll
                for (int r = 0; r < 16; ++r) { pr[r] = __builtin_amdgcn_exp2f(sv[r] - mx); lsum += pr[r]; }
#pragma unroll
                for (int s2 = 0; s2 < 2; ++s2) {
                    u32x4 pw; pw.x = pk2(pr[8 * s2 + 0], pr[8 * s2 + 1]); pw.y = pk2(pr[8 * s2 + 2], pr[8 * s2 + 3]); pw.z = pk2(pr[8 * s2 + 4], pr[8 * s2 + 5]); pw.w = pk2(pr[8 * s2 + 6], pr[8 * s2 + 7]);
                    const bf16x8 pb = __builtin_bit_cast(bf16x8, pw);
                    const int koff = (kt * 32 + 16 * s2 + 4 * h5) * 2;
                    { const LAS unsigned char* vb = F.lds + AT_V + c31 * AT_VS + koff; const u32x2 lo = *(const LAS u32x2*)vb, hi = *(const LAS u32x2*)(vb + 16);
                      const bf16x8 vf = __builtin_bit_cast(bf16x8, (u32x4){lo.x, lo.y, hi.x, hi.y}); o0 = __builtin_amdgcn_mfma_f32_32x32x16_bf16(vf, pb, o0, 0, 0, 0); }
                    { const LAS unsigned char* vb = F.lds + AT_V + (32 + c31) * AT_VS + koff; const u32x2 lo = *(const LAS u32x2*)vb, hi = *(const LAS u32x2*)(vb + 16);
                      const bf16x8 vf = __builtin_bit_cast(bf16x8, (u32x4){lo.x, lo.y, hi.x, hi.y}); o1 = __builtin_amdgcn_mfma_f32_32x32x16_bf16(vf, pb, o1, 0, 0, 0); }
                }
            }
            lsum += __shfl_xor(lsum, 32);
            const float linv = 1.0f / lsum;
            unsigned char* op = (unsigned char*)AO + (size_t)(tok0 + qi) * 1024 + hq * 64 + 4 * h5;
            const float ls = linv * AO8_SCALE;
#pragma unroll
            for (int gq = 0; gq < 4; ++gq) {
                int w0 = 0, w1 = 0;
                w0 = __builtin_amdgcn_cvt_pk_fp8_f32(o0[4 * gq] * ls, o0[4 * gq + 1] * ls, w0, false); w0 = __builtin_amdgcn_cvt_pk_fp8_f32(o0[4 * gq + 2] * ls, o0[4 * gq + 3] * ls, w0, true);
                w1 = __builtin_amdgcn_cvt_pk_fp8_f32(o1[4 * gq] * ls, o1[4 * gq + 1] * ls, w1, false); w1 = __builtin_amdgcn_cvt_pk_fp8_f32(o1[4 * gq + 2] * ls, o1[4 * gq + 3] * ls, w1, true);
                *(unsigned*)(op + 8 * gq) = (unsigned)w0; *(unsigned*)(op + 32 + 8 * gq) = (unsigned)w1; }
        }
    }
}

__device__ __forceinline__ unsigned enc_key(float f, unsigned tag, unsigned mask) { unsigned u = __builtin_bit_cast(unsigned, f); u = (u & ~mask) | tag; return (u & 0x80000000u) ? ~u : (u | 0x80000000u); }
__device__ __forceinline__ unsigned dec_key(unsigned m) { return (m & 0x80000000u) ? (m & 0x7fffffffu) : ~m; }
__device__ __forceinline__ unsigned umax(unsigned a, unsigned b) { return a > b ? a : b; }
__device__ __forceinline__ unsigned umin(unsigned a, unsigned b) { return a < b ? a : b; }
#define SORT_CE(i, j) do { const unsigned hi_ = umax(a[i], a[j]), lo_ = umin(a[i], a[j]); a[i] = hi_; a[j] = lo_; } while (0)
__device__ __forceinline__ void sort16_desc(unsigned (&a)[16]) {
    SORT_CE(0, 13); SORT_CE(1, 12); SORT_CE(2, 15); SORT_CE(3, 14); SORT_CE(4, 8); SORT_CE(5, 6); SORT_CE(7, 11); SORT_CE(9, 10);
    SORT_CE(0, 5); SORT_CE(1, 7); SORT_CE(2, 9); SORT_CE(3, 4); SORT_CE(6, 13); SORT_CE(8, 14); SORT_CE(10, 15); SORT_CE(11, 12);
    SORT_CE(0, 1); SORT_CE(2, 3); SORT_CE(4, 5); SORT_CE(6, 8); SORT_CE(7, 9); SORT_CE(10, 11); SORT_CE(12, 13); SORT_CE(14, 15);
    SORT_CE(0, 2); SORT_CE(1, 3); SORT_CE(4, 10); SORT_CE(5, 11); SORT_CE(6, 7); SORT_CE(8, 9); SORT_CE(12, 14); SORT_CE(13, 15);
    SORT_CE(1, 2); SORT_CE(3, 12); SORT_CE(4, 6); SORT_CE(5, 7); SORT_CE(8, 10); SORT_CE(9, 11); SORT_CE(13, 14);
    SORT_CE(1, 4); SORT_CE(2, 6); SORT_CE(5, 8); SORT_CE(7, 10); SORT_CE(9, 13); SORT_CE(11, 14);
    SORT_CE(2, 4); SORT_CE(3, 6); SORT_CE(9, 12); SORT_CE(11, 13);
    SORT_CE(3, 5); SORT_CE(6, 8); SORT_CE(7, 9); SORT_CE(10, 12);
    SORT_CE(3, 4); SORT_CE(5, 6); SORT_CE(7, 8); SORT_CE(9, 10); SORT_CE(11, 12);
    SORT_CE(6, 7); SORT_CE(8, 9);
}
#undef SORT_CE
__device__ __forceinline__ void merge16_desc(unsigned (&a)[16]) {
#pragma unroll
    for (int jj = 3; jj >= 0; --jj)
#pragma unroll
        for (int i = 0; i < 16; ++i) { const int j = 1 << jj, l = i ^ j; if (l > i) { const unsigned hi = umax(a[i], a[l]), lo = umin(a[i], a[l]); a[i] = hi; a[l] = lo; } }
}
template <int CTRL> __device__ __forceinline__ void xmerge16(unsigned (&a)[16]) {
    unsigned p[16];
#pragma unroll
    for (int i = 0; i < 16; ++i) p[i] = (unsigned)__builtin_amdgcn_update_dpp(0, (int)a[i], CTRL, 0xf, 0xf, true);
#pragma unroll
    for (int i = 0; i < 16; ++i) a[i] = umax(a[i], p[15 - i]);
    merge16_desc(a);
}
template <int CTRL> __device__ __forceinline__ unsigned dpp_u(unsigned v) { return (unsigned)__builtin_amdgcn_update_dpp(0, (int)v, CTRL, 0xf, 0xf, true); }
__device__ __forceinline__ void topk_phase_v3(const Frame& F) {
    const bf16_t* S = (const bf16_t*)(F.ws + WS_S); int* IDX = (int*)(F.ws + WS_IDX); float* GATE = (float*)(F.ws + WS_GATE);
    LAS unsigned* L = (LAS unsigned*)F.lds + F.wave * 1024;
    const int lane = F.lane, tk = lane >> 4, hc = lane & 15, h = hc >> 1, c = hc & 1;
    auto step = [&](const u32x4 (&cur)[16], const int tb) __attribute__((always_inline)) {
        const int t = tb + tk;
        unsigned top[16];
#pragma unroll
        for (int ck = 0; ck < 8; ++ck) {
            const u32x4 v = cur[2 * ck], w = cur[2 * ck + 1];
            const float fv[16] = {hlo(v.x), hhi(v.x), hlo(v.y), hhi(v.y), hlo(v.z), hhi(v.z), hlo(v.w), hhi(v.w), hlo(w.x), hhi(w.x), hlo(w.y), hhi(w.y), hlo(w.z), hhi(w.z), hlo(w.w), hhi(w.w)};
            unsigned nw[16];
#pragma unroll
            for (int j = 0; j < 16; ++j) nw[j] = enc_key(fv[j], (unsigned)(16 * ck + j), 127u);
            sort16_desc(nw);
            if (ck == 0) {
#pragma unroll
                for (int j = 0; j < 16; ++j) top[j] = nw[j];
            } else {
#pragma unroll
                for (int j = 0; j < 16; ++j) top[j] = umax(top[j], nw[15 - j]);
                merge16_desc(top);
            }
        }
#pragma unroll
        for (int i = 0; i < 16; ++i) L[lane * 16 + i] = top[i];
        float f1[16], f2[16];
#pragma unroll
        for (int i = 0; i < 16; ++i) { const unsigned o = dpp_u<0xB1>(top[i]); const unsigned u1 = dec_key(c ? o : top[i]) & ~127u, u2 = dec_key(c ? top[i] : o) & ~127u;
            f1[i] = __builtin_bit_cast(float, u1); f2[i] = __builtin_bit_cast(float, u2); }
        unsigned ca[16], cb[16];
#pragma unroll
        for (int i = 0; i < 16; ++i) { ca[i] = 0u; cb[i] = 0u; }
        { int n = 0;
#pragma unroll
          for (int i = 0; i < 16; ++i)
#pragma unroll
            for (int j = 0; j < 16; ++j) if ((i + 1) * (j + 1) <= 16) { const unsigned key = enc_key(f1[i] + f2[j], (unsigned)((i << 4) | j), 255u); const int slot = n >> 1, who = n & 1;
                if (slot < 16) ca[slot] = (c == who) ? key : ca[slot]; else cb[slot - 16] = (c == who) ? key : cb[slot - 16]; ++n; } }
        sort16_desc(ca); sort16_desc(cb);
#pragma unroll
        for (int i = 0; i < 16; ++i) ca[i] = umax(ca[i], cb[15 - i]);
        merge16_desc(ca);
        xmerge16<0xB1>(ca);
        float sc[8]; unsigned ex[8];
#pragma unroll
        for (int k = 0; k < 8; ++k) { unsigned wlo = ca[k], whi = ca[8 + k]; asm volatile("" : "+v"(wlo), "+v"(whi));
            const unsigned w = c ? whi : wlo;
            const unsigned tag = dec_key(w) & 255u; const unsigned u1 = dec_key(L[(lane & ~1) * 16 + (tag >> 4)]), u2 = dec_key(L[(lane | 1) * 16 + (tag & 15u)]);
            sc[k] = __builtin_bit_cast(float, u1 & ~127u) + __builtin_bit_cast(float, u2 & ~127u); ex[k] = ((u1 & 127u) << 7) | (u2 & 127u); }
        const float smax = __builtin_bit_cast(float, __builtin_amdgcn_update_dpp(0, __builtin_bit_cast(int, sc[0]), 0xA0, 0xf, 0xf, true));
        float e[8]; float sum = 0.f;
#pragma unroll
        for (int k = 0; k < 8; ++k) { e[k] = __expf(sc[k] - smax); sum += e[k]; }
        sum += __builtin_bit_cast(float, __builtin_amdgcn_update_dpp(0, __builtin_bit_cast(int, sum), 0xB1, 0xf, 0xf, true));
        const float inv = 1.0f / sum;
        int* ip = IDX + (size_t)t * 128 + h * 16 + 8 * c; float* gp = GATE + (size_t)t * 128 + h * 16 + 8 * c;
        *(u32x4*)ip = (u32x4){ex[0], ex[1], ex[2], ex[3]}; *(u32x4*)(ip + 4) = (u32x4){ex[4], ex[5], ex[6], ex[7]};
        *(f32x4*)gp = (f32x4){e[0] * inv, e[1] * inv, e[2] * inv, e[3] * inv}; *(f32x4*)(gp + 4) = (f32x4){e[4] * inv, e[5] * inv, e[6] * inv, e[7] * inv};
    };
#define TK_LD1(dst, ptr, OFF) asm volatile("global_load_dwordx4 %0, %1, off offset:" #OFF : "=v"(dst) : "v"(ptr) : "memory")
#define TK_LOAD(buf, tb_) do { const u32x4* sp_ = (const u32x4*)(S + (size_t)((tb_) + tk) * 2048 + hc * 128); \
        TK_LD1(buf[0], sp_, 0); TK_LD1(buf[1], sp_, 16); TK_LD1(buf[2], sp_, 32); TK_LD1(buf[3], sp_, 48); TK_LD1(buf[4], sp_, 64); TK_LD1(buf[5], sp_, 80); TK_LD1(buf[6], sp_, 96); TK_LD1(buf[7], sp_, 112); \
        TK_LD1(buf[8], sp_, 128); TK_LD1(buf[9], sp_, 144); TK_LD1(buf[10], sp_, 160); TK_LD1(buf[11], sp_, 176); TK_LD1(buf[12], sp_, 192); TK_LD1(buf[13], sp_, 208); TK_LD1(buf[14], sp_, 224); TK_LD1(buf[15], sp_, 240); } while (0)
#define TK_WAIT(buf, N) asm volatile("s_waitcnt vmcnt(" #N ")" : "+v"(buf[0]), "+v"(buf[1]), "+v"(buf[2]), "+v"(buf[3]), "+v"(buf[4]), "+v"(buf[5]), "+v"(buf[6]), "+v"(buf[7]), \
        "+v"(buf[8]), "+v"(buf[9]), "+v"(buf[10]), "+v"(buf[11]), "+v"(buf[12]), "+v"(buf[13]), "+v"(buf[14]), "+v"(buf[15]) :: "memory")
    const int dstep = 4 * F.NGW; int tb = 4 * F.gw;
    u32x4 bufa[16], bufb[16];
    if (tb >= T) return;
    TK_LOAD(bufa, tb);
    for (;;) {
        const int t1 = tb + dstep; TK_LOAD(bufb, t1 < T ? t1 : tb);
        TK_WAIT(bufa, 16);
        step(bufa, tb);
        if (t1 >= T) break;
        const int t2 = t1 + dstep; TK_LOAD(bufa, t2 < T ? t2 : t1);
        TK_WAIT(bufb, 16);
        step(bufb, t1);
        if (t2 >= T) break;
        tb = t2;
    }
    asm volatile("s_waitcnt vmcnt(0)" ::: "memory");
#undef TK_LOAD
#undef TK_LD1
#undef TK_WAIT
}

template <int S> __device__ __forceinline__ void reduce_scatter16(const float (&v)[16], int lane, float& z0, float& z1) {
    const bool b2 = (lane & (4 * S)) != 0, b1 = (lane & (2 * S)) != 0, b0 = (lane & S) != 0;
    float u[8], w[4];
#pragma unroll
    for (int k = 0; k < 8; ++k) { const float keep = b2 ? v[8 + k] : v[k], send = b2 ? v[k] : v[8 + k]; u[k] = keep + __shfl_xor(send, 4 * S); }
#pragma unroll
    for (int k = 0; k < 4; ++k) { const float keep = b1 ? u[4 + k] : u[k], send = b1 ? u[k] : u[4 + k]; w[k] = keep + __shfl_xor(send, 2 * S); }
    { const float keep = b0 ? w[2] : w[0], send = b0 ? w[0] : w[2]; z0 = keep + __shfl_xor(send, S); }
    { const float keep = b0 ? w[3] : w[1], send = b0 ? w[1] : w[3]; z1 = keep + __shfl_xor(send, S); }
}
__device__ __forceinline__ void ld_off16(const int* IDX, int t, int g, unsigned off, unsigned (&e)[16]) {
    const u32x4* ip = (const u32x4*)((const char*)IDX + (unsigned)(t * 512 + 64 * g)); const u32x4 i0 = ip[0], i1 = ip[1], i2 = ip[2], i3 = ip[3];
    e[0] = i0.x * 128u + off; e[1] = i0.y * 128u + off; e[2] = i0.z * 128u + off; e[3] = i0.w * 128u + off; e[4] = i1.x * 128u + off; e[5] = i1.y * 128u + off; e[6] = i1.z * 128u + off; e[7] = i1.w * 128u + off;
    e[8] = i2.x * 128u + off; e[9] = i2.y * 128u + off; e[10] = i2.z * 128u + off; e[11] = i2.w * 128u + off; e[12] = i3.x * 128u + off; e[13] = i3.y * 128u + off; e[14] = i3.z * 128u + off; e[15] = i3.w * 128u + off;
}
__device__ __forceinline__ void gather16(const unsigned char* tab, const unsigned (&e)[16], u32x4 (&wv)[16]) {
#pragma unroll
    for (int i = 0; i < 16; ++i) wv[i] = *(const u32x4*)(tab + e[i]);
}
#define FP4X32(W_, o) do { const u32x4 _w = (W_); \
    o[0] = __builtin_amdgcn_cvt_scalef32_pk_f32_fp4(_w.x, 1.0f, 0); o[1] = __builtin_amdgcn_cvt_scalef32_pk_f32_fp4(_w.x, 1.0f, 1); o[2] = __builtin_amdgcn_cvt_scalef32_pk_f32_fp4(_w.x, 1.0f, 2); o[3] = __builtin_amdgcn_cvt_scalef32_pk_f32_fp4(_w.x, 1.0f, 3); \
    o[4] = __builtin_amdgcn_cvt_scalef32_pk_f32_fp4(_w.y, 1.0f, 0); o[5] = __builtin_amdgcn_cvt_scalef32_pk_f32_fp4(_w.y, 1.0f, 1); o[6] = __builtin_amdgcn_cvt_scalef32_pk_f32_fp4(_w.y, 1.0f, 2); o[7] = __builtin_amdgcn_cvt_scalef32_pk_f32_fp4(_w.y, 1.0f, 3); \
    o[8] = __builtin_amdgcn_cvt_scalef32_pk_f32_fp4(_w.z, 1.0f, 0); o[9] = __builtin_amdgcn_cvt_scalef32_pk_f32_fp4(_w.z, 1.0f, 1); o[10] = __builtin_amdgcn_cvt_scalef32_pk_f32_fp4(_w.z, 1.0f, 2); o[11] = __builtin_amdgcn_cvt_scalef32_pk_f32_fp4(_w.z, 1.0f, 3); \
    o[12] = __builtin_amdgcn_cvt_scalef32_pk_f32_fp4(_w.w, 1.0f, 0); o[13] = __builtin_amdgcn_cvt_scalef32_pk_f32_fp4(_w.w, 1.0f, 1); o[14] = __builtin_amdgcn_cvt_scalef32_pk_f32_fp4(_w.w, 1.0f, 2); o[15] = __builtin_amdgcn_cvt_scalef32_pk_f32_fp4(_w.w, 1.0f, 3); } while (0)
__device__ __forceinline__ void peer_down_phase4(const Frame& F, int layer) {
    const int bx = blockIdx.x, p4 = bx & 3, par = (bx >> 2) & 1;
    const unsigned char* TD = F.ws + WS_TAB + (size_t)(2 * layer) * 16 * MiB + (size_t)p4 * (2 * MiB); const char* HNb = (const char*)(F.ws + WS_HN);
    const int* IDX = (const int*)(F.ws + WS_IDX); bf16_t* PART = (bf16_t*)(F.ws + WS_PART);
    const int nwp = (F.G - (bx & 7) + 7) >> 3, ww = (bx >> 3) * 8 + F.wave, stride = 2 * nwp * 8, tfirst = 2 * ww + par;
    const int lane = F.lane, r = lane & 7, g = lane >> 3, off = 256 * p4 + 32 * r;
    if (tfirst >= T) return;
    unsigned e1[16]; u32x4 wv[16];
    const unsigned toff = 16u * r;
    ld_off16(IDX, tfirst, g, toff, e1); gather16(TD, e1, wv);
    u32x4 xc[4];
#pragma unroll
    for (int k = 0; k < 4; ++k) xc[k] = *(const u32x4*)(HNb + (unsigned)(tfirst * 2048 + 2 * off + 16 * k));
    { const int t1 = tfirst + stride < T ? tfirst + stride : tfirst; ld_off16(IDX, t1, g, toff, e1); }
    for (int t0 = tfirst; t0 < T; t0 += stride) {
        const int t1 = t0 + stride < T ? t0 + stride : t0, t2 = t0 + 2 * stride < T ? t0 + 2 * stride : t0;
        unsigned e2[16]; ld_off16(IDX, t2, g, toff, e2);
        u32x4 xn[4];
#pragma unroll
        for (int k = 0; k < 4; ++k) xn[k] = *(const u32x4*)(HNb + (unsigned)(t1 * 2048 + 2 * off + 16 * k));
        const unsigned xw[16] = {xc[0].x, xc[0].y, xc[0].z, xc[0].w, xc[1].x, xc[1].y, xc[1].z, xc[1].w, xc[2].x, xc[2].y, xc[2].z, xc[2].w, xc[3].x, xc[3].y, xc[3].z, xc[3].w};
        float acc[16];
#pragma unroll
        for (int i = 0; i < 16; ++i) { const u32x4 w = wv[i]; wv[i] = *(const u32x4*)(TD + e1[i]);
            const unsigned ww4[4] = {w.x, w.y, w.z, w.w}; float sv = 0.f;
#pragma unroll
            for (int k = 0; k < 4; ++k) {
                sv = __builtin_amdgcn_fdot2_f32_bf16(__builtin_amdgcn_cvt_scalef32_pk_bf16_fp4(ww4[k], 1.0f, 0), __builtin_bit_cast(bfx2, xw[4 * k]), sv, false);
                sv = __builtin_amdgcn_fdot2_f32_bf16(__builtin_amdgcn_cvt_scalef32_pk_bf16_fp4(ww4[k], 1.0f, 1), __builtin_bit_cast(bfx2, xw[4 * k + 1]), sv, false);
                sv = __builtin_amdgcn_fdot2_f32_bf16(__builtin_amdgcn_cvt_scalef32_pk_bf16_fp4(ww4[k], 1.0f, 2), __builtin_bit_cast(bfx2, xw[4 * k + 2]), sv, false);
                sv = __builtin_amdgcn_fdot2_f32_bf16(__builtin_amdgcn_cvt_scalef32_pk_bf16_fp4(ww4[k], 1.0f, 3), __builtin_bit_cast(bfx2, xw[4 * k + 3]), sv, false); }
            acc[i] = sv; }
        float z0, z1; reduce_scatter16<1>(acc, lane, z0, z1);
        *(unsigned*)((char*)(PART + (size_t)p4 * T * 128) + (unsigned)(t0 * 256 + 32 * g + 4 * r)) = pk2(z0, z1);
#pragma unroll
        for (int k = 0; k < 4; ++k) xc[k] = xn[k];
#pragma unroll
        for (int i = 0; i < 16; ++i) e1[i] = e2[i];
    }
}
constexpr int D5_AUX = 131072;
#define D5_EL(iv, d) ((iv)[2 * ((d) & 1) + ((d) >> 3)][((d) >> 1) & 3])
#define D5_DMA(iv, d) __builtin_amdgcn_global_load_lds((const unsigned*)(TD + (D5_EL(iv, d) * 128u + (((d) & 1) ? sw1 : sw0))), (LAS unsigned*)(wl + (d) * 1024), 16, 0, 0)
#define D5_DMA_IDX(t, slot) do { __builtin_amdgcn_global_load_lds((const unsigned*)(IDX + (unsigned)((t) * 512) + l4), (LAS unsigned*)(xl + (slot) * 512), 4, 0, 0); \
                                 __builtin_amdgcn_global_load_lds((const unsigned*)(IDX + (unsigned)((t) * 512) + 256u + l4), (LAS unsigned*)(xl + (slot) * 512 + 256), 4, 0, 0); } while (0)
#define D5_DMA_H(t, slot) __builtin_amdgcn_global_load_lds((const unsigned*)(H8 + (unsigned)((t) * 1024) + l4), (LAS unsigned*)(xl + 1024 + (slot) * 256), 4, 0, 0)
#define D5_B(h, c) ((i32x8){(int)h[2 * (c)].x, (int)h[2 * (c)].y, (int)h[2 * (c)].z, (int)h[2 * (c)].w, (int)h[2 * (c) + 1].x, (int)h[2 * (c) + 1].y, (int)h[2 * (c) + 1].z, (int)h[2 * (c) + 1].w})
#define D5_A(a) ((i32x8){(int)(a).x, (int)(a).y, (int)(a).z, (int)(a).w, 0, 0, 0, 0})
__device__ __forceinline__ void peer_down_phase5(const Frame& F, int layer) {
    const int bx = blockIdx.x, p4 = bx & 3, par = (bx >> 2) & 1;
    const unsigned char* TD = F.ws + WS_TAB + (size_t)(2 * layer) * 16 * MiB + (size_t)p4 * (2 * MiB);
    const char* H8 = (const char*)(F.ws + WS_HN8) + 256 * p4; const char* IDX = (const char*)(F.ws + WS_IDX); char* PART = (char*)(F.ws + WS_PART) + (size_t)p4 * T * 256;
    const int nwp = (F.G - (bx & 7) + 7) >> 3, ww = (bx >> 3) * 8 + F.wave, stride = 2 * nwp * 8, tfirst = 2 * ww + par;
    if (tfirst >= T) return;
    const int lane = F.lane, rs = lane >> 3, sg = lane & 7, m = lane & 15, kg = lane >> 4;
    LAS unsigned char* wl = F.lds + F.wave * 16384; LAS unsigned char* xl = F.lds + D5_AUX + F.wave * 1536;
    const unsigned sw0 = (unsigned)((sg ^ kg) * 16), sw1 = (unsigned)((sg ^ (4 + kg)) * 16);
    const unsigned rd0 = (unsigned)(m * 128 + (kg ^ (m >> 1)) * 16), rd1 = (unsigned)(m * 128 + ((4 + kg) ^ (m >> 1)) * 16);
    const unsigned l4 = 4u * lane, ioff = 32u * rs, hoff = 16u * kg;
    { const u32x4* ip = (const u32x4*)(IDX + (unsigned)(tfirst * 512) + ioff); u32x4 i0[4]; i0[0] = ip[0]; i0[1] = ip[1]; i0[2] = ip[16]; i0[3] = ip[17];
      asm volatile("" : "+v"(i0[0]), "+v"(i0[1]), "+v"(i0[2]), "+v"(i0[3]) :: "memory");
      { const int t1 = tfirst + stride < T ? tfirst + stride : tfirst; D5_DMA_IDX(t1, 1); D5_DMA_H(tfirst, 0); }
      asm volatile("" ::: "memory");
#pragma unroll
      for (int d = 0; d < 16; ++d) D5_DMA(i0, d); }
    int sl = 0;
    for (int t0 = tfirst; t0 < T; t0 += stride, sl ^= 1) {
        const int t1 = t0 + stride < T ? t0 + stride : t0, t2 = t0 + 2 * stride < T ? t0 + 2 * stride : t0;
        D5_DMA_IDX(t2, sl); D5_DMA_H(t1, sl ^ 1);
        u32x4 i1[4], hb[4];
        f32x4 acc[8];
#pragma unroll
        for (int q = 0; q < 4; ++q) {
            asm volatile("s_waitcnt vmcnt(15)" ::: "memory");
            u32x4 a00 = *(const LAS u32x4*)(wl + (2 * q) * 2048 + rd0), a01 = *(const LAS u32x4*)(wl + (2 * q) * 2048 + rd1);
            u32x4 a10 = *(const LAS u32x4*)(wl + (2 * q + 1) * 2048 + rd0), a11 = *(const LAS u32x4*)(wl + (2 * q + 1) * 2048 + rd1);
            if (q == 0) {
                const LAS u32x4* ip = (const LAS u32x4*)(xl + (sl ^ 1) * 512 + ioff); i1[0] = ip[0]; i1[1] = ip[1]; i1[2] = ip[16]; i1[3] = ip[17];
                const LAS u32x4* hp = (const LAS u32x4*)(xl + 1024 + sl * 256 + hoff); hb[0] = hp[0]; hb[1] = hp[4]; hb[2] = hp[8]; hb[3] = hp[12];
                asm volatile("s_waitcnt lgkmcnt(0)" : "+v"(i1[0]), "+v"(i1[1]), "+v"(i1[2]), "+v"(i1[3]), "+v"(hb[0]), "+v"(hb[1]), "+v"(hb[2]), "+v"(hb[3]) :: "memory");
            }
            asm volatile("s_waitcnt lgkmcnt(0)" : "+v"(a00), "+v"(a01), "+v"(a10), "+v"(a11) :: "memory");
            D5_DMA(i1, 4 * q); D5_DMA(i1, 4 * q + 1); D5_DMA(i1, 4 * q + 2); D5_DMA(i1, 4 * q + 3);
            asm volatile("" ::: "memory");
            const i32x8 b0 = D5_B(hb, 0), b1 = D5_B(hb, 1);
            const f32x4 z = {0.f, 0.f, 0.f, 0.f};
            acc[2 * q] = __builtin_amdgcn_mfma_scale_f32_16x16x128_f8f6f4(D5_A(a00), b0, z, 4, 0, 0, 0, 0, 0);
            acc[2 * q + 1] = __builtin_amdgcn_mfma_scale_f32_16x16x128_f8f6f4(D5_A(a10), b0, z, 4, 0, 0, 0, 0, 0);
            acc[2 * q] = __builtin_amdgcn_mfma_scale_f32_16x16x128_f8f6f4(D5_A(a01), b1, acc[2 * q], 4, 0, 0, 0, 0, 0);
            acc[2 * q + 1] = __builtin_amdgcn_mfma_scale_f32_16x16x128_f8f6f4(D5_A(a11), b1, acc[2 * q + 1], 4, 0, 0, 0, 0, 0);
        }
        if (m < 4) {
            float v[8];
#pragma unroll
            for (int j = 0; j < 8; ++j) v[j] = m == 0 ? acc[j].x : m == 1 ? acc[j].y : m == 2 ? acc[j].z : acc[j].w;
            *(u32x4*)(PART + (unsigned)(t0 * 256 + 16 * (4 * kg + m))) = (u32x4){pk2(v[0], v[1]), pk2(v[2], v[3]), pk2(v[4], v[5]), pk2(v[6], v[7])};
        }
    }
    asm volatile("s_waitcnt vmcnt(0)" ::: "memory");
}
template <int NS> __device__ __forceinline__ void peer_reduce_phase(const Frame& F, int layer) {
    const u32x2* PART = (const u32x2*)(F.ws + WS_PART); const int* IDX = (const int*)(F.ws + WS_IDX); const float* GATE = (const float*)(F.ws + WS_GATE);
    bf16_t* AB = (bf16_t*)(F.ws + WS_AB);
    const f32x2* scl = (const f32x2*)(F.ws + WS_SCL) + (size_t)layer * 16384;
    const size_t n4 = (size_t)T * 128 / 4, stride = (size_t)F.G * 512;
    for (size_t i = (size_t)blockIdx.x * 512 + F.tid; i < n4; i += stride) {
        u32x2 pw[NS];
#pragma unroll
        for (int p = 0; p < NS; ++p) pw[p] = PART[(size_t)p * T * 32 + i];
        const u32x4 e = ((const u32x4*)IDX)[i]; const f32x4 gt = ((const f32x4*)GATE)[i];
        const f32x2 c0 = scl[e.x], c1 = scl[e.y], c2 = scl[e.z], c3 = scl[e.w];
        f32x4 s = {0.f, 0.f, 0.f, 0.f};
#pragma unroll
        for (int p = 0; p < NS; ++p) { s.x += bflo(pw[p].x); s.y += bfhi(pw[p].x); s.z += bflo(pw[p].y); s.w += bfhi(pw[p].y); }
        f32x4 o;
        o.x = gelu_tanh(s.x * c0.x) * gt.x * c0.y; o.y = gelu_tanh(s.y * c1.x) * gt.y * c1.y;
        o.z = gelu_tanh(s.z * c2.x) * gt.z * c2.y; o.w = gelu_tanh(s.w * c3.x) * gt.w * c3.y;
        ((u32x2*)AB)[i] = (u32x2){pk2(o.x, o.y), pk2(o.z, o.w)};
    }
}
__device__ __forceinline__ void peer_reduce_phase8(const Frame& F, int layer) {
    const u32x2* PART = (const u32x2*)(F.ws + WS_PART); const int* IDX = (const int*)(F.ws + WS_IDX); const float* GATE = (const float*)(F.ws + WS_GATE);
    unsigned char* AB8 = F.ws + WS_AB;
    const f32x2* scl = (const f32x2*)(F.ws + WS_SCL) + (size_t)layer * 16384;
    const size_t n4 = (size_t)T * 128 / 4, stride = (size_t)F.G * 512;
    for (size_t i = (size_t)blockIdx.x * 512 + F.tid; i < n4; i += stride) {
        u32x2 pw[4];
#pragma unroll
        for (int p = 0; p < 4; ++p) pw[p] = PART[(size_t)p * T * 32 + i];
        const u32x4 e = ((const u32x4*)IDX)[i]; const f32x4 gt = ((const f32x4*)GATE)[i];
        const f32x2 c0 = scl[e.x], c1 = scl[e.y], c2 = scl[e.z], c3 = scl[e.w];
        f32x4 s = {0.f, 0.f, 0.f, 0.f};
#pragma unroll
        for (int p = 0; p < 4; ++p) { s.x += bflo(pw[p].x); s.y += bfhi(pw[p].x); s.z += bflo(pw[p].y); s.w += bfhi(pw[p].y); }
        f32x4 o;
        o.x = gelu_tanh(s.x * c0.x) * gt.x * c0.y; o.y = gelu_tanh(s.y * c1.x) * gt.y * c1.y;
        o.z = gelu_tanh(s.z * c2.x) * gt.z * c2.y; o.w = gelu_tanh(s.w * c3.x) * gt.w * c3.y;
        float am = fmaxf(fmaxf(fabsf(o.x), fabsf(o.y)), fmaxf(fabsf(o.z), fabsf(o.w)));
#pragma unroll
        for (int d = 1; d < 32; d <<= 1) am = fmaxf(am, __shfl_xor(am, d));
        const float S = am > 0.f ? 256.0f / am : 1.0f;
        int w = 0; w = __builtin_amdgcn_cvt_pk_fp8_f32(o.x * S, o.y * S, w, false); w = __builtin_amdgcn_cvt_pk_fp8_f32(o.z * S, o.w * S, w, true);
        const size_t t = i >> 5; const unsigned j = (unsigned)i & 31u;
        *(unsigned*)(AB8 + t * 256 + 4 * j) = (unsigned)w;
        if (j == 0) *(float*)(AB8 + t * 256 + 128) = am * (1.0f / 256.0f);
    }
}
__device__ __forceinline__ unsigned hadd2(unsigned a, unsigned b) { const h16x2 r = __builtin_bit_cast(h16x2, a) + __builtin_bit_cast(h16x2, b); return __builtin_bit_cast(unsigned, r); }
__device__ __forceinline__ f32x4 reduce_scatter32h_g(const unsigned (&v)[16], int lane) {
    const bool b2 = (lane & 32) != 0, b1 = (lane & 16) != 0, b0 = (lane & 8) != 0;
    unsigned u[8], w[4], z[2];
#pragma unroll
    for (int k = 0; k < 8; ++k) { const unsigned keep = b2 ? v[8 + k] : v[k], send = b2 ? v[k] : v[8 + k]; u[k] = hadd2(keep, (unsigned)__shfl_xor((int)send, 32)); }
#pragma unroll
    for (int k = 0; k < 4; ++k) { const unsigned keep = b1 ? u[4 + k] : u[k], send = b1 ? u[k] : u[4 + k]; w[k] = hadd2(keep, (unsigned)__shfl_xor((int)send, 16)); }
#pragma unroll
    for (int k = 0; k < 2; ++k) { const unsigned keep = b0 ? w[2 + k] : w[k], send = b0 ? w[k] : w[2 + k]; z[k] = hadd2(keep, (unsigned)__shfl_xor((int)send, 8)); }
    return (f32x4){hlo(z[0]), hhi(z[0]), hlo(z[1]), hhi(z[1])};
}
__device__ __forceinline__ void peer_up_phase4(const Frame& F, int layer) {
    const int bx = blockIdx.x, p4 = bx & 3, par = (bx >> 2) & 1;
    const unsigned char* TU = F.ws + WS_TAB + (size_t)(2 * layer + 1) * 16 * MiB + (size_t)p4 * (2 * MiB);
    const int* IDX = (const int*)(F.ws + WS_IDX); const char* AB = (const char*)(F.ws + WS_AB);
    const int nwp = (F.G - (bx & 7) + 7) >> 3, ww = (bx >> 3) * 8 + F.wave, stride = 2 * nwp * 8, tfirst = 2 * ww + par;
    const int lane = F.lane, r = lane & 7, g = lane >> 3, hoff = 256 * p4 + 32 * r + 4 * g;
    if (tfirst >= T) return;
    unsigned e1[16]; u32x4 wv[16];
    const unsigned toff = 16u * r;
    ld_off16(IDX, tfirst, g, toff, e1); gather16(TU, e1, wv);
    u32x4 a0a = *(const u32x4*)(AB + (unsigned)(tfirst * 256 + 32 * g)), a0b = *(const u32x4*)(AB + (unsigned)(tfirst * 256 + 32 * g + 16));
    { const int t1 = tfirst + stride < T ? tfirst + stride : tfirst; ld_off16(IDX, t1, g, toff, e1); }
    for (int t0 = tfirst; t0 < T; t0 += stride) {
        const int t1 = t0 + stride < T ? t0 + stride : t0, t2 = t0 + 2 * stride < T ? t0 + 2 * stride : t0;
        unsigned e2[16]; ld_off16(IDX, t2, g, toff, e2);
        const u32x4 a1a = *(const u32x4*)(AB + (unsigned)(t1 * 256 + 32 * g)), a1b = *(const u32x4*)(AB + (unsigned)(t1 * 256 + 32 * g + 16));
        f32x4* hp = (f32x4*)((char*)F.out + (unsigned)(t0 * 4096 + 4 * hoff)); const f32x4 h0 = *hp;
        const unsigned aw[8] = {a0a.x, a0a.y, a0a.z, a0a.w, a0b.x, a0b.y, a0b.z, a0b.w};
        unsigned y2[16];
#pragma unroll
        for (int k = 0; k < 16; ++k) y2[k] = 0u;
#pragma unroll
        for (int i = 0; i < 16; ++i) { u32x4 w = wv[i]; wv[i] = *(const u32x4*)(TU + e1[i]);
            if (i > 0) asm volatile("" : "+v"(w.x), "+v"(w.y), "+v"(w.z), "+v"(w.w) : "v"(y2[0]), "v"(y2[15]));
            const float ai = (i & 1) ? bfhi(aw[i >> 1]) : bflo(aw[i >> 1]); const h16x2 av = {(_Float16)ai, (_Float16)ai};
            const unsigned ww4[4] = {w.x, w.y, w.z, w.w};
#pragma unroll
            for (int k = 0; k < 4; ++k) {
                { const h16x2 r = av * __builtin_amdgcn_cvt_scalef32_pk_f16_fp4(ww4[k], 1.0f, 0) + __builtin_bit_cast(h16x2, y2[4 * k]); y2[4 * k] = __builtin_bit_cast(unsigned, r); }
                { const h16x2 r = av * __builtin_amdgcn_cvt_scalef32_pk_f16_fp4(ww4[k], 1.0f, 1) + __builtin_bit_cast(h16x2, y2[4 * k + 1]); y2[4 * k + 1] = __builtin_bit_cast(unsigned, r); }
                { const h16x2 r = av * __builtin_amdgcn_cvt_scalef32_pk_f16_fp4(ww4[k], 1.0f, 2) + __builtin_bit_cast(h16x2, y2[4 * k + 2]); y2[4 * k + 2] = __builtin_bit_cast(unsigned, r); }
                { const h16x2 r = av * __builtin_amdgcn_cvt_scalef32_pk_f16_fp4(ww4[k], 1.0f, 3) + __builtin_bit_cast(h16x2, y2[4 * k + 3]); y2[4 * k + 3] = __builtin_bit_cast(unsigned, r); } } }
        const f32x4 z = reduce_scatter32h_g(y2, lane);
        *hp = h0 + z;
        a0a = a1a; a0b = a1b;
#pragma unroll
        for (int i = 0; i < 16; ++i) e1[i] = e2[i];
    }
}

constexpr int U5_AUX = 131072;
__device__ __forceinline__ void peer_up_phase5(const Frame& F, int layer) {
    const int bx = blockIdx.x, p4 = bx & 3, par = (bx >> 2) & 1;
    const unsigned char* TU = F.ws + WS_TAB + (size_t)(2 * layer + 1) * 16 * MiB + (size_t)p4 * (2 * MiB);
    const char* IDX = (const char*)(F.ws + WS_IDX); const char* AB8 = (const char*)(F.ws + WS_AB);
    char* H8 = (char*)(F.ws + WS_H8) + 256 * p4; float* HSQ = (float*)(F.ws + WS_HSQ);
    const char* HIN = (const char*)F.out + 512 * p4; char* OUT = (layer == 1 ? (char*)(F.ws + WS_H2) : (char*)F.out) + 512 * p4;
    const int nwp = (F.G - (bx & 7) + 7) >> 3, ww = (bx >> 3) * 8 + F.wave, stride = 2 * nwp * 8, tfirst = 2 * ww + par;
    if (tfirst >= T) return;
    const int lane = F.lane, rs = lane >> 3, sg = lane & 7, m = lane & 15, kg = lane >> 4;
    LAS unsigned char* wl = F.lds + F.wave * 16384; LAS unsigned char* xl = F.lds + U5_AUX + F.wave * 3584;
    const unsigned sw0 = (unsigned)((sg ^ kg) * 16), sw1 = (unsigned)((sg ^ (4 + kg)) * 16);
    const unsigned l4 = 4u * lane, l16 = 16u * lane;
    unsigned tb[8];
#pragma unroll
    for (int sgm = 0; sgm < 8; ++sgm) tb[sgm] = (unsigned)((32 * kg + m) * 128 + ((sgm ^ (m >> 1)) * 16));
    const unsigned hrd = (unsigned)(32 * m + 8 * kg);
#define U5_PIECE(ixv, d) __builtin_amdgcn_global_load_lds((const unsigned*)(TU + ((ixv)[d] * 128u + (((d) & 1) ? sw1 : sw0))), (LAS unsigned*)(wl + (d) * 1024), 16, 0, 0)
#define U5_DMA_IDX(t, slot) do { __builtin_amdgcn_global_load_lds((const unsigned*)(IDX + (unsigned)((t) * 512) + l4), (LAS unsigned*)(xl + (slot) * 512), 4, 0, 0); \
                                 __builtin_amdgcn_global_load_lds((const unsigned*)(IDX + (unsigned)((t) * 512) + 256u + l4), (LAS unsigned*)(xl + (slot) * 512 + 256), 4, 0, 0); } while (0)
#define U5_DMA_AB(t, slot) __builtin_amdgcn_global_load_lds((const unsigned*)(AB8 + (unsigned)((t) * 256) + l4), (LAS unsigned*)(xl + 1024 + (slot) * 256), 4, 0, 0)
#define U5_DMA_H(t, slot) do { __builtin_amdgcn_global_load_lds((const unsigned*)(HIN + (unsigned)((t) * 2048) + l4), (LAS unsigned*)(xl + 1536 + (slot) * 1024), 4, 0, 0); \
                               __builtin_amdgcn_global_load_lds((const unsigned*)(HIN + (unsigned)((t) * 2048) + 256u + l4), (LAS unsigned*)(xl + 1536 + (slot) * 1024 + 256), 4, 0, 0); } while (0)
    { unsigned i0[16];
#pragma unroll
      for (int d = 0; d < 16; ++d) i0[d] = *(const unsigned*)(IDX + (unsigned)(tfirst * 512) + (unsigned)(4 * rs + 32 * d));
#pragma unroll
      for (int d = 0; d < 16; ++d) asm volatile("" : "+v"(i0[d]) :: "memory");
      { const int t1 = tfirst + stride < T ? tfirst + stride : tfirst; U5_DMA_IDX(t1, 1); U5_DMA_AB(tfirst, 0); U5_DMA_H(tfirst, 0); }
      asm volatile("" ::: "memory");
#pragma unroll
      for (int d = 0; d < 16; ++d) U5_PIECE(i0, d); }
    int sl = 0, tprev = -1; f32x4 pend = {0.f, 0.f, 0.f, 0.f};
    for (int t0 = tfirst; t0 < T; t0 += stride, sl ^= 1) {
        const int t1 = t0 + stride < T ? t0 + stride : t0, t2 = t0 + 2 * stride < T ? t0 + 2 * stride : t0;
        asm volatile("s_waitcnt vmcnt(0)" ::: "memory");
        unsigned ix[16];
        { const LAS unsigned* ip = (const LAS unsigned*)(xl + (sl ^ 1) * 512 + 4 * rs);
#pragma unroll
          for (int d = 0; d < 16; ++d) ix[d] = ip[8 * d]; }
        const LAS u32x4* bp = (const LAS u32x4*)(xl + 1024 + sl * 256 + 16 * kg); u32x4 bl = bp[0], bh = bp[4];
        float inv = *(const LAS float*)(xl + 1024 + sl * 256 + 128);
        u32x2 hw = *(const LAS u32x2*)(xl + 1536 + sl * 1024 + hrd);
        i32x2 a0[16], a1[16];
#pragma unroll
        for (int cb = 0; cb < 16; ++cb) {
            a0[cb] = __builtin_amdgcn_ds_read_tr4_b64_v2i32((LAS i32x2*)(wl + tb[cb >> 1] + (cb & 1) * 8));
            a1[cb] = __builtin_amdgcn_ds_read_tr4_b64_v2i32((LAS i32x2*)(wl + tb[cb >> 1] + (cb & 1) * 8 + 2048)); }
        asm volatile("s_waitcnt lgkmcnt(0)" : "+v"(bl), "+v"(bh), "+v"(inv), "+v"(hw) :: "memory");
#pragma unroll
        for (int d = 0; d < 16; ++d) asm volatile("" : "+v"(ix[d]), "+v"(a0[d]), "+v"(a1[d]) :: "memory");
        if (tprev >= 0) { *(u32x2*)(OUT + (unsigned)(tprev * 2048) + hrd) = (u32x2){pk2(pend.x, pend.y), pk2(pend.z, pend.w)};
            if (layer == 0) { int w8 = 0; w8 = __builtin_amdgcn_cvt_pk_fp8_f32(pend.x, pend.y, w8, false); w8 = __builtin_amdgcn_cvt_pk_fp8_f32(pend.z, pend.w, w8, true);
                *(unsigned*)(H8 + (unsigned)(tprev * 1024) + (hrd >> 1)) = (unsigned)w8;
                const float sq = wave_sum((pend.x * pend.x + pend.y * pend.y) + (pend.z * pend.z + pend.w * pend.w));
                if (lane == 0) HSQ[tprev * 4 + p4] = sq; } }
        asm volatile("" ::: "memory");
        U5_DMA_IDX(t2, sl); U5_DMA_AB(t1, sl ^ 1); U5_DMA_H(t1, sl ^ 1);
#pragma unroll
        for (int d = 0; d < 16; ++d) U5_PIECE(ix, d);
        asm volatile("" ::: "memory");
        const i32x8 b = {(int)bl.x, (int)bl.y, (int)bl.z, (int)bl.w, (int)bh.x, (int)bh.y, (int)bh.z, (int)bh.w};
        const f32x4 z = {0.f, 0.f, 0.f, 0.f};
        f32x4 v = z;
#pragma unroll
        for (int cb = 0; cb < 16; ++cb) {
            const i32x8 a = {a0[cb].x, a0[cb].y, a1[cb].x, a1[cb].y, 0, 0, 0, 0};
            const f32x4 r = __builtin_amdgcn_mfma_scale_f32_16x16x128_f8f6f4(a, b, z, 4, 0, 0, 0, 0, 0);
            v = (m == cb) ? r : v; }
        pend = (f32x4){bflo(hw.x), bfhi(hw.x), bflo(hw.y), bfhi(hw.y)} + v * inv; tprev = t0;
    }
    asm volatile("s_waitcnt vmcnt(0)" ::: "memory");
    *(u32x2*)(OUT + (unsigned)(tprev * 2048) + hrd) = (u32x2){pk2(pend.x, pend.y), pk2(pend.z, pend.w)};
    if (layer == 0) { int w8 = 0; w8 = __builtin_amdgcn_cvt_pk_fp8_f32(pend.x, pend.y, w8, false); w8 = __builtin_amdgcn_cvt_pk_fp8_f32(pend.z, pend.w, w8, true);
        *(unsigned*)(H8 + (unsigned)(tprev * 1024) + (hrd >> 1)) = (unsigned)w8;
        const float sq = wave_sum((pend.x * pend.x + pend.y * pend.y) + (pend.z * pend.z + pend.w * pend.w));
        if (lane == 0) HSQ[tprev * 4 + p4] = sq; }
#undef U5_PIECE
#undef U5_DMA_IDX
#undef U5_DMA_AB
#undef U5_DMA_H
}

constexpr int SGM_VT = 0, SGM_WL = 384 * 272, SGM_STAT = SGM_WL + 128 * 272;
__device__ __forceinline__ void sg_mix_phase(const Frame& F) {
    bf16_t* V = (bf16_t*)(F.ws + WS_SG);
    const float* lng = F.in[7]; const float* lnb = F.in[8]; const float* wsp = F.in[9]; const float* bsp = F.in[10];
    LAS unsigned* VT32 = (LAS unsigned*)(F.lds + SGM_VT); LAS bf16_t* VT = (LAS bf16_t*)(F.lds + SGM_VT); LAS bf16_t* WL = (LAS bf16_t*)(F.lds + SGM_WL);
    LAS float* stat = (LAS float*)(F.lds + SGM_STAT);
    const int lane = F.lane, tid = F.tid, fr = lane & 15, fq = lane >> 4;
    for (int c = blockIdx.x; c < 256; c += F.G) {
#pragma unroll 1
        for (int r = 0; r < 16; ++r) {
            const int q = F.wave * 16 + r; const u32x4* row = (const u32x4*)(V + (size_t)(c * 128 + q) * DG);
            float v[48]; float s = 0.f;
#pragma unroll
            for (int i = 0; i < 6; ++i) { const u32x4 w = row[lane + 64 * i];
                v[8 * i + 0] = bflo(w.x); v[8 * i + 1] = bfhi(w.x); v[8 * i + 2] = bflo(w.y); v[8 * i + 3] = bfhi(w.y); v[8 * i + 4] = bflo(w.z); v[8 * i + 5] = bfhi(w.z); v[8 * i + 6] = bflo(w.w); v[8 * i + 7] = bfhi(w.w); }
#pragma unroll
            for (int i = 0; i < 48; ++i) s += v[i];
            const float mean = wave_sum(s) * (1.f / DG); float s2 = 0.f;
#pragma unroll
            for (int i = 0; i < 48; ++i) { const float d = v[i] - mean; s2 += d * d; }
            const float rstd = 1.0f / sqrtf(wave_sum(s2) * (1.f / DG) + 1e-5f);
            if (lane == 0) { stat[2 * q] = mean; stat[2 * q + 1] = rstd; }
        }
        __syncthreads();
#pragma unroll 1
        for (int g = 0; g < 8; ++g) {
#pragma unroll 1
            for (int it = 0; it < 4; ++it) { const int item = it * 512 + tid, p = item >> 4, q8 = (item & 15) * 8;
                const f32x4* wp = (const f32x4*)(wsp + ((size_t)g * 128 + p) * 128 + q8); const f32x4 a = wp[0], b = wp[1];
                u32x4 w; w.x = pk2(a.x, a.y); w.y = pk2(a.z, a.w); w.z = pk2(b.x, b.y); w.w = pk2(b.z, b.w);
                *(LAS u32x4*)(WL + p * 136 + q8) = w; }
#pragma unroll 1
            for (int it = 0; it < 6; ++it) { const int item = it * 512 + tid, qp = item & 63, dc = item >> 6; const int q0 = 2 * qp, col = g * 384 + 8 * dc;
                const u32x4 w0 = *(const u32x4*)(V + (size_t)(c * 128 + q0) * DG + col), w1 = *(const u32x4*)(V + (size_t)(c * 128 + q0 + 1) * DG + col);
                const float mu0 = stat[2 * q0], rs0 = stat[2 * q0 + 1], mu1 = stat[2 * q0 + 2], rs1 = stat[2 * q0 + 3];
                const f32x4 ga = *(const f32x4*)(lng + col), gb = *(const f32x4*)(lng + col + 4), ba = *(const f32x4*)(lnb + col), bb = *(const f32x4*)(lnb + col + 4);
                const float gm[8] = {ga.x, ga.y, ga.z, ga.w, gb.x, gb.y, gb.z, gb.w}, bt[8] = {ba.x, ba.y, ba.z, ba.w, bb.x, bb.y, bb.z, bb.w};
                const float a0[8] = {bflo(w0.x), bfhi(w0.x), bflo(w0.y), bfhi(w0.y), bflo(w0.z), bfhi(w0.z), bflo(w0.w), bfhi(w0.w)};
                const float a1[8] = {bflo(w1.x), bfhi(w1.x), bflo(w1.y), bfhi(w1.y), bflo(w1.z), bfhi(w1.z), bflo(w1.w), bfhi(w1.w)};
#pragma unroll
                for (int i = 0; i < 8; ++i) VT32[(8 * dc + i) * 68 + qp] = pk2((a0[i] - mu0) * rs0 * gm[i] + bt[i], (a1[i] - mu1) * rs1 * gm[i] + bt[i]); }
            __syncthreads();
            f32x4 acc[3][8];
#pragma unroll
            for (int a = 0; a < 3; ++a)
#pragma unroll
                for (int n = 0; n < 8; ++n) acc[a][n] = (f32x4){0.f, 0.f, 0.f, 0.f};
#pragma unroll 1
            for (int ks = 0; ks < 4; ++ks) { const int k0 = 32 * ks + 8 * fq;
                bf16x8 af[3], bfg[8];
#pragma unroll
                for (int a = 0; a < 3; ++a) af[a] = *(const LAS bf16x8*)(VT + (16 * (3 * F.wave + a) + fr) * 136 + k0);
#pragma unroll
                for (int n = 0; n < 8; ++n) bfg[n] = *(const LAS bf16x8*)(WL + (16 * n + fr) * 136 + k0);
#pragma unroll
                for (int a = 0; a < 3; ++a)
#pragma unroll
                    for (int n = 0; n < 8; ++n) acc[a][n] = __builtin_amdgcn_mfma_f32_16x16x32_bf16(af[a], bfg[n], acc[a][n], 0, 0, 0); }
#pragma unroll
            for (int n = 0; n < 8; ++n) { const int p = 16 * n + fr; const float bs = bsp[g * 128 + p];
#pragma unroll
                for (int a = 0; a < 3; ++a) { const int d0 = 16 * (3 * F.wave + a) + 4 * fq;
                    u32x2 w; w.x = pk2(acc[a][n][0] + bs, acc[a][n][1] + bs); w.y = pk2(acc[a][n][2] + bs, acc[a][n][3] + bs);
                    *(u32x2*)(V + (size_t)(c * 128 + p) * DG + g * 384 + d0) = w; } }
            __syncthreads();
        }
    }
}

__global__ void __launch_bounds__(512, 2) fwd(Args args) {
    extern __shared__ __attribute__((aligned(16))) unsigned char lds_raw[];
    Frame F;
    F.lds = (LAS unsigned char*)lds_raw;
    F.tid = threadIdx.x; F.lane = F.tid & 63; F.wave = __builtin_amdgcn_readfirstlane(F.tid >> 6);
    F.G = gridDim.x; F.gw = blockIdx.x * 8 + F.wave; F.NGW = F.G * 8;
    F.in = args.in; F.out = args.out; F.ws = args.ws;
    volatile LAS unsigned* MISC = (volatile LAS unsigned*)(F.lds + MISC_OFF);
    if (F.tid < 64) MISC[F.tid] = 0u;
    __syncthreads();
    const int lo = args.ph_lo, hi = args.ph_hi;
    unsigned* barw = (unsigned*)(F.ws + WS_CTL) + CW_BAR;
    XcdBarrier bar; bar.bar = barw; bar.x = 0; bar.st = MISC + 8;
    if (hi - lo > 1) bar = xcd_barrier_post(barw, MISC + 8);
#define IN(k) (lo <= (k) && (k) < hi)
#define SEAM(k) do { if (IN(k) && IN((k) + 1)) xcd_barrier(bar); } while (0)
    const int G = F.G, bx = blockIdx.x;
    bf16_t* HN = (bf16_t*)(F.ws + WS_HN); bf16_t* HB = (bf16_t*)F.out;

    if (IN(0)) { p0_prologue(F); } SEAM(0);
    if (IN(1)) {
        const bf16_t* HN8 = (const bf16_t*)(F.ws + WS_HN8B);
        { pg8::Gemm g{HN8, (const bf16_t*)(F.ws + WS_WQK), T, NQK, D / 2}; pg8::StaticOrder S; S.init(T, NQK, G, bx);
          pg8::EpiBf<3> E{(bf16_t*)(F.ws + WS_Q), 1024, (bf16_t*)(F.ws + WS_K), 1.0f / W8_SCALE};
          pg8::gemm_phase<1>(F.lds, g, S, E); }
        __syncthreads();
        { pg8::Gemm g{(const bf16_t*)(F.ws + WS_WV), HN8, 256, T, D / 2}; pg8::StaticOrder S; S.init(256, T, G, (bx + G / 2) % G);
          pg8::EpiBf<0> E{(bf16_t*)(F.ws + WS_VT), T, nullptr, 1.0f / W8_SCALE};
          pg8::gemm_phase<1>(F.lds, g, S, E); }
    } SEAM(1);
    if (IN(2)) { attn_phase_v2(F); } SEAM(2);
    if (IN(3)) {
        pg8::Gemm g{(const bf16_t*)(F.ws + WS_AO), (const bf16_t*)(F.ws + WS_WO), T, D, D / 2}; pg8::StaticOrder S; S.init(T, D, G, bx);
        pg8::EpiBf<6> E{HB, D, (bf16_t*)F.in[0], 1.0f / (W8_SCALE * AO8_SCALE)};
        pg8::gemm_phase<1>(F.lds, g, S, E);
    } SEAM(3);
    if (IN(4)) { quant_wqk(F); rmsnorm_rows_bf(F, HB, F.in[12], nullptr, F.ws + WS_HN8, F.ws + WS_HNI8, (float*)(F.ws + WS_HSC)); } SEAM(4);
    if (IN(5)) {
        pg8::Gemm g{(const bf16_t*)(F.ws + WS_HNI8), (const bf16_t*)(F.ws + WS_WQ8), T, 2048, D / 2}; pg8::StaticOrder S; S.init(T, 2048, G, bx);
        pg8::EpiBf<8> E{(bf16_t*)(F.ws + WS_S), 2048, (bf16_t*)(F.ws + WS_HSC), 1.0f, (const float*)(F.ws + WS_CTL) + CW_WSCL};
        pg8::gemm_phase<2>(F.lds, g, S, E);
    } SEAM(5);
    if (IN(6)) { topk_phase_v3(F); } SEAM(6);
    if (IN(7)) { peer_down_phase5(F, 0); } SEAM(7);
    if (IN(8)) { peer_reduce_phase8(F, 0); } SEAM(8);
    if (IN(9)) { peer_up_phase5(F, 0); } SEAM(9);
    if (IN(11)) {
        pg8::Gemm g{(const bf16_t*)(F.ws + WS_H8), (const bf16_t*)(F.ws + WS_WSGV), T, DG, D / 2}; pg8::StaticOrder S; S.init(T, DG, G, bx);
        pg8::EpiBf<1, true> E{(bf16_t*)(F.ws + WS_SG), DG, nullptr, 1.0f / W8_SCALE, nullptr, (const float*)(F.ws + WS_HSQ)};
        pg8::gemm_phase<1>(F.lds, g, S, E);
    } SEAM(11);
    if (IN(12)) { sg_mix_phase(F); } SEAM(12);
    if (IN(13)) {
        pg8::Gemm g{(const bf16_t*)(F.ws + WS_H8), (const bf16_t*)(F.ws + WS_WSGU), T, DG, D / 2}; pg8::StaticOrder S; S.init(T, DG, G, bx);
        pg8::EpiBf<5, true> E{(bf16_t*)(F.ws + WS_SG), DG, (bf16_t*)(F.ws + WS_SG8), 1.0f / W8_SCALE, nullptr, (const float*)(F.ws + WS_HSQ)};
        pg8::gemm_phase<1>(F.lds, g, S, E);
    } SEAM(13);
    if (IN(14)) {
        pg8::Gemm g{(const bf16_t*)(F.ws + WS_SG8), (const bf16_t*)(F.ws + WS_WSGO), T, D, DG / 2}; pg8::StaticOrder S; S.init(T, D, G, bx);
        pg8::EpiBf<7> E{HB, D, nullptr, 1.0f / W8_SCALE};
        pg8::gemm_phase<1>(F.lds, g, S, E);
    } SEAM(14);
    if (IN(15)) { rmsnorm_rows_bf(F, HB, F.in[12] + D, nullptr, F.ws + WS_HN8, F.ws + WS_HNI8, (float*)(F.ws + WS_HSC)); } SEAM(15);
    if (IN(16)) {
        pg8::Gemm g{(const bf16_t*)(F.ws + WS_HNI8), (const bf16_t*)(F.ws + WS_WQ8 + (size_t)2048 * 1024), T, 2048, D / 2}; pg8::StaticOrder S; S.init(T, 2048, G, bx);
        pg8::EpiBf<8> E{(bf16_t*)(F.ws + WS_S), 2048, (bf16_t*)(F.ws + WS_HSC), 1.0f, (const float*)(F.ws + WS_CTL) + CW_WSCL + 2048};
        pg8::gemm_phase<2>(F.lds, g, S, E);
    } SEAM(16);
    if (IN(17)) { topk_phase_v3(F); } SEAM(17);
    if (IN(18)) { peer_down_phase5(F, 1); } SEAM(18);
    if (IN(19)) { peer_reduce_phase8(F, 1); } SEAM(19);
    if (IN(20)) { peer_up_phase5(F, 1); } SEAM(20);
    if (IN(21)) { final_norm_bf(F, (const bf16_t*)(F.ws + WS_H2), F.out, F.in[17]); }
#undef IN
#undef SEAM
}

extern "C" void kernel_launch(void* const* d_in, const int* in_sizes, int n_in, void* d_out, int out_size, void* d_ws, size_t ws_size, hipStream_t stream) {
    static int grid = 0;
    if (grid == 0) {
        if (n_in != 18 || out_size != T * D || ws_size < WS_END) { fprintf(stderr, "kernel_launch: unexpected problem (n_in %d, out %d, ws %zu)\n", n_in, out_size, ws_size); grid = -1; return; }
        int dev = 0, cus = 0, per_cu = 0;
        if (hipGetDevice(&dev) != hipSuccess || hipDeviceGetAttribute(&cus, hipDeviceAttributeMultiprocessorCount, dev) != hipSuccess) { grid = -1; return; }
        if (hipFuncSetAttribute((const void*)fwd, hipFuncAttributeMaxDynamicSharedMemorySize, LDS_BYTES) != hipSuccess) { fprintf(stderr, "kernel_launch: hipFuncSetAttribute failed\n"); grid = -1; return; }
        if (hipOccupancyMaxActiveBlocksPerMultiprocessor(&per_cu, (const void*)fwd, 512, LDS_BYTES) != hipSuccess || per_cu < 1) fprintf(stderr, "kernel_launch: occupancy query says %d\n", per_cu);
        (void)hipGetLastError();
        grid = cus;
    }
    if (grid < 0) return;
    (void)hipMemsetAsync((char*)d_ws + WS_CTL, 0, CTL_ZERO_BYTES, stream);
    Args a{};
    for (int i = 0; i < 18; ++i) a.in[i] = (const float*)d_in[i];
    a.out = (float*)d_out; a.ws = (unsigned char*)d_ws;
#if MK_ONE_LAUNCH
    a.ph_lo = 0; a.ph_hi = NPH;
    hipLaunchKernelGGL(fwd, dim3(grid), dim3(512), LDS_BYTES, stream, a);
#else
    for (int ph = 0; ph < NPH; ++ph) {
        a.ph_lo = ph; a.ph_hi = ph + 1;
        hipLaunchKernelGGL(fwd, dim3(grid), dim3(512), LDS_BYTES, stream, a);
    }
#endif
}
```

```cpp
#include <hip/hip_runtime.h>
#include <cstdio>

#ifndef MK_ONE_LAUNCH
#define MK_ONE_LAUNCH 1
#endif

#define LAS __attribute__((address_space(3)))
#define GAS __attribute__((address_space(1)))
typedef unsigned short bf16_t;
typedef short bf16x8 __attribute__((ext_vector_type(8)));
typedef float f32x4 __attribute__((ext_vector_type(4)));
typedef float f32x2 __attribute__((ext_vector_type(2)));
typedef unsigned u32x4 __attribute__((ext_vector_type(4)));
typedef unsigned u32x2 __attribute__((ext_vector_type(2)));
typedef int i32x8 __attribute__((ext_vector_type(8)));
typedef int i32x2 __attribute__((ext_vector_type(2)));
typedef int i32x4 __attribute__((ext_vector_type(4)));

constexpr int T = 32768, D = 1024, SEQ = 2048;
constexpr int DG = 3072;
constexpr int NQK = 1280;
constexpr int NPH = 22;

constexpr size_t MiB = 1u << 20;
constexpr size_t WS_CTL = 0, CTL_ZERO_BYTES = 1 * MiB;
constexpr size_t WS_BIAS = 1 * MiB;
constexpr size_t WS_WQK = 2 * MiB;
constexpr size_t WS_WV = WS_WQK + (size_t)1280 * 1024 * 2;
constexpr size_t WS_WO = 5 * MiB;
constexpr size_t WS_WSGV = 7 * MiB;
constexpr size_t WS_WSGU = 13 * MiB;
constexpr size_t WS_WSGO = 19 * MiB;
constexpr size_t WS_WQKP = 25 * MiB;
constexpr size_t WS_HN = 34 * MiB;
constexpr size_t WS_SCL = 1 * MiB + 64 * 1024;
constexpr size_t WS_TAB = 98 * MiB;
constexpr size_t WS_IDX = 162 * MiB;
constexpr size_t WS_GATE = 178 * MiB;
constexpr size_t WS_SCR = 194 * MiB;
constexpr size_t WS_Q = WS_SCR, WS_K = WS_SCR + 64 * MiB, WS_VT = WS_SCR + 80 * MiB, WS_AO = WS_SCR + 96 * MiB;
constexpr size_t WS_S = WS_SCR;
constexpr size_t WS_SG = WS_SCR;
constexpr size_t WS_PART = WS_SCR;
constexpr size_t WS_AB = WS_SCR + 128 * MiB;
constexpr size_t WS_HN8 = WS_SCR + 200 * MiB;
constexpr size_t WS_H8 = 34 * MiB;
constexpr size_t WS_HSQ = 34 * MiB + 40 * MiB;
constexpr size_t WS_END = WS_SCR + 292 * MiB;
constexpr int CW_BAR = 4096;
constexpr int CW_COLMAX = 16384;
constexpr int CW_WSCL = 32768;
constexpr size_t WS_WQ8 = WS_SCR + 288 * MiB;
constexpr size_t WS_HNI8 = 34 * MiB;
constexpr size_t WS_HSC = 34 * MiB + 32 * MiB;
constexpr size_t WS_H2 = WS_SCR + 32 * MiB;
constexpr float AO8_SCALE = 8.0f;
constexpr float W8_SCALE = 256.0f;
constexpr size_t WS_HN8B = WS_IDX;
constexpr size_t WS_SG8 = WS_SCR + 192 * MiB;

constexpr int LDS_BYTES = 163840;
constexpr int MISC_OFF = LDS_BYTES - 256;

typedef __bf16 bfx2 __attribute__((ext_vector_type(2)));
__device__ __forceinline__ unsigned pk2(float lo, float hi) { const bfx2 v = {(__bf16)lo, (__bf16)hi}; return __builtin_bit_cast(unsigned, v); }
__device__ __forceinline__ unsigned f2bf(float f) { return pk2(f, 0.f) & 0xffffu; }
typedef _Float16 h16x2 __attribute__((ext_vector_type(2)));
__device__ __forceinline__ unsigned pkh2(float lo, float hi) { const h16x2 h = {(_Float16)lo, (_Float16)hi}; return __builtin_bit_cast(unsigned, h); }
__device__ __forceinline__ float hlo(unsigned w) { return (float)__builtin_bit_cast(h16x2, w).x; }
__device__ __forceinline__ float hhi(unsigned w) { return (float)__builtin_bit_cast(h16x2, w).y; }
__device__ __forceinline__ float bflo(unsigned w) { return __builtin_bit_cast(float, w << 16); }
__device__ __forceinline__ float bfhi(unsigned w) { return __builtin_bit_cast(float, w & 0xffff0000u); }
__device__ __forceinline__ float bf2f(bf16_t b) { return __builtin_bit_cast(float, ((unsigned)b) << 16); }
__device__ __forceinline__ float wave_sum(float v) {
#pragma unroll
    for (int o = 1; o < 64; o <<= 1) v += __shfl_xor(v, o);
    return v;
}
__device__ __forceinline__ float wave_max(float v) {
#pragma unroll
    for (int o = 1; o < 64; o <<= 1) v = fmaxf(v, __shfl_xor(v, o));
    return v;
}
__device__ __forceinline__ unsigned wave_max_u(unsigned v) {
#pragma unroll
    for (int o = 1; o < 64; o <<= 1) { const unsigned w = (unsigned)__shfl_xor((int)v, o); v = w > v ? w : v; }
    return v;
}
__device__ __forceinline__ float gelu_tanh(float x) {
    const float u = x * (-2.302208198144325f) * (1.0f + 0.044715f * x * x);
    return x * __builtin_amdgcn_rcpf(1.0f + __builtin_amdgcn_exp2f(u));
}
#define LDS_WAIT() asm volatile("s_waitcnt lgkmcnt(0)" ::: "memory")
#define VM_WAIT() asm volatile("s_waitcnt vmcnt(0)" ::: "memory")

namespace pg8 {
#define PG8_LAS __attribute__((address_space(3)))
constexpr int BM = 256, BK = 64, HALF = 128, HTB = HALF * BK * 2, STAGE_BYTES = 8 * HTB, NXCD = 8, WGM = 8;
__host__ __device__ __forceinline__ int lds_byte(int r, int c) { const int st = (r >> 4) * 2 + (c >> 5), rr = r & 15, cc = c & 31, ob = rr * 64 + cc * 2; return st * 1024 + (ob ^ (((ob >> 9) & 1) << 5)); }
__host__ __device__ __forceinline__ void stage_rc(int b, int& R, int& C) { const int st = b / 1024, sb = b % 1024, swz = sb ^ (((sb >> 9) & 1) << 5); R = (st >> 1) * 16 + swz / 64; C = (st & 1) * 32 + (swz % 64) / 2; }
__host__ __device__ __forceinline__ int perm32(int rho) { const int n = rho >> 4, i = rho & 15; return 8 * (i >> 2) + 4 * n + (i & 3); }
struct Unit { int pm, pn; };
struct Gemm { const bf16_t* A; const bf16_t* Bt; int M, N, K; };
struct StaticOrder {
    int nM, nN, nwg, G, c;
    __host__ __device__ void init(int M, int N, int G_, int c_) { nM = M / BM; nN = N / BM; nwg = nM * nN; G = G_; c = c_; }
    __host__ __device__ bool next(int i, Unit& u) const {
        const long L = (long)i * G + c; if (L >= nwg) return false;
        int wgid = (int)L; { const int q = nwg / NXCD, r = nwg % NXCD, xcd = wgid % NXCD, off = wgid / NXCD; wgid = (xcd < r ? xcd * (q + 1) : r * (q + 1) + (xcd - r) * q) + off; }
        const int nig = WGM * nN, gid = wgid / nig, fm = gid * WGM, gsz = (nM - fm) < WGM ? (nM - fm) : WGM;
        u.pm = fm + ((wgid % nig) % gsz); u.pn = (wgid % nig) / gsz; return true;
    }
    __device__ __forceinline__ void a_ready(const Unit&) const {}
    __device__ __forceinline__ void done(const Unit&) const {}
};

template <int MODE, bool RSQ = false> struct EpiBf {
    static constexpr int PERM = (MODE == 5) ? 2 : 1; static constexpr bool AFTER_DRAIN = false;
    bf16_t* O; int ldc; bf16_t* O2; float sc = 1.0f; const float* aux = nullptr; const float* rsq = nullptr;
    __device__ __forceinline__ void operator()(const f32x4 (&acc)[2][2][4][2], const Unit& u, int wr, int wc, int fr, int fq) const {
        const int row0 = u.pm * BM + wr * 64 + fr; int colt = u.pn * BM; bf16_t* base = O; int ld = ldc;
        if (MODE == 3) { if (u.pn >= 4) { base = O2; ld = 256; colt = 0; } else { ld = 1024; } }
        if (MODE == 5) {
            const int c16 = colt + wc * 64 + 16 * fq;
            float rr[2][4];
#pragma unroll
            for (int ai = 0; ai < 2; ++ai)
#pragma unroll
                for (int m = 0; m < 4; ++m) { rr[ai][m] = sc;
                    if (RSQ) { const f32x4 q4 = *(const f32x4*)(rsq + (size_t)(row0 + ai * HALF + m * 16) * 4); rr[ai][m] = sc * __builtin_amdgcn_rsqf(((q4.x + q4.y) + (q4.z + q4.w)) * (1.f / 1024.f) + 1e-6f); } }
#pragma unroll
            for (int ai = 0; ai < 2; ++ai) {
                u32x4 mx[4][2];
#pragma unroll
                for (int m = 0; m < 4; ++m) { const u32x4* mp = (const u32x4*)(O + (size_t)(row0 + ai * HALF + m * 16) * ld + c16); mx[m][0] = mp[0]; mx[m][1] = mp[1]; }
#pragma unroll
                for (int m = 0; m < 4; ++m) { unsigned ow[4];
#pragma unroll
                    for (int bj = 0; bj < 2; ++bj) { f32x4 v0 = acc[ai][bj][m][0] * rr[ai][m], v1 = acc[ai][bj][m][1] * rr[ai][m]; const u32x4 mv = mx[m][bj];
#pragma unroll
                        for (int j = 0; j < 4; ++j) { v0[j] = gelu_tanh(v0[j]); v1[j] = gelu_tanh(v1[j]); }
                        v0[0] *= bflo(mv.x); v0[1] *= bfhi(mv.x); v0[2] *= bflo(mv.y); v0[3] *= bfhi(mv.y); v1[0] *= bflo(mv.z); v1[1] *= bfhi(mv.z); v1[2] *= bflo(mv.w); v1[3] *= bfhi(mv.w);
                        int w0 = 0, w1 = 0;
                        w0 = __builtin_amdgcn_cvt_pk_fp8_f32(v0[0], v0[1], w0, false); w0 = __builtin_amdgcn_cvt_pk_fp8_f32(v0[2], v0[3], w0, true);
                        w1 = __builtin_amdgcn_cvt_pk_fp8_f32(v1[0], v1[1], w1, false); w1 = __builtin_amdgcn_cvt_pk_fp8_f32(v1[2], v1[3], w1, true);
                        ow[2 * bj] = (unsigned)w0; ow[2 * bj + 1] = (unsigned)w1; }
                    *(u32x4*)((unsigned char*)O2 + (size_t)(row0 + ai * HALF + m * 16) * ld + c16) = (u32x4){ow[0], ow[1], ow[2], ow[3]}; } }
            return;
        }
        const int col0 = colt + wc * 32 + 8 * fq;
        float rrow[2][4]; f32x4 ccol[2][2];
        if (RSQ || MODE == 8) {
#pragma unroll
            for (int ai = 0; ai < 2; ++ai)
#pragma unroll
                for (int m = 0; m < 4; ++m) { const int row = row0 + ai * HALF + m * 16;
                    if (RSQ) { const f32x4 q4 = *(const f32x4*)(rsq + (size_t)row * 4); rrow[ai][m] = ((q4.x + q4.y) + (q4.z + q4.w)) * (1.f / 1024.f) + 1e-6f; }
                    else rrow[ai][m] = ((const float*)O2)[row]; }
            if (MODE == 8) {
#pragma unroll
                for (int bj = 0; bj < 2; ++bj) { const f32x4* cp = (const f32x4*)(aux + col0 + bj * HALF); ccol[bj][0] = cp[0]; ccol[bj][1] = cp[1]; } }
            if (RSQ) {
#pragma unroll
                for (int ai = 0; ai < 2; ++ai)
#pragma unroll
                    for (int m = 0; m < 4; ++m) rrow[ai][m] = __builtin_amdgcn_rsqf(rrow[ai][m]); }
        }
#pragma unroll
        for (int ai = 0; ai < 2; ++ai) {
          u32x4 pre[4][2]; f32x4 prex[4][2][2];
          if (MODE == 2 || MODE == 5 || MODE == 7) {
#pragma unroll
            for (int m = 0; m < 4; ++m)
#pragma unroll
                for (int bj = 0; bj < 2; ++bj) pre[m][bj] = *(const u32x4*)(base + (size_t)(row0 + ai * HALF + m * 16) * ld + col0 + bj * HALF); }
          if (MODE == 6) {
#pragma unroll
            for (int m = 0; m < 4; ++m)
#pragma unroll
                for (int bj = 0; bj < 2; ++bj) { const f32x4* xp = (const f32x4*)((const float*)O2 + (size_t)(row0 + ai * HALF + m * 16) * ld + col0 + bj * HALF); prex[m][bj][0] = xp[0]; prex[m][bj][1] = xp[1]; } }
#pragma unroll
            for (int m = 0; m < 4; ++m) { bf16_t* rowp = base + (size_t)(row0 + ai * HALF + m * 16) * ld + col0;
#pragma unroll
                for (int bj = 0; bj < 2; ++bj) { f32x4 v0 = acc[ai][bj][m][0], v1 = acc[ai][bj][m][1];
                    if (RSQ) { const float rr = rrow[ai][m]; v0 = v0 * rr; v1 = v1 * rr; }
                    if (MODE == 8) { const float rs = rrow[ai][m]; const f32x4 c0 = ccol[bj][0] * rs, c1 = ccol[bj][1] * rs;
                        const i32x4 i0 = __builtin_bit_cast(i32x4, v0), i1 = __builtin_bit_cast(i32x4, v1);
                        v0 = (f32x4){(float)i0.x, (float)i0.y, (float)i0.z, (float)i0.w} * c0; v1 = (f32x4){(float)i1.x, (float)i1.y, (float)i1.z, (float)i1.w} * c1; }
                    if (MODE == 0 || MODE == 3) {
#pragma unroll
                        for (int j = 0; j < 4; ++j) { v0[j] *= sc; v1[j] *= sc; } }
                    if (MODE == 6) { v0 = prex[m][bj][0] + v0 * sc; v1 = prex[m][bj][1] + v1 * sc; }
                    if (MODE == 7) { const u32x4 hv = pre[m][bj];
                        v0[0] = bflo(hv.x) + v0[0] * sc; v0[1] = bfhi(hv.x) + v0[1] * sc; v0[2] = bflo(hv.y) + v0[2] * sc; v0[3] = bfhi(hv.y) + v0[3] * sc;
                        v1[0] = bflo(hv.z) + v1[0] * sc; v1[1] = bfhi(hv.z) + v1[1] * sc; v1[2] = bflo(hv.w) + v1[2] * sc; v1[3] = bfhi(hv.w) + v1[3] * sc; }
                    if (MODE == 1 || MODE == 2 || MODE == 5) {
#pragma unroll
                        for (int j = 0; j < 4; ++j) { v0[j] = gelu_tanh(v0[j] * sc); v1[j] = gelu_tanh(v1[j] * sc); } }
                    if (MODE == 2 || MODE == 5) { const u32x4 mv = pre[m][bj];
                        v0[0] *= bflo(mv.x); v0[1] *= bfhi(mv.x); v0[2] *= bflo(mv.y); v0[3] *= bfhi(mv.y);
                        v1[0] *= bflo(mv.z); v1[1] *= bfhi(mv.z); v1[2] *= bflo(mv.w); v1[3] *= bfhi(mv.w); }
                    if (MODE == 5) { int w0 = 0, w1 = 0;
                        w0 = __builtin_amdgcn_cvt_pk_fp8_f32(v0[0], v0[1], w0, false); w0 = __builtin_amdgcn_cvt_pk_fp8_f32(v0[2], v0[3], w0, true);
                        w1 = __builtin_amdgcn_cvt_pk_fp8_f32(v1[0], v1[1], w1, false); w1 = __builtin_amdgcn_cvt_pk_fp8_f32(v1[2], v1[3], w1, true);
                        *(u32x2*)((unsigned char*)O2 + (size_t)(row0 + ai * HALF + m * 16) * ld + col0 + bj * HALF) = (u32x2){(unsigned)w0, (unsigned)w1}; continue; }
                    u32x4 w;
                    if (MODE == 4 || MODE == 8) { w.x = pkh2(v0[0], v0[1]); w.y = pkh2(v0[2], v0[3]); w.z = pkh2(v1[0], v1[1]); w.w = pkh2(v1[2], v1[3]); }
                    else { w.x = pk2(v0[0], v0[1]); w.y = pk2(v0[2], v0[3]); w.z = pk2(v1[0], v1[1]); w.w = pk2(v1[2], v1[3]); }
                    *(u32x4*)(rowp + bj * HALF) = w; } } }
    }
};
template <int MODE> struct EpiF32 {
    static constexpr bool PERM = false, AFTER_DRAIN = false;
    float* C; int ldc; const float* B; float sc = 1.0f;
    __device__ __forceinline__ void operator()(const f32x4 (&acc)[2][2][4][2], const Unit& u, int wr, int wc, int fr, int fq) const {
        const int row0 = u.pm * BM + wr * 64 + fr, col0 = u.pn * BM + wc * 32 + 4 * fq;
#pragma unroll
        for (int ai = 0; ai < 2; ++ai)
#pragma unroll
            for (int m = 0; m < 4; ++m) { float* rowp = C + (size_t)(row0 + ai * HALF + m * 16) * ldc + col0;
#pragma unroll
                for (int bj = 0; bj < 2; ++bj)
#pragma unroll
                    for (int n = 0; n < 2; ++n) { f32x4* p = (f32x4*)(rowp + bj * HALF + n * 16);
                        if (MODE == 1) *p = *p + acc[ai][bj][m][n] * sc;
                        else if (MODE == 2) *p = *(const f32x4*)(B + (p - (f32x4*)C) * 4) + acc[ai][bj][m][n] * sc;
                        else *p = acc[ai][bj][m][n]; } }
    }
};

template <int F8 = 0, class Epi, class Sched>
__device__ __forceinline__ void gemm_phase(PG8_LAS unsigned char* lds, const Gemm g, const Sched& S, const Epi& E) {
    const int tid = threadIdx.x, wid = __builtin_amdgcn_readfirstlane(tid >> 6), lane = tid & 63, wr = wid >> 2, wc = wid & 3, fr = lane & 15, fq = lane >> 4;
    const int K = g.K, nt = K / BK;
    unsigned voffA[2], voffB[2];
#pragma unroll
    for (int i = 0; i < 2; ++i) { int R, C; stage_rc(tid * 16 + i * 8192, R, C); const int Rb = Epi::PERM == 2 ? (64 * (R >> 5) + 16 * ((R >> 2) & 3) + 4 * ((R >> 4) & 1) + (R & 3)) : Epi::PERM ? ((R & ~31) + perm32(R & 31)) : R;
        voffA[i] = (unsigned)(R * K + C) * 2u; voffB[i] = (unsigned)(Rb * K + C) * 2u; }
    const size_t kstep = (size_t)(BK * 2);
    const size_t hstep = (size_t)HALF * K * 2;
    const size_t hstepB = Epi::PERM == 2 ? (size_t)8 * K * 2 : hstep;
    const size_t tstep = 2 * hstep;
    const unsigned ldsw = (unsigned)wid * 1024u;
    const int aoff = lds_byte(wr * 64 + fr, fq * 8), boff = lds_byte(wc * 32 + fr, fq * 8);
#define PG8_SA(b, h) (((b) * 2 + (h)) * HTB)
#define PG8_SB(b, h) ((4 + (b) * 2 + (h)) * HTB)
#define PG8_STAGE(bufoff, gbase, voff) do { const char* gb_ = (const char*)(gbase); asm volatile("" : "+s"(gb_));        \
        _Pragma("unroll") for (int _i = 0; _i < 2; ++_i) { unsigned vo_ = (voff)[_i]; asm volatile("" : "+v"(vo_)); \
        __builtin_amdgcn_global_load_lds((const unsigned*)(gb_ + vo_), (PG8_LAS unsigned*)(lds + (bufoff) + ldsw + _i * 8192), 16, 0, 0); } } while (0)
#define PG8_LD8(dst8, cbase_, voff_, cnt_) do { unsigned o_ = (unsigned)(voff_); asm volatile("" : "+v"(o_));        \
        _Pragma("unroll") for (int i_ = 0; i_ < cnt_; ++i_) { const i32x4 lo_ = *(const PG8_LAS i32x4*)(lds + (cbase_) + o_ + i_ * 2048), hi_ = *(const PG8_LAS i32x4*)(lds + (cbase_) + o_ + i_ * 2048 + 1024); \
        dst8[i_] = (i32x8){lo_.x, lo_.y, lo_.z, lo_.w, hi_.x, hi_.y, hi_.z, hi_.w}; } } while (0)
#define PG8_LDA(dst, b, h) do { if (F8 == 1) PG8_LD8(Ah8, PG8_SA(b, h), aoff, 2); else { _Pragma("unroll") for (int m = 0; m < 4; ++m) _Pragma("unroll") for (int k = 0; k < 2; ++k) dst[m][k] = *(const PG8_LAS bf16x8*)(lds + PG8_SA(b, h) + aoff + m * 2048 + k * 1024); } } while (0)
#define PG8_LDB(dst, b, h) do { if (F8 == 1) PG8_LD8(dst##8, PG8_SB(b, h), boff, 2); else { _Pragma("unroll") for (int n = 0; n < 2; ++n) _Pragma("unroll") for (int k = 0; k < 2; ++k) dst[n][k] = *(const PG8_LAS bf16x8*)(lds + PG8_SB(b, h) + boff + n * 2048 + k * 1024); } } while (0)
#define PG8_MM8(ai, bj, mm, Bt, Ax) do { _Pragma("unroll") for (int n = 0; n < 2; ++n) { \
        acc[ai][bj][mm][n] = __builtin_amdgcn_mfma_scale_f32_16x16x128_f8f6f4(Bt##8[n], Ax[0], acc[ai][bj][mm][n], 0, 0, 0, 0, 0, 0); \
        acc[ai][bj][(mm) + 1][n] = __builtin_amdgcn_mfma_scale_f32_16x16x128_f8f6f4(Bt##8[n], Ax[1], acc[ai][bj][(mm) + 1][n], 0, 0, 0, 0, 0, 0); } } while (0)
#define PG8_MMA(ai, bj, At, Bt, bb) do { __builtin_amdgcn_s_setprio(1); \
        if (F8 == 1) { if ((bj) == 0) { PG8_SCHED; PG8_LD8(Bh8, PG8_SA(bb, ai) + 2 * 2048, aoff, 2); PG8_SCHED; PG8_MM8(ai, bj, 0, Bt, Ah8); PG8_SCHED; PG8_MM8(ai, bj, 2, Bt, Bh8); } \
                  else { PG8_MM8(ai, bj, 0, Bt, Ah8); PG8_MM8(ai, bj, 2, Bt, Bh8); } } \
        else if (F8 == 2) { _Pragma("unroll") for (int m = 0; m < 4; ++m) _Pragma("unroll") for (int n = 0; n < 2; ++n) _Pragma("unroll") for (int k = 0; k < 2; ++k) \
            acc[ai][bj][m][n] = __builtin_bit_cast(f32x4, __builtin_amdgcn_mfma_i32_16x16x64_i8(__builtin_bit_cast(i32x4, Bt[n][k]), __builtin_bit_cast(i32x4, At[m][k]), __builtin_bit_cast(i32x4, acc[ai][bj][m][n]), 0, 0, 0)); } \
        else { _Pragma("unroll") for (int m = 0; m < 4; ++m) _Pragma("unroll") for (int n = 0; n < 2; ++n) _Pragma("unroll") for (int k = 0; k < 2; ++k) \
            acc[ai][bj][m][n] = __builtin_amdgcn_mfma_f32_16x16x32_bf16(Bt[n][k], At[m][k], acc[ai][bj][m][n], 0, 0, 0); } \
        __builtin_amdgcn_s_setprio(0); } while (0)
#define PG8_WAIT_V(n) asm volatile("s_waitcnt vmcnt(" #n ")" ::: "memory")
#define PG8_WAIT_L(n) asm volatile("s_waitcnt lgkmcnt(" #n ")" ::: "memory")
#define PG8_BAR __builtin_amdgcn_s_barrier()
#define PG8_SCHED __builtin_amdgcn_sched_barrier(0)
    Unit cur, nxt; int ui = 0;
    if (!S.next(0, cur)) return;
    f32x4 acc[2][2][4][2];
#pragma unroll
    for (int a = 0; a < 2; ++a)
#pragma unroll
        for (int b = 0; b < 2; ++b)
#pragma unroll
            for (int m = 0; m < 4; ++m)
#pragma unroll
                for (int n = 0; n < 2; ++n) acc[a][b][m][n] = (f32x4){0.f, 0.f, 0.f, 0.f};
    bf16x8 At[4][2], B0[2][2], B1[2][2]; i32x8 Ah8[2], Bh8[2], B08[2], B18[2];
    const char* cA = (const char*)g.A + (size_t)cur.pm * tstep; const char* cB = (const char*)g.Bt + (size_t)cur.pn * tstep;
    S.a_ready(cur);
    PG8_STAGE(PG8_SB(0, 0), cB, voffB); PG8_STAGE(PG8_SA(0, 0), cA, voffA); PG8_STAGE(PG8_SB(0, 1), cB + hstepB, voffB); PG8_STAGE(PG8_SA(0, 1), cA + hstep, voffA);
    if (wr == 1) PG8_BAR;
    PG8_WAIT_V(4); PG8_BAR;
    PG8_STAGE(PG8_SB(1, 0), cB + kstep, voffB); PG8_STAGE(PG8_SA(1, 0), cA + kstep, voffA); PG8_STAGE(PG8_SB(1, 1), cB + hstepB + kstep, voffB);
    PG8_WAIT_V(6); PG8_BAR;
    for (;;) {
        const bool has_next = S.next(ui + 1, nxt);
        const char* nA = has_next ? (const char*)g.A + (size_t)nxt.pm * tstep : cA; const char* nB = has_next ? (const char*)g.Bt + (size_t)nxt.pn * tstep : cB;
        for (int t = 0; t < nt; t += 2) {
            const bool last = (t == nt - 2);
            const char* a1 = cA + (size_t)(t + 1) * kstep;
            const char* a2 = last ? nA : cA + (size_t)(t + 2) * kstep; const char* b2 = last ? nB : cB + (size_t)(t + 2) * kstep;
            const char* a3 = a2 + kstep; const char* b3 = b2 + kstep;
            if (last && has_next) S.a_ready(nxt);
            PG8_LDB(B0, 0, 0); PG8_SCHED; PG8_LDA(At, 0, 0); PG8_STAGE(PG8_SA(1, 1), a1 + hstep, voffA);
            PG8_WAIT_L(8); PG8_BAR; PG8_WAIT_L(0); PG8_MMA(0, 0, At, B0, 0); PG8_BAR; PG8_SCHED;
            PG8_LDB(B1, 0, 1); PG8_STAGE(PG8_SB(0, 0), b2, voffB);
            PG8_BAR; PG8_WAIT_L(0); PG8_MMA(0, 1, At, B1, 0); PG8_BAR; if (F8 == 1) PG8_SCHED;
            PG8_LDA(At, 0, 1); PG8_STAGE(PG8_SA(0, 0), a2, voffA);
            PG8_BAR; PG8_WAIT_L(0); PG8_MMA(1, 0, At, B0, 0); PG8_BAR; PG8_SCHED;
            PG8_STAGE(PG8_SB(0, 1), b2 + hstepB, voffB);
            PG8_WAIT_V(6); PG8_BAR; PG8_MMA(1, 1, At, B1, 0); PG8_BAR; if (F8 == 1) PG8_SCHED;
            PG8_LDB(B0, 1, 0); PG8_SCHED; PG8_LDA(At, 1, 0); PG8_STAGE(PG8_SA(0, 1), a2 + hstep, voffA);
            PG8_WAIT_L(8); PG8_BAR; PG8_WAIT_L(0); PG8_MMA(0, 0, At, B0, 1); PG8_BAR; PG8_SCHED;
            PG8_LDB(B1, 1, 1); PG8_STAGE(PG8_SB(1, 0), b3, voffB);
            PG8_BAR; PG8_WAIT_L(0); PG8_MMA(0, 1, At, B1, 1); PG8_BAR; if (F8 == 1) PG8_SCHED;
            PG8_LDA(At, 1, 1); PG8_STAGE(PG8_SA(1, 0), a3, voffA);
            PG8_BAR; PG8_WAIT_L(0); PG8_MMA(1, 0, At, B0, 1); PG8_BAR; PG8_SCHED;
            PG8_STAGE(PG8_SB(1, 1), b3 + hstepB, voffB);
            PG8_WAIT_V(6); PG8_BAR; PG8_MMA(1, 1, At, B1, 1); PG8_BAR; if (F8 == 1) PG8_SCHED;
        }
        { int fr_ = fr, fq_ = fq; asm volatile("" : "+v"(fr_), "+v"(fq_));
          E(acc, cur, wr, wc, fr_, fq_); } S.done(cur);
        if (!has_next) break;
#pragma unroll
        for (int a = 0; a < 2; ++a)
#pragma unroll
            for (int b = 0; b < 2; ++b)
#pragma unroll
                for (int m = 0; m < 4; ++m)
#pragma unroll
                    for (int n = 0; n < 2; ++n) acc[a][b][m][n] = (f32x4){0.f, 0.f, 0.f, 0.f};
        cur = nxt; cA = nA; cB = nB; ++ui;
    }
    PG8_WAIT_V(0);
    if (wr == 0) PG8_BAR;
    PG8_BAR;
#undef PG8_SA
#undef PG8_SB
#undef PG8_STAGE
#undef PG8_LDA
#undef PG8_LDB
#undef PG8_MMA
#undef PG8_LD8
#undef PG8_MM8
#undef PG8_WAIT_V
#undef PG8_WAIT_L
#undef PG8_BAR
#undef PG8_SCHED
}
}

#define XB_TMO      128
#define XB_XCNT(j)  (256  + 64 * (j))
#define XB_XSUB(j)  (1280 + 64 * (j))
#define XB_XGEN(j)  (2304 + 64 * (j))
#define XB_TOP      3328
#define XB_TOPGEN   3392
#define XCD_BAR_WORDS 3456
#define XB_SPIN_CAP (1u << 18)
__device__ __forceinline__ unsigned xb_ld(unsigned* p)              { return __hip_atomic_load(p, __ATOMIC_RELAXED, __HIP_MEMORY_SCOPE_AGENT); }
__device__ __forceinline__ unsigned xb_add(unsigned* p, unsigned v) { return __hip_atomic_fetch_add(p, v, __ATOMIC_RELAXED, __HIP_MEMORY_SCOPE_AGENT); }
__device__ __forceinline__ unsigned xb_xcc_id() { return (unsigned)__builtin_amdgcn_s_getreg((3 << 11) | 20) & 0xFu; }
#define XB_SPIN(cond, bar) do { unsigned _sp = 0; while (cond) { __builtin_amdgcn_s_sleep(1); \
    if ((++_sp & 255u) == 0u) { if (xb_ld(&(bar)[XB_TMO])) break; if (_sp > XB_SPIN_CAP) { atomicAdd(&(bar)[XB_TMO], 1u); break; } } } } while (0)
struct XcdBarrier { unsigned* bar; unsigned x; volatile LAS unsigned* st; };
__device__ __forceinline__ XcdBarrier xcd_barrier_post(unsigned* bar, volatile LAS unsigned* st) {
    XcdBarrier b; b.bar = bar; b.x = xb_xcc_id(); b.st = st;
    if (threadIdx.x == 0) (void)xb_add(&bar[XB_XCNT(b.x)], 1u);
    return b;
}
__device__ __forceinline__ void xcd_barrier_complete(unsigned* bar, unsigned x, unsigned& nloc, unsigned& nx) {
    const unsigned G = gridDim.x * gridDim.y * gridDim.z;
    unsigned sum, cnt, mine, sp = 0u;
    for (;;) {
        sum = 0u; cnt = 0u; mine = 0u;
#pragma unroll
        for (unsigned j = 0; j < 16; ++j) { const unsigned c = xb_ld(&bar[XB_XCNT(j)]); sum += c; cnt += (c > 0u) ? 1u : 0u; mine = (j == x) ? c : mine; }
        if (sum == G) break;
        __builtin_amdgcn_s_sleep(1);
        if ((++sp & 255u) == 0u) { if (xb_ld(&bar[XB_TMO])) break; if (sp > XB_SPIN_CAP) { atomicAdd(&bar[XB_TMO], 1u); break; } }
    }
    nloc = mine > 0u ? mine : 1u; nx = cnt > 0u ? cnt : 1u;
}
__device__ __forceinline__ void xcd_barrier(const XcdBarrier& b) {
    asm volatile("s_waitcnt vmcnt(0)" ::: "memory");
    __syncthreads();
    if (threadIdx.x == 0) {
        unsigned* bar = b.bar;
        __builtin_amdgcn_s_waitcnt(0);
        unsigned nloc = b.st[0], nx = b.st[1];
        if (nloc == 0u) { xcd_barrier_complete(bar, b.x, nloc, nx); b.st[0] = nloc; b.st[1] = nx; }
        const unsigned old = xb_add(&bar[XB_XSUB(b.x)], 1u);
        const unsigned gen = old / nloc;
        if (old + 1u == (gen + 1u) * nloc) {
            __builtin_amdgcn_fence(__ATOMIC_RELEASE, "agent");
            asm volatile("s_waitcnt vmcnt(0)" ::: "memory");
            const unsigned og = xb_add(&bar[XB_TOP], 1u);
            const unsigned tg = og / nx;
            if (og + 1u == (tg + 1u) * nx) xb_add(&bar[XB_TOPGEN], 1u);
            else XB_SPIN(xb_ld(&bar[XB_TOPGEN]) == tg, bar);
            __builtin_amdgcn_fence(__ATOMIC_ACQUIRE, "agent");
            xb_add(&bar[XB_XGEN(b.x)], 1u);
            asm volatile("s_waitcnt vmcnt(0)" ::: "memory");
        } else {
            XB_SPIN(xb_ld(&bar[XB_XGEN(b.x)]) == gen, bar);
            __builtin_amdgcn_fence(__ATOMIC_ACQUIRE, "agent");
            asm volatile("s_waitcnt vmcnt(0)" ::: "memory");
        }
    }
    __syncthreads();
}

struct Args { const float* in[18]; float* out; unsigned char* ws; int ph_lo, ph_hi; };
struct Frame {
    LAS unsigned char* lds;
    int tid, lane, wave, G, gw, NGW;
    const float* const* in; float* out; unsigned char* ws;
};

__device__ __forceinline__ void transpose_item(const float* W, int ldw, int col0, bf16_t* WT, int K, int nblk, float scale, LAS float* scr, int item, int lane, bool f8 = false, const float* kgain = nullptr) {
    const int kb = item / nblk, nb = item % nblk, k0 = 64 * kb, n0 = 32 * nb;
#pragma unroll 8
    for (int i = 0; i < 32; ++i) { const int kk = 2 * i + (lane >> 5); scr[kk * 33 + (lane & 31)] = W[(size_t)(k0 + kk) * ldw + col0 + n0 + (lane & 31)] * (kgain ? kgain[k0 + kk] : 1.0f); }
    LDS_WAIT();
    const int c = lane & 7;
#pragma unroll
    for (int j = 0; j < 4; ++j) { const int n = (lane >> 3) + 8 * j; const LAS float* s = scr + (8 * c) * 33 + n;
        if (f8) { int w0 = 0, w1 = 0;
            w0 = __builtin_amdgcn_cvt_pk_fp8_f32(s[0 * 33] * scale, s[1 * 33] * scale, w0, false); w0 = __builtin_amdgcn_cvt_pk_fp8_f32(s[2 * 33] * scale, s[3 * 33] * scale, w0, true);
            w1 = __builtin_amdgcn_cvt_pk_fp8_f32(s[4 * 33] * scale, s[5 * 33] * scale, w1, false); w1 = __builtin_amdgcn_cvt_pk_fp8_f32(s[6 * 33] * scale, s[7 * 33] * scale, w1, true);
            *(u32x2*)((unsigned char*)WT + (size_t)(n0 + n) * K + k0 + 8 * c) = (u32x2){(unsigned)w0, (unsigned)w1}; continue; }
        u32x4 o; o.x = pk2(s[0 * 33] * scale, s[1 * 33] * scale); o.y = pk2(s[2 * 33] * scale, s[3 * 33] * scale); o.z = pk2(s[4 * 33] * scale, s[5 * 33] * scale); o.w = pk2(s[6 * 33] * scale, s[7 * 33] * scale);
        *(u32x4*)(WT + (size_t)(n0 + n) * K + k0 + 8 * c) = o; }
    LDS_WAIT();
}
__device__ __forceinline__ void rmsnorm_rows(const Frame& F, const float* src, const float* g, bf16_t* dst, float* cpy, unsigned char* dst8 = nullptr) {
    const f32x4* gp = (const f32x4*)g + F.lane;
    f32x4 gv[4];
#pragma unroll
    for (int j = 0; j < 4; ++j) gv[j] = gp[64 * j];
    for (int m = F.gw; m < T; m += F.NGW) {
        const f32x4* xr = (const f32x4*)(src + (size_t)m * D) + F.lane;
        f32x4 v[4]; float s = 0.f;
#pragma unroll
        for (int j = 0; j < 4; ++j) { v[j] = xr[64 * j]; s += (v[j].x * v[j].x + v[j].y * v[j].y) + (v[j].z * v[j].z + v[j].w * v[j].w); }
        const float rstd = 1.0f / sqrtf(wave_sum(s) * (1.f / D) + 1e-6f);
        if (cpy) { f32x4* cr = (f32x4*)(cpy + (size_t)m * D) + F.lane;
#pragma unroll
            for (int j = 0; j < 4; ++j) cr[64 * j] = v[j]; }
        if (dst) { u32x2* o8 = (u32x2*)(dst + (size_t)m * D) + F.lane;
#pragma unroll
        for (int j = 0; j < 4; ++j) { u32x2 w; w.x = pk2(v[j].x * rstd * gv[j].x, v[j].y * rstd * gv[j].y); w.y = pk2(v[j].z * rstd * gv[j].z, v[j].w * rstd * gv[j].w); o8[64 * j] = w; } }
        if (dst8) { unsigned* o4 = (unsigned*)(dst8 + (size_t)m * D) + F.lane;
#pragma unroll
            for (int j = 0; j < 4; ++j) { int w = 0; w = __builtin_amdgcn_cvt_pk_fp8_f32(v[j].x * rstd * gv[j].x, v[j].y * rstd * gv[j].y, w, false); w = __builtin_amdgcn_cvt_pk_fp8_f32(v[j].z * rstd * gv[j].z, v[j].w * rstd * gv[j].w, w, true); o4[64 * j] = (unsigned)w; } }
    }
}
__device__ __forceinline__ void quant_wqk(const Frame& F) {
    const bf16_t* W = (const bf16_t*)(F.ws + WS_WQKP); unsigned char* Q8 = F.ws + WS_WQ8;
    const unsigned* CM = (const unsigned*)(F.ws + WS_CTL) + CW_COLMAX; float* WSCL = (float*)(F.ws + WS_CTL) + CW_WSCL;
    for (int r = F.gw; r < 4096; r += F.NGW) {
        const float cm = __builtin_bit_cast(float, __hip_atomic_load(CM + r, __ATOMIC_RELAXED, __HIP_MEMORY_SCOPE_AGENT));
        const float sc = cm > 0.f ? 127.0f / cm : 0.f;
        const u32x4* wp = (const u32x4*)(W + (size_t)r * 1024 + 16 * F.lane); const u32x4 a = wp[0], b = wp[1];
        const float v[16] = {bflo(a.x), bfhi(a.x), bflo(a.y), bfhi(a.y), bflo(a.z), bfhi(a.z), bflo(a.w), bfhi(a.w), bflo(b.x), bfhi(b.x), bflo(b.y), bfhi(b.y), bflo(b.z), bfhi(b.z), bflo(b.w), bfhi(b.w)};
        unsigned o[4];
#pragma unroll
        for (int j = 0; j < 4; ++j) { unsigned w = 0u;
#pragma unroll
            for (int e = 0; e < 4; ++e) { int q = (int)rintf(v[4 * j + e] * sc); q = q > 127 ? 127 : (q < -127 ? -127 : q); w |= ((unsigned)q & 255u) << (8 * e); }
            o[j] = w; }
        *(u32x4*)(Q8 + (size_t)r * 1024 + 16 * F.lane) = (u32x4){o[0], o[1], o[2], o[3]};
        if (F.lane == 0) WSCL[r] = cm * (1.0f / 127.0f);
    }
}
__device__ __forceinline__ void rmsnorm_rows_bf(const Frame& F, const bf16_t* src, const float* g, bf16_t* dst, unsigned char* dst8, unsigned char* dsti = nullptr, float* rowsc = nullptr) {
    const f32x4* gp = (const f32x4*)g + F.lane;
    f32x4 gv[4];
#pragma unroll
    for (int j = 0; j < 4; ++j) gv[j] = gp[64 * j];
    for (int m = F.gw; m < T; m += F.NGW) {
        const u32x2* xr = (const u32x2*)(src + (size_t)m * D) + F.lane;
        f32x4 v[4]; float s = 0.f;
#pragma unroll
        for (int j = 0; j < 4; ++j) { const u32x2 w = xr[64 * j]; v[j] = (f32x4){bflo(w.x), bfhi(w.x), bflo(w.y), bfhi(w.y)}; s += (v[j].x * v[j].x + v[j].y * v[j].y) + (v[j].z * v[j].z + v[j].w * v[j].w); }
        const float rstd = 1.0f / sqrtf(wave_sum(s) * (1.f / D) + 1e-6f);
        if (dst) { u32x2* o8 = (u32x2*)(dst + (size_t)m * D) + F.lane;
#pragma unroll
        for (int j = 0; j < 4; ++j) { u32x2 w; w.x = pk2(v[j].x * rstd * gv[j].x, v[j].y * rstd * gv[j].y); w.y = pk2(v[j].z * rstd * gv[j].z, v[j].w * rstd * gv[j].w); o8[64 * j] = w; } }
        if (dst8) { unsigned* o4 = (unsigned*)(dst8 + (size_t)m * D) + F.lane;
#pragma unroll
            for (int j = 0; j < 4; ++j) { int w = 0; w = __builtin_amdgcn_cvt_pk_fp8_f32(v[j].x * rstd * gv[j].x, v[j].y * rstd * gv[j].y, w, false); w = __builtin_amdgcn_cvt_pk_fp8_f32(v[j].z * rstd * gv[j].z, v[j].w * rstd * gv[j].w, w, true); o4[64 * j] = (unsigned)w; } }
        if (dsti) {
            f32x4 y[4]; float am = 0.f;
#pragma unroll
            for (int j = 0; j < 4; ++j) { y[j] = v[j] * rstd * gv[j]; am = fmaxf(am, fmaxf(fmaxf(fabsf(y[j].x), fabsf(y[j].y)), fmaxf(fabsf(y[j].z), fabsf(y[j].w)))); }
            am = wave_max(am);
            const float qs = am > 0.f ? 127.0f / am : 0.f;
            unsigned* oi = (unsigned*)(dsti + (size_t)m * D) + F.lane;
#pragma unroll
            for (int j = 0; j < 4; ++j) { const int q0 = (int)rintf(y[j].x * qs), q1 = (int)rintf(y[j].y * qs), q2 = (int)rintf(y[j].z * qs), q3 = (int)rintf(y[j].w * qs);
                oi[64 * j] = ((unsigned)q0 & 255u) | (((unsigned)q1 & 255u) << 8) | (((unsigned)q2 & 255u) << 16) | ((unsigned)q3 << 24); }
            if (F.lane == 0) rowsc[m] = am * (1.0f / 127.0f);
        }
    }
}
__device__ __forceinline__ void final_norm_bf(const Frame& F, const bf16_t* h, float* out, const float* g) {
    const f32x4* gp = (const f32x4*)g + F.lane;
    f32x4 gv[4];
#pragma unroll
    for (int j = 0; j < 4; ++j) gv[j] = gp[64 * j];
    for (int m = F.gw; m < T; m += F.NGW) {
        const u32x2* xr = (const u32x2*)(h + (size_t)m * D) + F.lane;
        f32x4 v[4]; float s = 0.f;
#pragma unroll
        for (int j = 0; j < 4; ++j) { const u32x2 w = xr[64 * j]; v[j] = (f32x4){bflo(w.x), bfhi(w.x), bflo(w.y), bfhi(w.y)}; s += (v[j].x * v[j].x + v[j].y * v[j].y) + (v[j].z * v[j].z + v[j].w * v[j].w); }
        const float rstd = 1.0f / sqrtf(wave_sum(s) * (1.f / D) + 1e-6f);
        f32x4* orow = (f32x4*)(out + (size_t)m * D) + F.lane;
#pragma unroll
        for (int j = 0; j < 4; ++j) orow[64 * j] = v[j] * rstd * gv[j];
    }
}
__device__ __forceinline__ void final_norm(const Frame& F, float* h, const float* g) {
    const f32x4* gp = (const f32x4*)g + F.lane;
    f32x4 gv[4];
#pragma unroll
    for (int j = 0; j < 4; ++j) gv[j] = gp[64 * j];
    for (int m = F.gw; m < T; m += F.NGW) {
        f32x4* xr = (f32x4*)(h + (size_t)m * D) + F.lane;
        f32x4 v[4]; float s = 0.f;
#pragma unroll
        for (int j = 0; j < 4; ++j) { v[j] = xr[64 * j]; s += (v[j].x * v[j].x + v[j].y * v[j].y) + (v[j].z * v[j].z + v[j].w * v[j].w); }
        const float rstd = 1.0f / sqrtf(wave_sum(s) * (1.f / D) + 1e-6f);
#pragma unroll
        for (int j = 0; j < 4; ++j) xr[64 * j] = v[j] * rstd * gv[j];
    }
}
__device__ __forceinline__ void cvt_fp4_rows(const Frame& F, const float* src, unsigned char* dst, float* inv) {
    for (int r = F.gw; r < 16384; r += F.NGW) {
        const f32x4* p = (const f32x4*)(src + (size_t)r * 1024 + 16 * F.lane);
        const f32x4 v0 = p[0], v1 = p[1], v2 = p[2], v3 = p[3];
        float m = fmaxf(fmaxf(fmaxf(fabsf(v0.x), fabsf(v0.y)), fmaxf(fabsf(v0.z), fabsf(v0.w))), fmaxf(fmaxf(fabsf(v1.x), fabsf(v1.y)), fmaxf(fabsf(v1.z), fabsf(v1.w))));
        m = fmaxf(m, fmaxf(fmaxf(fmaxf(fabsf(v2.x), fabsf(v2.y)), fmaxf(fabsf(v2.z), fabsf(v2.w))), fmaxf(fmaxf(fabsf(v3.x), fabsf(v3.y)), fmaxf(fabsf(v3.z), fabsf(v3.w)))));
        m = wave_max(m);
        const float sc = m > 0.f ? 6.0f / m : 1.0f;
        unsigned w0 = 0u, w1 = 0u;
        w0 = __builtin_amdgcn_cvt_scalef32_pk_fp4_f32(w0, v0.x * sc, v0.y * sc, 1.0f, 0); w0 = __builtin_amdgcn_cvt_scalef32_pk_fp4_f32(w0, v0.z * sc, v0.w * sc, 1.0f, 1);
        w0 = __builtin_amdgcn_cvt_scalef32_pk_fp4_f32(w0, v1.x * sc, v1.y * sc, 1.0f, 2); w0 = __builtin_amdgcn_cvt_scalef32_pk_fp4_f32(w0, v1.z * sc, v1.w * sc, 1.0f, 3);
        w1 = __builtin_amdgcn_cvt_scalef32_pk_fp4_f32(w1, v2.x * sc, v2.y * sc, 1.0f, 0); w1 = __builtin_amdgcn_cvt_scalef32_pk_fp4_f32(w1, v2.z * sc, v2.w * sc, 1.0f, 1);
        w1 = __builtin_amdgcn_cvt_scalef32_pk_fp4_f32(w1, v3.x * sc, v3.y * sc, 1.0f, 2); w1 = __builtin_amdgcn_cvt_scalef32_pk_fp4_f32(w1, v3.z * sc, v3.w * sc, 1.0f, 3);
        *(u32x2*)(dst + (size_t)(F.lane >> 4) * (2 * MiB) + (size_t)r * 128 + 8 * (F.lane & 15)) = (u32x2){w0, w1};
        if (F.lane == 0) inv[2 * r] = m > 0.f ? m * (1.0f / 6.0f) : 1.0f;
    }
}
__device__ __forceinline__ int t5_bucket(int rel) {
    const int ret = rel > 0 ? 16 : 0; const int n = rel < 0 ? -rel : rel;
    int v;
    if (n < 8) v = n; else if (n < 12) v = 8; else if (n < 16) v = 9; else if (n < 23) v = 10; else if (n < 32) v = 11;
    else if (n < 46) v = 12; else if (n < 64) v = 13; else if (n < 91) v = 14; else v = 15;
    return ret + v;
}

__device__ __forceinline__ void p0_prologue(const Frame& F) {
    LAS float* scr = (LAS float*)(F.lds + F.wave * 16384);
    bf16_t* WQK = (bf16_t*)(F.ws + WS_WQK); bf16_t* WV = (bf16_t*)(F.ws + WS_WV); bf16_t* WO = (bf16_t*)(F.ws + WS_WO);
    bf16_t* WSGV = (bf16_t*)(F.ws + WS_WSGV); bf16_t* WSGU = (bf16_t*)(F.ws + WS_WSGU); bf16_t* WSGO = (bf16_t*)(F.ws + WS_WSGO);
    constexpr int I_QK = 16 * 40, I_V = 16 * 8, I_O = 16 * 32, I_SG = 16 * 96, I_SGO = 48 * 32;
    constexpr int NITEMS = I_QK + I_V + I_O + 2 * I_SG + I_SGO;
    for (int it = F.gw; it < NITEMS; it += F.NGW) {
        int r = it;
        if (r < I_QK) { const int nb = r % 40; transpose_item(F.in[3], 1536, 0, WQK, 1024, 40, (nb < 32 ? 0.125f * 1.4426950408889634f : 1.0f) * W8_SCALE, scr, r, F.lane, true); continue; } r -= I_QK;
        if (r < I_V) { transpose_item(F.in[3], 1536, 1280, WV, 1024, 8, W8_SCALE, scr, r, F.lane, true); continue; } r -= I_V;
        if (r < I_O) { transpose_item(F.in[4], 1024, 0, WO, 1024, 32, W8_SCALE, scr, r, F.lane, true); continue; } r -= I_O;
        if (r < I_SG) { transpose_item(F.in[6], 6144, 0, WSGU, 1024, 96, W8_SCALE, scr, r, F.lane, true, F.in[2] + D); continue; } r -= I_SG;
        if (r < I_SG) { transpose_item(F.in[6], 6144, 3072, WSGV, 1024, 96, W8_SCALE, scr, r, F.lane, true, F.in[2] + D); continue; } r -= I_SG;
        transpose_item(F.in[11], 1024, 0, WSGO, 3072, 32, W8_SCALE, scr, r, F.lane, true);
    }
    {
        bf16_t* WQKP = (bf16_t*)(F.ws + WS_WQKP);
        const int fr = F.lane & 15, fq = F.lane >> 4;
        for (int task = F.gw; task < 2 * 16 * 64; task += F.NGW) {
            const int l = task >> 10, hc = (task >> 6) & 15, k0 = (task & 63) * 16;
            const f32x4* ap = (const f32x4*)(F.in[13] + ((size_t)l * 1024 + k0 + fr) * 2048 + hc * 128 + 32 * fq);
            f32x4 av[8];
#pragma unroll
            for (int i = 0; i < 8; ++i) av[i] = ap[i];
#pragma unroll 1
            for (int nt = 0; nt < 8; ++nt) {
                const f32x4* bp = (const f32x4*)(F.in[14] + ((size_t)(l * 16 + hc) * 128 + nt * 16 + fr) * 128 + 32 * fq);
                f32x4 bv[8];
#pragma unroll
                for (int i = 0; i < 8; ++i) bv[i] = bp[i];
                f32x4 acc = {0.f, 0.f, 0.f, 0.f};
#pragma unroll
                for (int i = 0; i < 8; ++i)
#pragma unroll
                    for (int j = 0; j < 4; ++j) acc = __builtin_amdgcn_mfma_f32_16x16x4f32(av[i][j], bv[i][j], acc, 0, 0, 0);
                *(u32x2*)(WQKP + ((size_t)l * 2048 + hc * 128 + nt * 16 + fr) * 1024 + k0 + 4 * fq) = (u32x2){pk2(acc[0], acc[1]), pk2(acc[2], acc[3])};
                { float mx = fmaxf(fmaxf(fabsf(acc[0]), fabsf(acc[1])), fmaxf(fabsf(acc[2]), fabsf(acc[3])));
                  mx = fmaxf(mx, __shfl_xor(mx, 16)); mx = fmaxf(mx, __shfl_xor(mx, 32));
                  if (fq == 0) atomicMax((unsigned*)(F.ws + WS_CTL) + CW_COLMAX + l * 2048 + hc * 128 + nt * 16 + fr, __builtin_bit_cast(unsigned, mx)); }
            }
        }
    }
    if (blockIdx.x == 0) {
        float* bt = (float*)(F.ws + WS_BIAS);
        for (int i = F.tid; i < 16 * 257; i += 512) { const int hq = i / 257, r = i % 257 - 128; bt[hq * 260 + r + 128] = F.in[1][t5_bucket(r) * 16 + hq] * 1.4426950408889634f; }
    }
    rmsnorm_rows(F, F.in[0], F.in[2], nullptr, nullptr, F.ws + WS_HN8B);
    for (int l = 0; l < 2; ++l) {
        cvt_fp4_rows(F, F.in[15] + (size_t)l * 16384 * 1024, F.ws + WS_TAB + (size_t)(2 * l) * 16 * MiB, (float*)(F.ws + WS_SCL) + (size_t)l * 32768);
        cvt_fp4_rows(F, F.in[16] + (size_t)l * 16384 * 1024, F.ws + WS_TAB + (size_t)(2 * l + 1) * 16 * MiB, (float*)(F.ws + WS_SCL) + (size_t)l * 32768 + 1);
    }
}

typedef float f32x16 __attribute__((ext_vector_type(16)));
constexpr int AT_K = 0, AT_KS = 144, AT_V = 384 * AT_KS, AT_VS = 792, AT_B = AT_V + 64 * AT_VS;
__device__ __forceinline__ void attn_phase_v2(const Frame& F) {
    const bf16_t* Q = (const bf16_t*)(F.ws + WS_Q); const bf16_t* Kb = (const bf16_t*)(F.ws + WS_K); const bf16_t* Vt = (const bf16_t*)(F.ws + WS_VT);
    bf16_t* AO = (bf16_t*)(F.ws + WS_AO); const float* bias = (const float*)(F.ws + WS_BIAS); const float* sinkp = F.in[5];
    const int lane = F.lane, tid = F.tid, h5 = lane >> 5, c31 = lane & 31, g = F.wave >> 1, qh = F.wave & 1;
    LAS float* bl = (LAS float*)(F.lds + AT_B) + g * 260;
    for (int unit = blockIdx.x; unit < 1024; unit += F.G) {
        const int hkv = unit & 3, qb = (unit >> 2) & 15, b = unit >> 6;
        const int tok0 = b * 2048 + qb * 128, kbase = tok0 - 128;
        __syncthreads();
#pragma unroll 2
        for (int it = 0; it < 6; ++it) { const int id = it * 512 + tid, row = id >> 3, ch = id & 7, pos = qb * 128 - 128 + row;
            u32x4 v = (u32x4){0u, 0u, 0u, 0u};
            if (pos >= 0 && pos < 2048) v = *(const u32x4*)(Kb + (size_t)(kbase + row) * 256 + hkv * 64 + ch * 8);
            *(LAS u32x4*)(F.lds + AT_K + row * AT_KS + ch * 16) = v; }
#pragma unroll 2
        for (int it = 0; it < 6; ++it) { const int id = it * 512 + tid, d = id / 48, ch = id % 48, pos0 = qb * 128 - 128 + ch * 8;
            u32x4 v = (u32x4){0u, 0u, 0u, 0u};
            if (pos0 >= 0 && pos0 < 2048) v = *(const u32x4*)(Vt + (size_t)(hkv * 64 + d) * T + kbase + ch * 8);
            *(LAS u32x2*)(F.lds + AT_V + d * AT_VS + ch * 16) = (u32x2){v.x, v.y}; *(LAS u32x2*)(F.lds + AT_V + d * AT_VS + ch * 16 + 8) = (u32x2){v.z, v.w}; }
        for (int i = tid; i < 4 * 260; i += 512) ((LAS float*)(F.lds + AT_B))[i] = bias[hkv * 4 * 260 + i];
        __syncthreads();
        const int hq = hkv * 4 + g; const float sinkv = sinkp[hq] * 1.4426950408889634f;
#pragma unroll 1
        for (int qt = 0; qt < 2; ++qt) {
            const int q0 = 64 * qh + 32 * qt;
            const bf16_t* qrow = Q + (size_t)(tok0 + q0 + c31) * 1024 + hq * 64 + 8 * h5;
            bf16x8 qf[4];
#pragma unroll
            for (int s2 = 0; s2 < 4; ++s2) qf[s2] = *(const bf16x8*)(qrow + 16 * s2);
            const int kt0 = q0 >> 5; int kt_lo = kt0, kt_hi = kt0 + 8;
            if (qb == 0 && kt_lo < 4) kt_lo = 4;
            if (qb == 15 && kt_hi > 7) kt_hi = 7;
            const int qi = q0 + c31;
            float mx = sinkv, lsum = h5 == 0 ? 1.0f : 0.f;
            f32x16 o0 = {0.f, 0.f, 0.f, 0.f, 0.f, 0.f, 0.f, 0.f, 0.f, 0.f, 0.f, 0.f, 0.f, 0.f, 0.f, 0.f}, o1 = o0;
#pragma unroll 1
            for (int kt = kt_lo; kt <= kt_hi; ++kt) {
                f32x16 sa = {0.f, 0.f, 0.f, 0.f, 0.f, 0.f, 0.f, 0.f, 0.f, 0.f, 0.f, 0.f, 0.f, 0.f, 0.f, 0.f};
#pragma unroll
                for (int s2 = 0; s2 < 4; ++s2) { const bf16x8 kf = *(const LAS bf16x8*)(F.lds + AT_K + (kt * 32 + c31) * AT_KS + s2 * 32 + h5 * 16); sa = __builtin_amdgcn_mfma_f32_32x32x16_bf16(kf, qf[s2], sa, 0, 0, 0); }
                float sv[16]; float tmax = -INFINITY;
                if (kt > kt0 && kt < kt0 + 8) {
                    const LAS float* bp = bl + (kt * 32 + 4 * h5 - qi);
#pragma unroll
                    for (int r = 0; r < 16; ++r) { sv[r] = sa[r] + bp[(r & 3) + 8 * (r >> 2)]; tmax = fmaxf(tmax, sv[r]); }
                } else {
#pragma unroll
                    for (int r = 0; r < 16; ++r) { const int key = kt * 32 + (r & 3) + 8 * (r >> 2) + 4 * h5, rel = key - 128 - qi; const bool ok = rel >= -128 && rel <= 128;
                        const int bi = rel < -128 ? 0 : (rel > 128 ? 256 : rel + 128);
                        sv[r] = ok ? sa[r] + bl[bi] : -INFINITY; tmax = fmaxf(tmax, sv[r]); }
                }
                tmax = fmaxf(tmax, __shfl_xor(tmax, 32));
                if (__any(tmax > mx)) {
                    const float mn = fmaxf(mx, tmax), scl = __builtin_amdgcn_exp2f(mx - mn); mx = mn; lsum *= scl;
#pragma unroll
                    for (int r = 0; r < 16; ++r) { o0[r] *= scl; o1[r] *= scl; }
                }
                float pr[16];
#pragma unroll
                for (int r = 0; r < 16; ++r) { pr[r] = __builtin_amdgcn_exp2f(sv[r] - mx); lsum += pr[r]; }
#pragma unroll
                for (int s2 = 0; s2 < 2; ++s2) {
                    u32x4 pw; pw.x = pk2(pr[8 * s2 + 0], pr[8 * s2 + 1]); pw.y = pk2(pr[8 * s2 + 2], pr[8 * s2 + 3]); pw.z = pk2(pr[8 * s2 + 4], pr[8 * s2 + 5]); pw.w = pk2(pr[8 * s2 + 6], pr[8 * s2 + 7]);
                    const bf16x8 pb = __builtin_bit_cast(bf16x8, pw);
                    const int koff = (kt * 32 + 16 * s2 + 4 * h5) * 2;
                    { const LAS unsigned char* vb = F.lds + AT_V + c31 * AT_VS + koff; const u32x2 lo = *(const LAS u32x2*)vb, hi = *(const LAS u32x2*)(vb + 16);
                      const bf16x8 vf = __builtin_bit_cast(bf16x8, (u32x4){lo.x, lo.y, hi.x, hi.y}); o0 = __builtin_amdgcn_mfma_f32_32x32x16_bf16(vf, pb, o0, 0, 0, 0); }
                    { const LAS unsigned char* vb = F.lds + AT_V + (32 + c31) * AT_VS + koff; const u32x2 lo = *(const LAS u32x2*)vb, hi = *(const LAS u32x2*)(vb + 16);
                      const bf16x8 vf = __builtin_bit_cast(bf16x8, (u32x4){lo.x, lo.y, hi.x, hi.y}); o1 = __builtin_amdgcn_mfma_f32_32x32x16_bf16(vf, pb, o1, 0, 0, 0); }
                }
            }
            lsum += __shfl_xor(lsum, 32);
            const float linv = 1.0f / lsum;
            unsigned char* op = (unsigned char*)AO + (size_t)(tok0 + qi) * 1024 + hq * 64 + 4 * h5;
            const float ls = linv * AO8_SCALE;
#pragma unroll
            for (int gq = 0; gq < 4; ++gq) {
                int w0 = 0, w1 = 0;
                w0 = __builtin_amdgcn_cvt_pk_fp8_f32(o0[4 * gq] * ls, o0[4 * gq + 1] * ls, w0, false); w0 = __builtin_amdgcn_cvt_pk_fp8_f32(o0[4 * gq + 2] * ls, o0[4 * gq + 3] * ls, w0, true);
                w1 = __builtin_amdgcn_cvt_pk_fp8_f32(o1[4 * gq] * ls, o1[4 * gq + 1] * ls, w1, false); w1 = __builtin_amdgcn_cvt_pk_fp8_f32(o1[4 * gq + 2] * ls, o1[4 * gq + 3] * ls, w1, true);
                *(unsigned*)(op + 8 * gq) = (unsigned)w0; *(unsigned*)(op + 32 + 8 * gq) = (unsigned)w1; }
        }
    }
}

__device__ __forceinline__ unsigned enc_key(float f, unsigned tag, unsigned mask) { unsigned u = __builtin_bit_cast(unsigned, f); u = (u & ~mask) | tag; return (u & 0x80000000u) ? ~u : (u | 0x80000000u); }
__device__ __forceinline__ unsigned dec_key(unsigned m) { return (m & 0x80000000u) ? (m & 0x7fffffffu) : ~m; }
__device__ __forceinline__ unsigned umax(unsigned a, unsigned b) { return a > b ? a : b; }
__device__ __forceinline__ unsigned umin(unsigned a, unsigned b) { return a < b ? a : b; }
#define SORT_CE(i, j) do { const unsigned hi_ = umax(a[i], a[j]), lo_ = umin(a[i], a[j]); a[i] = hi_; a[j] = lo_; } while (0)
__device__ __forceinline__ void sort16_desc(unsigned (&a)[16]) {
    SORT_CE(0, 13); SORT_CE(1, 12); SORT_CE(2, 15); SORT_CE(3, 14); SORT_CE(4, 8); SORT_CE(5, 6); SORT_CE(7, 11); SORT_CE(9, 10);
    SORT_CE(0, 5); SORT_CE(1, 7); SORT_CE(2, 9); SORT_CE(3, 4); SORT_CE(6, 13); SORT_CE(8, 14); SORT_CE(10, 15); SORT_CE(11, 12);
    SORT_CE(0, 1); SORT_CE(2, 3); SORT_CE(4, 5); SORT_CE(6, 8); SORT_CE(7, 9); SORT_CE(10, 11); SORT_CE(12, 13); SORT_CE(14, 15);
    SORT_CE(0, 2); SORT_CE(1, 3); SORT_CE(4, 10); SORT_CE(5, 11); SORT_CE(6, 7); SORT_CE(8, 9); SORT_CE(12, 14); SORT_CE(13, 15);
    SORT_CE(1, 2); SORT_CE(3, 12); SORT_CE(4, 6); SORT_CE(5, 7); SORT_CE(8, 10); SORT_CE(9, 11); SORT_CE(13, 14);
    SORT_CE(1, 4); SORT_CE(2, 6); SORT_CE(5, 8); SORT_CE(7, 10); SORT_CE(9, 13); SORT_CE(11, 14);
    SORT_CE(2, 4); SORT_CE(3, 6); SORT_CE(9, 12); SORT_CE(11, 13);
    SORT_CE(3, 5); SORT_CE(6, 8); SORT_CE(7, 9); SORT_CE(10, 12);
    SORT_CE(3, 4); SORT_CE(5, 6); SORT_CE(7, 8); SORT_CE(9, 10); SORT_CE(11, 12);
    SORT_CE(6, 7); SORT_CE(8, 9);
}
#undef SORT_CE
__device__ __forceinline__ void merge16_desc(unsigned (&a)[16]) {
#pragma unroll
    for (int jj = 3; jj >= 0; --jj)
#pragma unroll
        for (int i = 0; i < 16; ++i) { const int j = 1 << jj, l = i ^ j; if (l > i) { const unsigned hi = umax(a[i], a[l]), lo = umin(a[i], a[l]); a[i] = hi; a[l] = lo; } }
}
template <int CTRL> __device__ __forceinline__ void xmerge16(unsigned (&a)[16]) {
    unsigned p[16];
#pragma unroll
    for (int i = 0; i < 16; ++i) p[i] = (unsigned)__builtin_amdgcn_update_dpp(0, (int)a[i], CTRL, 0xf, 0xf, true);
#pragma unroll
    for (int i = 0; i < 16; ++i) a[i] = umax(a[i], p[15 - i]);
    merge16_desc(a);
}
template <int CTRL> __device__ __forceinline__ unsigned dpp_u(unsigned v) { return (unsigned)__builtin_amdgcn_update_dpp(0, (int)v, CTRL, 0xf, 0xf, true); }
__device__ __forceinline__ void topk_phase_v3(const Frame& F) {
    const bf16_t* S = (const bf16_t*)(F.ws + WS_S); int* IDX = (int*)(F.ws + WS_IDX); float* GATE = (float*)(F.ws + WS_GATE);
    LAS unsigned* L = (LAS unsigned*)F.lds + F.wave * 1024;
    const int lane = F.lane, tk = lane >> 4, hc = lane & 15, h = hc >> 1, c = hc & 1;
    auto step = [&](const u32x4 (&cur)[16], const int tb) __attribute__((always_inline)) {
        const int t = tb + tk;
        unsigned top[16];
#pragma unroll
        for (int ck = 0; ck < 8; ++ck) {
            const u32x4 v = cur[2 * ck], w = cur[2 * ck + 1];
            const float fv[16] = {hlo(v.x), hhi(v.x), hlo(v.y), hhi(v.y), hlo(v.z), hhi(v.z), hlo(v.w), hhi(v.w), hlo(w.x), hhi(w.x), hlo(w.y), hhi(w.y), hlo(w.z), hhi(w.z), hlo(w.w), hhi(w.w)};
            unsigned nw[16];
#pragma unroll
            for (int j = 0; j < 16; ++j) nw[j] = enc_key(fv[j], (unsigned)(16 * ck + j), 127u);
            sort16_desc(nw);
            if (ck == 0) {
#pragma unroll
                for (int j = 0; j < 16; ++j) top[j] = nw[j];
            } else {
#pragma unroll
                for (int j = 0; j < 16; ++j) top[j] = umax(top[j], nw[15 - j]);
                merge16_desc(top);
            }
        }
#pragma unroll
        for (int i = 0; i < 16; ++i) L[lane * 16 + i] = top[i];
        float f1[16], f2[16];
#pragma unroll
        for (int i = 0; i < 16; ++i) { const unsigned o = dpp_u<0xB1>(top[i]); const unsigned u1 = dec_key(c ? o : top[i]) & ~127u, u2 = dec_key(c ? top[i] : o) & ~127u;
            f1[i] = __builtin_bit_cast(float, u1); f2[i] = __builtin_bit_cast(float, u2); }
        unsigned ca[16], cb[16];
#pragma unroll
        for (int i = 0; i < 16; ++i) { ca[i] = 0u; cb[i] = 0u; }
        { int n = 0;
#pragma unroll
          for (int i = 0; i < 16; ++i)
#pragma unroll
            for (int j = 0; j < 16; ++j) if ((i + 1) * (j + 1) <= 16) { const unsigned key = enc_key(f1[i] + f2[j], (unsigned)((i << 4) | j), 255u); const int slot = n >> 1, who = n & 1;
                if (slot < 16) ca[slot] = (c == who) ? key : ca[slot]; else cb[slot - 16] = (c == who) ? key : cb[slot - 16]; ++n; } }
        sort16_desc(ca); sort16_desc(cb);
#pragma unroll
        for (int i = 0; i < 16; ++i) ca[i] = umax(ca[i], cb[15 - i]);
        merge16_desc(ca);
        xmerge16<0xB1>(ca);
        float sc[8]; unsigned ex[8];
#pragma unroll
        for (int k = 0; k < 8; ++k) { unsigned wlo = ca[k], whi = ca[8 + k]; asm volatile("" : "+v"(wlo), "+v"(whi));
            const unsigned w = c ? whi : wlo;
            const unsigned tag = dec_key(w) & 255u; const unsigned u1 = dec_key(L[(lane & ~1) * 16 + (tag >> 4)]), u2 = dec_key(L[(lane | 1) * 16 + (tag & 15u)]);
            sc[k] = __builtin_bit_cast(float, u1 & ~127u) + __builtin_bit_cast(float, u2 & ~127u); ex[k] = ((u1 & 127u) << 7) | (u2 & 127u); }
        const float smax = __builtin_bit_cast(float, __builtin_amdgcn_update_dpp(0, __builtin_bit_cast(int, sc[0]), 0xA0, 0xf, 0xf, true));
        float e[8]; float sum = 0.f;
#pragma unroll
        for (int k = 0; k < 8; ++k) { e[k] = __expf(sc[k] - smax); sum += e[k]; }
        sum += __builtin_bit_cast(float, __builtin_amdgcn_update_dpp(0, __builtin_bit_cast(int, sum), 0xB1, 0xf, 0xf, true));
        const float inv = 1.0f / sum;
        int* ip = IDX + (size_t)t * 128 + h * 16 + 8 * c; float* gp = GATE + (size_t)t * 128 + h * 16 + 8 * c;
        *(u32x4*)ip = (u32x4){ex[0], ex[1], ex[2], ex[3]}; *(u32x4*)(ip + 4) = (u32x4){ex[4], ex[5], ex[6], ex[7]};
        *(f32x4*)gp = (f32x4){e[0] * inv, e[1] * inv, e[2] * inv, e[3] * inv}; *(f32x4*)(gp + 4) = (f32x4){e[4] * inv, e[5] * inv, e[6] * inv, e[7] * inv};
    };
#define TK_LD1(dst, ptr, OFF) asm volatile("global_load_dwordx4 %0, %1, off offset:" #OFF : "=v"(dst) : "v"(ptr) : "memory")
#define TK_LOAD(buf, tb_) do { const u32x4* sp_ = (const u32x4*)(S + (size_t)((tb_) + tk) * 2048 + hc * 128); \
        TK_LD1(buf[0], sp_, 0); TK_LD1(buf[1], sp_, 16); TK_LD1(buf[2], sp_, 32); TK_LD1(buf[3], sp_, 48); TK_LD1(buf[4], sp_, 64); TK_LD1(buf[5], sp_, 80); TK_LD1(buf[6], sp_, 96); TK_LD1(buf[7], sp_, 112); \
        TK_LD1(buf[8], sp_, 128); TK_LD1(buf[9], sp_, 144); TK_LD1(buf[10], sp_, 160); TK_LD1(buf[11], sp_, 176); TK_LD1(buf[12], sp_, 192); TK_LD1(buf[13], sp_, 208); TK_LD1(buf[14], sp_, 224); TK_LD1(buf[15], sp_, 240); } while (0)
#define TK_WAIT(buf, N) asm volatile("s_waitcnt vmcnt(" #N ")" : "+v"(buf[0]), "+v"(buf[1]), "+v"(buf[2]), "+v"(buf[3]), "+v"(buf[4]), "+v"(buf[5]), "+v"(buf[6]), "+v"(buf[7]), \
        "+v"(buf[8]), "+v"(buf[9]), "+v"(buf[10]), "+v"(buf[11]), "+v"(buf[12]), "+v"(buf[13]), "+v"(buf[14]), "+v"(buf[15]) :: "memory")
    const int dstep = 4 * F.NGW; int tb = 4 * F.gw;
    u32x4 bufa[16], bufb[16];
    if (tb >= T) return;
    TK_LOAD(bufa, tb);
    for (;;) {
        const int t1 = tb + dstep; TK_LOAD(bufb, t1 < T ? t1 : tb);
        TK_WAIT(bufa, 16);
        step(bufa, tb);
        if (t1 >= T) break;
        const int t2 = t1 + dstep; TK_LOAD(bufa, t2 < T ? t2 : t1);
        TK_WAIT(bufb, 16);
        step(bufb, t1);
        if (t2 >= T) break;
        tb = t2;
    }
    asm volatile("s_waitcnt vmcnt(0)" ::: "memory");
#undef TK_LOAD
#undef TK_LD1
#undef TK_WAIT
}

template <int S> __device__ __forceinline__ void reduce_scatter16(const float (&v)[16], int lane, float& z0, float& z1) {
    const bool b2 = (lane & (4 * S)) != 0, b1 = (lane & (2 * S)) != 0, b0 = (lane & S) != 0;
    float u[8], w[4];
#pragma unroll
    for (int k = 0; k < 8; ++k) { const float keep = b2 ? v[8 + k] : v[k], send = b2 ? v[k] : v[8 + k]; u[k] = keep + __shfl_xor(send, 4 * S); }
#pragma unroll
    for (int k = 0; k < 4; ++k) { const float keep = b1 ? u[4 + k] : u[k], send = b1 ? u[k] : u[4 + k]; w[k] = keep + __shfl_xor(send, 2 * S); }
    { const float keep = b0 ? w[2] : w[0], send = b0 ? w[0] : w[2]; z0 = keep + __shfl_xor(send, S); }
    { const float keep = b0 ? w[3] : w[1], send = b0 ? w[1] : w[3]; z1 = keep + __shfl_xor(send, S); }
}
__device__ __forceinline__ void ld_off16(const int* IDX, int t, int g, unsigned off, unsigned (&e)[16]) {
    const u32x4* ip = (const u32x4*)((const char*)IDX + (unsigned)(t * 512 + 64 * g)); const u32x4 i0 = ip[0], i1 = ip[1], i2 = ip[2], i3 = ip[3];
    e[0] = i0.x * 128u + off; e[1] = i0.y * 128u + off; e[2] = i0.z * 128u + off; e[3] = i0.w * 128u + off; e[4] = i1.x * 128u + off; e[5] = i1.y * 128u + off; e[6] = i1.z * 128u + off; e[7] = i1.w * 128u + off;
    e[8] = i2.x * 128u + off; e[9] = i2.y * 128u + off; e[10] = i2.z * 128u + off; e[11] = i2.w * 128u + off; e[12] = i3.x * 128u + off; e[13] = i3.y * 128u + off; e[14] = i3.z * 128u + off; e[15] = i3.w * 128u + off;
}
__device__ __forceinline__ void gather16(const unsigned char* tab, const unsigned (&e)[16], u32x4 (&wv)[16]) {
#pragma unroll
    for (int i = 0; i < 16; ++i) wv[i] = *(const u32x4*)(tab + e[i]);
}
#define FP4X32(W_, o) do { const u32x4 _w = (W_); \
    o[0] = __builtin_amdgcn_cvt_scalef32_pk_f32_fp4(_w.x, 1.0f, 0); o[1] = __builtin_amdgcn_cvt_scalef32_pk_f32_fp4(_w.x, 1.0f, 1); o[2] = __builtin_amdgcn_cvt_scalef32_pk_f32_fp4(_w.x, 1.0f, 2); o[3] = __builtin_amdgcn_cvt_scalef32_pk_f32_fp4(_w.x, 1.0f, 3); \
    o[4] = __builtin_amdgcn_cvt_scalef32_pk_f32_fp4(_w.y, 1.0f, 0); o[5] = __builtin_amdgcn_cvt_scalef32_pk_f32_fp4(_w.y, 1.0f, 1); o[6] = __builtin_amdgcn_cvt_scalef32_pk_f32_fp4(_w.y, 1.0f, 2); o[7] = __builtin_amdgcn_cvt_scalef32_pk_f32_fp4(_w.y, 1.0f, 3); \
    o[8] = __builtin_amdgcn_cvt_scalef32_pk_f32_fp4(_w.z, 1.0f, 0); o[9] = __builtin_amdgcn_cvt_scalef32_pk_f32_fp4(_w.z, 1.0f, 1); o[10] = __builtin_amdgcn_cvt_scalef32_pk_f32_fp4(_w.z, 1.0f, 2); o[11] = __builtin_amdgcn_cvt_scalef32_pk_f32_fp4(_w.z, 1.0f, 3); \
    o[12] = __builtin_amdgcn_cvt_scalef32_pk_f32_fp4(_w.w, 1.0f, 0); o[13] = __builtin_amdgcn_cvt_scalef32_pk_f32_fp4(_w.w, 1.0f, 1); o[14] = __builtin_amdgcn_cvt_scalef32_pk_f32_fp4(_w.w, 1.0f, 2); o[15] = __builtin_amdgcn_cvt_scalef32_pk_f32_fp4(_w.w, 1.0f, 3); } while (0)
__device__ __forceinline__ void peer_down_phase4(const Frame& F, int layer) {
    const int bx = blockIdx.x, p4 = bx & 3, par = (bx >> 2) & 1;
    const unsigned char* TD = F.ws + WS_TAB + (size_t)(2 * layer) * 16 * MiB + (size_t)p4 * (2 * MiB); const char* HNb = (const char*)(F.ws + WS_HN);
    const int* IDX = (const int*)(F.ws + WS_IDX); bf16_t* PART = (bf16_t*)(F.ws + WS_PART);
    const int nwp = (F.G - (bx & 7) + 7) >> 3, ww = (bx >> 3) * 8 + F.wave, stride = 2 * nwp * 8, tfirst = 2 * ww + par;
    const int lane = F.lane, r = lane & 7, g = lane >> 3, off = 256 * p4 + 32 * r;
    if (tfirst >= T) return;
    unsigned e1[16]; u32x4 wv[16];
    const unsigned toff = 16u * r;
    ld_off16(IDX, tfirst, g, toff, e1); gather16(TD, e1, wv);
    u32x4 xc[4];
#pragma unroll
    for (int k = 0; k < 4; ++k) xc[k] = *(const u32x4*)(HNb + (unsigned)(tfirst * 2048 + 2 * off + 16 * k));
    { const int t1 = tfirst + stride < T ? tfirst + stride : tfirst; ld_off16(IDX, t1, g, toff, e1); }
    for (int t0 = tfirst; t0 < T; t0 += stride) {
        const int t1 = t0 + stride < T ? t0 + stride : t0, t2 = t0 + 2 * stride < T ? t0 + 2 * stride : t0;
        unsigned e2[16]; ld_off16(IDX, t2, g, toff, e2);
        u32x4 xn[4];
#pragma unroll
        for (int k = 0; k < 4; ++k) xn[k] = *(const u32x4*)(HNb + (unsigned)(t1 * 2048 + 2 * off + 16 * k));
        const unsigned xw[16] = {xc[0].x, xc[0].y, xc[0].z, xc[0].w, xc[1].x, xc[1].y, xc[1].z, xc[1].w, xc[2].x, xc[2].y, xc[2].z, xc[2].w, xc[3].x, xc[3].y, xc[3].z, xc[3].w};
        float acc[16];
#pragma unroll
        for (int i = 0; i < 16; ++i) { const u32x4 w = wv[i]; wv[i] = *(const u32x4*)(TD + e1[i]);
            const unsigned ww4[4] = {w.x, w.y, w.z, w.w}; float sv = 0.f;
#pragma unroll
            for (int k = 0; k < 4; ++k) {
                sv = __builtin_amdgcn_fdot2_f32_bf16(__builtin_amdgcn_cvt_scalef32_pk_bf16_fp4(ww4[k], 1.0f, 0), __builtin_bit_cast(bfx2, xw[4 * k]), sv, false);
                sv = __builtin_amdgcn_fdot2_f32_bf16(__builtin_amdgcn_cvt_scalef32_pk_bf16_fp4(ww4[k], 1.0f, 1), __builtin_bit_cast(bfx2, xw[4 * k + 1]), sv, false);
                sv = __builtin_amdgcn_fdot2_f32_bf16(__builtin_amdgcn_cvt_scalef32_pk_bf16_fp4(ww4[k], 1.0f, 2), __builtin_bit_cast(bfx2, xw[4 * k + 2]), sv, false);
                sv = __builtin_amdgcn_fdot2_f32_bf16(__builtin_amdgcn_cvt_scalef32_pk_bf16_fp4(ww4[k], 1.0f, 3), __builtin_bit_cast(bfx2, xw[4 * k + 3]), sv, false); }
            acc[i] = sv; }
        float z0, z1; reduce_scatter16<1>(acc, lane, z0, z1);
        *(unsigned*)((char*)(PART + (size_t)p4 * T * 128) + (unsigned)(t0 * 256 + 32 * g + 4 * r)) = pk2(z0, z1);
#pragma unroll
        for (int k = 0; k < 4; ++k) xc[k] = xn[k];
#pragma unroll
        for (int i = 0; i < 16; ++i) e1[i] = e2[i];
    }
}
constexpr int D5_AUX = 131072;
#define D5_EL(iv, d) ((iv)[2 * ((d) & 1) + ((d) >> 3)][((d) >> 1) & 3])
#define D5_DMA(iv, d) __builtin_amdgcn_global_load_lds((const unsigned*)(TD + (D5_EL(iv, d) * 128u + (((d) & 1) ? sw1 : sw0))), (LAS unsigned*)(wl + (d) * 1024), 16, 0, 0)
#define D5_DMA_IDX(t, slot) do { __builtin_amdgcn_global_load_lds((const unsigned*)(IDX + (unsigned)((t) * 512) + l4), (LAS unsigned*)(xl + (slot) * 512), 4, 0, 0); \
                                 __builtin_amdgcn_global_load_lds((const unsigned*)(IDX + (unsigned)((t) * 512) + 256u + l4), (LAS unsigned*)(xl + (slot) * 512 + 256), 4, 0, 0); } while (0)
#define D5_DMA_H(t, slot) __builtin_amdgcn_global_load_lds((const unsigned*)(H8 + (unsigned)((t) * 1024) + l4), (LAS unsigned*)(xl + 1024 + (slot) * 256), 4, 0, 0)
#define D5_B(h, c) ((i32x8){(int)h[2 * (c)].x, (int)h[2 * (c)].y, (int)h[2 * (c)].z, (int)h[2 * (c)].w, (int)h[2 * (c) + 1].x, (int)h[2 * (c) + 1].y, (int)h[2 * (c) + 1].z, (int)h[2 * (c) + 1].w})
#define D5_A(a) ((i32x8){(int)(a).x, (int)(a).y, (int)(a).z, (int)(a).w, 0, 0, 0, 0})
__device__ __forceinline__ void peer_down_phase5(const Frame& F, int layer) {
    const int bx = blockIdx.x, p4 = bx & 3, par = (bx >> 2) & 1;
    const unsigned char* TD = F.ws + WS_TAB + (size_t)(2 * layer) * 16 * MiB + (size_t)p4 * (2 * MiB);
    const char* H8 = (const char*)(F.ws + WS_HN8) + 256 * p4; const char* IDX = (const char*)(F.ws + WS_IDX); char* PART = (char*)(F.ws + WS_PART) + (size_t)p4 * T * 256;
    const int nwp = (F.G - (bx & 7) + 7) >> 3, ww = (bx >> 3) * 8 + F.wave, stride = 2 * nwp * 8, tfirst = 2 * ww + par;
    if (tfirst >= T) return;
    const int lane = F.lane, rs = lane >> 3, sg = lane & 7, m = lane & 15, kg = lane >> 4;
    LAS unsigned char* wl = F.lds + F.wave * 16384; LAS unsigned char* xl = F.lds + D5_AUX + F.wave * 1536;
    const unsigned sw0 = (unsigned)((sg ^ kg) * 16), sw1 = (unsigned)((sg ^ (4 + kg)) * 16);
    const unsigned rd0 = (unsigned)(m * 128 + (kg ^ (m >> 1)) * 16), rd1 = (unsigned)(m * 128 + ((4 + kg) ^ (m >> 1)) * 16);
    const unsigned l4 = 4u * lane, ioff = 32u * rs, hoff = 16u * kg;
    { const u32x4* ip = (const u32x4*)(IDX + (unsigned)(tfirst * 512) + ioff); u32x4 i0[4]; i0[0] = ip[0]; i0[1] = ip[1]; i0[2] = ip[16]; i0[3] = ip[17];
      asm volatile("" : "+v"(i0[0]), "+v"(i0[1]), "+v"(i0[2]), "+v"(i0[3]) :: "memory");
      { const int t1 = tfirst + stride < T ? tfirst + stride : tfirst; D5_DMA_IDX(t1, 1); D5_DMA_H(tfirst, 0); }
      asm volatile("" ::: "memory");
#pragma unroll
      for (int d = 0; d < 16; ++d) D5_DMA(i0, d); }
    int sl = 0;
    for (int t0 = tfirst; t0 < T; t0 += stride, sl ^= 1) {
        const int t1 = t0 + stride < T ? t0 + stride : t0, t2 = t0 + 2 * stride < T ? t0 + 2 * stride : t0;
        D5_DMA_IDX(t2, sl); D5_DMA_H(t1, sl ^ 1);
        u32x4 i1[4], hb[4];
        f32x4 acc[8];
#pragma unroll
        for (int q = 0; q < 4; ++q) {
            asm volatile("s_waitcnt vmcnt(15)" ::: "memory");
            u32x4 a00 = *(const LAS u32x4*)(wl + (2 * q) * 2048 + rd0), a01 = *(const LAS u32x4*)(wl + (2 * q) * 2048 + rd1);
            u32x4 a10 = *(const LAS u32x4*)(wl + (2 * q + 1) * 2048 + rd0), a11 = *(const LAS u32x4*)(wl + (2 * q + 1) * 2048 + rd1);
            if (q == 0) {
                const LAS u32x4* ip = (const LAS u32x4*)(xl + (sl ^ 1) * 512 + ioff); i1[0] = ip[0]; i1[1] = ip[1]; i1[2] = ip[16]; i1[3] = ip[17];
                const LAS u32x4* hp = (const LAS u32x4*)(xl + 1024 + sl * 256 + hoff); hb[0] = hp[0]; hb[1] = hp[4]; hb[2] = hp[8]; hb[3] = hp[12];
                asm volatile("s_waitcnt lgkmcnt(0)" : "+v"(i1[0]), "+v"(i1[1]), "+v"(i1[2]), "+v"(i1[3]), "+v"(hb[0]), "+v"(hb[1]), "+v"(hb[2]), "+v"(hb[3]) :: "memory");
            }
            asm volatile("s_waitcnt lgkmcnt(0)" : "+v"(a00), "+v"(a01), "+v"(a10), "+v"(a11) :: "memory");
            D5_DMA(i1, 4 * q); D5_DMA(i1, 4 * q + 1); D5_DMA(i1, 4 * q + 2); D5_DMA(i1, 4 * q + 3);
            asm volatile("" ::: "memory");
            const i32x8 b0 = D5_B(hb, 0), b1 = D5_B(hb, 1);
            const f32x4 z = {0.f, 0.f, 0.f, 0.f};
            acc[2 * q] = __builtin_amdgcn_mfma_scale_f32_16x16x128_f8f6f4(D5_A(a00), b0, z, 4, 0, 0, 0, 0, 0);
            acc[2 * q + 1] = __builtin_amdgcn_mfma_scale_f32_16x16x128_f8f6f4(D5_A(a10), b0, z, 4, 0, 0, 0, 0, 0);
            acc[2 * q] = __builtin_amdgcn_mfma_scale_f32_16x16x128_f8f6f4(D5_A(a01), b1, acc[2 * q], 4, 0, 0, 0, 0, 0);
            acc[2 * q + 1] = __builtin_amdgcn_mfma_scale_f32_16x16x128_f8f6f4(D5_A(a11), b1, acc[2 * q + 1], 4, 0, 0, 0, 0, 0);
        }
        if (m < 4) {
            float v[8];
#pragma unroll
            for (int j = 0; j < 8; ++j) v[j] = m == 0 ? acc[j].x : m == 1 ? acc[j].y : m == 2 ? acc[j].z : acc[j].w;
            *(u32x4*)(PART + (unsigned)(t0 * 256 + 16 * (4 * kg + m))) = (u32x4){pk2(v[0], v[1]), pk2(v[2], v[3]), pk2(v[4], v[5]), pk2(v[6], v[7])};
        }
    }
    asm volatile("s_waitcnt vmcnt(0)" ::: "memory");
}
template <int NS> __device__ __forceinline__ void peer_reduce_phase(const Frame& F, int layer) {
    const u32x2* PART = (const u32x2*)(F.ws + WS_PART); const int* IDX = (const int*)(F.ws + WS_IDX); const float* GATE = (const float*)(F.ws + WS_GATE);
    bf16_t* AB = (bf16_t*)(F.ws + WS_AB);
    const f32x2* scl = (const f32x2*)(F.ws + WS_SCL) + (size_t)layer * 16384;
    const size_t n4 = (size_t)T * 128 / 4, stride = (size_t)F.G * 512;
    for (size_t i = (size_t)blockIdx.x * 512 + F.tid; i < n4; i += stride) {
        u32x2 pw[NS];
#pragma unroll
        for (int p = 0; p < NS; ++p) pw[p] = PART[(size_t)p * T * 32 + i];
        const u32x4 e = ((const u32x4*)IDX)[i]; const f32x4 gt = ((const f32x4*)GATE)[i];
        const f32x2 c0 = scl[e.x], c1 = scl[e.y], c2 = scl[e.z], c3 = scl[e.w];
        f32x4 s = {0.f, 0.f, 0.f, 0.f};
#pragma unroll
        for (int p = 0; p < NS; ++p) { s.x += bflo(pw[p].x); s.y += bfhi(pw[p].x); s.z += bflo(pw[p].y); s.w += bfhi(pw[p].y); }
        f32x4 o;
        o.x = gelu_tanh(s.x * c0.x) * gt.x * c0.y; o.y = gelu_tanh(s.y * c1.x) * gt.y * c1.y;
        o.z = gelu_tanh(s.z * c2.x) * gt.z * c2.y; o.w = gelu_tanh(s.w * c3.x) * gt.w * c3.y;
        ((u32x2*)AB)[i] = (u32x2){pk2(o.x, o.y), pk2(o.z, o.w)};
    }
}
__device__ __forceinline__ void peer_reduce_phase8(const Frame& F, int layer) {
    const u32x2* PART = (const u32x2*)(F.ws + WS_PART); const int* IDX = (const int*)(F.ws + WS_IDX); const float* GATE = (const float*)(F.ws + WS_GATE);
    unsigned char* AB8 = F.ws + WS_AB;
    const f32x2* scl = (const f32x2*)(F.ws + WS_SCL) + (size_t)layer * 16384;
    const size_t n4 = (size_t)T * 128 / 4, stride = (size_t)F.G * 512;
    for (size_t i = (size_t)blockIdx.x * 512 + F.tid; i < n4; i += stride) {
        u32x2 pw[4];
#pragma unroll
        for (int p = 0; p < 4; ++p) pw[p] = PART[(size_t)p * T * 32 + i];
        const u32x4 e = ((const u32x4*)IDX)[i]; const f32x4 gt = ((const f32x4*)GATE)[i];
        const f32x2 c0 = scl[e.x], c1 = scl[e.y], c2 = scl[e.z], c3 = scl[e.w];
        f32x4 s = {0.f, 0.f, 0.f, 0.f};
#pragma unroll
        for (int p = 0; p < 4; ++p) { s.x += bflo(pw[p].x); s.y += bfhi(pw[p].x); s.z += bflo(pw[p].y); s.w += bfhi(pw[p].y); }
        f32x4 o;
        o.x = gelu_tanh(s.x * c0.x) * gt.x * c0.y; o.y = gelu_tanh(s.y * c1.x) * gt.y * c1.y;
        o.z = gelu_tanh(s.z * c2.x) * gt.z * c2.y; o.w = gelu_tanh(s.w * c3.x) * gt.w * c3.y;
        float am = fmaxf(fmaxf(fabsf(o.x), fabsf(o.y)), fmaxf(fabsf(o.z), fabsf(o.w)));
#pragma unroll
        for (int d = 1; d < 32; d <<= 1) am = fmaxf(am, __shfl_xor(am, d));
        const float S = am > 0.f ? 256.0f / am : 1.0f;
        int w = 0; w = __builtin_amdgcn_cvt_pk_fp8_f32(o.x * S, o.y * S, w, false); w = __builtin_amdgcn_cvt_pk_fp8_f32(o.z * S, o.w * S, w, true);
        const size_t t = i >> 5; const unsigned j = (unsigned)i & 31u;
        *(unsigned*)(AB8 + t * 256 + 4 * j) = (unsigned)w;
        if (j == 0) *(float*)(AB8 + t * 256 + 128) = am * (1.0f / 256.0f);
    }
}
__device__ __forceinline__ unsigned hadd2(unsigned a, unsigned b) { const h16x2 r = __builtin_bit_cast(h16x2, a) + __builtin_bit_cast(h16x2, b); return __builtin_bit_cast(unsigned, r); }
__device__ __forceinline__ f32x4 reduce_scatter32h_g(const unsigned (&v)[16], int lane) {
    const bool b2 = (lane & 32) != 0, b1 = (lane & 16) != 0, b0 = (lane & 8) != 0;
    unsigned u[8], w[4], z[2];
#pragma unroll
    for (int k = 0; k < 8; ++k) { const unsigned keep = b2 ? v[8 + k] : v[k], send = b2 ? v[k] : v[8 + k]; u[k] = hadd2(keep, (unsigned)__shfl_xor((int)send, 32)); }
#pragma unroll
    for (int k = 0; k < 4; ++k) { const unsigned keep = b1 ? u[4 + k] : u[k], send = b1 ? u[k] : u[4 + k]; w[k] = hadd2(keep, (unsigned)__shfl_xor((int)send, 16)); }
#pragma unroll
    for (int k = 0; k < 2; ++k) { const unsigned keep = b0 ? w[2 + k] : w[k], send = b0 ? w[k] : w[2 + k]; z[k] = hadd2(keep, (unsigned)__shfl_xor((int)send, 8)); }
    return (f32x4){hlo(z[0]), hhi(z[0]), hlo(z[1]), hhi(z[1])};
}
__device__ __forceinline__ void peer_up_phase4(const Frame& F, int layer) {
    const int bx = blockIdx.x, p4 = bx & 3, par = (bx >> 2) & 1;
    const unsigned char* TU = F.ws + WS_TAB + (size_t)(2 * layer + 1) * 16 * MiB + (size_t)p4 * (2 * MiB);
    const int* IDX = (const int*)(F.ws + WS_IDX); const char* AB = (const char*)(F.ws + WS_AB);
    const int nwp = (F.G - (bx & 7) + 7) >> 3, ww = (bx >> 3) * 8 + F.wave, stride = 2 * nwp * 8, tfirst = 2 * ww + par;
    const int lane = F.lane, r = lane & 7, g = lane >> 3, hoff = 256 * p4 + 32 * r + 4 * g;
    if (tfirst >= T) return;
    unsigned e1[16]; u32x4 wv[16];
    const unsigned toff = 16u * r;
    ld_off16(IDX, tfirst, g, toff, e1); gather16(TU, e1, wv);
    u32x4 a0a = *(const u32x4*)(AB + (unsigned)(tfirst * 256 + 32 * g)), a0b = *(const u32x4*)(AB + (unsigned)(tfirst * 256 + 32 * g + 16));
    { const int t1 = tfirst + stride < T ? tfirst + stride : tfirst; ld_off16(IDX, t1, g, toff, e1); }
    for (int t0 = tfirst; t0 < T; t0 += stride) {
        const int t1 = t0 + stride < T ? t0 + stride : t0, t2 = t0 + 2 * stride < T ? t0 + 2 * stride : t0;
        unsigned e2[16]; ld_off16(IDX, t2, g, toff, e2);
        const u32x4 a1a = *(const u32x4*)(AB + (unsigned)(t1 * 256 + 32 * g)), a1b = *(const u32x4*)(AB + (unsigned)(t1 * 256 + 32 * g + 16));
        f32x4* hp = (f32x4*)((char*)F.out + (unsigned)(t0 * 4096 + 4 * hoff)); const f32x4 h0 = *hp;
        const unsigned aw[8] = {a0a.x, a0a.y, a0a.z, a0a.w, a0b.x, a0b.y, a0b.z, a0b.w};
        unsigned y2[16];
#pragma unroll
        for (int k = 0; k < 16; ++k) y2[k] = 0u;
#pragma unroll
        for (int i = 0; i < 16; ++i) { u32x4 w = wv[i]; wv[i] = *(const u32x4*)(TU + e1[i]);
            if (i > 0) asm volatile("" : "+v"(w.x), "+v"(w.y), "+v"(w.z), "+v"(w.w) : "v"(y2[0]), "v"(y2[15]));
            const float ai = (i & 1) ? bfhi(aw[i >> 1]) : bflo(aw[i >> 1]); const h16x2 av = {(_Float16)ai, (_Float16)ai};
            const unsigned ww4[4] = {w.x, w.y, w.z, w.w};
#pragma unroll
            for (int k = 0; k < 4; ++k) {
                { const h16x2 r = av * __builtin_amdgcn_cvt_scalef32_pk_f16_fp4(ww4[k], 1.0f, 0) + __builtin_bit_cast(h16x2, y2[4 * k]); y2[4 * k] = __builtin_bit_cast(unsigned, r); }
                { const h16x2 r = av * __builtin_amdgcn_cvt_scalef32_pk_f16_fp4(ww4[k], 1.0f, 1) + __builtin_bit_cast(h16x2, y2[4 * k + 1]); y2[4 * k + 1] = __builtin_bit_cast(unsigned, r); }
                { const h16x2 r = av * __builtin_amdgcn_cvt_scalef32_pk_f16_fp4(ww4[k], 1.0f, 2) + __builtin_bit_cast(h16x2, y2[4 * k + 2]); y2[4 * k + 2] = __builtin_bit_cast(unsigned, r); }
                { const h16x2 r = av * __builtin_amdgcn_cvt_scalef32_pk_f16_fp4(ww4[k], 1.0f, 3) + __builtin_bit_cast(h16x2, y2[4 * k + 3]); y2[4 * k + 3] = __builtin_bit_cast(unsigned, r); } } }
        const f32x4 z = reduce_scatter32h_g(y2, lane);
        *hp = h0 + z;
        a0a = a1a; a0b = a1b;
#pragma unroll
        for (int i = 0; i < 16; ++i) e1[i] = e2[i];
    }
}

constexpr int U5_AUX = 131072;
__device__ __forceinline__ void peer_up_phase5(const Frame& F, int layer) {
    const int bx = blockIdx.x, p4 = bx & 3, par = (bx >> 2) & 1;
    const unsigned char* TU = F.ws + WS_TAB + (size_t)(2 * layer + 1) * 16 * MiB + (size_t)p4 * (2 * MiB);
    const char* IDX = (const char*)(F.ws + WS_IDX); const char* AB8 = (const char*)(F.ws + WS_AB);
    char* H8 = (char*)(F.ws + WS_H8) + 256 * p4; float* HSQ = (float*)(F.ws + WS_HSQ);
    const char* HIN = (const char*)F.out + 512 * p4; char* OUT = (layer == 1 ? (char*)(F.ws + WS_H2) : (char*)F.out) + 512 * p4;
    const int nwp = (F.G - (bx & 7) + 7) >> 3, ww = (bx >> 3) * 8 + F.wave, stride = 2 * nwp * 8, tfirst = 2 * ww + par;
    if (tfirst >= T) return;
    const int lane = F.lane, rs = lane >> 3, sg = lane & 7, m = lane & 15, kg = lane >> 4;
    LAS unsigned char* wl = F.lds + F.wave * 16384; LAS unsigned char* xl = F.lds + U5_AUX + F.wave * 3584;
    const unsigned sw0 = (unsigned)((sg ^ kg) * 16), sw1 = (unsigned)((sg ^ (4 + kg)) * 16);
    const unsigned l4 = 4u * lane, l16 = 16u * lane;
    unsigned tb[8];
#pragma unroll
    for (int sgm = 0; sgm < 8; ++sgm) tb[sgm] = (unsigned)((32 * kg + m) * 128 + ((sgm ^ (m >> 1)) * 16));
    const unsigned hrd = (unsigned)(32 * m + 8 * kg);
#define U5_PIECE(ixv, d) __builtin_amdgcn_global_load_lds((const unsigned*)(TU + ((ixv)[d] * 128u + (((d) & 1) ? sw1 : sw0))), (LAS unsigned*)(wl + (d) * 1024), 16, 0, 0)
#define U5_DMA_IDX(t, slot) do { __builtin_amdgcn_global_load_lds((const unsigned*)(IDX + (unsigned)((t) * 512) + l4), (LAS unsigned*)(xl + (slot) * 512), 4, 0, 0); \
                                 __builtin_amdgcn_global_load_lds((const unsigned*)(IDX + (unsigned)((t) * 512) + 256u + l4), (LAS unsigned*)(xl + (slot) * 512 + 256), 4, 0, 0); } while (0)
#define U5_DMA_AB(t, slot) __builtin_amdgcn_global_load_lds((const unsigned*)(AB8 + (unsigned)((t) * 256) + l4), (LAS unsigned*)(xl + 1024 + (slot) * 256), 4, 0, 0)
#define U5_DMA_H(t, slot) do { __builtin_amdgcn_global_load_lds((const unsigned*)(HIN + (unsigned)((t) * 2048) + l4), (LAS unsigned*)(xl + 1536 + (slot) * 1024), 4, 0, 0); \
                               __builtin_amdgcn_global_load_lds((const unsigned*)(HIN + (unsigned)((t) * 2048) + 256u + l4), (LAS unsigned*)(xl + 1536 + (slot) * 1024 + 256), 4, 0, 0); } while (0)
    { unsigned i0[16];
#pragma unroll
      for (int d = 0; d < 16; ++d) i0[d] = *(const unsigned*)(IDX + (unsigned)(tfirst * 512) + (unsigned)(4 * rs + 32 * d));
#pragma unroll
      for (int d = 0; d < 16; ++d) asm volatile("" : "+v"(i0[d]) :: "memory");
      { const int t1 = tfirst + stride < T ? tfirst + stride : tfirst; U5_DMA_IDX(t1, 1); U5_DMA_AB(tfirst, 0); U5_DMA_H(tfirst, 0); }
      asm volatile("" ::: "memory");
#pragma unroll
      for (int d = 0; d < 16; ++d) U5_PIECE(i0, d); }
    int sl = 0, tprev = -1; f32x4 pend = {0.f, 0.f, 0.f, 0.f};
    for (int t0 = tfirst; t0 < T; t0 += stride, sl ^= 1) {
        const int t1 = t0 + stride < T ? t0 + stride : t0, t2 = t0 + 2 * stride < T ? t0 + 2 * stride : t0;
        asm volatile("s_waitcnt vmcnt(0)" ::: "memory");
        unsigned ix[16];
        { const LAS unsigned* ip = (const LAS unsigned*)(xl + (sl ^ 1) * 512 + 4 * rs);
#pragma unroll
          for (int d = 0; d < 16; ++d) ix[d] = ip[8 * d]; }
        const LAS u32x4* bp = (const LAS u32x4*)(xl + 1024 + sl * 256 + 16 * kg); u32x4 bl = bp[0], bh = bp[4];
        float inv = *(const LAS float*)(xl + 1024 + sl * 256 + 128);
        u32x2 hw = *(const LAS u32x2*)(xl + 1536 + sl * 1024 + hrd);
        i32x2 a0[16], a1[16];
#pragma unroll
        for (int cb = 0; cb < 16; ++cb) {
            a0[cb] = __builtin_amdgcn_ds_read_tr4_b64_v2i32((LAS i32x2*)(wl + tb[cb >> 1] + (cb & 1) * 8));
            a1[cb] = __builtin_amdgcn_ds_read_tr4_b64_v2i32((LAS i32x2*)(wl + tb[cb >> 1] + (cb & 1) * 8 + 2048)); }
        asm volatile("s_waitcnt lgkmcnt(0)" : "+v"(bl), "+v"(bh), "+v"(inv), "+v"(hw) :: "memory");
#pragma unroll
        for (int d = 0; d < 16; ++d) asm volatile("" : "+v"(ix[d]), "+v"(a0[d]), "+v"(a1[d]) :: "memory");
        if (tprev >= 0) { *(u32x2*)(OUT + (unsigned)(tprev * 2048) + hrd) = (u32x2){pk2(pend.x, pend.y), pk2(pend.z, pend.w)};
            if (layer == 0) { int w8 = 0; w8 = __builtin_amdgcn_cvt_pk_fp8_f32(pend.x, pend.y, w8, false); w8 = __builtin_amdgcn_cvt_pk_fp8_f32(pend.z, pend.w, w8, true);
                *(unsigned*)(H8 + (unsigned)(tprev * 1024) + (hrd >> 1)) = (unsigned)w8;
                const float sq = wave_sum((pend.x * pend.x + pend.y * pend.y) + (pend.z * pend.z + pend.w * pend.w));
                if (lane == 0) HSQ[tprev * 4 + p4] = sq; } }
        asm volatile("" ::: "memory");
        U5_DMA_IDX(t2, sl); U5_DMA_AB(t1, sl ^ 1); U5_DMA_H(t1, sl ^ 1);
#pragma unroll
        for (int d = 0; d < 16; ++d) U5_PIECE(ix, d);
        asm volatile("" ::: "memory");
        const i32x8 b = {(int)bl.x, (int)bl.y, (int)bl.z, (int)bl.w, (int)bh.x, (int)bh.y, (int)bh.z, (int)bh.w};
        const f32x4 z = {0.f, 0.f, 0.f, 0.f};
        f32x4 v = z;
#pragma unroll
        for (int cb = 0; cb < 16; ++cb) {
            const i32x8 a = {a0[cb].x, a0[cb].y, a1[cb].x, a1[cb].y, 0, 0, 0, 0};
            const f32x4 r = __builtin_amdgcn_mfma_scale_f32_16x16x128_f8f6f4(a, b, z, 4, 0, 0, 0, 0, 0);
            v = (m == cb) ? r : v; }
        pend = (f32x4){bflo(hw.x), bfhi(hw.x), bflo(hw.y), bfhi(hw.y)} + v * inv; tprev = t0;
    }
    asm volatile("s_waitcnt vmcnt(0)" ::: "memory");
    *(u32x2*)(OUT + (unsigned)(tprev * 2048) + hrd) = (u32x2){pk2(pend.x, pend.y), pk2(pend.z, pend.w)};
    if (layer == 0) { int w8 = 0; w8 = __builtin_amdgcn_cvt_pk_fp8_f32(pend.x, pend.y, w8, false); w8 = __builtin_amdgcn_cvt_pk_fp8_f32(pend.z, pend.w, w8, true);
        *(unsigned*)(H8 + (unsigned)(tprev * 1024) + (hrd >> 1)) = (unsigned)w8;
        const float sq = wave_sum((pend.x * pend.x + pend.y * pend.y) + (pend.z * pend.z + pend.w * pend.w));
        if (lane == 0) HSQ[tprev * 4 + p4] = sq; }
#undef U5_PIECE
#undef U5_DMA_IDX
#undef U5_DMA_AB
#undef U5_DMA_H
}

constexpr int SGM_VT = 0, SGM_WL = 384 * 272, SGM_STAT = SGM_WL + 128 * 272;
__device__ __forceinline__ void sg_mix_phase(const Frame& F) {
    bf16_t* V = (bf16_t*)(F.ws + WS_SG);
    const float* lng = F.in[7]; const float* lnb = F.in[8]; const float* wsp = F.in[9]; const float* bsp = F.in[10];
    LAS unsigned* VT32 = (LAS unsigned*)(F.lds + SGM_VT); LAS bf16_t* VT = (LAS bf16_t*)(F.lds + SGM_VT); LAS bf16_t* WL = (LAS bf16_t*)(F.lds + SGM_WL);
    LAS float* stat = (LAS float*)(F.lds + SGM_STAT);
    const int lane = F.lane, tid = F.tid, fr = lane & 15, fq = lane >> 4;
    for (int c = blockIdx.x; c < 256; c += F.G) {
#pragma unroll 1
        for (int r = 0; r < 16; ++r) {
            const int q = F.wave * 16 + r; const u32x4* row = (const u32x4*)(V + (size_t)(c * 128 + q) * DG);
            float v[48]; float s = 0.f;
#pragma unroll
            for (int i = 0; i < 6; ++i) { const u32x4 w = row[lane + 64 * i];
                v[8 * i + 0] = bflo(w.x); v[8 * i + 1] = bfhi(w.x); v[8 * i + 2] = bflo(w.y); v[8 * i + 3] = bfhi(w.y); v[8 * i + 4] = bflo(w.z); v[8 * i + 5] = bfhi(w.z); v[8 * i + 6] = bflo(w.w); v[8 * i + 7] = bfhi(w.w); }
#pragma unroll
            for (int i = 0; i < 48; ++i) s += v[i];
            const float mean = wave_sum(s) * (1.f / DG); float s2 = 0.f;
#pragma unroll
            for (int i = 0; i < 48; ++i) { const float d = v[i] - mean; s2 += d * d; }
            const float rstd = 1.0f / sqrtf(wave_sum(s2) * (1.f / DG) + 1e-5f);
            if (lane == 0) { stat[2 * q] = mean; stat[2 * q + 1] = rstd; }
        }
        __syncthreads();
#pragma unroll 1
        for (int g = 0; g < 8; ++g) {
#pragma unroll 1
            for (int it = 0; it < 4; ++it) { const int item = it * 512 + tid, p = item >> 4, q8 = (item & 15) * 8;
                const f32x4* wp = (const f32x4*)(wsp + ((size_t)g * 128 + p) * 128 + q8); const f32x4 a = wp[0], b = wp[1];
                u32x4 w; w.x = pk2(a.x, a.y); w.y = pk2(a.z, a.w); w.z = pk2(b.x, b.y); w.w = pk2(b.z, b.w);
                *(LAS u32x4*)(WL + p * 136 + q8) = w; }
#pragma unroll 1
            for (int it = 0; it < 6; ++it) { const int item = it * 512 + tid, qp = item & 63, dc = item >> 6; const int q0 = 2 * qp, col = g * 384 + 8 * dc;
                const u32x4 w0 = *(const u32x4*)(V + (size_t)(c * 128 + q0) * DG + col), w1 = *(const u32x4*)(V + (size_t)(c * 128 + q0 + 1) * DG + col);
                const float mu0 = stat[2 * q0], rs0 = stat[2 * q0 + 1], mu1 = stat[2 * q0 + 2], rs1 = stat[2 * q0 + 3];
                const f32x4 ga = *(const f32x4*)(lng + col), gb = *(const f32x4*)(lng + col + 4), ba = *(const f32x4*)(lnb + col), bb = *(const f32x4*)(lnb + col + 4);
                const float gm[8] = {ga.x, ga.y, ga.z, ga.w, gb.x, gb.y, gb.z, gb.w}, bt[8] = {ba.x, ba.y, ba.z, ba.w, bb.x, bb.y, bb.z, bb.w};
                const float a0[8] = {bflo(w0.x), bfhi(w0.x), bflo(w0.y), bfhi(w0.y), bflo(w0.z), bfhi(w0.z), bflo(w0.w), bfhi(w0.w)};
                const float a1[8] = {bflo(w1.x), bfhi(w1.x), bflo(w1.y), bfhi(w1.y), bflo(w1.z), bfhi(w1.z), bflo(w1.w), bfhi(w1.w)};
#pragma unroll
                for (int i = 0; i < 8; ++i) VT32[(8 * dc + i) * 68 + qp] = pk2((a0[i] - mu0) * rs0 * gm[i] + bt[i], (a1[i] - mu1) * rs1 * gm[i] + bt[i]); }
            __syncthreads();
            f32x4 acc[3][8];
#pragma unroll
            for (int a = 0; a < 3; ++a)
#pragma unroll
                for (int n = 0; n < 8; ++n) acc[a][n] = (f32x4){0.f, 0.f, 0.f, 0.f};
#pragma unroll 1
            for (int ks = 0; ks < 4; ++ks) { const int k0 = 32 * ks + 8 * fq;
                bf16x8 af[3], bfg[8];
#pragma unroll
                for (int a = 0; a < 3; ++a) af[a] = *(const LAS bf16x8*)(VT + (16 * (3 * F.wave + a) + fr) * 136 + k0);
#pragma unroll
                for (int n = 0; n < 8; ++n) bfg[n] = *(const LAS bf16x8*)(WL + (16 * n + fr) * 136 + k0);
#pragma unroll
                for (int a = 0; a < 3; ++a)
#pragma unroll
                    for (int n = 0; n < 8; ++n) acc[a][n] = __builtin_amdgcn_mfma_f32_16x16x32_bf16(af[a], bfg[n], acc[a][n], 0, 0, 0); }
#pragma unroll
            for (int n = 0; n < 8; ++n) { const int p = 16 * n + fr; const float bs = bsp[g * 128 + p];
#pragma unroll
                for (int a = 0; a < 3; ++a) { const int d0 = 16 * (3 * F.wave + a) + 4 * fq;
                    u32x2 w; w.x = pk2(acc[a][n][0] + bs, acc[a][n][1] + bs); w.y = pk2(acc[a][n][2] + bs, acc[a][n][3] + bs);
                    *(u32x2*)(V + (size_t)(c * 128 + p) * DG + g * 384 + d0) = w; } }
            __syncthreads();
        }
    }
}

__global__ void __launch_bounds__(512, 2) fwd(Args args) {
    extern __shared__ __attribute__((aligned(16))) unsigned char lds_raw[];
    Frame F;
    F.lds = (LAS unsigned char*)lds_raw;
    F.tid = threadIdx.x; F.lane = F.tid & 63; F.wave = __builtin_amdgcn_readfirstlane(F.tid >> 6);
    F.G = gridDim.x; F.gw = blockIdx.x * 8 + F.wave; F.NGW = F.G * 8;
    F.in = args.in; F.out = args.out; F.ws = args.ws;
    volatile LAS unsigned* MISC = (volatile LAS unsigned*)(F.lds + MISC_OFF);
    if (F.tid < 64) MISC[F.tid] = 0u;
    __syncthreads();
    const int lo = args.ph_lo, hi = args.ph_hi;
    unsigned* barw = (unsigned*)(F.ws + WS_CTL) + CW_BAR;
    XcdBarrier bar; bar.bar = barw; bar.x = 0; bar.st = MISC + 8;
    if (hi - lo > 1) bar = xcd_barrier_post(barw, MISC + 8);
#define IN(k) (lo <= (k) && (k) < hi)
#define SEAM(k) do { if (IN(k) && IN((k) + 1)) xcd_barrier(bar); } while (0)
    const int G = F.G, bx = blockIdx.x;
    bf16_t* HN = (bf16_t*)(F.ws + WS_HN); bf16_t* HB = (bf16_t*)F.out;

    if (IN(0)) { p0_prologue(F); } SEAM(0);
    if (IN(1)) {
        const bf16_t* HN8 = (const bf16_t*)(F.ws + WS_HN8B);
        { pg8::Gemm g{HN8, (const bf16_t*)(F.ws + WS_WQK), T, NQK, D / 2}; pg8::StaticOrder S; S.init(T, NQK, G, bx);
          pg8::EpiBf<3> E{(bf16_t*)(F.ws + WS_Q), 1024, (bf16_t*)(F.ws + WS_K), 1.0f / W8_SCALE};
          pg8::gemm_phase<1>(F.lds, g, S, E); }
        __syncthreads();
        { pg8::Gemm g{(const bf16_t*)(F.ws + WS_WV), HN8, 256, T, D / 2}; pg8::StaticOrder S; S.init(256, T, G, (bx + G / 2) % G);
          pg8::EpiBf<0> E{(bf16_t*)(F.ws + WS_VT), T, nullptr, 1.0f / W8_SCALE};
          pg8::gemm_phase<1>(F.lds, g, S, E); }
    } SEAM(1);
    if (IN(2)) { attn_phase_v2(F); } SEAM(2);
    if (IN(3)) {
        pg8::Gemm g{(const bf16_t*)(F.ws + WS_AO), (const bf16_t*)(F.ws + WS_WO), T, D, D / 2}; pg8::StaticOrder S; S.init(T, D, G, bx);
        pg8::EpiBf<6> E{HB, D, (bf16_t*)F.in[0], 1.0f / (W8_SCALE * AO8_SCALE)};
        pg8::gemm_phase<1>(F.lds, g, S, E);
    } SEAM(3);
    if (IN(4)) { quant_wqk(F); rmsnorm_rows_bf(F, HB, F.in[12], nullptr, F.ws + WS_HN8, F.ws + WS_HNI8, (float*)(F.ws + WS_HSC)); } SEAM(4);
    if (IN(5)) {
        pg8::Gemm g{(const bf16_t*)(F.ws + WS_HNI8), (const bf16_t*)(F.ws + WS_WQ8), T, 2048, D / 2}; pg8::StaticOrder S; S.init(T, 2048, G, bx);
        pg8::EpiBf<8> E{(bf16_t*)(F.ws + WS_S), 2048, (bf16_t*)(F.ws + WS_HSC), 1.0f, (const float*)(F.ws + WS_CTL) + CW_WSCL};
        pg8::gemm_phase<2>(F.lds, g, S, E);
    } SEAM(5);
    if (IN(6)) { topk_phase_v3(F); } SEAM(6);
    if (IN(7)) { peer_down_phase5(F, 0); } SEAM(7);
    if (IN(8)) { peer_reduce_phase8(F, 0); } SEAM(8);
    if (IN(9)) { peer_up_phase5(F, 0); } SEAM(9);
    if (IN(11)) {
        pg8::Gemm g{(const bf16_t*)(F.ws + WS_H8), (const bf16_t*)(F.ws + WS_WSGV), T, DG, D / 2}; pg8::StaticOrder S; S.init(T, DG, G, bx);
        pg8::EpiBf<1, true> E{(bf16_t*)(F.ws + WS_SG), DG, nullptr, 1.0f / W8_SCALE, nullptr, (const float*)(F.ws + WS_HSQ)};
        pg8::gemm_phase<1>(F.lds, g, S, E);
    } SEAM(11);
    if (IN(12)) { sg_mix_phase(F); } SEAM(12);
    if (IN(13)) {
        pg8::Gemm g{(const bf16_t*)(F.ws + WS_H8), (const bf16_t*)(F.ws + WS_WSGU), T, DG, D / 2}; pg8::StaticOrder S; S.init(T, DG, G, bx);
        pg8::EpiBf<5, true> E{(bf16_t*)(F.ws + WS_SG), DG, (bf16_t*)(F.ws + WS_SG8), 1.0f / W8_SCALE, nullptr, (const float*)(F.ws + WS_HSQ)};
        pg8::gemm_phase<1>(F.lds, g, S, E);
    } SEAM(13);
    if (IN(14)) {
        pg8::Gemm g{(const bf16_t*)(F.ws + WS_SG8), (const bf16_t*)(F.ws + WS_WSGO), T, D, DG / 2}; pg8::StaticOrder S; S.init(T, D, G, bx);
        pg8::EpiBf<7> E{HB, D, nullptr, 1.0f / W8_SCALE};
        pg8::gemm_phase<1>(F.lds, g, S, E);
    } SEAM(14);
    if (IN(15)) { rmsnorm_rows_bf(F, HB, F.in[12] + D, nullptr, F.ws + WS_HN8, F.ws + WS_HNI8, (float*)(F.ws + WS_HSC)); } SEAM(15);
    if (IN(16)) {
        pg8::Gemm g{(const bf16_t*)(F.ws + WS_HNI8), (const bf16_t*)(F.ws + WS_WQ8 + (size_t)2048 * 1024), T, 2048, D / 2}; pg8::StaticOrder S; S.init(T, 2048, G, bx);
        pg8::EpiBf<8> E{(bf16_t*)(F.ws + WS_S), 2048, (bf16_t*)(F.ws + WS_HSC), 1.0f, (const float*)(F.ws + WS_CTL) + CW_WSCL + 2048};
        pg8::gemm_phase<2>(F.lds, g, S, E);
    } SEAM(16);
    if (IN(17)) { topk_phase_v3(F); } SEAM(17);
    if (IN(18)) { peer_down_phase5(F, 1); } SEAM(18);
    if (IN(19)) { peer_reduce_phase8(F, 1); } SEAM(19);
    if (IN(20)) { peer_up_phase5(F, 1); } SEAM(20);
    if (IN(21)) { final_norm_bf(F, (const bf16_t*)(F.ws + WS_H2), F.out, F.in[17]); }
#undef IN
#undef SEAM
}

extern "C" void kernel_launch(void* const* d_in, const int* in_sizes, int n_in, void* d_out, int out_size, void* d_ws, size_t ws_size, hipStream_t stream) {
    static int grid = 0;
    if (grid == 0) {
        if (n_in != 18 || out_size != T * D || ws_size < WS_END) { fprintf(stderr, "kernel_launch: unexpected problem (n_in %d, out %d, ws %zu)\n", n_in, out_size, ws_size); grid = -1; return; }
        int dev = 0, cus = 0, per_cu = 0;
        if (hipGetDevice(&dev) != hipSuccess || hipDeviceGetAttribute(&cus, hipDeviceAttributeMultiprocessorCount, dev) != hipSuccess) { grid = -1; return; }
        if (hipFuncSetAttribute((const void*)fwd, hipFuncAttributeMaxDynamicSharedMemorySize, LDS_BYTES) != hipSuccess) { fprintf(stderr, "kernel_launch: hipFuncSetAttribute failed\n"); grid = -1; return; }
        if (hipOccupancyMaxActiveBlocksPerMultiprocessor(&per_cu, (const void*)fwd, 512, LDS_BYTES) != hipSuccess || per_cu < 1) fprintf(stderr, "kernel_launch: occupancy query says %d\n", per_cu);
        (void)hipGetLastError();
        grid = cus;
    }
    if (grid < 0) return;
    (void)hipMemsetAsync((char*)d_ws + WS_CTL, 0, CTL_ZERO_BYTES, stream);
    Args a{};
    for (int i = 0; i < 18; ++i) a.in[i] = (const float*)d_in[i];
    a.out = (float*)d_out; a.ws = (unsigned char*)d_ws;
#if MK_ONE_LAUNCH
    a.ph_lo = 0; a.ph_hi = NPH;
    hipLaunchKernelGGL(fwd, dim3(grid), dim3(512), LDS_BYTES, stream, a);
#else
    for (int ph = 0; ph < NPH; ++ph) {
        a.ph_lo = ph; a.ph_hi = ph + 1;
        hipLaunchKernelGGL(fwd, dim3(grid), dim3(512), LDS_BYTES, stream, a);
    }
#endif
}
```

```cpp
#include <hip/hip_runtime.h>
#include <cstdio>

#ifndef MK_ONE_LAUNCH
#define MK_ONE_LAUNCH 1
#endif

#define LAS __attribute__((address_space(3)))
#define GAS __attribute__((address_space(1)))
typedef unsigned short bf16_t;
typedef short bf16x8 __attribute__((ext_vector_type(8)));
typedef float f32x4 __attribute__((ext_vector_type(4)));
typedef float f32x2 __attribute__((ext_vector_type(2)));
typedef unsigned u32x4 __attribute__((ext_vector_type(4)));
typedef unsigned u32x2 __attribute__((ext_vector_type(2)));
typedef int i32x8 __attribute__((ext_vector_type(8)));
typedef int i32x2 __attribute__((ext_vector_type(2)));
typedef int i32x4 __attribute__((ext_vector_type(4)));

constexpr int T = 32768, D = 1024, SEQ = 2048;
constexpr int DG = 3072;
constexpr int NQK = 1280;
constexpr int NPH = 22;

constexpr size_t MiB = 1u << 20;
constexpr size_t WS_CTL = 0, CTL_ZERO_BYTES = 1 * MiB;
constexpr size_t WS_BIAS = 1 * MiB;
constexpr size_t WS_WQK = 2 * MiB;
constexpr size_t WS_WV = WS_WQK + (size_t)1280 * 1024 * 2;
constexpr size_t WS_WO = 5 * MiB;
constexpr size_t WS_WSGV = 7 * MiB;
constexpr size_t WS_WSGU = 13 * MiB;
constexpr size_t WS_WSGO = 19 * MiB;
constexpr size_t WS_WQKP = 25 * MiB;
constexpr size_t WS_HN = 34 * MiB;
constexpr size_t WS_SCL = 1 * MiB + 64 * 1024;
constexpr size_t WS_TAB = 98 * MiB;
constexpr size_t WS_IDX = 162 * MiB;
constexpr size_t WS_GATE = 178 * MiB;
constexpr size_t WS_SCR = 194 * MiB;
constexpr size_t WS_Q = WS_SCR, WS_K = WS_SCR + 64 * MiB, WS_VT = WS_SCR + 80 * MiB, WS_AO = WS_SCR + 96 * MiB;
constexpr size_t WS_S = WS_SCR;
constexpr size_t WS_SG = WS_SCR;
constexpr size_t WS_PART = WS_SCR;
constexpr size_t WS_AB = WS_SCR + 128 * MiB;
constexpr size_t WS_HN8 = WS_SCR + 200 * MiB;
constexpr size_t WS_H8 = 34 * MiB;
constexpr size_t WS_HSQ = 34 * MiB + 40 * MiB;
constexpr size_t WS_END = WS_SCR + 292 * MiB;
constexpr int CW_BAR = 4096;
constexpr int CW_COLMAX = 16384;
constexpr int CW_WSCL = 32768;
constexpr size_t WS_WQ8 = WS_SCR + 288 * MiB;
constexpr size_t WS_HNI8 = 34 * MiB;
constexpr size_t WS_HSC = 34 * MiB + 32 * MiB;
constexpr size_t WS_H2 = WS_SCR + 32 * MiB;
constexpr float AO8_SCALE = 8.0f;
constexpr float W8_SCALE = 256.0f;
constexpr size_t WS_HN8B = WS_IDX;
constexpr size_t WS_SG8 = WS_SCR + 192 * MiB;

constexpr int LDS_BYTES = 163840;
constexpr int MISC_OFF = LDS_BYTES - 256;

typedef __bf16 bfx2 __attribute__((ext_vector_type(2)));
__device__ __forceinline__ unsigned pk2(float lo, float hi) { const bfx2 v = {(__bf16)lo, (__bf16)hi}; return __builtin_bit_cast(unsigned, v); }
__device__ __forceinline__ unsigned f2bf(float f) { return pk2(f, 0.f) & 0xffffu; }
typedef _Float16 h16x2 __attribute__((ext_vector_type(2)));
__device__ __forceinline__ unsigned pkh2(float lo, float hi) { const h16x2 h = {(_Float16)lo, (_Float16)hi}; return __builtin_bit_cast(unsigned, h); }
__device__ __forceinline__ float hlo(unsigned w) { return (float)__builtin_bit_cast(h16x2, w).x; }
__device__ __forceinline__ float hhi(unsigned w) { return (float)__builtin_bit_cast(h16x2, w).y; }
__device__ __forceinline__ float bflo(unsigned w) { return __builtin_bit_cast(float, w << 16); }
__device__ __forceinline__ float bfhi(unsigned w) { return __builtin_bit_cast(float, w & 0xffff0000u); }
__device__ __forceinline__ float bf2f(bf16_t b) { return __builtin_bit_cast(float, ((unsigned)b) << 16); }
__device__ __forceinline__ float wave_sum(float v) {
#pragma unroll
    for (int o = 1; o < 64; o <<= 1) v += __shfl_xor(v, o);
    return v;
}
__device__ __forceinline__ float wave_max(float v) {
#pragma unroll
    for (int o = 1; o < 64; o <<= 1) v = fmaxf(v, __shfl_xor(v, o));
    return v;
}
__device__ __forceinline__ unsigned wave_max_u(unsigned v) {
#pragma unroll
    for (int o = 1; o < 64; o <<= 1) { const unsigned w = (unsigned)__shfl_xor((int)v, o); v = w > v ? w : v; }
    return v;
}
__device__ __forceinline__ float gelu_tanh(float x) {
    const float u = x * (-2.302208198144325f) * (1.0f + 0.044715f * x * x);
    return x * __builtin_amdgcn_rcpf(1.0f + __builtin_amdgcn_exp2f(u));
}
#define LDS_WAIT() asm volatile("s_waitcnt lgkmcnt(0)" ::: "memory")
#define VM_WAIT() asm volatile("s_waitcnt vmcnt(0)" ::: "memory")

namespace pg8 {
#define PG8_LAS __attribute__((address_space(3)))
constexpr int BM = 256, BK = 64, HALF = 128, HTB = HALF * BK * 2, STAGE_BYTES = 8 * HTB, NXCD = 8, WGM = 8;
__host__ __device__ __forceinline__ int lds_byte(int r, int c) { const int st = (r >> 4) * 2 + (c >> 5), rr = r & 15, cc = c & 31, ob = rr * 64 + cc * 2; return st * 1024 + (ob ^ (((ob >> 9) & 1) << 5)); }
__host__ __device__ __forceinline__ void stage_rc(int b, int& R, int& C) { const int st = b / 1024, sb = b % 1024, swz = sb ^ (((sb >> 9) & 1) << 5); R = (st >> 1) * 16 + swz / 64; C = (st & 1) * 32 + (swz % 64) / 2; }
__host__ __device__ __forceinline__ int perm32(int rho) { const int n = rho >> 4, i = rho & 15; return 8 * (i >> 2) + 4 * n + (i & 3); }
struct Unit { int pm, pn; };
struct Gemm { const bf16_t* A; const bf16_t* Bt; int M, N, K; };
struct StaticOrder {
    int nM, nN, nwg, G, c;
    __host__ __device__ void init(int M, int N, int G_, int c_) { nM = M / BM; nN = N / BM; nwg = nM * nN; G = G_; c = c_; }
    __host__ __device__ bool next(int i, Unit& u) const {
        const long L = (long)i * G + c; if (L >= nwg) return false;
        int wgid = (int)L; { const int q = nwg / NXCD, r = nwg % NXCD, xcd = wgid % NXCD, off = wgid / NXCD; wgid = (xcd < r ? xcd * (q + 1) : r * (q + 1) + (xcd - r) * q) + off; }
        const int nig = WGM * nN, gid = wgid / nig, fm = gid * WGM, gsz = (nM - fm) < WGM ? (nM - fm) : WGM;
        u.pm = fm + ((wgid % nig) % gsz); u.pn = (wgid % nig) / gsz; return true;
    }
    __device__ __forceinline__ void a_ready(const Unit&) const {}
    __device__ __forceinline__ void done(const Unit&) const {}
};

template <int MODE, bool RSQ = false> struct EpiBf {
    static constexpr int PERM = (MODE == 5) ? 2 : 1; static constexpr bool AFTER_DRAIN = false;
    bf16_t* O; int ldc; bf16_t* O2; float sc = 1.0f; const float* aux = nullptr; const float* rsq = nullptr;
    __device__ __forceinline__ void operator()(const f32x4 (&acc)[2][2][4][2], const Unit& u, int wr, int wc, int fr, int fq) const {
        const int row0 = u.pm * BM + wr * 64 + fr; int colt = u.pn * BM; bf16_t* base = O; int ld = ldc;
        if (MODE == 3) { if (u.pn >= 4) { base = O2; ld = 256; colt = 0; } else { ld = 1024; } }
        if (MODE == 5) {
            const int c16 = colt + wc * 64 + 16 * fq;
            float rr[2][4];
#pragma unroll
            for (int ai = 0; ai < 2; ++ai)
#pragma unroll
                for (int m = 0; m < 4; ++m) { rr[ai][m] = sc;
                    if (RSQ) { const f32x4 q4 = *(const f32x4*)(rsq + (size_t)(row0 + ai * HALF + m * 16) * 4); rr[ai][m] = sc * __builtin_amdgcn_rsqf(((q4.x + q4.y) + (q4.z + q4.w)) * (1.f / 1024.f) + 1e-6f); } }
#pragma unroll
            for (int ai = 0; ai < 2; ++ai) {
                u32x4 mx[4][2];
#pragma unroll
                for (int m = 0; m < 4; ++m) { const u32x4* mp = (const u32x4*)(O + (size_t)(row0 + ai * HALF + m * 16) * ld + c16); mx[m][0] = mp[0]; mx[m][1] = mp[1]; }
#pragma unroll
                for (int m = 0; m < 4; ++m) { unsigned ow[4];
#pragma unroll
                    for (int bj = 0; bj < 2; ++bj) { f32x4 v0 = acc[ai][bj][m][0] * rr[ai][m], v1 = acc[ai][bj][m][1] * rr[ai][m]; const u32x4 mv = mx[m][bj];
#pragma unroll
                        for (int j = 0; j < 4; ++j) { v0[j] = gelu_tanh(v0[j]); v1[j] = gelu_tanh(v1[j]); }
                        v0[0] *= bflo(mv.x); v0[1] *= bfhi(mv.x); v0[2] *= bflo(mv.y); v0[3] *= bfhi(mv.y); v1[0] *= bflo(mv.z); v1[1] *= bfhi(mv.z); v1[2] *= bflo(mv.w); v1[3] *= bfhi(mv.w);
                        int w0 = 0, w1 = 0;
                        w0 = __builtin_amdgcn_cvt_pk_fp8_f32(v0[0], v0[1], w0, false); w0 = __builtin_amdgcn_cvt_pk_fp8_f32(v0[2], v0[3], w0, true);
                        w1 = __builtin_amdgcn_cvt_pk_fp8_f32(v1[0], v1[1], w1, false); w1 = __builtin_amdgcn_cvt_pk_fp8_f32(v1[2], v1[3], w1, true);
                        ow[2 * bj] = (unsigned)w0; ow[2 * bj + 1] = (unsigned)w1; }
                    *(u32x4*)((unsigned char*)O2 + (size_t)(row0 + ai * HALF + m * 16) * ld + c16) = (u32x4){ow[0], ow[1], ow[2], ow[3]}; } }
            return;
        }
        const int col0 = colt + wc * 32 + 8 * fq;
        float rrow[2][4]; f32x4 ccol[2][2];
        if (RSQ || MODE == 8) {
#pragma unroll
            for (int ai = 0; ai < 2; ++ai)
#pragma unroll
                for (int m = 0; m < 4; ++m) { const int row = row0 + ai * HALF + m * 16;
                    if (RSQ) { const f32x4 q4 = *(const f32x4*)(rsq + (size_t)row * 4); rrow[ai][m] = ((q4.x + q4.y) + (q4.z + q4.w)) * (1.f / 1024.f) + 1e-6f; }
                    else rrow[ai][m] = ((const float*)O2)[row]; }
            if (MODE == 8) {
#pragma unroll
                for (int bj = 0; bj < 2; ++bj) { const f32x4* cp = (const f32x4*)(aux + col0 + bj * HALF); ccol[bj][0] = cp[0]; ccol[bj][1] = cp[1]; } }
            if (RSQ) {
#pragma unroll
                for (int ai = 0; ai < 2; ++ai)
#pragma unroll
                    for (int m = 0; m < 4; ++m) rrow[ai][m] = __builtin_amdgcn_rsqf(rrow[ai][m]); }
        }
#pragma unroll
        for (int ai = 0; ai < 2; ++ai) {
          u32x4 pre[4][2]; f32x4 prex[4][2][2];
          if (MODE == 2 || MODE == 5 || MODE == 7) {
#pragma unroll
            for (int m = 0; m < 4; ++m)
#pragma unroll
                for (int bj = 0; bj < 2; ++bj) pre[m][bj] = *(const u32x4*)(base + (size_t)(row0 + ai * HALF + m * 16) * ld + col0 + bj * HALF); }
          if (MODE == 6) {
#pragma unroll
            for (int m = 0; m < 4; ++m)
#pragma unroll
                for (int bj = 0; bj < 2; ++bj) { const f32x4* xp = (const f32x4*)((const float*)O2 + (size_t)(row0 + ai * HALF + m * 16) * ld + col0 + bj * HALF); prex[m][bj][0] = xp[0]; prex[m][bj][1] = xp[1]; } }
#pragma unroll
            for (int m = 0; m < 4; ++m) { bf16_t* rowp = base + (size_t)(row0 + ai * HALF + m * 16) * ld + col0;
#pragma unroll
                for (int bj = 0; bj < 2; ++bj) { f32x4 v0 = acc[ai][bj][m][0], v1 = acc[ai][bj][m][1];
                    if (RSQ) { const float rr = rrow[ai][m]; v0 = v0 * rr; v1 = v1 * rr; }
                    if (MODE == 8) { const float rs = rrow[ai][m]; const f32x4 c0 = ccol[bj][0] * rs, c1 = ccol[bj][1] * rs;
                        const i32x4 i0 = __builtin_bit_cast(i32x4, v0), i1 = __builtin_bit_cast(i32x4, v1);
                        v0 = (f32x4){(float)i0.x, (float)i0.y, (float)i0.z, (float)i0.w} * c0; v1 = (f32x4){(float)i1.x, (float)i1.y, (float)i1.z, (float)i1.w} * c1; }
                    if (MODE == 0 || MODE == 3) {
#pragma unroll
                        for (int j = 0; j < 4; ++j) { v0[j] *= sc; v1[j] *= sc; } }
                    if (MODE == 6) { v0 = prex[m][bj][0] + v0 * sc; v1 = prex[m][bj][1] + v1 * sc; }
                    if (MODE == 7) { const u32x4 hv = pre[m][bj];
                        v0[0] = bflo(hv.x) + v0[0] * sc; v0[1] = bfhi(hv.x) + v0[1] * sc; v0[2] = bflo(hv.y) + v0[2] * sc; v0[3] = bfhi(hv.y) + v0[3] * sc;
                        v1[0] = bflo(hv.z) + v1[0] * sc; v1[1] = bfhi(hv.z) + v1[1] * sc; v1[2] = bflo(hv.w) + v1[2] * sc; v1[3] = bfhi(hv.w) + v1[3] * sc; }
                    if (MODE == 1 || MODE == 2 || MODE == 5) {
#pragma unroll
                        for (int j = 0; j < 4; ++j) { v0[j] = gelu_tanh(v0[j] * sc); v1[j] = gelu_tanh(v1[j] * sc); } }
                    if (MODE == 2 || MODE == 5) { const u32x4 mv = pre[m][bj];
                        v0[0] *= bflo(mv.x); v0[1] *= bfhi(mv.x); v0[2] *= bflo(mv.y); v0[3] *= bfhi(mv.y);
                        v1[0] *= bflo(mv.z); v1[1] *= bfhi(mv.z); v1[2] *= bflo(mv.w); v1[3] *= bfhi(mv.w); }
                    if (MODE == 5) { int w0 = 0, w1 = 0;
                        w0 = __builtin_amdgcn_cvt_pk_fp8_f32(v0[0], v0[1], w0, false); w0 = __builtin_amdgcn_cvt_pk_fp8_f32(v0[2], v0[3], w0, true);
                        w1 = __builtin_amdgcn_cvt_pk_fp8_f32(v1[0], v1[1], w1, false); w1 = __builtin_amdgcn_cvt_pk_fp8_f32(v1[2], v1[3], w1, true);
                        *(u32x2*)((unsigned char*)O2 + (size_t)(row0 + ai * HALF + m * 16) * ld + col0 + bj * HALF) = (u32x2){(unsigned)w0, (unsigned)w1}; continue; }
                    u32x4 w;
                    if (MODE == 4 || MODE == 8) { w.x = pkh2(v0[0], v0[1]); w.y = pkh2(v0[2], v0[3]); w.z = pkh2(v1[0], v1[1]); w.w = pkh2(v1[2], v1[3]); }
                    else { w.x = pk2(v0[0], v0[1]); w.y = pk2(v0[2], v0[3]); w.z = pk2(v1[0], v1[1]); w.w = pk2(v1[2], v1[3]); }
                    *(u32x4*)(rowp + bj * HALF) = w; } } }
    }
};
template <int MODE> struct EpiF32 {
    static constexpr bool PERM = false, AFTER_DRAIN = false;
    float* C; int ldc; const float* B; float sc = 1.0f;
    __device__ __forceinline__ void operator()(const f32x4 (&acc)[2][2][4][2], const Unit& u, int wr, int wc, int fr, int fq) const {
        const int row0 = u.pm * BM + wr * 64 + fr, col0 = u.pn * BM + wc * 32 + 4 * fq;
#pragma unroll
        for (int ai = 0; ai < 2; ++ai)
#pragma unroll
            for (int m = 0; m < 4; ++m) { float* rowp = C + (size_t)(row0 + ai * HALF + m * 16) * ldc + col0;
#pragma unroll
                for (int bj = 0; bj < 2; ++bj)
#pragma unroll
                    for (int n = 0; n < 2; ++n) { f32x4* p = (f32x4*)(rowp + bj * HALF + n * 16);
                        if (MODE == 1) *p = *p + acc[ai][bj][m][n] * sc;
                        else if (MODE == 2) *p = *(const f32x4*)(B + (p - (f32x4*)C) * 4) + acc[ai][bj][m][n] * sc;
                        else *p = acc[ai][bj][m][n]; } }
    }
};

template <int F8 = 0, class Epi, class Sched>
__device__ __forceinline__ void gemm_phase(PG8_LAS unsigned char* lds, const Gemm g, const Sched& S, const Epi& E) {
    const int tid = threadIdx.x, wid = __builtin_amdgcn_readfirstlane(tid >> 6), lane = tid & 63, wr = wid >> 2, wc = wid & 3, fr = lane & 15, fq = lane >> 4;
    const int K = g.K, nt = K / BK;
    unsigned voffA[2], voffB[2];
#pragma unroll
    for (int i = 0; i < 2; ++i) { int R, C; stage_rc(tid * 16 + i * 8192, R, C); const int Rb = Epi::PERM == 2 ? (64 * (R >> 5) + 16 * ((R >> 2) & 3) + 4 * ((R >> 4) & 1) + (R & 3)) : Epi::PERM ? ((R & ~31) + perm32(R & 31)) : R;
        voffA[i] = (unsigned)(R * K + C) * 2u; voffB[i] = (unsigned)(Rb * K + C) * 2u; }
    const size_t kstep = (size_t)(BK * 2);
    const size_t hstep = (size_t)HALF * K * 2;
    const size_t hstepB = Epi::PERM == 2 ? (size_t)8 * K * 2 : hstep;
    const size_t tstep = 2 * hstep;
    const unsigned ldsw = (unsigned)wid * 1024u;
    const int aoff = lds_byte(wr * 64 + fr, fq * 8), boff = lds_byte(wc * 32 + fr, fq * 8);
#define PG8_SA(b, h) (((b) * 2 + (h)) * HTB)
#define PG8_SB(b, h) ((4 + (b) * 2 + (h)) * HTB)
#define PG8_STAGE(bufoff, gbase, voff) do { const char* gb_ = (const char*)(gbase); asm volatile("" : "+s"(gb_));        \
        _Pragma("unroll") for (int _i = 0; _i < 2; ++_i) { unsigned vo_ = (voff)[_i]; asm volatile("" : "+v"(vo_)); \
        __builtin_amdgcn_global_load_lds((const unsigned*)(gb_ + vo_), (PG8_LAS unsigned*)(lds + (bufoff) + ldsw + _i * 8192), 16, 0, 0); } } while (0)
#define PG8_LD8(dst8, cbase_, voff_, cnt_) do { unsigned o_ = (unsigned)(voff_); asm volatile("" : "+v"(o_));        \
        _Pragma("unroll") for (int i_ = 0; i_ < cnt_; ++i_) { const i32x4 lo_ = *(const PG8_LAS i32x4*)(lds + (cbase_) + o_ + i_ * 2048), hi_ = *(const PG8_LAS i32x4*)(lds + (cbase_) + o_ + i_ * 2048 + 1024); \
        dst8[i_] = (i32x8){lo_.x, lo_.y, lo_.z, lo_.w, hi_.x, hi_.y, hi_.z, hi_.w}; } } while (0)
#define PG8_LDA(dst, b, h) do { if (F8 == 1) PG8_LD8(Ah8, PG8_SA(b, h), aoff, 2); else { _Pragma("unroll") for (int m = 0; m < 4; ++m) _Pragma("unroll") for (int k = 0; k < 2; ++k) dst[m][k] = *(const PG8_LAS bf16x8*)(lds + PG8_SA(b, h) + aoff + m * 2048 + k * 1024); } } while (0)
#define PG8_LDB(dst, b, h) do { if (F8 == 1) PG8_LD8(dst##8, PG8_SB(b, h), boff, 2); else { _Pragma("unroll") for (int n = 0; n < 2; ++n) _Pragma("unroll") for (int k = 0; k < 2; ++k) dst[n][k] = *(const PG8_LAS bf16x8*)(lds + PG8_SB(b, h) + boff + n * 2048 + k * 1024); } } while (0)
#define PG8_MM8(ai, bj, mm, Bt, Ax) do { _Pragma("unroll") for (int n = 0; n < 2; ++n) { \
        acc[ai][bj][mm][n] = __builtin_amdgcn_mfma_scale_f32_16x16x128_f8f6f4(Bt##8[n], Ax[0], acc[ai][bj][mm][n], 0, 0, 0, 0, 0, 0); \
        acc[ai][bj][(mm) + 1][n] = __builtin_amdgcn_mfma_scale_f32_16x16x128_f8f6f4(Bt##8[n], Ax[1], acc[ai][bj][(mm) + 1][n], 0, 0, 0, 0, 0, 0); } } while (0)
#define PG8_MMA(ai, bj, At, Bt, bb) do { __builtin_amdgcn_s_setprio(1); \
        if (F8 == 1) { if ((bj) == 0) { PG8_SCHED; PG8_LD8(Bh8, PG8_SA(bb, ai) + 2 * 2048, aoff, 2); PG8_SCHED; PG8_MM8(ai, bj, 0, Bt, Ah8); PG8_SCHED; PG8_MM8(ai, bj, 2, Bt, Bh8); } \
                  else { PG8_MM8(ai, bj, 0, Bt, Ah8); PG8_MM8(ai, bj, 2, Bt, Bh8); } } \
        else if (F8 == 2) { _Pragma("unroll") for (int m = 0; m < 4; ++m) _Pragma("unroll") for (int n = 0; n < 2; ++n) _Pragma("unroll") for (int k = 0; k < 2; ++k) \
            acc[ai][bj][m][n] = __builtin_bit_cast(f32x4, __builtin_amdgcn_mfma_i32_16x16x64_i8(__builtin_bit_cast(i32x4, Bt[n][k]), __builtin_bit_cast(i32x4, At[m][k]), __builtin_bit_cast(i32x4, acc[ai][bj][m][n]), 0, 0, 0)); } \
        else { _Pragma("unroll") for (int m = 0; m < 4; ++m) _Pragma("unroll") for (int n = 0; n < 2; ++n) _Pragma("unroll") for (int k = 0; k < 2; ++k) \
            acc[ai][bj][m][n] = __builtin_amdgcn_mfma_f32_16x16x32_bf16(Bt[n][k], At[m][k], acc[ai][bj][m][n], 0, 0, 0); } \
        __builtin_amdgcn_s_setprio(0); } while (0)
#define PG8_WAIT_V(n) asm volatile("s_waitcnt vmcnt(" #n ")" ::: "memory")
#define PG8_WAIT_L(n) asm volatile("s_waitcnt lgkmcnt(" #n ")" ::: "memory")
#define PG8_BAR __builtin_amdgcn_s_barrier()
#define PG8_SCHED __builtin_amdgcn_sched_barrier(0)
    Unit cur, nxt; int ui = 0;
    if (!S.next(0, cur)) return;
    f32x4 acc[2][2][4][2];
#pragma unroll
    for (int a = 0; a < 2; ++a)
#pragma unroll
        for (int b = 0; b < 2; ++b)
#pragma unroll
            for (int m = 0; m < 4; ++m)
#pragma unroll
                for (int n = 0; n < 2; ++n) acc[a][b][m][n] = (f32x4){0.f, 0.f, 0.f, 0.f};
    bf16x8 At[4][2], B0[2][2], B1[2][2]; i32x8 Ah8[2], Bh8[2], B08[2], B18[2];
    const char* cA = (const char*)g.A + (size_t)cur.pm * tstep; const char* cB = (const char*)g.Bt + (size_t)cur.pn * tstep;
    S.a_ready(cur);
    PG8_STAGE(PG8_SB(0, 0), cB, voffB); PG8_STAGE(PG8_SA(0, 0), cA, voffA); PG8_STAGE(PG8_SB(0, 1), cB + hstepB, voffB); PG8_STAGE(PG8_SA(0, 1), cA + hstep, voffA);
    if (wr == 1) PG8_BAR;
    PG8_WAIT_V(4); PG8_BAR;
    PG8_STAGE(PG8_SB(1, 0), cB + kstep, voffB); PG8_STAGE(PG8_SA(1, 0), cA + kstep, voffA); PG8_STAGE(PG8_SB(1, 1), cB + hstepB + kstep, voffB);
    PG8_WAIT_V(6); PG8_BAR;
    for (;;) {
        const bool has_next = S.next(ui + 1, nxt);
        const char* nA = has_next ? (const char*)g.A + (size_t)nxt.pm * tstep : cA; const char* nB = has_next ? (const char*)g.Bt + (size_t)nxt.pn * tstep : cB;
        for (int t = 0; t < nt; t += 2) {
            const bool last = (t == nt - 2);
            const char* a1 = cA + (size_t)(t + 1) * kstep;
            const char* a2 = last ? nA : cA + (size_t)(t + 2) * kstep; const char* b2 = last ? nB : cB + (size_t)(t + 2) * kstep;
            const char* a3 = a2 + kstep; const char* b3 = b2 + kstep;
            if (last && has_next) S.a_ready(nxt);
            PG8_LDB(B0, 0, 0); PG8_SCHED; PG8_LDA(At, 0, 0); PG8_STAGE(PG8_SA(1, 1), a1 + hstep, voffA);
            PG8_WAIT_L(8); PG8_BAR; PG8_WAIT_L(0); PG8_MMA(0, 0, At, B0, 0); PG8_BAR; PG8_SCHED;
            PG8_LDB(B1, 0, 1); PG8_STAGE(PG8_SB(0, 0), b2, voffB);
            PG8_BAR; PG8_WAIT_L(0); PG8_MMA(0, 1, At, B1, 0); PG8_BAR; if (F8 == 1) PG8_SCHED;
            PG8_LDA(At, 0, 1); PG8_STAGE(PG8_SA(0, 0), a2, voffA);
            PG8_BAR; PG8_WAIT_L(0); PG8_MMA(1, 0, At, B0, 0); PG8_BAR; PG8_SCHED;
            PG8_STAGE(PG8_SB(0, 1), b2 + hstepB, voffB);
            PG8_WAIT_V(6); PG8_BAR; PG8_MMA(1, 1, At, B1, 0); PG8_BAR; if (F8 == 1) PG8_SCHED;
            PG8_LDB(B0, 1, 0); PG8_SCHED; PG8_LDA(At, 1, 0); PG8_STAGE(PG8_SA(0, 1), a2 + hstep, voffA);
            PG8_WAIT_L(8); PG8_BAR; PG8_WAIT_L(0); PG8_MMA(0, 0, At, B0, 1); PG8_BAR; PG8_SCHED;
            PG8_LDB(B1, 1, 1); PG8_STAGE(PG8_SB(1, 0), b3, voffB);
            PG8_BAR; PG8_WAIT_L(0); PG8_MMA(0, 1, At, B1, 1); PG8_BAR; if (F8 == 1) PG8_SCHED;
            PG8_LDA(At, 1, 1); PG8_STAGE(PG8_SA(1, 0), a3, voffA);
            PG8_BAR; PG8_WAIT_L(0); PG8_MMA(1, 0, At, B0, 1); PG8_BAR; PG8_SCHED;
            PG8_STAGE(PG8_SB(1, 1), b3 + hstepB, voffB);
            PG8_WAIT_V(6); PG8_BAR; PG8_MMA(1, 1, At, B1, 1); PG8_BAR; if (F8 == 1) PG8_SCHED;
        }
        { int fr_ = fr, fq_ = fq; asm volatile("" : "+v"(fr_), "+v"(fq_));
          E(acc, cur, wr, wc, fr_, fq_); } S.done(cur);
        if (!has_next) break;
#pragma unroll
        for (int a = 0; a < 2; ++a)
#pragma unroll
            for (int b = 0; b < 2; ++b)
#pragma unroll
                for (int m = 0; m < 4; ++m)
#pragma unroll
                    for (int n = 0; n < 2; ++n) acc[a][b][m][n] = (f32x4){0.f, 0.f, 0.f, 0.f};
        cur = nxt; cA = nA; cB = nB; ++ui;
    }
    PG8_WAIT_V(0);
    if (wr == 0) PG8_BAR;
    PG8_BAR;
#undef PG8_SA
#undef PG8_SB
#undef PG8_STAGE
#undef PG8_LDA
#undef PG8_LDB
#undef PG8_MMA
#undef PG8_LD8
#undef PG8_MM8
#undef PG8_WAIT_V
#undef PG8_WAIT_L
#undef PG8_BAR
#undef PG8_SCHED
}
}

#define XB_TMO      128
#define XB_XCNT(j)  (256  + 64 * (j))
#define XB_XSUB(j)  (1280 + 64 * (j))
#define XB_XGEN(j)  (2304 + 64 * (j))
#define XB_TOP      3328
#define XB_TOPGEN   3392
#define XCD_BAR_WORDS 3456
#define XB_SPIN_CAP (1u << 18)
__device__ __forceinline__ unsigned xb_ld(unsigned* p)              { return __hip_atomic_load(p, __ATOMIC_RELAXED, __HIP_MEMORY_SCOPE_AGENT); }
__device__ __forceinline__ unsigned xb_add(unsigned* p, unsigned v) { return __hip_atomic_fetch_add(p, v, __ATOMIC_RELAXED, __HIP_MEMORY_SCOPE_AGENT); }
__device__ __forceinline__ unsigned xb_xcc_id() { return (unsigned)__builtin_amdgcn_s_getreg((3 << 11) | 20) & 0xFu; }
#define XB_SPIN(cond, bar) do { unsigned _sp = 0; while (cond) { __builtin_amdgcn_s_sleep(1); \
    if ((++_sp & 255u) == 0u) { if (xb_ld(&(bar)[XB_TMO])) break; if (_sp > XB_SPIN_CAP) { atomicAdd(&(bar)[XB_TMO], 1u); break; } } } } while (0)
struct XcdBarrier { unsigned* bar; unsigned x; volatile LAS unsigned* st; };
__device__ __forceinline__ XcdBarrier xcd_barrier_post(unsigned* bar, volatile LAS unsigned* st) {
    XcdBarrier b; b.bar = bar; b.x = xb_xcc_id(); b.st = st;
    if (threadIdx.x == 0) (void)xb_add(&bar[XB_XCNT(b.x)], 1u);
    return b;
}
__device__ __forceinline__ void xcd_barrier_complete(unsigned* bar, unsigned x, unsigned& nloc, unsigned& nx) {
    const unsigned G = gridDim.x * gridDim.y * gridDim.z;
    unsigned sum, cnt, mine, sp = 0u;
    for (;;) {
        sum = 0u; cnt = 0u; mine = 0u;
#pragma unroll
        for (unsigned j = 0; j < 16; ++j) { const unsigned c = xb_ld(&bar[XB_XCNT(j)]); sum += c; cnt += (c > 0u) ? 1u : 0u; mine = (j == x) ? c : mine; }
        if (sum == G) break;
        __builtin_amdgcn_s_sleep(1);
        if ((++sp & 255u) == 0u) { if (xb_ld(&bar[XB_TMO])) break; if (sp > XB_SPIN_CAP) { atomicAdd(&bar[XB_TMO], 1u); break; } }
    }
    nloc = mine > 0u ? mine : 1u; nx = cnt > 0u ? cnt : 1u;
}
__device__ __forceinline__ void xcd_barrier(const XcdBarrier& b) {
    asm volatile("s_waitcnt vmcnt(0)" ::: "memory");
    __syncthreads();
    if (threadIdx.x == 0) {
        unsigned* bar = b.bar;
        __builtin_amdgcn_s_waitcnt(0);
        unsigned nloc = b.st[0], nx = b.st[1];
        if (nloc == 0u) { xcd_barrier_complete(bar, b.x, nloc, nx); b.st[0] = nloc; b.st[1] = nx; }
        const unsigned old = xb_add(&bar[XB_XSUB(b.x)], 1u);
        const unsigned gen = old / nloc;
        if (old + 1u == (gen + 1u) * nloc) {
            __builtin_amdgcn_fence(__ATOMIC_RELEASE, "agent");
            asm volatile("s_waitcnt vmcnt(0)" ::: "memory");
            const unsigned og = xb_add(&bar[XB_TOP], 1u);
            const unsigned tg = og / nx;
            if (og + 1u == (tg + 1u) * nx) xb_add(&bar[XB_TOPGEN], 1u);
            else XB_SPIN(xb_ld(&bar[XB_TOPGEN]) == tg, bar);
            __builtin_amdgcn_fence(__ATOMIC_ACQUIRE, "agent");
            xb_add(&bar[XB_XGEN(b.x)], 1u);
            asm volatile("s_waitcnt vmcnt(0)" ::: "memory");
        } else {
            XB_SPIN(xb_ld(&bar[XB_XGEN(b.x)]) == gen, bar);
            __builtin_amdgcn_fence(__ATOMIC_ACQUIRE, "agent");
            asm volatile("s_waitcnt vmcnt(0)" ::: "memory");
        }
    }
    __syncthreads();
}

struct Args { const float* in[18]; float* out; unsigned char* ws; int ph_lo, ph_hi; };
struct Frame {
    LAS unsigned char* lds;
    int tid, lane, wave, G, gw, NGW;
    const float* const* in; float* out; unsigned char* ws;
};

__device__ __forceinline__ void transpose_item(const float* W, int ldw, int col0, bf16_t* WT, int K, int nblk, float scale, LAS float* scr, int item, int lane, bool f8 = false, const float* kgain = nullptr) {
    const int kb = item / nblk, nb = item % nblk, k0 = 64 * kb, n0 = 32 * nb;
#pragma unroll 8
    for (int i = 0; i < 32; ++i) { const int kk = 2 * i + (lane >> 5); scr[kk * 33 + (lane & 31)] = W[(size_t)(k0 + kk) * ldw + col0 + n0 + (lane & 31)] * (kgain ? kgain[k0 + kk] : 1.0f); }
    LDS_WAIT();
    const int c = lane & 7;
#pragma unroll
    for (int j = 0; j < 4; ++j) { const int n = (lane >> 3) + 8 * j; const LAS float* s = scr + (8 * c) * 33 + n;
        if (f8) { int w0 = 0, w1 = 0;
            w0 = __builtin_amdgcn_cvt_pk_fp8_f32(s[0 * 33] * scale, s[1 * 33] * scale, w0, false); w0 = __builtin_amdgcn_cvt_pk_fp8_f32(s[2 * 33] * scale, s[3 * 33] * scale, w0, true);
            w1 = __builtin_amdgcn_cvt_pk_fp8_f32(s[4 * 33] * scale, s[5 * 33] * scale, w1, false); w1 = __builtin_amdgcn_cvt_pk_fp8_f32(s[6 * 33] * scale, s[7 * 33] * scale, w1, true);
            *(u32x2*)((unsigned char*)WT + (size_t)(n0 + n) * K + k0 + 8 * c) = (u32x2){(unsigned)w0, (unsigned)w1}; continue; }
        u32x4 o; o.x = pk2(s[0 * 33] * scale, s[1 * 33] * scale); o.y = pk2(s[2 * 33] * scale, s[3 * 33] * scale); o.z = pk2(s[4 * 33] * scale, s[5 * 33] * scale); o.w = pk2(s[6 * 33] * scale, s[7 * 33] * scale);
        *(u32x4*)(WT + (size_t)(n0 + n) * K + k0 + 8 * c) = o; }
    LDS_WAIT();
}
__device__ __forceinline__ void rmsnorm_rows(const Frame& F, const float* src, const float* g, bf16_t* dst, float* cpy, unsigned char* dst8 = nullptr) {
    const f32x4* gp = (const f32x4*)g + F.lane;
    f32x4 gv[4];
#pragma unroll
    for (int j = 0; j < 4; ++j) gv[j] = gp[64 * j];
    for (int m = F.gw; m < T; m += F.NGW) {
        const f32x4* xr = (const f32x4*)(src + (size_t)m * D) + F.lane;
        f32x4 v[4]; float s = 0.f;
#pragma unroll
        for (int j = 0; j < 4; ++j) { v[j] = xr[64 * j]; s += (v[j].x * v[j].x + v[j].y * v[j].y) + (v[j].z * v[j].z + v[j].w * v[j].w); }
        const float rstd = 1.0f / sqrtf(wave_sum(s) * (1.f / D) + 1e-6f);
        if (cpy) { f32x4* cr = (f32x4*)(cpy + (size_t)m * D) + F.lane;
#pragma unroll
            for (int j = 0; j < 4; ++j) cr[64 * j] = v[j]; }
        if (dst) { u32x2* o8 = (u32x2*)(dst + (size_t)m * D) + F.lane;
#pragma unroll
        for (int j = 0; j < 4; ++j) { u32x2 w; w.x = pk2(v[j].x * rstd * gv[j].x, v[j].y * rstd * gv[j].y); w.y = pk2(v[j].z * rstd * gv[j].z, v[j].w * rstd * gv[j].w); o8[64 * j] = w; } }
        if (dst8) { unsigned* o4 = (unsigned*)(dst8 + (size_t)m * D) + F.lane;
#pragma unroll
            for (int j = 0; j < 4; ++j) { int w = 0; w = __builtin_amdgcn_cvt_pk_fp8_f32(v[j].x * rstd * gv[j].x, v[j].y * rstd * gv[j].y, w, false); w = __builtin_amdgcn_cvt_pk_fp8_f32(v[j].z * rstd * gv[j].z, v[j].w * rstd * gv[j].w, w, true); o4[64 * j] = (unsigned)w; } }
    }
}
__device__ __forceinline__ void quant_wqk(const Frame& F) {
    const bf16_t* W = (const bf16_t*)(F.ws + WS_WQKP); unsigned char* Q8 = F.ws + WS_WQ8;
    const unsigned* CM = (const unsigned*)(F.ws + WS_CTL) + CW_COLMAX; float* WSCL = (float*)(F.ws + WS_CTL) + CW_WSCL;
    for (int r = F.gw; r < 4096; r += F.NGW) {
        const float cm = __builtin_bit_cast(float, __hip_atomic_load(CM + r, __ATOMIC_RELAXED, __HIP_MEMORY_SCOPE_AGENT));
        const float sc = cm > 0.f ? 127.0f / cm : 0.f;
        const u32x4* wp = (const u32x4*)(W + (size_t)r * 1024 + 16 * F.lane); const u32x4 a = wp[0], b = wp[1];
        const float v[16] = {bflo(a.x), bfhi(a.x), bflo(a.y), bfhi(a.y), bflo(a.z), bfhi(a.z), bflo(a.w), bfhi(a.w), bflo(b.x), bfhi(b.x), bflo(b.y), bfhi(b.y), bflo(b.z), bfhi(b.z), bflo(b.w), bfhi(b.w)};
        unsigned o[4];
#pragma unroll
        for (int j = 0; j < 4; ++j) { unsigned w = 0u;
#pragma unroll
            for (int e = 0; e < 4; ++e) { int q = (int)rintf(v[4 * j + e] * sc); q = q > 127 ? 127 : (q < -127 ? -127 : q); w |= ((unsigned)q & 255u) << (8 * e); }
            o[j] = w; }
        *(u32x4*)(Q8 + (size_t)r * 1024 + 16 * F.lane) = (u32x4){o[0], o[1], o[2], o[3]};
        if (F.lane == 0) WSCL[r] = cm * (1.0f / 127.0f);
    }
}
__device__ __forceinline__ void rmsnorm_rows_bf(const Frame& F, const bf16_t* src, const float* g, bf16_t* dst, unsigned char* dst8, unsigned char* dsti = nullptr, float* rowsc = nullptr) {
    const f32x4* gp = (const f32x4*)g + F.lane;
    f32x4 gv[4];
#pragma unroll
    for (int j = 0; j < 4; ++j) gv[j] = gp[64 * j];
    for (int m = F.gw; m < T; m += F.NGW) {
        const u32x2* xr = (const u32x2*)(src + (size_t)m * D) + F.lane;
        f32x4 v[4]; float s = 0.f;
#pragma unroll
        for (int j = 0; j < 4; ++j) { const u32x2 w = xr[64 * j]; v[j] = (f32x4){bflo(w.x), bfhi(w.x), bflo(w.y), bfhi(w.y)}; s += (v[j].x * v[j].x + v[j].y * v[j].y) + (v[j].z * v[j].z + v[j].w * v[j].w); }
        const float rstd = 1.0f / sqrtf(wave_sum(s) * (1.f / D) + 1e-6f);
        if (dst) { u32x2* o8 = (u32x2*)(dst + (size_t)m * D) + F.lane;
#pragma unroll
        for (int j = 0; j < 4; ++j) { u32x2 w; w.x = pk2(v[j].x * rstd * gv[j].x, v[j].y * rstd * gv[j].y); w.y = pk2(v[j].z * rstd * gv[j].z, v[j].w * rstd * gv[j].w); o8[64 * j] = w; } }
        if (dst8) { unsigned* o4 = (unsigned*)(dst8 + (size_t)m * D) + F.lane;
#pragma unroll
            for (int j = 0; j < 4; ++j) { int w = 0; w = __builtin_amdgcn_cvt_pk_fp8_f32(v[j].x * rstd * gv[j].x, v[j].y * rstd * gv[j].y, w, false); w = __builtin_amdgcn_cvt_pk_fp8_f32(v[j].z * rstd * gv[j].z, v[j].w * rstd * gv[j].w, w, true); o4[64 * j] = (unsigned)w; } }
        if (dsti) {
            f32x4 y[4]; float am = 0.f;
#pragma unroll
            for (int j = 0; j < 4; ++j) { y[j] = v[j] * rstd * gv[j]; am = fmaxf(am, fmaxf(fmaxf(fabsf(y[j].x), fabsf(y[j].y)), fmaxf(fabsf(y[j].z), fabsf(y[j].w)))); }
            am = wave_max(am);
            const float qs = am > 0.f ? 127.0f / am : 0.f;
            unsigned* oi = (unsigned*)(dsti + (size_t)m * D) + F.lane;
#pragma unroll
            for (int j = 0; j < 4; ++j) { const int q0 = (int)rintf(y[j].x * qs), q1 = (int)rintf(y[j].y * qs), q2 = (int)rintf(y[j].z * qs), q3 = (int)rintf(y[j].w * qs);
                oi[64 * j] = ((unsigned)q0 & 255u) | (((unsigned)q1 & 255u) << 8) | (((unsigned)q2 & 255u) << 16) | ((unsigned)q3 << 24); }
            if (F.lane == 0) rowsc[m] = am * (1.0f / 127.0f);
        }
    }
}
__device__ __forceinline__ void final_norm_bf(const Frame& F, const bf16_t* h, float* out, const float* g) {
    const f32x4* gp = (const f32x4*)g + F.lane;
    f32x4 gv[4];
#pragma unroll
    for (int j = 0; j < 4; ++j) gv[j] = gp[64 * j];
    for (int m = F.gw; m < T; m += F.NGW) {
        const u32x2* xr = (const u32x2*)(h + (size_t)m * D) + F.lane;
        f32x4 v[4]; float s = 0.f;
#pragma unroll
        for (int j = 0; j < 4; ++j) { const u32x2 w = xr[64 * j]; v[j] = (f32x4){bflo(w.x), bfhi(w.x), bflo(w.y), bfhi(w.y)}; s += (v[j].x * v[j].x + v[j].y * v[j].y) + (v[j].z * v[j].z + v[j].w * v[j].w); }
        const float rstd = 1.0f / sqrtf(wave_sum(s) * (1.f / D) + 1e-6f);
        f32x4* orow = (f32x4*)(out + (size_t)m * D) + F.lane;
#pragma unroll
        for (int j = 0; j < 4; ++j) orow[64 * j] = v[j] * rstd * gv[j];
    }
}
__device__ __forceinline__ void final_norm(const Frame& F, float* h, const float* g) {
    const f32x4* gp = (const f32x4*)g + F.lane;
    f32x4 gv[4];
#pragma unroll
    for (int j = 0; j < 4; ++j) gv[j] = gp[64 * j];
    for (int m = F.gw; m < T; m += F.NGW) {
        f32x4* xr = (f32x4*)(h + (size_t)m * D) + F.lane;
        f32x4 v[4]; float s = 0.f;
#pragma unroll
        for (int j = 0; j < 4; ++j) { v[j] = xr[64 * j]; s += (v[j].x * v[j].x + v[j].y * v[j].y) + (v[j].z * v[j].z + v[j].w * v[j].w); }
        const float rstd = 1.0f / sqrtf(wave_sum(s) * (1.f / D) + 1e-6f);
#pragma unroll
        for (int j = 0; j < 4; ++j) xr[64 * j] = v[j] * rstd * gv[j];
    }
}
__device__ __forceinline__ void cvt_fp4_rows(const Frame& F, const float* src, unsigned char* dst, float* inv) {
    for (int r = F.gw; r < 16384; r += F.NGW) {
        const f32x4* p = (const f32x4*)(src + (size_t)r * 1024 + 16 * F.lane);
        const f32x4 v0 = p[0], v1 = p[1], v2 = p[2], v3 = p[3];
        float m = fmaxf(fmaxf(fmaxf(fabsf(v0.x), fabsf(v0.y)), fmaxf(fabsf(v0.z), fabsf(v0.w))), fmaxf(fmaxf(fabsf(v1.x), fabsf(v1.y)), fmaxf(fabsf(v1.z), fabsf(v1.w))));
        m = fmaxf(m, fmaxf(fmaxf(fmaxf(fabsf(v2.x), fabsf(v2.y)), fmaxf(fabsf(v2.z), fabsf(v2.w))), fmaxf(fmaxf(fabsf(v3.x), fabsf(v3.y)), fmaxf(fabsf(v3.z), fabsf(v3.w)))));
        m = wave_max(m);
        const float sc = m > 0.f ? 6.0f / m : 1.0f;
        unsigned w0 = 0u, w1 = 0u;
        w0 = __builtin_amdgcn_cvt_scalef32_pk_fp4_f32(w0, v0.x * sc, v0.y * sc, 1.0f, 0); w0 = __builtin_amdgcn_cvt_scalef32_pk_fp4_f32(w0, v0.z * sc, v0.w * sc, 1.0f, 1);
        w0 = __builtin_amdgcn_cvt_scalef32_pk_fp4_f32(w0, v1.x * sc, v1.y * sc, 1.0f, 2); w0 = __builtin_amdgcn_cvt_scalef32_pk_fp4_f32(w0, v1.z * sc, v1.w * sc, 1.0f, 3);
        w1 = __builtin_amdgcn_cvt_scalef32_pk_fp4_f32(w1, v2.x * sc, v2.y * sc, 1.0f, 0); w1 = __builtin_amdgcn_cvt_scalef32_pk_fp4_f32(w1, v2.z * sc, v2.w * sc, 1.0f, 1);
        w1 = __builtin_amdgcn_cvt_scalef32_pk_fp4_f32(w1, v3.x * sc, v3.y * sc, 1.0f, 2); w1 = __builtin_amdgcn_cvt_scalef32_pk_fp4_f32(w1, v3.z * sc, v3.w * sc, 1.0f, 3);
        *(u32x2*)(dst + (size_t)(F.lane >> 4) * (2 * MiB) + (size_t)r * 128 + 8 * (F.lane & 15)) = (u32x2){w0, w1};
        if (F.lane == 0) inv[2 * r] = m > 0.f ? m * (1.0f / 6.0f) : 1.0f;
    }
}
__device__ __forceinline__ int t5_bucket(int rel) {
    const int ret = rel > 0 ? 16 : 0; const int n = rel < 0 ? -rel : rel;
    int v;
    if (n < 8) v = n; else if (n < 12) v = 8; else if (n < 16) v = 9; else if (n < 23) v = 10; else if (n < 32) v = 11;
    else if (n < 46) v = 12; else if (n < 64) v = 13; else if (n < 91) v = 14; else v = 15;
    return ret + v;
}

__device__ __forceinline__ void p0_prologue(const Frame& F) {
    LAS float* scr = (LAS float*)(F.lds + F.wave * 16384);
    bf16_t* WQK = (bf16_t*)(F.ws + WS_WQK); bf16_t* WV = (bf16_t*)(F.ws + WS_WV); bf16_t* WO = (bf16_t*)(F.ws + WS_WO);
    bf16_t* WSGV = (bf16_t*)(F.ws + WS_WSGV); bf16_t* WSGU = (bf16_t*)(F.ws + WS_WSGU); bf16_t* WSGO = (bf16_t*)(F.ws + WS_WSGO);
    constexpr int I_QK = 16 * 40, I_V = 16 * 8, I_O = 16 * 32, I_SG = 16 * 96, I_SGO = 48 * 32;
    constexpr int NITEMS = I_QK + I_V + I_O + 2 * I_SG + I_SGO;
    for (int it = F.gw; it < NITEMS; it += F.NGW) {
        int r = it;
        if (r < I_QK) { const int nb = r % 40; transpose_item(F.in[3], 1536, 0, WQK, 1024, 40, (nb < 32 ? 0.125f * 1.4426950408889634f : 1.0f) * W8_SCALE, scr, r, F.lane, true); continue; } r -= I_QK;
        if (r < I_V) { transpose_item(F.in[3], 1536, 1280, WV, 1024, 8, W8_SCALE, scr, r, F.lane, true); continue; } r -= I_V;
        if (r < I_O) { transpose_item(F.in[4], 1024, 0, WO, 1024, 32, W8_SCALE, scr, r, F.lane, true); continue; } r -= I_O;
        if (r < I_SG) { transpose_item(F.in[6], 6144, 0, WSGU, 1024, 96, W8_SCALE, scr, r, F.lane, true, F.in[2] + D); continue; } r -= I_SG;
        if (r < I_SG) { transpose_item(F.in[6], 6144, 3072, WSGV, 1024, 96, W8_SCALE, scr, r, F.lane, true, F.in[2] + D); continue; } r -= I_SG;
        transpose_item(F.in[11], 1024, 0, WSGO, 3072, 32, W8_SCALE, scr, r, F.lane, true);
    }
    {
        bf16_t* WQKP = (bf16_t*)(F.ws + WS_WQKP);
        const int fr = F.lane & 15, fq = F.lane >> 4;
        for (int task = F.gw; task < 2 * 16 * 64; task += F.NGW) {
            const int l = task >> 10, hc = (task >> 6) & 15, k0 = (task & 63) * 16;
            const f32x4* ap = (const f32x4*)(F.in[13] + ((size_t)l * 1024 + k0 + fr) * 2048 + hc * 128 + 32 * fq);
            f32x4 av[8];
#pragma unroll
            for (int i = 0; i < 8; ++i) av[i] = ap[i];
#pragma unroll 1
            for (int nt = 0; nt < 8; ++nt) {
                const f32x4* bp = (const f32x4*)(F.in[14] + ((size_t)(l * 16 + hc) * 128 + nt * 16 + fr) * 128 + 32 * fq);
                f32x4 bv[8];
#pragma unroll
                for (int i = 0; i < 8; ++i) bv[i] = bp[i];
                f32x4 acc = {0.f, 0.f, 0.f, 0.f};
#pragma unroll
                for (int i = 0; i < 8; ++i)
#pragma unroll
                    for (int j = 0; j < 4; ++j) acc = __builtin_amdgcn_mfma_f32_16x16x4f32(av[i][j], bv[i][j], acc, 0, 0, 0);
                *(u32x2*)(WQKP + ((size_t)l * 2048 + hc * 128 + nt * 16 + fr) * 1024 + k0 + 4 * fq) = (u32x2){pk2(acc[0], acc[1]), pk2(acc[2], acc[3])};
                { float mx = fmaxf(fmaxf(fabsf(acc[0]), fabsf(acc[1])), fmaxf(fabsf(acc[2]), fabsf(acc[3])));
                  mx = fmaxf(mx, __shfl_xor(mx, 16)); mx = fmaxf(mx, __shfl_xor(mx, 32));
                  if (fq == 0) atomicMax((unsigned*)(F.ws + WS_CTL) + CW_COLMAX + l * 2048 + hc * 128 + nt * 16 + fr, __builtin_bit_cast(unsigned, mx)); }
            }
        }
    }
    if (blockIdx.x == 0) {
        float* bt = (float*)(F.ws + WS_BIAS);
        for (int i = F.tid; i < 16 * 257; i += 512) { const int hq = i / 257, r = i % 257 - 128; bt[hq * 260 + r + 128] = F.in[1][t5_bucket(r) * 16 + hq] * 1.4426950408889634f; }
    }
    rmsnorm_rows(F, F.in[0], F.in[2], nullptr, nullptr, F.ws + WS_HN8B);
    for (int l = 0; l < 2; ++l) {
        cvt_fp4_rows(F, F.in[15] + (size_t)l * 16384 * 1024, F.ws + WS_TAB + (size_t)(2 * l) * 16 * MiB, (float*)(F.ws + WS_SCL) + (size_t)l * 32768);
        cvt_fp4_rows(F, F.in[16] + (size_t)l * 16384 * 1024, F.ws + WS_TAB + (size_t)(2 * l + 1) * 16 * MiB, (float*)(F.ws + WS_SCL) + (size_t)l * 32768 + 1);
    }
}

typedef float f32x16 __attribute__((ext_vector_type(16)));
constexpr int AT_K = 0, AT_KS = 144, AT_V = 384 * AT_KS, AT_VS = 792, AT_B = AT_V + 64 * AT_VS;
__device__ __forceinline__ void attn_phase_v2(const Frame& F) {
    const bf16_t* Q = (const bf16_t*)(F.ws + WS_Q); const bf16_t* Kb = (const bf16_t*)(F.ws + WS_K); const bf16_t* Vt = (const bf16_t*)(F.ws + WS_VT);
    bf16_t* AO = (bf16_t*)(F.ws + WS_AO); const float* bias = (const float*)(F.ws + WS_BIAS); const float* sinkp = F.in[5];
    const int lane = F.lane, tid = F.tid, h5 = lane >> 5, c31 = lane & 31, g = F.wave >> 1, qh = F.wave & 1;
    LAS float* bl = (LAS float*)(F.lds + AT_B) + g * 260;
    for (int unit = blockIdx.x; unit < 1024; unit += F.G) {
        const int hkv = unit & 3, qb = (unit >> 2) & 15, b = unit >> 6;
        const int tok0 = b * 2048 + qb * 128, kbase = tok0 - 128;
        __syncthreads();
#pragma unroll 2
        for (int it = 0; it < 6; ++it) { const int id = it * 512 + tid, row = id >> 3, ch = id & 7, pos = qb * 128 - 128 + row;
            u32x4 v = (u32x4){0u, 0u, 0u, 0u};
            if (pos >= 0 && pos < 2048) v = *(const u32x4*)(Kb + (size_t)(kbase + row) * 256 + hkv * 64 + ch * 8);
            *(LAS u32x4*)(F.lds + AT_K + row * AT_KS + ch * 16) = v; }
#pragma unroll 2
        for (int it = 0; it < 6; ++it) { const int id = it * 512 + tid, d = id / 48, ch = id % 48, pos0 = qb * 128 - 128 + ch * 8;
            u32x4 v = (u32x4){0u, 0u, 0u, 0u};
            if (pos0 >= 0 && pos0 < 2048) v = *(const u32x4*)(Vt + (size_t)(hkv * 64 + d) * T + kbase + ch * 8);
            *(LAS u32x2*)(F.lds + AT_V + d * AT_VS + ch * 16) = (u32x2){v.x, v.y}; *(LAS u32x2*)(F.lds + AT_V + d * AT_VS + ch * 16 + 8) = (u32x2){v.z, v.w}; }
        for (int i = tid; i < 4 * 260; i += 512) ((LAS float*)(F.lds + AT_B))[i] = bias[hkv * 4 * 260 + i];
        __syncthreads();
        const int hq = hkv * 4 + g; const float sinkv = sinkp[hq] * 1.4426950408889634f;
#pragma unroll 1
        for (int qt = 0; qt < 2; ++qt) {
            const int q0 = 64 * qh + 32 * qt;
            const bf16_t* qrow = Q + (size_t)(tok0 + q0 + c31) * 1024 + hq * 64 + 8 * h5;
            bf16x8 qf[4];
#pragma unroll
            for (int s2 = 0; s2 < 4; ++s2) qf[s2] = *(const bf16x8*)(qrow + 16 * s2);
            const int kt0 = q0 >> 5; int kt_lo = kt0, kt_hi = kt0 + 8;
            if (qb == 0 && kt_lo < 4) kt_lo = 4;
            if (qb == 15 && kt_hi > 7) kt_hi = 7;
            const int qi = q0 + c31;
            float mx = sinkv, lsum = h5 == 0 ? 1.0f : 0.f;
            f32x16 o0 = {0.f, 0.f, 0.f, 0.f, 0.f, 0.f, 0.f, 0.f, 0.f, 0.f, 0.f, 0.f, 0.f, 0.f, 0.f, 0.f}, o1 = o0;
#pragma unroll 1
            for (int kt = kt_lo; kt <= kt_hi; ++kt) {
                f32x16 sa = {0.f, 0.f, 0.f, 0.f, 0.f, 0.f, 0.f, 0.f, 0.f, 0.f, 0.f, 0.f, 0.f, 0.f, 0.f, 0.f};
#pragma unroll
                for (int s2 = 0; s2 < 4; ++s2) { const bf16x8 kf = *(const LAS bf16x8*)(F.lds + AT_K + (kt * 32 + c31) * AT_KS + s2 * 32 + h5 * 16); sa = __builtin_amdgcn_mfma_f32_32x32x16_bf16(kf, qf[s2], sa, 0, 0, 0); }
                float sv[16]; float tmax = -INFINITY;
                if (kt > kt0 && kt < kt0 + 8) {
                    const LAS float* bp = bl + (kt * 32 + 4 * h5 - qi);
#pragma unroll
                    for (int r = 0; r < 16; ++r) { sv[r] = sa[r] + bp[(r & 3) + 8 * (r >> 2)]; tmax = fmaxf(tmax, sv[r]); }
                } else {
#pragma unroll
                    for (int r = 0; r < 16; ++r) { const int key = kt * 32 + (r & 3) + 8 * (r >> 2) + 4 * h5, rel = key - 128 - qi; const bool ok = rel >= -128 && rel <= 128;
                        const int bi = rel < -128 ? 0 : (rel > 128 ? 256 : rel + 128);
                        sv[r] = ok ? sa[r] + bl[bi] : -INFINITY; tmax = fmaxf(tmax, sv[r]); }
                }
                tmax = fmaxf(tmax, __shfl_xor(tmax, 32));
                if (__any(tmax > mx)) {
                    const float mn = fmaxf(mx, tmax), scl = __builtin_amdgcn_exp2f(mx - mn); mx = mn; lsum *= scl;
#pragma unroll
                    for (int r = 0; r < 16; ++r) { o0[r] *= scl; o1[r] *= scl; }
                }
                float pr[16];
#pragma unroll
                for (int r = 0; r < 16; ++r) { pr[r] = __builtin_amdgcn_exp2f(sv[r] - mx); lsum += pr[r]; }
#pragma unroll
                for (int s2 = 0; s2 < 2; ++s2) {
                    u32x4 pw; pw.x = pk2(pr[8 * s2 + 0], pr[8 * s2 + 1]); pw.y = pk2(pr[8 * s2 + 2], pr[8 * s2 + 3]); pw.z = pk2(pr[8 * s2 + 4], pr[8 * s2 + 5]); pw.w = pk2(pr[8 * s2 + 6], pr[8 * s2 + 7]);
                    const bf16x8 pb = __builtin_bit_cast(bf16x8, pw);
                    const int koff = (kt * 32 + 16 * s2 + 4 * h5) * 2;
                    { const LAS unsigned char* vb = F.lds + AT_V + c31 * AT_VS + koff; const u32x2 lo = *(const LAS u32x2*)vb, hi = *(const LAS u32x2*)(vb + 16);
                      const bf16x8 vf = __builtin_bit_cast(bf16x8, (u32x4){lo.x, lo.y, hi.x, hi.y}); o0 = __builtin_amdgcn_mfma_f32_32x32x16_bf16(vf, pb, o0, 0, 0, 0); }
                    { const LAS unsigned char* vb = F.lds + AT_V + (32 + c31) * AT_VS + koff; const u32x2 lo = *(const LAS u32x2*)vb, hi = *(const LAS u32x2*)(vb + 16);
                      const bf16x8 vf = __builtin_bit_cast(bf16x8, (u32x4){lo.x, lo.y, hi.x, hi.y}); o1 = __builtin_amdgcn_mfma_f32_32x32x16_bf16(vf, pb, o1, 0, 0, 0); }
                }
            }
            lsum += __shfl_xor(lsum, 32);
            const float linv = 1.0f / lsum;
            unsigned char* op = (unsigned char*)AO + (size_t)(tok0 + qi) * 1024 + hq * 64 + 4 * h5;
            const float ls = linv * AO8_SCALE;
#pragma unroll
            for (int gq = 0; gq < 4; ++gq) {
                int w0 = 0, w1 = 0;
                w0 = __builtin_amdgcn_cvt_pk_fp8_f32(o0[4 * gq] * ls, o0[4 * gq + 1] * ls, w0, false); w0 = __builtin_amdgcn_cvt_pk_fp8_f32(o0[4 * gq + 2] * ls, o0[4 * gq + 3] * ls, w0, true);
                w1 = __builtin_amdgcn_cvt_pk_fp8_f32(o1[4 * gq] * ls, o1[4 * gq + 1] * ls, w1, false); w1 = __builtin_amdgcn_cvt_pk_fp8_f32(o1[4 * gq + 2] * ls, o1[4 * gq + 3] * ls, w1, true);
                *(unsigned*)(op + 8 * gq) = (unsigned)w0; *(unsigned*)(op + 32 + 8 * gq) = (unsigned)w1; }
        }
    }
}

__device__ __forceinline__ unsigned enc_key(float f, unsigned tag, unsigned mask) { unsigned u = __builtin_bit_cast(unsigned, f); u = (u & ~mask) | tag; return (u & 0x80000000u) ? ~u : (u | 0x80000000u); }
__device__ __forceinline__ unsigned dec_key(unsigned m) { return (m & 0x80000000u) ? (m & 0x7fffffffu) : ~m; }
__device__ __forceinline__ unsigned umax(unsigned a, unsigned b) { return a > b ? a : b; }
__device__ __forceinline__ unsigned umin(unsigned a, unsigned b) { return a < b ? a : b; }
#define SORT_CE(i, j) do { const unsigned hi_ = umax(a[i], a[j]), lo_ = umin(a[i], a[j]); a[i] = hi_; a[j] = lo_; } while (0)
__device__ __forceinline__ void sort16_desc(unsigned (&a)[16]) {
    SORT_CE(0, 13); SORT_CE(1, 12); SORT_CE(2, 15); SORT_CE(3, 14); SORT_CE(4, 8); SORT_CE(5, 6); SORT_CE(7, 11); SORT_CE(9, 10);
    SORT_CE(0, 5); SORT_CE(1, 7); SORT_CE(2, 9); SORT_CE(3, 4); SORT_CE(6, 13); SORT_CE(8, 14); SORT_CE(10, 15); SORT_CE(11, 12);
    SORT_CE(0, 1); SORT_CE(2, 3); SORT_CE(4, 5); SORT_CE(6, 8); SORT_CE(7, 9); SORT_CE(10, 11); SORT_CE(12, 13); SORT_CE(14, 15);
    SORT_CE(0, 2); SORT_CE(1, 3); SORT_CE(4, 10); SORT_CE(5, 11); SORT_CE(6, 7); SORT_CE(8, 9); SORT_CE(12, 14); SORT_CE(13, 15);
    SORT_CE(1, 2); SORT_CE(3, 12); SORT_CE(4, 6); SORT_CE(5, 7); SORT_CE(8, 10); SORT_CE(9, 11); SORT_CE(13, 14);
    SORT_CE(1, 4); SORT_CE(2, 6); SORT_CE(5, 8); SORT_CE(7, 10); SORT_CE(9, 13); SORT_CE(11, 14);
    SORT_CE(2, 4); SORT_CE(3, 6); SORT_CE(9, 12); SORT_CE(11, 13);
    SORT_CE(3, 5); SORT_CE(6, 8); SORT_CE(7, 9); SORT_CE(10, 12);
    SORT_CE(3, 4); SORT_CE(5, 6); SORT_CE(7, 8); SORT_CE(9, 10); SORT_CE(11, 12);
    SORT_CE(6, 7); SORT_CE(8, 9);
}
#undef SORT_CE
__device__ __forceinline__ void merge16_desc(unsigned (&a)[16]) {
#pragma unroll
    for (int jj = 3; jj >= 0; --jj)
#pragma unroll
        for (int i = 0; i < 16; ++i) { const int j = 1 << jj, l = i ^ j; if (l > i) { const unsigned hi = umax(a[i], a[l]), lo = umin(a[i], a[l]); a[i] = hi; a[l] = lo; } }
}
template <int CTRL> __device__ __forceinline__ void xmerge16(unsigned (&a)[16]) {
    unsigned p[16];
#pragma unroll
    for (int i = 0; i < 16; ++i) p[i] = (unsigned)__builtin_amdgcn_update_dpp(0, (int)a[i], CTRL, 0xf, 0xf, true);
#pragma unroll
    for (int i = 0; i < 16; ++i) a[i] = umax(a[i], p[15 - i]);
    merge16_desc(a);
}
template <int CTRL> __device__ __forceinline__ unsigned dpp_u(unsigned v) { return (unsigned)__builtin_amdgcn_update_dpp(0, (int)v, CTRL, 0xf, 0xf, true); }
__device__ __forceinline__ void topk_phase_v3(const Frame& F) {
    const bf16_t* S = (const bf16_t*)(F.ws + WS_S); int* IDX = (int*)(F.ws + WS_IDX); float* GATE = (float*)(F.ws + WS_GATE);
    LAS unsigned* L = (LAS unsigned*)F.lds + F.wave * 1024;
    const int lane = F.lane, tk = lane >> 4, hc = lane & 15, h = hc >> 1, c = hc & 1;
    auto step = [&](const u32x4 (&cur)[16], const int tb) __attribute__((always_inline)) {
        const int t = tb + tk;
        unsigned top[16];
#pragma unroll
        for (int ck = 0; ck < 8; ++ck) {
            const u32x4 v = cur[2 * ck], w = cur[2 * ck + 1];
            const float fv[16] = {hlo(v.x), hhi(v.x), hlo(v.y), hhi(v.y), hlo(v.z), hhi(v.z), hlo(v.w), hhi(v.w), hlo(w.x), hhi(w.x), hlo(w.y), hhi(w.y), hlo(w.z), hhi(w.z), hlo(w.w), hhi(w.w)};
            unsigned nw[16];
#pragma unroll
            for (int j = 0; j < 16; ++j) nw[j] = enc_key(fv[j], (unsigned)(16 * ck + j), 127u);
            sort16_desc(nw);
            if (ck == 0) {
#pragma unroll
                for (int j = 0; j < 16; ++j) top[j] = nw[j];
            } else {
#pragma unroll
                for (int j = 0; j < 16; ++j) top[j] = umax(top[j], nw[15 - j]);
                merge16_desc(top);
            }
        }
#pragma unroll
        for (int i = 0; i < 16; ++i) L[lane * 16 + i] = top[i];
        float f1[16], f2[16];
#pragma unroll
        for (int i = 0; i < 16; ++i) { const unsigned o = dpp_u<0xB1>(top[i]); const unsigned u1 = dec_key(c ? o : top[i]) & ~127u, u2 = dec_key(c ? top[i] : o) & ~127u;
            f1[i] = __builtin_bit_cast(float, u1); f2[i] = __builtin_bit_cast(float, u2); }
        unsigned ca[16], cb[16];
#pragma unroll
        for (int i = 0; i < 16; ++i) { ca[i] = 0u; cb[i] = 0u; }
        { int n = 0;
#pragma unroll
          for (int i = 0; i < 16; ++i)
#pragma unroll
            for (int j = 0; j < 16; ++j) if ((i + 1) * (j + 1) <= 16) { const unsigned key = enc_key(f1[i] + f2[j], (unsigned)((i << 4) | j), 255u); const int slot = n >> 1, who = n & 1;
                if (slot < 16) ca[slot] = (c == who) ? key : ca[slot]; else cb[slot - 16] = (c == who) ? key : cb[slot - 16]; ++n; } }
        sort16_desc(ca); sort16_desc(cb);
#pragma unroll
        for (int i = 0; i < 16; ++i) ca[i] = umax(ca[i], cb[15 - i]);
        merge16_desc(ca);
        xmerge16<0xB1>(ca);
        float sc[8]; unsigned ex[8];
#pragma unroll
        for (int k = 0; k < 8; ++k) { unsigned wlo = ca[k], whi = ca[8 + k]; asm volatile("" : "+v"(wlo), "+v"(whi));
            const unsigned w = c ? whi : wlo;
            const unsigned tag = dec_key(w) & 255u; const unsigned u1 = dec_key(L[(lane & ~1) * 16 + (tag >> 4)]), u2 = dec_key(L[(lane | 1) * 16 + (tag & 15u)]);
            sc[k] = __builtin_bit_cast(float, u1 & ~127u) + __builtin_bit_cast(float, u2 & ~127u); ex[k] = ((u1 & 127u) << 7) | (u2 & 127u); }
        const float smax = __builtin_bit_cast(float, __builtin_amdgcn_update_dpp(0, __builtin_bit_cast(int, sc[0]), 0xA0, 0xf, 0xf, true));
        float e[8]; float sum = 0.f;
#pragma unroll
        for (int k = 0; k < 8; ++k) { e[k] = __expf(sc[k] - smax); sum += e[k]; }
        sum += __builtin_bit_cast(float, __builtin_amdgcn_update_dpp(0, __builtin_bit_cast(int, sum), 0xB1, 0xf, 0xf, true));
        const float inv = 1.0f / sum;
        int* ip = IDX + (size_t)t * 128 + h * 16 + 8 * c; float* gp = GATE + (size_t)t * 128 + h * 16 + 8 * c;
        *(u32x4*)ip = (u32x4){ex[0], ex[1], ex[2], ex[3]}; *(u32x4*)(ip + 4) = (u32x4){ex[4], ex[5], ex[6], ex[7]};
        *(f32x4*)gp = (f32x4){e[0] * inv, e[1] * inv, e[2] * inv, e[3] * inv}; *(f32x4*)(gp + 4) = (f32x4){e[4] * inv, e[5] * inv, e[6] * inv, e[7] * inv};
    };
#define TK_LD1(dst, ptr, OFF) asm volatile("global_load_dwordx4 %0, %1, off offset:" #OFF : "=v"(dst) : "v"(ptr) : "memory")
#define TK_LOAD(buf, tb_) do { const u32x4* sp_ = (const u32x4*)(S + (size_t)((tb_) + tk) * 2048 + hc * 128); \
        TK_LD1(buf[0], sp_, 0); TK_LD1(buf[1], sp_, 16); TK_LD1(buf[2], sp_, 32); TK_LD1(buf[3], sp_, 48); TK_LD1(buf[4], sp_, 64); TK_LD1(buf[5], sp_, 80); TK_LD1(buf[6], sp_, 96); TK_LD1(buf[7], sp_, 112); \
        TK_LD1(buf[8], sp_, 128); TK_LD1(buf[9], sp_, 144); TK_LD1(buf[10], sp_, 160); TK_LD1(buf[11], sp_, 176); TK_LD1(buf[12], sp_, 192); TK_LD1(buf[13], sp_, 208); TK_LD1(buf[14], sp_, 224); TK_LD1(buf[15], sp_, 240); } while (0)
#define TK_WAIT(buf, N) asm volatile("s_waitcnt vmcnt(" #N ")" : "+v"(buf[0]), "+v"(buf[1]), "+v"(buf[2]), "+v"(buf[3]), "+v"(buf[4]), "+v"(buf[5]), "+v"(buf[6]), "+v"(buf[7]), \
        "+v"(buf[8]), "+v"(buf[9]), "+v"(buf[10]), "+v"(buf[11]), "+v"(buf[12]), "+v"(buf[13]), "+v"(buf[14]), "+v"(buf[15]) :: "memory")
    const int dstep = 4 * F.NGW; int tb = 4 * F.gw;
    u32x4 bufa[16], bufb[16];
    if (tb >= T) return;
    TK_LOAD(bufa, tb);
    for (;;) {
        const int t1 = tb + dstep; TK_LOAD(bufb, t1 < T ? t1 : tb);
        TK_WAIT(bufa, 16);
        step(bufa, tb);
        if (t1 >= T) break;
        const int t2 = t1 + dstep; TK_LOAD(bufa, t2 < T ? t2 : t1);
        TK_WAIT(bufb, 16);
        step(bufb, t1);
        if (t2 >= T) break;
        tb = t2;
    }
    asm volatile("s_waitcnt vmcnt(0)" ::: "memory");
#undef TK_LOAD
#undef TK_LD1
#undef TK_WAIT
}

template <int S> __device__ __forceinline__ void reduce_scatter16(const float (&v)[16], int lane, float& z0, float& z1) {
    const bool b2 = (lane & (4 * S)) != 0, b1 = (lane & (2 * S)) != 0, b0 = (lane & S) != 0;
    float u[8], w[4];
#pragma unroll
    for (int k = 0; k < 8; ++k) { const float keep = b2 ? v[8 + k] : v[k], send = b2 ? v[k] : v[8 + k]; u[k] = keep + __shfl_xor(send, 4 * S); }
#pragma unroll
    for (int k = 0; k < 4; ++k) { const float keep = b1 ? u[4 + k] : u[k], send = b1 ? u[k] : u[4 + k]; w[k] = keep + __shfl_xor(send, 2 * S); }
    { const float keep = b0 ? w[2] : w[0], send = b0 ? w[0] : w[2]; z0 = keep + __shfl_xor(send, S); }
    { const float keep = b0 ? w[3] : w[1], send = b0 ? w[1] : w[3]; z1 = keep + __shfl_xor(send, S); }
}
__device__ __forceinline__ void ld_off16(const int* IDX, int t, int g, unsigned off, unsigned (&e)[16]) {
    const u32x4* ip = (const u32x4*)((const char*)IDX + (unsigned)(t * 512 + 64 * g)); const u32x4 i0 = ip[0], i1 = ip[1], i2 = ip[2], i3 = ip[3];
    e[0] = i0.x * 128u + off; e[1] = i0.y * 128u + off; e[2] = i0.z * 128u + off; e[3] = i0.w * 128u + off; e[4] = i1.x * 128u + off; e[5] = i1.y * 128u + off; e[6] = i1.z * 128u + off; e[7] = i1.w * 128u + off;
    e[8] = i2.x * 128u + off; e[9] = i2.y * 128u + off; e[10] = i2.z * 128u + off; e[11] = i2.w * 128u + off; e[12] = i3.x * 128u + off; e[13] = i3.y * 128u + off; e[14] = i3.z * 128u + off; e[15] = i3.w * 128u + off;
}
__device__ __forceinline__ void gather16(const unsigned char* tab, const unsigned (&e)[16], u32x4 (&wv)[16]) {
#pragma unroll
    for (int i = 0; i < 16; ++i) wv[i] = *(const u32x4*)(tab + e[i]);
}
#define FP4X32(W_, o) do { const u32x4 _w = (W_); \
    o[0] = __builtin_amdgcn_cvt_scalef32_pk_f32_fp4(_w.x, 1.0f, 0); o[1] = __builtin_amdgcn_cvt_scalef32_pk_f32_fp4(_w.x, 1.0f, 1); o[2] = __builtin_amdgcn_cvt_scalef32_pk_f32_fp4(_w.x, 1.0f, 2); o[3] = __builtin_amdgcn_cvt_scalef32_pk_f32_fp4(_w.x, 1.0f, 3); \
    o[4] = __builtin_amdgcn_cvt_scalef32_pk_f32_fp4(_w.y, 1.0f, 0); o[5] = __builtin_amdgcn_cvt_scalef32_pk_f32_fp4(_w.y, 1.0f, 1); o[6] = __builtin_amdgcn_cvt_scalef32_pk_f32_fp4(_w.y, 1.0f, 2); o[7] = __builtin_amdgcn_cvt_scalef32_pk_f32_fp4(_w.y, 1.0f, 3); \
    o[8] = __builtin_amdgcn_cvt_scalef32_pk_f32_fp4(_w.z, 1.0f, 0); o[9] = __builtin_amdgcn_cvt_scalef32_pk_f32_fp4(_w.z, 1.0f, 1); o[10] = __builtin_amdgcn_cvt_scalef32_pk_f32_fp4(_w.z, 1.0f, 2); o[11] = __builtin_amdgcn_cvt_scalef32_pk_f32_fp4(_w.z, 1.0f, 3); \
    o[12] = __builtin_amdgcn_cvt_scalef32_pk_f32_fp4(_w.w, 1.0f, 0); o[13] = __builtin_amdgcn_cvt_scalef32_pk_f32_fp4(_w.w, 1.0f, 1); o[14] = __builtin_amdgcn_cvt_scalef32_pk_f32_fp4(_w.w, 1.0f, 2); o[15] = __builtin_amdgcn_cvt_scalef32_pk_f32_fp4(_w.w, 1.0f, 3); } while (0)
__device__ __forceinline__ void peer_down_phase4(const Frame& F, int layer) {
    const int bx = blockIdx.x, p4 = bx & 3, par = (bx >> 2) & 1;
    const unsigned char* TD = F.ws + WS_TAB + (size_t)(2 * layer) * 16 * MiB + (size_t)p4 * (2 * MiB); const char* HNb = (const char*)(F.ws + WS_HN);
    const int* IDX = (const int*)(F.ws + WS_IDX); bf16_t* PART = (bf16_t*)(F.ws + WS_PART);
    const int nwp = (F.G - (bx & 7) + 7) >> 3, ww = (bx >> 3) * 8 + F.wave, stride = 2 * nwp * 8, tfirst = 2 * ww + par;
    const int lane = F.lane, r = lane & 7, g = lane >> 3, off = 256 * p4 + 32 * r;
    if (tfirst >= T) return;
    unsigned e1[16]; u32x4 wv[16];
    const unsigned toff = 16u * r;
    ld_off16(IDX, tfirst, g, toff, e1); gather16(TD, e1, wv);
    u32x4 xc[4];
#pragma unroll
    for (int k = 0; k < 4; ++k) xc[k] = *(const u32x4*)(HNb + (unsigned)(tfirst * 2048 + 2 * off + 16 * k));
    { const int t1 = tfirst + stride < T ? tfirst + stride : tfirst; ld_off16(IDX, t1, g, toff, e1); }
    for (int t0 = tfirst; t0 < T; t0 += stride) {
        const int t1 = t0 + stride < T ? t0 + stride : t0, t2 = t0 + 2 * stride < T ? t0 + 2 * stride : t0;
        unsigned e2[16]; ld_off16(IDX, t2, g, toff, e2);
        u32x4 xn[4];
#pragma unroll
        for (int k = 0; k < 4; ++k) xn[k] = *(const u32x4*)(HNb + (unsigned)(t1 * 2048 + 2 * off + 16 * k));
        const unsigned xw[16] = {xc[0].x, xc[0].y, xc[0].z, xc[0].w, xc[1].x, xc[1].y, xc[1].z, xc[1].w, xc[2].x, xc[2].y, xc[2].z, xc[2].w, xc[3].x, xc[3].y, xc[3].z, xc[3].w};
        float acc[16];
#pragma unroll
        for (int i = 0; i < 16; ++i) { const u32x4 w = wv[i]; wv[i] = *(const u32x4*)(TD + e1[i]);
            const unsigned ww4[4] = {w.x, w.y, w.z, w.w}; float sv = 0.f;
#pragma unroll
            for (int k = 0; k < 4; ++k) {
                sv = __builtin_amdgcn_fdot2_f32_bf16(__builtin_amdgcn_cvt_scalef32_pk_bf16_fp4(ww4[k], 1.0f, 0), __builtin_bit_cast(bfx2, xw[4 * k]), sv, false);
                sv = __builtin_amdgcn_fdot2_f32_bf16(__builtin_amdgcn_cvt_scalef32_pk_bf16_fp4(ww4[k], 1.0f, 1), __builtin_bit_cast(bfx2, xw[4 * k + 1]), sv, false);
                sv = __builtin_amdgcn_fdot2_f32_bf16(__builtin_amdgcn_cvt_scalef32_pk_bf16_fp4(ww4[k], 1.0f, 2), __builtin_bit_cast(bfx2, xw[4 * k + 2]), sv, false);
                sv = __builtin_amdgcn_fdot2_f32_bf16(__builtin_amdgcn_cvt_scalef32_pk_bf16_fp4(ww4[k], 1.0f, 3), __builtin_bit_cast(bfx2, xw[4 * k + 3]), sv, false); }
            acc[i] = sv; }
        float z0, z1; reduce_scatter16<1>(acc, lane, z0, z1);
        *(unsigned*)((char*)(PART + (size_t)p4 * T * 128) + (unsigned)(t0 * 256 + 32 * g + 4 * r)) = pk2(z0, z1);
#pragma unroll
        for (int k = 0; k < 4; ++k) xc[k] = xn[k];
#pragma unroll
        for (int i = 0; i < 16; ++i) e1[i] = e2[i];
    }
}
constexpr int D5_AUX = 131072;
#define D5_EL(iv, d) ((iv)[2 * ((d) & 1) + ((d) >> 3)][((d) >> 1) & 3])
#define D5_DMA(iv, d) __builtin_amdgcn_global_load_lds((const unsigned*)(TD + (D5_EL(iv, d) * 128u + (((d) & 1) ? sw1 : sw0))), (LAS unsigned*)(wl + (d) * 1024), 16, 0, 0)
#define D5_DMA_IDX(t, slot) do { __builtin_amdgcn_global_load_lds((const unsigned*)(IDX + (unsigned)((t) * 512) + l4), (LAS unsigned*)(xl + (slot) * 512), 4, 0, 0); \
                                 __builtin_amdgcn_global_load_lds((const unsigned*)(IDX + (unsigned)((t) * 512) + 256u + l4), (LAS unsigned*)(xl + (slot) * 512 + 256), 4, 0, 0); } while (0)
#define D5_DMA_H(t, slot) __builtin_amdgcn_global_load_lds((const unsigned*)(H8 + (unsigned)((t) * 1024) + l4), (LAS unsigned*)(xl + 1024 + (slot) * 256), 4, 0, 0)
#define D5_B(h, c) ((i32x8){(int)h[2 * (c)].x, (int)h[2 * (c)].y, (int)h[2 * (c)].z, (int)h[2 * (c)].w, (int)h[2 * (c) + 1].x, (int)h[2 * (c) + 1].y, (int)h[2 * (c) + 1].z, (int)h[2 * (c) + 1].w})
#define D5_A(a) ((i32x8){(int)(a).x, (int)(a).y, (int)(a).z, (int)(a).w, 0, 0, 0, 0})
__device__ __forceinline__ void peer_down_phase5(const Frame& F, int layer) {
    const int bx = blockIdx.x, p4 = bx & 3, par = (bx >> 2) & 1;
    const unsigned char* TD = F.ws + WS_TAB + (size_t)(2 * layer) * 16 * MiB + (size_t)p4 * (2 * MiB);
    const char* H8 = (const char*)(F.ws + WS_HN8) + 256 * p4; const char* IDX = (const char*)(F.ws + WS_IDX); char* PART = (char*)(F.ws + WS_PART) + (size_t)p4 * T * 256;
    const int nwp = (F.G - (bx & 7) + 7) >> 3, ww = (bx >> 3) * 8 + F.wave, stride = 2 * nwp * 8, tfirst = 2 * ww + par;
    if (tfirst >= T) return;
    const int lane = F.lane, rs = lane >> 3, sg = lane & 7, m = lane & 15, kg = lane >> 4;
    LAS unsigned char* wl = F.lds + F.wave * 16384; LAS unsigned char* xl = F.lds + D5_AUX + F.wave * 1536;
    const unsigned sw0 = (unsigned)((sg ^ kg) * 16), sw1 = (unsigned)((sg ^ (4 + kg)) * 16);
    const unsigned rd0 = (unsigned)(m * 128 + (kg ^ (m >> 1)) * 16), rd1 = (unsigned)(m * 128 + ((4 + kg) ^ (m >> 1)) * 16);
    const unsigned l4 = 4u * lane, ioff = 32u * rs, hoff = 16u * kg;
    { const u32x4* ip = (const u32x4*)(IDX + (unsigned)(tfirst * 512) + ioff); u32x4 i0[4]; i0[0] = ip[0]; i0[1] = ip[1]; i0[2] = ip[16]; i0[3] = ip[17];
      asm volatile("" : "+v"(i0[0]), "+v"(i0[1]), "+v"(i0[2]), "+v"(i0[3]) :: "memory");
      { const int t1 = tfirst + stride < T ? tfirst + stride : tfirst; D5_DMA_IDX(t1, 1); D5_DMA_H(tfirst, 0); }
      asm volatile("" ::: "memory");
#pragma unroll
      for (int d = 0; d < 16; ++d) D5_DMA(i0, d); }
    int sl = 0;
    for (int t0 = tfirst; t0 < T; t0 += stride, sl ^= 1) {
        const int t1 = t0 + stride < T ? t0 + stride : t0, t2 = t0 + 2 * stride < T ? t0 + 2 * stride : t0;
        D5_DMA_IDX(t2, sl); D5_DMA_H(t1, sl ^ 1);
        u32x4 i1[4], hb[4];
        f32x4 acc[8];
#pragma unroll
        for (int q = 0; q < 4; ++q) {
            asm volatile("s_waitcnt vmcnt(15)" ::: "memory");
            u32x4 a00 = *(const LAS u32x4*)(wl + (2 * q) * 2048 + rd0), a01 = *(const LAS u32x4*)(wl + (2 * q) * 2048 + rd1);
            u32x4 a10 = *(const LAS u32x4*)(wl + (2 * q + 1) * 2048 + rd0), a11 = *(const LAS u32x4*)(wl + (2 * q + 1) * 2048 + rd1);
            if (q == 0) {
                const LAS u32x4* ip = (const LAS u32x4*)(xl + (sl ^ 1) * 512 + ioff); i1[0] = ip[0]; i1[1] = ip[1]; i1[2] = ip[16]; i1[3] = ip[17];
                const LAS u32x4* hp = (const LAS u32x4*)(xl + 1024 + sl * 256 + hoff); hb[0] = hp[0]; hb[1] = hp[4]; hb[2] = hp[8]; hb[3] = hp[12];
                asm volatile("s_waitcnt lgkmcnt(0)" : "+v"(i1[0]), "+v"(i1[1]), "+v"(i1[2]), "+v"(i1[3]), "+v"(hb[0]), "+v"(hb[1]), "+v"(hb[2]), "+v"(hb[3]) :: "memory");
            }
            asm volatile("s_waitcnt lgkmcnt(0)" : "+v"(a00), "+v"(a01), "+v"(a10), "+v"(a11) :: "memory");
            D5_DMA(i1, 4 * q); D5_DMA(i1, 4 * q + 1); D5_DMA(i1, 4 * q + 2); D5_DMA(i1, 4 * q + 3);
            asm volatile("" ::: "memory");
            const i32x8 b0 = D5_B(hb, 0), b1 = D5_B(hb, 1);
            const f32x4 z = {0.f, 0.f, 0.f, 0.f};
            acc[2 * q] = __builtin_amdgcn_mfma_scale_f32_16x16x128_f8f6f4(D5_A(a00), b0, z, 4, 0, 0, 0, 0, 0);
            acc[2 * q + 1] = __builtin_amdgcn_mfma_scale_f32_16x16x128_f8f6f4(D5_A(a10), b0, z, 4, 0, 0, 0, 0, 0);
            acc[2 * q] = __builtin_amdgcn_mfma_scale_f32_16x16x128_f8f6f4(D5_A(a01), b1, acc[2 * q], 4, 0, 0, 0, 0, 0);
            acc[2 * q + 1] = __builtin_amdgcn_mfma_scale_f32_16x16x128_f8f6f4(D5_A(a11), b1, acc[2 * q + 1], 4, 0, 0, 0, 0, 0);
        }
        if (m < 4) {
            float v[8];
#pragma unroll
            for (int j = 0; j < 8; ++j) v[j] = m == 0 ? acc[j].x : m == 1 ? acc[j].y : m == 2 ? acc[j].z : acc[j].w;
            *(u32x4*)(PART + (unsigned)(t0 * 256 + 16 * (4 * kg + m))) = (u32x4){pk2(v[0], v[1]), pk2(v[2], v[3]), pk2(v[4], v[5]), pk2(v[6], v[7])};
        }
    }
    asm volatile("s_waitcnt vmcnt(0)" ::: "memory");
}
template <int NS> __device__ __forceinline__ void peer_reduce_phase(const Frame& F, int layer) {
    const u32x2* PART = (const u32x2*)(F.ws + WS_PART); const int* IDX = (const int*)(F.ws + WS_IDX); const float* GATE = (const float*)(F.ws + WS_GATE);
    bf16_t* AB = (bf16_t*)(F.ws + WS_AB);
    const f32x2* scl = (const f32x2*)(F.ws + WS_SCL) + (size_t)layer * 16384;
    const size_t n4 = (size_t)T * 128 / 4, stride = (size_t)F.G * 512;
    for (size_t i = (size_t)blockIdx.x * 512 + F.tid; i < n4; i += stride) {
        u32x2 pw[NS];
#pragma unroll
        for (int p = 0; p < NS; ++p) pw[p] = PART[(size_t)p * T * 32 + i];
        const u32x4 e = ((const u32x4*)IDX)[i]; const f32x4 gt = ((const f32x4*)GATE)[i];
        const f32x2 c0 = scl[e.x], c1 = scl[e.y], c2 = scl[e.z], c3 = scl[e.w];
        f32x4 s = {0.f, 0.f, 0.f, 0.f};
#pragma unroll
        for (int p = 0; p < NS; ++p) { s.x += bflo(pw[p].x); s.y += bfhi(pw[p].x); s.z += bflo(pw[p].y); s.w += bfhi(pw[p].y); }
        f32x4 o;
        o.x = gelu_tanh(s.x * c0.x) * gt.x * c0.y; o.y = gelu_tanh(s.y * c1.x) * gt.y * c1.y;
        o.z = gelu_tanh(s.z * c2.x) * gt.z * c2.y; o.w = gelu_tanh(s.w * c3.x) * gt.w * c3.y;
        ((u32x2*)AB)[i] = (u32x2){pk2(o.x, o.y), pk2(o.z, o.w)};
    }
}
__device__ __forceinline__ void peer_reduce_phase8(const Frame& F, int layer) {
    const u32x2* PART = (const u32x2*)(F.ws + WS_PART); const int* IDX = (const int*)(F.ws + WS_IDX); const float* GATE = (const float*)(F.ws + WS_GATE);
    unsigned char* AB8 = F.ws + WS_AB;
    const f32x2* scl = (const f32x2*)(F.ws + WS_SCL) + (size_t)layer * 16384;
    const size_t n4 = (size_t)T * 128 / 4, stride = (size_t)F.G * 512;
    for (size_t i = (size_t)blockIdx.x * 512 + F.tid; i < n4; i += stride) {
        u32x2 pw[4];
#pragma unroll
        for (int p = 0; p < 4; ++p) pw[p] = PART[(size_t)p * T * 32 + i];
        const u32x4 e = ((const u32x4*)IDX)[i]; const f32x4 gt = ((const f32x4*)GATE)[i];
        const f32x2 c0 = scl[e.x], c1 = scl[e.y], c2 = scl[e.z], c3 = scl[e.w];
        f32x4 s = {0.f, 0.f, 0.f, 0.f};
#pragma unroll
        for (int p = 0; p < 4; ++p) { s.x += bflo(pw[p].x); s.y += bfhi(pw[p].x); s.z += bflo(pw[p].y); s.w += bfhi(pw[p].y); }
        f32x4 o;
        o.x = gelu_tanh(s.x * c0.x) * gt.x * c0.y; o.y = gelu_tanh(s.y * c1.x) * gt.y * c1.y;
        o.z = gelu_tanh(s.z * c2.x) * gt.z * c2.y; o.w = gelu_tanh(s.w * c3.x) * gt.w * c3.y;
        float am = fmaxf(fmaxf(fabsf(o.x), fabsf(o.y)), fmaxf(fabsf(o.z), fabsf(o.w)));
#pragma unroll
        for (int d = 1; d < 32; d <<= 1) am = fmaxf(am, __shfl_xor(am, d));
        const float S = am > 0.f ? 256.0f / am : 1.0f;
        int w = 0; w = __builtin_amdgcn_cvt_pk_fp8_f32(o.x * S, o.y * S, w, false); w = __builtin_amdgcn_cvt_pk_fp8_f32(o.z * S, o.w * S, w, true);
        const size_t t = i >> 5; const unsigned j = (unsigned)i & 31u;
        *(unsigned*)(AB8 + t * 256 + 4 * j) = (unsigned)w;
        if (j == 0) *(float*)(AB8 + t * 256 + 128) = am * (1.0f / 256.0f);
    }
}
__device__ __forceinline__ unsigned hadd2(unsigned a, unsigned b) { const h16x2 r = __builtin_bit_cast(h16x2, a) + __builtin_bit_cast(h16x2, b); return __builtin_bit_cast(unsigned, r); }
__device__ __forceinline__ f32x4 reduce_scatter32h_g(const unsigned (&v)[16], int lane) {
    const bool b2 = (lane & 32) != 0, b1 = (lane & 16) != 0, b0 = (lane & 8) != 0;
    unsigned u[8], w[4], z[2];
#pragma unroll
    for (int k = 0; k < 8; ++k) { const unsigned keep = b2 ? v[8 + k] : v[k], send = b2 ? v[k] : v[8 + k]; u[k] = hadd2(keep, (unsigned)__shfl_xor((int)send, 32)); }
#pragma unroll
    for (int k = 0; k < 4; ++k) { const unsigned keep = b1 ? u[4 + k] : u[k], send = b1 ? u[k] : u[4 + k]; w[k] = hadd2(keep, (unsigned)__shfl_xor((int)send, 16)); }
#pragma unroll
    for (int k = 0; k < 2; ++k) { const unsigned keep = b0 ? w[2 + k] : w[k], send = b0 ? w[k] : w[2 + k]; z[k] = hadd2(keep, (unsigned)__shfl_xor((int)send, 8)); }
    return (f32x4){hlo(z[0]), hhi(z[0]), hlo(z[1]), hhi(z[1])};
}
__device__ __forceinline__ void peer_up_phase4(const Frame& F, int layer) {
    const int bx = blockIdx.x, p4 = bx & 3, par = (bx >> 2) & 1;
    const unsigned char* TU = F.ws + WS_TAB + (size_t)(2 * layer + 1) * 16 * MiB + (size_t)p4 * (2 * MiB);
    const int* IDX = (const int*)(F.ws + WS_IDX); const char* AB = (const char*)(F.ws + WS_AB);
    const int nwp = (F.G - (bx & 7) + 7) >> 3, ww = (bx >> 3) * 8 + F.wave, stride = 2 * nwp * 8, tfirst = 2 * ww + par;
    const int lane = F.lane, r = lane & 7, g = lane >> 3, hoff = 256 * p4 + 32 * r + 4 * g;
    if (tfirst >= T) return;
    unsigned e1[16]; u32x4 wv[16];
    const unsigned toff = 16u * r;
    ld_off16(IDX, tfirst, g, toff, e1); gather16(TU, e1, wv);
    u32x4 a0a = *(const u32x4*)(AB + (unsigned)(tfirst * 256 + 32 * g)), a0b = *(const u32x4*)(AB + (unsigned)(tfirst * 256 + 32 * g + 16));
    { const int t1 = tfirst + stride < T ? tfirst + stride : tfirst; ld_off16(IDX, t1, g, toff, e1); }
    for (int t0 = tfirst; t0 < T; t0 += stride) {
        const int t1 = t0 + stride < T ? t0 + stride : t0, t2 = t0 + 2 * stride < T ? t0 + 2 * stride : t0;
        unsigned e2[16]; ld_off16(IDX, t2, g, toff, e2);
        const u32x4 a1a = *(const u32x4*)(AB + (unsigned)(t1 * 256 + 32 * g)), a1b = *(const u32x4*)(AB + (unsigned)(t1 * 256 + 32 * g + 16));
        f32x4* hp = (f32x4*)((char*)F.out + (unsigned)(t0 * 4096 + 4 * hoff)); const f32x4 h0 = *hp;
        const unsigned aw[8] = {a0a.x, a0a.y, a0a.z, a0a.w, a0b.x, a0b.y, a0b.z, a0b.w};
        unsigned y2[16];
#pragma unroll
        for (int k = 0; k < 16; ++k) y2[k] = 0u;
#pragma unroll
        for (int i = 0; i < 16; ++i) { u32x4 w = wv[i]; wv[i] = *(const u32x4*)(TU + e1[i]);
            if (i > 0) asm volatile("" : "+v"(w.x), "+v"(w.y), "+v"(w.z), "+v"(w.w) : "v"(y2[0]), "v"(y2[15]));
            const float ai = (i & 1) ? bfhi(aw[i >> 1]) : bflo(aw[i >> 1]); const h16x2 av = {(_Float16)ai, (_Float16)ai};
            const unsigned ww4[4] = {w.x, w.y, w.z, w.w};
#pragma unroll
            for (int k = 0; k < 4; ++k) {
                { const h16x2 r = av * __builtin_amdgcn_cvt_scalef32_pk_f16_fp4(ww4[k], 1.0f, 0) + __builtin_bit_cast(h16x2, y2[4 * k]); y2[4 * k] = __builtin_bit_cast(unsigned, r); }
                { const h16x2 r = av * __builtin_amdgcn_cvt_scalef32_pk_f16_fp4(ww4[k], 1.0f, 1) + __builtin_bit_cast(h16x2, y2[4 * k + 1]); y2[4 * k + 1] = __builtin_bit_cast(unsigned, r); }
                { const h16x2 r = av * __builtin_amdgcn_cvt_scalef32_pk_f16_fp4(ww4[k], 1.0f, 2) + __builtin_bit_cast(h16x2, y2[4 * k + 2]); y2[4 * k + 2] = __builtin_bit_cast(unsigned, r); }
                { const h16x2 r = av * __builtin_amdgcn_cvt_scalef32_pk_f16_fp4(ww4[k], 1.0f, 3) + __builtin_bit_cast(h16x2, y2[4 * k + 3]); y2[4 * k + 3] = __builtin_bit_cast(unsigned, r); } } }
        const f32x4 z = reduce_scatter32h_g(y2, lane);
        *hp = h0 + z;
        a0a = a1a; a0b = a1b;
#pragma unroll
        for (int i = 0; i < 16; ++i) e1[i] = e2[i];
    }
}

constexpr int U5_AUX = 131072;
__device__ __forceinline__ void peer_up_phase5(const Frame& F, int layer) {
    const int bx = blockIdx.x, p4 = bx & 3, par = (bx >> 2) & 1;
    const unsigned char* TU = F.ws + WS_TAB + (size_t)(2 * layer + 1) * 16 * MiB + (size_t)p4 * (2 * MiB);
    const char* IDX = (const char*)(F.ws + WS_IDX); const char* AB8 = (const char*)(F.ws + WS_AB);
    char* H8 = (char*)(F.ws + WS_H8) + 256 * p4; float* HSQ = (float*)(F.ws + WS_HSQ);
    const char* HIN = (const char*)F.out + 512 * p4; char* OUT = (layer == 1 ? (char*)(F.ws + WS_H2) : (char*)F.out) + 512 * p4;
    const int nwp = (F.G - (bx & 7) + 7) >> 3, ww = (bx >> 3) * 8 + F.wave, stride = 2 * nwp * 8, tfirst = 2 * ww + par;
    if (tfirst >= T) return;
    const int lane = F.lane, rs = lane >> 3, sg = lane & 7, m = lane & 15, kg = lane >> 4;
    LAS unsigned char* wl = F.lds + F.wave * 16384; LAS unsigned char* xl = F.lds + U5_AUX + F.wave * 3584;
    const unsigned sw0 = (unsigned)((sg ^ kg) * 16), sw1 = (unsigned)((sg ^ (4 + kg)) * 16);
    const unsigned l4 = 4u * lane, l16 = 16u * lane;
    unsigned tb[8];
#pragma unroll
    for (int sgm = 0; sgm < 8; ++sgm) tb[sgm] = (unsigned)((32 * kg + m) * 128 + ((sgm ^ (m >> 1)) * 16));
    const unsigned hrd = (unsigned)(32 * m + 8 * kg);
#define U5_PIECE(ixv, d) __builtin_amdgcn_global_load_lds((const unsigned*)(TU + ((ixv)[d] * 128u + (((d) & 1) ? sw1 : sw0))), (LAS unsigned*)(wl + (d) * 1024), 16, 0, 0)
#define U5_DMA_IDX(t, slot) do { __builtin_amdgcn_global_load_lds((const unsigned*)(IDX + (unsigned)((t) * 512) + l4), (LAS unsigned*)(xl + (slot) * 512), 4, 0, 0); \
                                 __builtin_amdgcn_global_load_lds((const unsigned*)(IDX + (unsigned)((t) * 512) + 256u + l4), (LAS unsigned*)(xl + (slot) * 512 + 256), 4, 0, 0); } while (0)
#define U5_DMA_AB(t, slot) __builtin_amdgcn_global_load_lds((const unsigned*)(AB8 + (unsigned)((t) * 256) + l4), (LAS unsigned*)(xl + 1024 + (slot) * 256), 4, 0, 0)
#define U5_DMA_H(t, slot) do { __builtin_amdgcn_global_load_lds((const unsigned*)(HIN + (unsigned)((t) * 2048) + l4), (LAS unsigned*)(xl + 1536 + (slot) * 1024), 4, 0, 0); \
                               __builtin_amdgcn_global_load_lds((const unsigned*)(HIN + (unsigned)((t) * 2048) + 256u + l4), (LAS unsigned*)(xl + 1536 + (slot) * 1024 + 256), 4, 0, 0); } while (0)
    { unsigned i0[16];
#pragma unroll
      for (int d = 0; d < 16; ++d) i0[d] = *(const unsigned*)(IDX + (unsigned)(tfirst * 512) + (unsigned)(4 * rs + 32 * d));
#pragma unroll
      for (int d = 0; d < 16; ++d) asm volatile("" : "+v"(i0[d]) :: "memory");
      { const int t1 = tfirst + stride < T ? tfirst + stride : tfirst; U5_DMA_IDX(t1, 1); U5_DMA_AB(tfirst, 0); U5_DMA_H(tfirst, 0); }
      asm volatile("" ::: "memory");
#pragma unroll
      for (int d = 0; d < 16; ++d) U5_PIECE(i0, d); }
    int sl = 0, tprev = -1; f32x4 pend = {0.f, 0.f, 0.f, 0.f};
    for (int t0 = tfirst; t0 < T; t0 += stride, sl ^= 1) {
        const int t1 = t0 + stride < T ? t0 + stride : t0, t2 = t0 + 2 * stride < T ? t0 + 2 * stride : t0;
        asm volatile("s_waitcnt vmcnt(0)" ::: "memory");
        unsigned ix[16];
        { const LAS unsigned* ip = (const LAS unsigned*)(xl + (sl ^ 1) * 512 + 4 * rs);
#pragma unroll
          for (int d = 0; d < 16; ++d) ix[d] = ip[8 * d]; }
        const LAS u32x4* bp = (const LAS u32x4*)(xl + 1024 + sl * 256 + 16 * kg); u32x4 bl = bp[0], bh = bp[4];
        float inv = *(const LAS float*)(xl + 1024 + sl * 256 + 128);
        u32x2 hw = *(const LAS u32x2*)(xl + 1536 + sl * 1024 + hrd);
        i32x2 a0[16], a1[16];
#pragma unroll
        for (int cb = 0; cb < 16; ++cb) {
            a0[cb] = __builtin_amdgcn_ds_read_tr4_b64_v2i32((LAS i32x2*)(wl + tb[cb >> 1] + (cb & 1) * 8));
            a1[cb] = __builtin_amdgcn_ds_read_tr4_b64_v2i32((LAS i32x2*)(wl + tb[cb >> 1] + (cb & 1) * 8 + 2048)); }
        asm volatile("s_waitcnt lgkmcnt(0)" : "+v"(bl), "+v"(bh), "+v"(inv), "+v"(hw) :: "memory");
#pragma unroll
        for (int d = 0; d < 16; ++d) asm volatile("" : "+v"(ix[d]), "+v"(a0[d]), "+v"(a1[d]) :: "memory");
        if (tprev >= 0) { *(u32x2*)(OUT + (unsigned)(tprev * 2048) + hrd) = (u32x2){pk2(pend.x, pend.y), pk2(pend.z, pend.w)};
            if (layer == 0) { int w8 = 0; w8 = __builtin_amdgcn_cvt_pk_fp8_f32(pend.x, pend.y, w8, false); w8 = __builtin_amdgcn_cvt_pk_fp8_f32(pend.z, pend.w, w8, true);
                *(unsigned*)(H8 + (unsigned)(tprev * 1024) + (hrd >> 1)) = (unsigned)w8;
                const float sq = wave_sum((pend.x * pend.x + pend.y * pend.y) + (pend.z * pend.z + pend.w * pend.w));
                if (lane == 0) HSQ[tprev * 4 + p4] = sq; } }
        asm volatile("" ::: "memory");
        U5_DMA_IDX(t2, sl); U5_DMA_AB(t1, sl ^ 1); U5_DMA_H(t1, sl ^ 1);
#pragma unroll
        for (int d = 0; d < 16; ++d) U5_PIECE(ix, d);
        asm volatile("" ::: "memory");
        const i32x8 b = {(int)bl.x, (int)bl.y, (int)bl.z, (int)bl.w, (int)bh.x, (int)bh.y, (int)bh.z, (int)bh.w};
        const f32x4 z = {0.f, 0.f, 0.f, 0.f};
        f32x4 v = z;
#pragma unroll
        for (int cb = 0; cb < 16; ++cb) {
            const i32x8 a = {a0[cb].x, a0[cb].y, a1[cb].x, a1[cb].y, 0, 0, 0, 0};
            const f32x4 r = __builtin_amdgcn_mfma_scale_f32_16x16x128_f8f6f4(a, b, z, 4, 0, 0, 0, 0, 0);
            v = (m == cb) ? r : v; }
        pend = (f32x4){bflo(hw.x), bfhi(hw.x), bflo(hw.y), bfhi(hw.y)} + v * inv; tprev = t0;
    }
    asm volatile("s_waitcnt vmcnt(0)" ::: "memory");
    *(u32x2*)(OUT + (unsigned)(tprev * 2048) + hrd) = (u32x2){pk2(pend.x, pend.y), pk2(pend.z, pend.w)};
    if (layer == 0) { int w8 = 0; w8 = __builtin_amdgcn_cvt_pk_fp8_f32(pend.x, pend.y, w8, false); w8 = __builtin_amdgcn_cvt_pk_fp8_f32(pend.z, pend.w, w8, true);
        *(unsigned*)(H8 + (unsigned)(tprev * 1024) + (hrd >> 1)) = (unsigned)w8;
        const float sq = wave_sum((pend.x * pend.x + pend.y * pend.y) + (pend.z * pend.z + pend.w * pend.w));
        if (lane == 0) HSQ[tprev * 4 + p4] = sq; }
#undef U5_PIECE
#undef U5_DMA_IDX
#undef U5_DMA_AB
#undef U5_DMA_H
}

constexpr int SGM_VT = 0, SGM_WL = 384 * 272, SGM_STAT = SGM_WL + 128 * 272;
__device__ __forceinline__ void sg_mix_phase(const Frame& F) {
    bf16_t* V = (bf16_t*)(F.ws + WS_SG);
    const float* lng = F.in[7]; const float* lnb = F.in[8]; const float* wsp = F.in[9]; const float* bsp = F.in[10];
    LAS unsigned* VT32 = (LAS unsigned*)(F.lds + SGM_VT); LAS bf16_t* VT = (LAS bf16_t*)(F.lds + SGM_VT); LAS bf16_t* WL = (LAS bf16_t*)(F.lds + SGM_WL);
    LAS float* stat = (LAS float*)(F.lds + SGM_STAT);
    const int lane = F.lane, tid = F.tid, fr = lane & 15, fq = lane >> 4;
    for (int c = blockIdx.x; c < 256; c += F.G) {
#pragma unroll 1
        for (int r4 = 0; r4 < 16; r4 += 4) {
            u32x4 w[4][6];
#pragma unroll
            for (int rr = 0; rr < 4; ++rr) { const u32x4* row = (const u32x4*)(V + (size_t)(c * 128 + F.wave * 16 + r4 + rr) * DG);
#pragma unroll
                for (int i = 0; i < 6; ++i) w[rr][i] = row[lane + 64 * i]; }
#pragma unroll
            for (int rr = 0; rr < 4; ++rr) { const int q = F.wave * 16 + r4 + rr;
                float v[48]; float s = 0.f;
#pragma unroll
                for (int i = 0; i < 6; ++i) { const u32x4 x = w[rr][i];
                    v[8 * i + 0] = bflo(x.x); v[8 * i + 1] = bfhi(x.x); v[8 * i + 2] = bflo(x.y); v[8 * i + 3] = bfhi(x.y); v[8 * i + 4] = bflo(x.z); v[8 * i + 5] = bfhi(x.z); v[8 * i + 6] = bflo(x.w); v[8 * i + 7] = bfhi(x.w); }
#pragma unroll
                for (int i = 0; i < 48; ++i) s += v[i];
                const float mean = wave_sum(s) * (1.f / DG); float s2 = 0.f;
#pragma unroll
                for (int i = 0; i < 48; ++i) { const float d = v[i] - mean; s2 += d * d; }
                const float rstd = 1.0f / sqrtf(wave_sum(s2) * (1.f / DG) + 1e-5f);
                if (lane == 0) { stat[2 * q] = mean; stat[2 * q + 1] = rstd; } }
        }
        __syncthreads();
#pragma unroll 1
        for (int g = 0; g < 8; ++g) {
#pragma unroll 1
            for (int it = 0; it < 4; ++it) { const int item = it * 512 + tid, p = item >> 4, q8 = (item & 15) * 8;
                const f32x4* wp = (const f32x4*)(wsp + ((size_t)g * 128 + p) * 128 + q8); const f32x4 a = wp[0], b = wp[1];
                u32x4 w; w.x = pk2(a.x, a.y); w.y = pk2(a.z, a.w); w.z = pk2(b.x, b.y); w.w = pk2(b.z, b.w);
                *(LAS u32x4*)(WL + p * 136 + q8) = w; }
#pragma unroll 1
            for (int it = 0; it < 6; ++it) { const int item = it * 512 + tid, qp = item & 63, dc = item >> 6; const int q0 = 2 * qp, col = g * 384 + 8 * dc;
                const u32x4 w0 = *(const u32x4*)(V + (size_t)(c * 128 + q0) * DG + col), w1 = *(const u32x4*)(V + (size_t)(c * 128 + q0 + 1) * DG + col);
                const float mu0 = stat[2 * q0], rs0 = stat[2 * q0 + 1], mu1 = stat[2 * q0 + 2], rs1 = stat[2 * q0 + 3];
                const f32x4 ga = *(const f32x4*)(lng + col), gb = *(const f32x4*)(lng + col + 4), ba = *(const f32x4*)(lnb + col), bb = *(const f32x4*)(lnb + col + 4);
                const float gm[8] = {ga.x, ga.y, ga.z, ga.w, gb.x, gb.y, gb.z, gb.w}, bt[8] = {ba.x, ba.y, ba.z, ba.w, bb.x, bb.y, bb.z, bb.w};
                const float a0[8] = {bflo(w0.x), bfhi(w0.x), bflo(w0.y), bfhi(w0.y), bflo(w0.z), bfhi(w0.z), bflo(w0.w), bfhi(w0.w)};
                const float a1[8] = {bflo(w1.x), bfhi(w1.x), bflo(w1.y), bfhi(w1.y), bflo(w1.z), bfhi(w1.z), bflo(w1.w), bfhi(w1.w)};
#pragma unroll
                for (int i = 0; i < 8; ++i) VT32[(8 * dc + i) * 68 + qp] = pk2((a0[i] - mu0) * rs0 * gm[i] + bt[i], (a1[i] - mu1) * rs1 * gm[i] + bt[i]); }
            __syncthreads();
            f32x4 acc[3][8];
#pragma unroll
            for (int a = 0; a < 3; ++a)
#pragma unroll
                for (int n = 0; n < 8; ++n) acc[a][n] = (f32x4){0.f, 0.f, 0.f, 0.f};
#pragma unroll 1
            for (int ks = 0; ks < 4; ++ks) { const int k0 = 32 * ks + 8 * fq;
                bf16x8 af[3], bfg[8];
#pragma unroll
                for (int a = 0; a < 3; ++a) af[a] = *(const LAS bf16x8*)(VT + (16 * (3 * F.wave + a) + fr) * 136 + k0);
#pragma unroll
                for (int n = 0; n < 8; ++n) bfg[n] = *(const LAS bf16x8*)(WL + (16 * n + fr) * 136 + k0);
#pragma unroll
                for (int a = 0; a < 3; ++a)
#pragma unroll
                    for (int n = 0; n < 8; ++n) acc[a][n] = __builtin_amdgcn_mfma_f32_16x16x32_bf16(af[a], bfg[n], acc[a][n], 0, 0, 0); }
#pragma unroll
            for (int n = 0; n < 8; ++n) { const int p = 16 * n + fr; const float bs = bsp[g * 128 + p];
#pragma unroll
                for (int a = 0; a < 3; ++a) { const int d0 = 16 * (3 * F.wave + a) + 4 * fq;
                    u32x2 w; w.x = pk2(acc[a][n][0] + bs, acc[a][n][1] + bs); w.y = pk2(acc[a][n][2] + bs, acc[a][n][3] + bs);
                    *(u32x2*)(V + (size_t)(c * 128 + p) * DG + g * 384 + d0) = w; } }
            __syncthreads();
        }
    }
}

__global__ void __launch_bounds__(512, 2) fwd(Args args) {
    extern __shared__ __attribute__((aligned(16))) unsigned char lds_raw[];
    Frame F;
    F.lds = (LAS unsigned char*)lds_raw;
    F.tid = threadIdx.x; F.lane = F.tid & 63; F.wave = __builtin_amdgcn_readfirstlane(F.tid >> 6);
    F.G = gridDim.x; F.gw = blockIdx.x * 8 + F.wave; F.NGW = F.G * 8;
    F.in = args.in; F.out = args.out; F.ws = args.ws;
    volatile LAS unsigned* MISC = (volatile LAS unsigned*)(F.lds + MISC_OFF);
    if (F.tid < 64) MISC[F.tid] = 0u;
    __syncthreads();
    const int lo = args.ph_lo, hi = args.ph_hi;
    unsigned* barw = (unsigned*)(F.ws + WS_CTL) + CW_BAR;
    XcdBarrier bar; bar.bar = barw; bar.x = 0; bar.st = MISC + 8;
    if (hi - lo > 1) bar = xcd_barrier_post(barw, MISC + 8);
#define IN(k) (lo <= (k) && (k) < hi)
#define SEAM(k) do { if (IN(k) && IN((k) + 1)) xcd_barrier(bar); } while (0)
    const int G = F.G, bx = blockIdx.x;
    bf16_t* HN = (bf16_t*)(F.ws + WS_HN); bf16_t* HB = (bf16_t*)F.out;

    if (IN(0)) { p0_prologue(F); } SEAM(0);
    if (IN(1)) {
        const bf16_t* HN8 = (const bf16_t*)(F.ws + WS_HN8B);
        { pg8::Gemm g{HN8, (const bf16_t*)(F.ws + WS_WQK), T, NQK, D / 2}; pg8::StaticOrder S; S.init(T, NQK, G, bx);
          pg8::EpiBf<3> E{(bf16_t*)(F.ws + WS_Q), 1024, (bf16_t*)(F.ws + WS_K), 1.0f / W8_SCALE};
          pg8::gemm_phase<1>(F.lds, g, S, E); }
        __syncthreads();
        { pg8::Gemm g{(const bf16_t*)(F.ws + WS_WV), HN8, 256, T, D / 2}; pg8::StaticOrder S; S.init(256, T, G, (bx + G / 2) % G);
          pg8::EpiBf<0> E{(bf16_t*)(F.ws + WS_VT), T, nullptr, 1.0f / W8_SCALE};
          pg8::gemm_phase<1>(F.lds, g, S, E); }
    } SEAM(1);
    if (IN(2)) { attn_phase_v2(F); } SEAM(2);
    if (IN(3)) {
        pg8::Gemm g{(const bf16_t*)(F.ws + WS_AO), (const bf16_t*)(F.ws + WS_WO), T, D, D / 2}; pg8::StaticOrder S; S.init(T, D, G, bx);
        pg8::EpiBf<6> E{HB, D, (bf16_t*)F.in[0], 1.0f / (W8_SCALE * AO8_SCALE)};
        pg8::gemm_phase<1>(F.lds, g, S, E);
    } SEAM(3);
    if (IN(4)) { quant_wqk(F); rmsnorm_rows_bf(F, HB, F.in[12], nullptr, F.ws + WS_HN8, F.ws + WS_HNI8, (float*)(F.ws + WS_HSC)); } SEAM(4);
    if (IN(5)) {
        pg8::Gemm g{(const bf16_t*)(F.ws + WS_HNI8), (const bf16_t*)(F.ws + WS_WQ8), T, 2048, D / 2}; pg8::StaticOrder S; S.init(T, 2048, G, bx);
        pg8::EpiBf<8> E{(bf16_t*)(F.ws + WS_S), 2048, (bf16_t*)(F.ws + WS_HSC), 1.0f, (const float*)(F.ws + WS_CTL) + CW_WSCL};
        pg8::gemm_phase<2>(F.lds, g, S, E);
    } SEAM(5);
    if (IN(6)) { topk_phase_v3(F); } SEAM(6);
    if (IN(7)) { peer_down_phase5(F, 0); } SEAM(7);
    if (IN(8)) { peer_reduce_phase8(F, 0); } SEAM(8);
    if (IN(9)) { peer_up_phase5(F, 0); } SEAM(9);
    if (IN(11)) {
        pg8::Gemm g{(const bf16_t*)(F.ws + WS_H8), (const bf16_t*)(F.ws + WS_WSGV), T, DG, D / 2}; pg8::StaticOrder S; S.init(T, DG, G, bx);
        pg8::EpiBf<1, true> E{(bf16_t*)(F.ws + WS_SG), DG, nullptr, 1.0f / W8_SCALE, nullptr, (const float*)(F.ws + WS_HSQ)};
        pg8::gemm_phase<1>(F.lds, g, S, E);
    } SEAM(11);
    if (IN(12)) { sg_mix_phase(F); } SEAM(12);
    if (IN(13)) {
        pg8::Gemm g{(const bf16_t*)(F.ws + WS_H8), (const bf16_t*)(F.ws + WS_WSGU), T, DG, D / 2}; pg8::StaticOrder S; S.init(T, DG, G, bx);
        pg8::EpiBf<5, true> E{(bf16_t*)(F.ws + WS_SG), DG, (bf16_t*)(F.ws + WS_SG8), 1.0f / W8_SCALE, nullptr, (const float*)(F.ws + WS_HSQ)};
        pg8::gemm_phase<1>(F.lds, g, S, E);
    } SEAM(13);
    if (IN(14)) {
        pg8::Gemm g{(const bf16_t*)(F.ws + WS_SG8), (const bf16_t*)(F.ws + WS_WSGO), T, D, DG / 2}; pg8::StaticOrder S; S.init(T, D, G, bx);
        pg8::EpiBf<7> E{HB, D, nullptr, 1.0f / W8_SCALE};
        pg8::gemm_phase<1>(F.lds, g, S, E);
    } SEAM(14);
    if (IN(15)) { rmsnorm_rows_bf(F, HB, F.in[12] + D, nullptr, F.ws + WS_HN8, F.ws + WS_HNI8, (float*)(F.ws + WS_HSC)); } SEAM(15);
    if (IN(16)) {
        pg8::Gemm g{(const bf16_t*)(F.ws + WS_HNI8), (const bf16_t*)(F.ws + WS_WQ8 + (size_t)2048 * 1024), T, 2048, D / 2}; pg8::StaticOrder S; S.init(T, 2048, G, bx);
        pg8::EpiBf<8> E{(bf16_t*)(F.ws + WS_S), 2048, (bf16_t*)(F.ws + WS_HSC), 1.0f, (const float*)(F.ws + WS_CTL) + CW_WSCL + 2048};
        pg8::gemm_phase<2>(F.lds, g, S, E);
    } SEAM(16);
    if (IN(17)) { topk_phase_v3(F); } SEAM(17);
    if (IN(18)) { peer_down_phase5(F, 1); } SEAM(18);
    if (IN(19)) { peer_reduce_phase8(F, 1); } SEAM(19);
    if (IN(20)) { peer_up_phase5(F, 1); } SEAM(20);
    if (IN(21)) { final_norm_bf(F, (const bf16_t*)(F.ws + WS_H2), F.out, F.in[17]); }
#undef IN
#undef SEAM
}

extern "C" void kernel_launch(void* const* d_in, const int* in_sizes, int n_in, void* d_out, int out_size, void* d_ws, size_t ws_size, hipStream_t stream) {
    static int grid = 0;
    if (grid == 0) {
        if (n_in != 18 || out_size != T * D || ws_size < WS_END) { fprintf(stderr, "kernel_launch: unexpected problem (n_in %d, out %d, ws %zu)\n", n_in, out_size, ws_size); grid = -1; return; }
        int dev = 0, cus = 0, per_cu = 0;
        if (hipGetDevice(&dev) != hipSuccess || hipDeviceGetAttribute(&cus, hipDeviceAttributeMultiprocessorCount, dev) != hipSuccess) { grid = -1; return; }
        if (hipFuncSetAttribute((const void*)fwd, hipFuncAttributeMaxDynamicSharedMemorySize, LDS_BYTES) != hipSuccess) { fprintf(stderr, "kernel_launch: hipFuncSetAttribute failed\n"); grid = -1; return; }
        if (hipOccupancyMaxActiveBlocksPerMultiprocessor(&per_cu, (const void*)fwd, 512, LDS_BYTES) != hipSuccess || per_cu < 1) fprintf(stderr, "kernel_launch: occupancy query says %d\n", per_cu);
        (void)hipGetLastError();
        grid = cus;
    }
    if (grid < 0) return;
    (void)hipMemsetAsync((char*)d_ws + WS_CTL, 0, CTL_ZERO_BYTES, stream);
    Args a{};
    for (int i = 0; i < 18; ++i) a.in[i] = (const float*)d_in[i];
    a.out = (float*)d_out; a.ws = (unsigned char*)d_ws;
#if MK_ONE_LAUNCH
    a.ph_lo = 0; a.ph_hi = NPH;
    hipLaunchKernelGGL(fwd, dim3(grid), dim3(512), LDS_BYTES, stream, a);
#else
    for (int ph = 0; ph < NPH; ++ph) {
        a.ph_lo = ph; a.ph_hi = ph + 1;
        hipLaunchKernelGGL(fwd, dim3(grid), dim3(512), LDS_BYTES, stream, a);
    }
#endif
}
```

```cpp
#include <hip/hip_runtime.h>
#include <cstdio>

#ifndef MK_ONE_LAUNCH
#define MK_ONE_LAUNCH 1
#endif

#define LAS __attribute__((address_space(3)))
#define GAS __attribute__((address_space(1)))
typedef unsigned short bf16_t;
typedef short bf16x8 __attribute__((ext_vector_type(8)));
typedef float f32x4 __attribute__((ext_vector_type(4)));
typedef float f32x2 __attribute__((ext_vector_type(2)));
typedef unsigned u32x4 __attribute__((ext_vector_type(4)));
typedef unsigned u32x2 __attribute__((ext_vector_type(2)));
typedef int i32x8 __attribute__((ext_vector_type(8)));
typedef int i32x2 __attribute__((ext_vector_type(2)));
typedef int i32x4 __attribute__((ext_vector_type(4)));

constexpr int T = 32768, D = 1024, SEQ = 2048;
constexpr int DG = 3072;
constexpr int NQK = 1280;
constexpr int NPH = 22;

constexpr size_t MiB = 1u << 20;
constexpr size_t WS_CTL = 0, CTL_ZERO_BYTES = 1 * MiB;
constexpr size_t WS_BIAS = 1 * MiB;
constexpr size_t WS_WQK = 2 * MiB;
constexpr size_t WS_WV = WS_WQK + (size_t)1280 * 1024 * 2;
constexpr size_t WS_WO = 5 * MiB;
constexpr size_t WS_WSGV = 7 * MiB;
constexpr size_t WS_WSGU = 13 * MiB;
constexpr size_t WS_WSGO = 19 * MiB;
constexpr size_t WS_WQKP = 25 * MiB;
constexpr size_t WS_HN = 34 * MiB;
constexpr size_t WS_SCL = 1 * MiB + 64 * 1024;
constexpr size_t WS_TAB = 98 * MiB;
constexpr size_t WS_IDX = 162 * MiB;
constexpr size_t WS_GATE = 178 * MiB;
constexpr size_t WS_SCR = 194 * MiB;
constexpr size_t WS_Q = WS_SCR, WS_K = WS_SCR + 64 * MiB, WS_VT = WS_SCR + 80 * MiB, WS_AO = WS_SCR + 96 * MiB;
constexpr size_t WS_S = WS_SCR;
constexpr size_t WS_SG = WS_SCR;
constexpr size_t WS_PART = WS_SCR;
constexpr size_t WS_AB = WS_SCR + 128 * MiB;
constexpr size_t WS_HN8 = WS_SCR + 200 * MiB;
constexpr size_t WS_H8 = 34 * MiB;
constexpr size_t WS_HSQ = 34 * MiB + 40 * MiB;
constexpr size_t WS_END = WS_SCR + 292 * MiB;
constexpr int CW_BAR = 4096;
constexpr int CW_COLMAX = 16384;
constexpr int CW_WSCL = 32768;
constexpr size_t WS_WQ8 = WS_SCR + 288 * MiB;
constexpr size_t WS_HNI8 = 34 * MiB;
constexpr size_t WS_HSC = 34 * MiB + 32 * MiB;
constexpr size_t WS_H2 = WS_SCR + 32 * MiB;
constexpr float AO8_SCALE = 8.0f;
constexpr float W8_SCALE = 256.0f;
constexpr size_t WS_HN8B = WS_IDX;
constexpr size_t WS_MX8 = WS_SCR + 192 * MiB;
constexpr size_t WS_SG8 = WS_SCR;

constexpr int LDS_BYTES = 163840;
constexpr int MISC_OFF = LDS_BYTES - 256;

typedef __bf16 bfx2 __attribute__((ext_vector_type(2)));
__device__ __forceinline__ unsigned pk2(float lo, float hi) { const bfx2 v = {(__bf16)lo, (__bf16)hi}; return __builtin_bit_cast(unsigned, v); }
__device__ __forceinline__ unsigned f2bf(float f) { return pk2(f, 0.f) & 0xffffu; }
typedef _Float16 h16x2 __attribute__((ext_vector_type(2)));
__device__ __forceinline__ unsigned pkh2(float lo, float hi) { const h16x2 h = {(_Float16)lo, (_Float16)hi}; return __builtin_bit_cast(unsigned, h); }
__device__ __forceinline__ float hlo(unsigned w) { return (float)__builtin_bit_cast(h16x2, w).x; }
__device__ __forceinline__ float hhi(unsigned w) { return (float)__builtin_bit_cast(h16x2, w).y; }
__device__ __forceinline__ float bflo(unsigned w) { return __builtin_bit_cast(float, w << 16); }
__device__ __forceinline__ float bfhi(unsigned w) { return __builtin_bit_cast(float, w & 0xffff0000u); }
__device__ __forceinline__ float bf2f(bf16_t b) { return __builtin_bit_cast(float, ((unsigned)b) << 16); }
template <int CTRL> __device__ __forceinline__ float dppf(float v) { return __builtin_bit_cast(float, __builtin_amdgcn_update_dpp(0, __builtin_bit_cast(int, v), CTRL, 0xf, 0xf, true)); }
__device__ __forceinline__ float rlane(float v, int l) { return __builtin_bit_cast(float, __builtin_amdgcn_readlane(__builtin_bit_cast(int, v), l)); }
__device__ __forceinline__ float wave_sum(float v) {
    v += dppf<0xB1>(v); v += dppf<0x4E>(v); v += dppf<0x141>(v); v += dppf<0x140>(v);
    return (rlane(v, 0) + rlane(v, 16)) + (rlane(v, 32) + rlane(v, 48));
}
__device__ __forceinline__ float wave_max(float v) {
    v = fmaxf(v, dppf<0xB1>(v)); v = fmaxf(v, dppf<0x4E>(v)); v = fmaxf(v, dppf<0x141>(v)); v = fmaxf(v, dppf<0x140>(v));
    return fmaxf(fmaxf(rlane(v, 0), rlane(v, 16)), fmaxf(rlane(v, 32), rlane(v, 48)));
}
__device__ __forceinline__ unsigned wave_max_u(unsigned v) {
#pragma unroll
    for (int o = 1; o < 64; o <<= 1) { const unsigned w = (unsigned)__shfl_xor((int)v, o); v = w > v ? w : v; }
    return v;
}
__device__ __forceinline__ float gelu_tanh(float x) {
    const float u = x * (-2.302208198144325f) * (1.0f + 0.044715f * x * x);
    return x * __builtin_amdgcn_rcpf(1.0f + __builtin_amdgcn_exp2f(u));
}
#define LDS_WAIT() asm volatile("s_waitcnt lgkmcnt(0)" ::: "memory")
#define VM_WAIT() asm volatile("s_waitcnt vmcnt(0)" ::: "memory")

namespace pg8 {
#define PG8_LAS __attribute__((address_space(3)))
constexpr int BM = 256, BK = 64, HALF = 128, HTB = HALF * BK * 2, STAGE_BYTES = 8 * HTB, NXCD = 8, WGM = 8;
__host__ __device__ __forceinline__ int lds_byte(int r, int c) { const int st = (r >> 4) * 2 + (c >> 5), rr = r & 15, cc = c & 31, ob = rr * 64 + cc * 2; return st * 1024 + (ob ^ (((ob >> 9) & 1) << 5)); }
__host__ __device__ __forceinline__ void stage_rc(int b, int& R, int& C) { const int st = b / 1024, sb = b % 1024, swz = sb ^ (((sb >> 9) & 1) << 5); R = (st >> 1) * 16 + swz / 64; C = (st & 1) * 32 + (swz % 64) / 2; }
__host__ __device__ __forceinline__ int perm32(int rho) { const int n = rho >> 4, i = rho & 15; return 8 * (i >> 2) + 4 * n + (i & 3); }
struct Unit { int pm, pn; };
struct Gemm { const bf16_t* A; const bf16_t* Bt; int M, N, K; };
struct StaticOrder {
    int nM, nN, nwg, G, c;
    __host__ __device__ void init(int M, int N, int G_, int c_) { nM = M / BM; nN = N / BM; nwg = nM * nN; G = G_; c = c_; }
    __host__ __device__ bool next(int i, Unit& u) const {
        const long L = (long)i * G + c; if (L >= nwg) return false;
        int wgid = (int)L; { const int q = nwg / NXCD, r = nwg % NXCD, xcd = wgid % NXCD, off = wgid / NXCD; wgid = (xcd < r ? xcd * (q + 1) : r * (q + 1) + (xcd - r) * q) + off; }
        const int nig = WGM * nN, gid = wgid / nig, fm = gid * WGM, gsz = (nM - fm) < WGM ? (nM - fm) : WGM;
        u.pm = fm + ((wgid % nig) % gsz); u.pn = (wgid % nig) / gsz; return true;
    }
    __device__ __forceinline__ void a_ready(const Unit&) const {}
    __device__ __forceinline__ void done(const Unit&) const {}
};

template <int MODE, bool RSQ = false> struct EpiBf {
    static constexpr int PERM = (MODE == 5 || MODE == 9) ? 2 : 1; static constexpr bool AFTER_DRAIN = false;
    bf16_t* O; int ldc; bf16_t* O2; float sc = 1.0f; const float* aux = nullptr; const float* rsq = nullptr;
    __device__ __forceinline__ void operator()(const f32x4 (&acc)[2][2][4][2], const Unit& u, int wr, int wc, int fr, int fq) const {
        const int row0 = u.pm * BM + wr * 64 + fr; int colt = u.pn * BM; bf16_t* base = O; int ld = ldc;
        if (MODE == 3) { if (u.pn >= 4) { base = O2; ld = 256; colt = 0; } else { ld = 1024; } }
        if (MODE == 5) {
            const int c16 = colt + wc * 64 + 16 * fq;
            float rr[2][4];
#pragma unroll
            for (int ai = 0; ai < 2; ++ai)
#pragma unroll
                for (int m = 0; m < 4; ++m) { rr[ai][m] = sc;
                    if (RSQ) { const f32x4 q4 = *(const f32x4*)(rsq + (size_t)(row0 + ai * HALF + m * 16) * 4); rr[ai][m] = sc * __builtin_amdgcn_rsqf(((q4.x + q4.y) + (q4.z + q4.w)) * (1.f / 1024.f) + 1e-6f); } }
            u32x4 mxa[2][4];
#pragma unroll
            for (int ai = 0; ai < 2; ++ai)
#pragma unroll
                for (int m = 0; m < 4; ++m) mxa[ai][m] = *(const u32x4*)((const unsigned char*)O + (size_t)(row0 + ai * HALF + m * 16) * ld + c16);
#pragma unroll
            for (int ai = 0; ai < 2; ++ai) {
#pragma unroll
                for (int m = 0; m < 4; ++m) { unsigned ow[4]; const u32x4 mq = mxa[ai][m];
#pragma unroll
                    for (int bj = 0; bj < 2; ++bj) { f32x4 v0 = acc[ai][bj][m][0] * rr[ai][m], v1 = acc[ai][bj][m][1] * rr[ai][m]; const int ma = (int)(bj ? mq.z : mq.x), mb = (int)(bj ? mq.w : mq.y);
#pragma unroll
                        for (int j = 0; j < 4; ++j) { v0[j] = gelu_tanh(v0[j]); v1[j] = gelu_tanh(v1[j]); }
                        const f32x2 m0 = __builtin_amdgcn_cvt_pk_f32_fp8(ma, false), m1 = __builtin_amdgcn_cvt_pk_f32_fp8(ma, true), m2 = __builtin_amdgcn_cvt_pk_f32_fp8(mb, false), m3 = __builtin_amdgcn_cvt_pk_f32_fp8(mb, true);
                        v0[0] *= m0.x; v0[1] *= m0.y; v0[2] *= m1.x; v0[3] *= m1.y; v1[0] *= m2.x; v1[1] *= m2.y; v1[2] *= m3.x; v1[3] *= m3.y;
                        int w0 = 0, w1 = 0;
                        w0 = __builtin_amdgcn_cvt_pk_fp8_f32(v0[0], v0[1], w0, false); w0 = __builtin_amdgcn_cvt_pk_fp8_f32(v0[2], v0[3], w0, true);
                        w1 = __builtin_amdgcn_cvt_pk_fp8_f32(v1[0], v1[1], w1, false); w1 = __builtin_amdgcn_cvt_pk_fp8_f32(v1[2], v1[3], w1, true);
                        ow[2 * bj] = (unsigned)w0; ow[2 * bj + 1] = (unsigned)w1; }
                    *(u32x4*)((unsigned char*)O2 + (size_t)(row0 + ai * HALF + m * 16) * ld + c16) = (u32x4){ow[0], ow[1], ow[2], ow[3]}; } }
            return;
        }
        if (MODE == 9) {
            const int c16 = colt + wc * 64 + 16 * fq;
            float rr[2][4];
#pragma unroll
            for (int ai = 0; ai < 2; ++ai)
#pragma unroll
                for (int m = 0; m < 4; ++m) { rr[ai][m] = sc;
                    if (RSQ) { const f32x4 q4 = *(const f32x4*)(rsq + (size_t)(row0 + ai * HALF + m * 16) * 4); rr[ai][m] = sc * __builtin_amdgcn_rsqf(((q4.x + q4.y) + (q4.z + q4.w)) * (1.f / 1024.f) + 1e-6f); } }
#pragma unroll
            for (int ai = 0; ai < 2; ++ai)
#pragma unroll
                for (int m = 0; m < 4; ++m) { unsigned ow[4];
#pragma unroll
                    for (int bj = 0; bj < 2; ++bj) { f32x4 v0 = acc[ai][bj][m][0] * rr[ai][m], v1 = acc[ai][bj][m][1] * rr[ai][m];
#pragma unroll
                        for (int j = 0; j < 4; ++j) { v0[j] = gelu_tanh(v0[j]); v1[j] = gelu_tanh(v1[j]); }
                        int w0 = 0, w1 = 0;
                        w0 = __builtin_amdgcn_cvt_pk_fp8_f32(v0[0], v0[1], w0, false); w0 = __builtin_amdgcn_cvt_pk_fp8_f32(v0[2], v0[3], w0, true);
                        w1 = __builtin_amdgcn_cvt_pk_fp8_f32(v1[0], v1[1], w1, false); w1 = __builtin_amdgcn_cvt_pk_fp8_f32(v1[2], v1[3], w1, true);
                        ow[2 * bj] = (unsigned)w0; ow[2 * bj + 1] = (unsigned)w1; }
                    *(u32x4*)((unsigned char*)O2 + (size_t)(row0 + ai * HALF + m * 16) * ld + c16) = (u32x4){ow[0], ow[1], ow[2], ow[3]}; }
            return;
        }
        const int col0 = colt + wc * 32 + 8 * fq;
        float rrow[2][4]; f32x4 ccol[2][2];
        if (RSQ || MODE == 8) {
#pragma unroll
            for (int ai = 0; ai < 2; ++ai)
#pragma unroll
                for (int m = 0; m < 4; ++m) { const int row = row0 + ai * HALF + m * 16;
                    if (RSQ) { const f32x4 q4 = *(const f32x4*)(rsq + (size_t)row * 4); rrow[ai][m] = ((q4.x + q4.y) + (q4.z + q4.w)) * (1.f / 1024.f) + 1e-6f; }
                    else rrow[ai][m] = ((const float*)O2)[row]; }
            if (MODE == 8) {
#pragma unroll
                for (int bj = 0; bj < 2; ++bj) { const f32x4* cp = (const f32x4*)(aux + col0 + bj * HALF); ccol[bj][0] = cp[0]; ccol[bj][1] = cp[1]; } }
            if (RSQ) {
#pragma unroll
                for (int ai = 0; ai < 2; ++ai)
#pragma unroll
                    for (int m = 0; m < 4; ++m) rrow[ai][m] = __builtin_amdgcn_rsqf(rrow[ai][m]); }
        }
#pragma unroll
        for (int ai = 0; ai < 2; ++ai) {
          u32x4 pre[4][2]; f32x4 prex[4][2][2];
          if (MODE == 2 || MODE == 5 || MODE == 7) {
#pragma unroll
            for (int m = 0; m < 4; ++m)
#pragma unroll
                for (int bj = 0; bj < 2; ++bj) pre[m][bj] = *(const u32x4*)(base + (size_t)(row0 + ai * HALF + m * 16) * ld + col0 + bj * HALF); }
          if (MODE == 6) {
#pragma unroll
            for (int m = 0; m < 4; ++m)
#pragma unroll
                for (int bj = 0; bj < 2; ++bj) { const f32x4* xp = (const f32x4*)((const float*)O2 + (size_t)(row0 + ai * HALF + m * 16) * ld + col0 + bj * HALF); prex[m][bj][0] = xp[0]; prex[m][bj][1] = xp[1]; } }
#pragma unroll
            for (int m = 0; m < 4; ++m) { bf16_t* rowp = base + (size_t)(row0 + ai * HALF + m * 16) * ld + col0;
#pragma unroll
                for (int bj = 0; bj < 2; ++bj) { f32x4 v0 = acc[ai][bj][m][0], v1 = acc[ai][bj][m][1];
                    if (RSQ) { const float rr = rrow[ai][m]; v0 = v0 * rr; v1 = v1 * rr; }
                    if (MODE == 8) { const float rs = rrow[ai][m]; const f32x4 c0 = ccol[bj][0] * rs, c1 = ccol[bj][1] * rs;
                        const i32x4 i0 = __builtin_bit_cast(i32x4, v0), i1 = __builtin_bit_cast(i32x4, v1);
                        v0 = (f32x4){(float)i0.x, (float)i0.y, (float)i0.z, (float)i0.w} * c0; v1 = (f32x4){(float)i1.x, (float)i1.y, (float)i1.z, (float)i1.w} * c1; }
                    if (MODE == 0 || MODE == 3) {
#pragma unroll
                        for (int j = 0; j < 4; ++j) { v0[j] *= sc; v1[j] *= sc; } }
                    if (MODE == 6) { v0 = prex[m][bj][0] + v0 * sc; v1 = prex[m][bj][1] + v1 * sc; }
                    if (MODE == 7) { const u32x4 hv = pre[m][bj];
                        v0[0] = bflo(hv.x) + v0[0] * sc; v0[1] = bfhi(hv.x) + v0[1] * sc; v0[2] = bflo(hv.y) + v0[2] * sc; v0[3] = bfhi(hv.y) + v0[3] * sc;
                        v1[0] = bflo(hv.z) + v1[0] * sc; v1[1] = bfhi(hv.z) + v1[1] * sc; v1[2] = bflo(hv.w) + v1[2] * sc; v1[3] = bfhi(hv.w) + v1[3] * sc; }
                    if (MODE == 1 || MODE == 2 || MODE == 5) {
#pragma unroll
                        for (int j = 0; j < 4; ++j) { v0[j] = gelu_tanh(v0[j] * sc); v1[j] = gelu_tanh(v1[j] * sc); } }
                    if (MODE == 2 || MODE == 5) { const u32x4 mv = pre[m][bj];
                        v0[0] *= bflo(mv.x); v0[1] *= bfhi(mv.x); v0[2] *= bflo(mv.y); v0[3] *= bfhi(mv.y);
                        v1[0] *= bflo(mv.z); v1[1] *= bfhi(mv.z); v1[2] *= bflo(mv.w); v1[3] *= bfhi(mv.w); }
                    if (MODE == 5) { int w0 = 0, w1 = 0;
                        w0 = __builtin_amdgcn_cvt_pk_fp8_f32(v0[0], v0[1], w0, false); w0 = __builtin_amdgcn_cvt_pk_fp8_f32(v0[2], v0[3], w0, true);
                        w1 = __builtin_amdgcn_cvt_pk_fp8_f32(v1[0], v1[1], w1, false); w1 = __builtin_amdgcn_cvt_pk_fp8_f32(v1[2], v1[3], w1, true);
                        *(u32x2*)((unsigned char*)O2 + (size_t)(row0 + ai * HALF + m * 16) * ld + col0 + bj * HALF) = (u32x2){(unsigned)w0, (unsigned)w1}; continue; }
                    u32x4 w;
                    if (MODE == 4 || MODE == 8) { w.x = pkh2(v0[0], v0[1]); w.y = pkh2(v0[2], v0[3]); w.z = pkh2(v1[0], v1[1]); w.w = pkh2(v1[2], v1[3]); }
                    else { w.x = pk2(v0[0], v0[1]); w.y = pk2(v0[2], v0[3]); w.z = pk2(v1[0], v1[1]); w.w = pk2(v1[2], v1[3]); }
                    *(u32x4*)(rowp + bj * HALF) = w; } } }
    }
};
template <int MODE> struct EpiF32 {
    static constexpr bool PERM = false, AFTER_DRAIN = false;
    float* C; int ldc; const float* B; float sc = 1.0f;
    __device__ __forceinline__ void operator()(const f32x4 (&acc)[2][2][4][2], const Unit& u, int wr, int wc, int fr, int fq) const {
        const int row0 = u.pm * BM + wr * 64 + fr, col0 = u.pn * BM + wc * 32 + 4 * fq;
#pragma unroll
        for (int ai = 0; ai < 2; ++ai)
#pragma unroll
            for (int m = 0; m < 4; ++m) { float* rowp = C + (size_t)(row0 + ai * HALF + m * 16) * ldc + col0;
#pragma unroll
                for (int bj = 0; bj < 2; ++bj)
#pragma unroll
                    for (int n = 0; n < 2; ++n) { f32x4* p = (f32x4*)(rowp + bj * HALF + n * 16);
                        if (MODE == 1) *p = *p + acc[ai][bj][m][n] * sc;
                        else if (MODE == 2) *p = *(const f32x4*)(B + (p - (f32x4*)C) * 4) + acc[ai][bj][m][n] * sc;
                        else *p = acc[ai][bj][m][n]; } }
    }
};

template <int F8 = 0, class Epi, class Sched>
__device__ __forceinline__ void gemm_phase(PG8_LAS unsigned char* lds, const Gemm g, const Sched& S, const Epi& E) {
    const int tid = threadIdx.x, wid = __builtin_amdgcn_readfirstlane(tid >> 6), lane = tid & 63, wr = wid >> 2, wc = wid & 3, fr = lane & 15, fq = lane >> 4;
    const int K = g.K, nt = K / BK;
    unsigned voffA[2], voffB[2];
#pragma unroll
    for (int i = 0; i < 2; ++i) { int R, C; stage_rc(tid * 16 + i * 8192, R, C); const int Rb = Epi::PERM == 2 ? (64 * (R >> 5) + 16 * ((R >> 2) & 3) + 4 * ((R >> 4) & 1) + (R & 3)) : Epi::PERM ? ((R & ~31) + perm32(R & 31)) : R;
        voffA[i] = (unsigned)(R * K + C) * 2u; voffB[i] = (unsigned)(Rb * K + C) * 2u; }
    const size_t kstep = (size_t)(BK * 2);
    const size_t hstep = (size_t)HALF * K * 2;
    const size_t hstepB = Epi::PERM == 2 ? (size_t)8 * K * 2 : hstep;
    const size_t tstep = 2 * hstep;
    const unsigned ldsw = (unsigned)wid * 1024u;
    const int aoff = lds_byte(wr * 64 + fr, fq * 8), boff = lds_byte(wc * 32 + fr, fq * 8);
#define PG8_SA(b, h) (((b) * 2 + (h)) * HTB)
#define PG8_SB(b, h) ((4 + (b) * 2 + (h)) * HTB)
#define PG8_STAGE(bufoff, gbase, voff) do { const char* gb_ = (const char*)(gbase); asm volatile("" : "+s"(gb_));        \
        _Pragma("unroll") for (int _i = 0; _i < 2; ++_i) { unsigned vo_ = (voff)[_i]; asm volatile("" : "+v"(vo_)); \
        __builtin_amdgcn_global_load_lds((const unsigned*)(gb_ + vo_), (PG8_LAS unsigned*)(lds + (bufoff) + ldsw + _i * 8192), 16, 0, 0); } } while (0)
#define PG8_LD8(dst8, cbase_, voff_, cnt_) do { unsigned o_ = (unsigned)(voff_); asm volatile("" : "+v"(o_));        \
        _Pragma("unroll") for (int i_ = 0; i_ < cnt_; ++i_) { const i32x4 lo_ = *(const PG8_LAS i32x4*)(lds + (cbase_) + o_ + i_ * 2048), hi_ = *(const PG8_LAS i32x4*)(lds + (cbase_) + o_ + i_ * 2048 + 1024); \
        dst8[i_] = (i32x8){lo_.x, lo_.y, lo_.z, lo_.w, hi_.x, hi_.y, hi_.z, hi_.w}; } } while (0)
#define PG8_LDA(dst, b, h) do { if (F8 == 1) PG8_LD8(Ah8, PG8_SA(b, h), aoff, 2); else { _Pragma("unroll") for (int m = 0; m < 4; ++m) _Pragma("unroll") for (int k = 0; k < 2; ++k) dst[m][k] = *(const PG8_LAS bf16x8*)(lds + PG8_SA(b, h) + aoff + m * 2048 + k * 1024); } } while (0)
#define PG8_LDB(dst, b, h) do { if (F8 == 1) PG8_LD8(dst##8, PG8_SB(b, h), boff, 2); else { _Pragma("unroll") for (int n = 0; n < 2; ++n) _Pragma("unroll") for (int k = 0; k < 2; ++k) dst[n][k] = *(const PG8_LAS bf16x8*)(lds + PG8_SB(b, h) + boff + n * 2048 + k * 1024); } } while (0)
#define PG8_MM8(ai, bj, mm, Bt, Ax) do { _Pragma("unroll") for (int n = 0; n < 2; ++n) { \
        acc[ai][bj][mm][n] = __builtin_amdgcn_mfma_scale_f32_16x16x128_f8f6f4(Bt##8[n], Ax[0], acc[ai][bj][mm][n], 0, 0, 0, 0, 0, 0); \
        acc[ai][bj][(mm) + 1][n] = __builtin_amdgcn_mfma_scale_f32_16x16x128_f8f6f4(Bt##8[n], Ax[1], acc[ai][bj][(mm) + 1][n], 0, 0, 0, 0, 0, 0); } } while (0)
#define PG8_MMA(ai, bj, At, Bt, bb) do { __builtin_amdgcn_s_setprio(1); \
        if (F8 == 1) { if ((bj) == 0) { PG8_SCHED; PG8_LD8(Bh8, PG8_SA(bb, ai) + 2 * 2048, aoff, 2); PG8_SCHED; PG8_MM8(ai, bj, 0, Bt, Ah8); PG8_SCHED; PG8_MM8(ai, bj, 2, Bt, Bh8); } \
                  else { PG8_MM8(ai, bj, 0, Bt, Ah8); PG8_MM8(ai, bj, 2, Bt, Bh8); } } \
        else if (F8 == 2) { _Pragma("unroll") for (int m = 0; m < 4; ++m) _Pragma("unroll") for (int n = 0; n < 2; ++n) _Pragma("unroll") for (int k = 0; k < 2; ++k) \
            acc[ai][bj][m][n] = __builtin_bit_cast(f32x4, __builtin_amdgcn_mfma_i32_16x16x64_i8(__builtin_bit_cast(i32x4, Bt[n][k]), __builtin_bit_cast(i32x4, At[m][k]), __builtin_bit_cast(i32x4, acc[ai][bj][m][n]), 0, 0, 0)); } \
        else { _Pragma("unroll") for (int m = 0; m < 4; ++m) _Pragma("unroll") for (int n = 0; n < 2; ++n) _Pragma("unroll") for (int k = 0; k < 2; ++k) \
            acc[ai][bj][m][n] = __builtin_amdgcn_mfma_f32_16x16x32_bf16(Bt[n][k], At[m][k], acc[ai][bj][m][n], 0, 0, 0); } \
        __builtin_amdgcn_s_setprio(0); } while (0)
#define PG8_WAIT_V(n) asm volatile("s_waitcnt vmcnt(" #n ")" ::: "memory")
#define PG8_WAIT_L(n) asm volatile("s_waitcnt lgkmcnt(" #n ")" ::: "memory")
#define PG8_BAR __builtin_amdgcn_s_barrier()
#define PG8_SCHED __builtin_amdgcn_sched_barrier(0)
    Unit cur, nxt; int ui = 0;
    if (!S.next(0, cur)) return;
    f32x4 acc[2][2][4][2];
#pragma unroll
    for (int a = 0; a < 2; ++a)
#pragma unroll
        for (int b = 0; b < 2; ++b)
#pragma unroll
            for (int m = 0; m < 4; ++m)
#pragma unroll
                for (int n = 0; n < 2; ++n) acc[a][b][m][n] = (f32x4){0.f, 0.f, 0.f, 0.f};
    bf16x8 At[4][2], B0[2][2], B1[2][2]; i32x8 Ah8[2], Bh8[2], B08[2], B18[2];
    const char* cA = (const char*)g.A + (size_t)cur.pm * tstep; const char* cB = (const char*)g.Bt + (size_t)cur.pn * tstep;
    S.a_ready(cur);
    PG8_STAGE(PG8_SB(0, 0), cB, voffB); PG8_STAGE(PG8_SA(0, 0), cA, voffA); PG8_STAGE(PG8_SB(0, 1), cB + hstepB, voffB); PG8_STAGE(PG8_SA(0, 1), cA + hstep, voffA);
    if (wr == 1) PG8_BAR;
    PG8_WAIT_V(4); PG8_BAR;
    PG8_STAGE(PG8_SB(1, 0), cB + kstep, voffB); PG8_STAGE(PG8_SA(1, 0), cA + kstep, voffA); PG8_STAGE(PG8_SB(1, 1), cB + hstepB + kstep, voffB);
    PG8_WAIT_V(6); PG8_BAR;
    for (;;) {
        const bool has_next = S.next(ui + 1, nxt);
        const char* nA = has_next ? (const char*)g.A + (size_t)nxt.pm * tstep : cA; const char* nB = has_next ? (const char*)g.Bt + (size_t)nxt.pn * tstep : cB;
        for (int t = 0; t < nt; t += 2) {
            const bool last = (t == nt - 2);
            const char* a1 = cA + (size_t)(t + 1) * kstep;
            const char* a2 = last ? nA : cA + (size_t)(t + 2) * kstep; const char* b2 = last ? nB : cB + (size_t)(t + 2) * kstep;
            const char* a3 = a2 + kstep; const char* b3 = b2 + kstep;
            if (last && has_next) S.a_ready(nxt);
            PG8_LDB(B0, 0, 0); PG8_SCHED; PG8_LDA(At, 0, 0); PG8_STAGE(PG8_SA(1, 1), a1 + hstep, voffA);
            PG8_WAIT_L(8); PG8_BAR; PG8_WAIT_L(0); PG8_MMA(0, 0, At, B0, 0); PG8_BAR; PG8_SCHED;
            PG8_LDB(B1, 0, 1); PG8_STAGE(PG8_SB(0, 0), b2, voffB);
            PG8_BAR; PG8_WAIT_L(0); PG8_MMA(0, 1, At, B1, 0); PG8_BAR; if (F8 == 1) PG8_SCHED;
            PG8_LDA(At, 0, 1); PG8_STAGE(PG8_SA(0, 0), a2, voffA);
            PG8_BAR; PG8_WAIT_L(0); PG8_MMA(1, 0, At, B0, 0); PG8_BAR; PG8_SCHED;
            PG8_STAGE(PG8_SB(0, 1), b2 + hstepB, voffB);
            PG8_WAIT_V(6); PG8_BAR; PG8_MMA(1, 1, At, B1, 0); PG8_BAR; if (F8 == 1) PG8_SCHED;
            PG8_LDB(B0, 1, 0); PG8_SCHED; PG8_LDA(At, 1, 0); PG8_STAGE(PG8_SA(0, 1), a2 + hstep, voffA);
            PG8_WAIT_L(8); PG8_BAR; PG8_WAIT_L(0); PG8_MMA(0, 0, At, B0, 1); PG8_BAR; PG8_SCHED;
            PG8_LDB(B1, 1, 1); PG8_STAGE(PG8_SB(1, 0), b3, voffB);
            PG8_BAR; PG8_WAIT_L(0); PG8_MMA(0, 1, At, B1, 1); PG8_BAR; if (F8 == 1) PG8_SCHED;
            PG8_LDA(At, 1, 1); PG8_STAGE(PG8_SA(1, 0), a3, voffA);
            PG8_BAR; PG8_WAIT_L(0); PG8_MMA(1, 0, At, B0, 1); PG8_BAR; PG8_SCHED;
            PG8_STAGE(PG8_SB(1, 1), b3 + hstepB, voffB);
            PG8_WAIT_V(6); PG8_BAR; PG8_MMA(1, 1, At, B1, 1); PG8_BAR; if (F8 == 1) PG8_SCHED;
        }
        { int fr_ = fr, fq_ = fq; asm volatile("" : "+v"(fr_), "+v"(fq_));
          E(acc, cur, wr, wc, fr_, fq_); } S.done(cur);
        if (!has_next) break;
#pragma unroll
        for (int a = 0; a < 2; ++a)
#pragma unroll
            for (int b = 0; b < 2; ++b)
#pragma unroll
                for (int m = 0; m < 4; ++m)
#pragma unroll
                    for (int n = 0; n < 2; ++n) acc[a][b][m][n] = (f32x4){0.f, 0.f, 0.f, 0.f};
        cur = nxt; cA = nA; cB = nB; ++ui;
    }
    PG8_WAIT_V(0);
    if (wr == 0) PG8_BAR;
    PG8_BAR;
#undef PG8_SA
#undef PG8_SB
#undef PG8_STAGE
#undef PG8_LDA
#undef PG8_LDB
#undef PG8_MMA
#undef PG8_LD8
#undef PG8_MM8
#undef PG8_WAIT_V
#undef PG8_WAIT_L
#undef PG8_BAR
#undef PG8_SCHED
}
}

#define XB_TMO      128
#define XB_XCNT(j)  (256  + 64 * (j))
#define XB_XSUB(j)  (1280 + 64 * (j))
#define XB_XGEN(j)  (2304 + 64 * (j))
#define XB_TOP      3328
#define XB_TOPGEN   3392
#define XCD_BAR_WORDS 3456
#define XB_SPIN_CAP (1u << 18)
__device__ __forceinline__ unsigned xb_ld(unsigned* p)              { return __hip_atomic_load(p, __ATOMIC_RELAXED, __HIP_MEMORY_SCOPE_AGENT); }
__device__ __forceinline__ unsigned xb_add(unsigned* p, unsigned v) { return __hip_atomic_fetch_add(p, v, __ATOMIC_RELAXED, __HIP_MEMORY_SCOPE_AGENT); }
__device__ __forceinline__ unsigned xb_xcc_id() { return (unsigned)__builtin_amdgcn_s_getreg((3 << 11) | 20) & 0xFu; }
#define XB_SPIN(cond, bar) do { unsigned _sp = 0; while (cond) { __builtin_amdgcn_s_sleep(1); \
    if ((++_sp & 255u) == 0u) { if (xb_ld(&(bar)[XB_TMO])) break; if (_sp > XB_SPIN_CAP) { atomicAdd(&(bar)[XB_TMO], 1u); break; } } } } while (0)
struct XcdBarrier { unsigned* bar; unsigned x; volatile LAS unsigned* st; };
__device__ __forceinline__ XcdBarrier xcd_barrier_post(unsigned* bar, volatile LAS unsigned* st) {
    XcdBarrier b; b.bar = bar; b.x = xb_xcc_id(); b.st = st;
    if (threadIdx.x == 0) (void)xb_add(&bar[XB_XCNT(b.x)], 1u);
    return b;
}
__device__ __forceinline__ void xcd_barrier_complete(unsigned* bar, unsigned x, unsigned& nloc, unsigned& nx) {
    const unsigned G = gridDim.x * gridDim.y * gridDim.z;
    unsigned sum, cnt, mine, sp = 0u;
    for (;;) {
        sum = 0u; cnt = 0u; mine = 0u;
#pragma unroll
        for (unsigned j = 0; j < 16; ++j) { const unsigned c = xb_ld(&bar[XB_XCNT(j)]); sum += c; cnt += (c > 0u) ? 1u : 0u; mine = (j == x) ? c : mine; }
        if (sum == G) break;
        __builtin_amdgcn_s_sleep(1);
        if ((++sp & 255u) == 0u) { if (xb_ld(&bar[XB_TMO])) break; if (sp > XB_SPIN_CAP) { atomicAdd(&bar[XB_TMO], 1u); break; } }
    }
    nloc = mine > 0u ? mine : 1u; nx = cnt > 0u ? cnt : 1u;
}
__device__ __forceinline__ void xcd_barrier(const XcdBarrier& b) {
    asm volatile("s_waitcnt vmcnt(0)" ::: "memory");
    __syncthreads();
    if (threadIdx.x == 0) {
        unsigned* bar = b.bar;
        __builtin_amdgcn_s_waitcnt(0);
        unsigned nloc = b.st[0], nx = b.st[1];
        if (nloc == 0u) { xcd_barrier_complete(bar, b.x, nloc, nx); b.st[0] = nloc; b.st[1] = nx; }
        const unsigned old = xb_add(&bar[XB_XSUB(b.x)], 1u);
        const unsigned gen = old / nloc;
        if (old + 1u == (gen + 1u) * nloc) {
            __builtin_amdgcn_fence(__ATOMIC_RELEASE, "agent");
            asm volatile("s_waitcnt vmcnt(0)" ::: "memory");
            (void)xb_add(&bar[XB_TOP], 1u);
        }
        XB_SPIN(xb_ld(&bar[XB_TOP]) < (gen + 1u) * nx, bar);
        __builtin_amdgcn_fence(__ATOMIC_ACQUIRE, "agent");
        asm volatile("s_waitcnt vmcnt(0)" ::: "memory");
    }
    __syncthreads();
}

struct Args { const float* in[18]; float* out; unsigned char* ws; int ph_lo, ph_hi; };
struct Frame {
    LAS unsigned char* lds;
    int tid, lane, wave, G, gw, NGW;
    const float* const* in; float* out; unsigned char* ws;
};

__device__ __forceinline__ void transpose_item(const float* W, int ldw, int col0, bf16_t* WT, int K, int nblk, float scale, LAS float* scr, int item, int lane, bool f8 = false, const float* kgain = nullptr) {
    const int kb = item / nblk, nb = item % nblk, k0 = 64 * kb, n0 = 32 * nb;
#pragma unroll 8
    for (int i = 0; i < 32; ++i) { const int kk = 2 * i + (lane >> 5); scr[kk * 33 + (lane & 31)] = W[(size_t)(k0 + kk) * ldw + col0 + n0 + (lane & 31)] * (kgain ? kgain[k0 + kk] : 1.0f); }
    LDS_WAIT();
    const int c = lane & 7;
#pragma unroll
    for (int j = 0; j < 4; ++j) { const int n = (lane >> 3) + 8 * j; const LAS float* s = scr + (8 * c) * 33 + n;
        if (f8) { int w0 = 0, w1 = 0;
            w0 = __builtin_amdgcn_cvt_pk_fp8_f32(s[0 * 33] * scale, s[1 * 33] * scale, w0, false); w0 = __builtin_amdgcn_cvt_pk_fp8_f32(s[2 * 33] * scale, s[3 * 33] * scale, w0, true);
            w1 = __builtin_amdgcn_cvt_pk_fp8_f32(s[4 * 33] * scale, s[5 * 33] * scale, w1, false); w1 = __builtin_amdgcn_cvt_pk_fp8_f32(s[6 * 33] * scale, s[7 * 33] * scale, w1, true);
            *(u32x2*)((unsigned char*)WT + (size_t)(n0 + n) * K + k0 + 8 * c) = (u32x2){(unsigned)w0, (unsigned)w1}; continue; }
        u32x4 o; o.x = pk2(s[0 * 33] * scale, s[1 * 33] * scale); o.y = pk2(s[2 * 33] * scale, s[3 * 33] * scale); o.z = pk2(s[4 * 33] * scale, s[5 * 33] * scale); o.w = pk2(s[6 * 33] * scale, s[7 * 33] * scale);
        *(u32x4*)(WT + (size_t)(n0 + n) * K + k0 + 8 * c) = o; }
    LDS_WAIT();
}
__device__ __forceinline__ void rmsnorm_rows(const Frame& F, const float* src, const float* g, bf16_t* dst, float* cpy, unsigned char* dst8 = nullptr) {
    const f32x4* gp = (const f32x4*)g + F.lane;
    f32x4 gv[4];
#pragma unroll
    for (int j = 0; j < 4; ++j) gv[j] = gp[64 * j];
    for (int m = F.gw; m < T; m += F.NGW) {
        const f32x4* xr = (const f32x4*)(src + (size_t)m * D) + F.lane;
        f32x4 v[4]; float s = 0.f;
#pragma unroll
        for (int j = 0; j < 4; ++j) { v[j] = xr[64 * j]; s += (v[j].x * v[j].x + v[j].y * v[j].y) + (v[j].z * v[j].z + v[j].w * v[j].w); }
        const float rstd = 1.0f / sqrtf(wave_sum(s) * (1.f / D) + 1e-6f);
        if (cpy) { f32x4* cr = (f32x4*)(cpy + (size_t)m * D) + F.lane;
#pragma unroll
            for (int j = 0; j < 4; ++j) cr[64 * j] = v[j]; }
        if (dst) { u32x2* o8 = (u32x2*)(dst + (size_t)m * D) + F.lane;
#pragma unroll
        for (int j = 0; j < 4; ++j) { u32x2 w; w.x = pk2(v[j].x * rstd * gv[j].x, v[j].y * rstd * gv[j].y); w.y = pk2(v[j].z * rstd * gv[j].z, v[j].w * rstd * gv[j].w); o8[64 * j] = w; } }
        if (dst8) { unsigned* o4 = (unsigned*)(dst8 + (size_t)m * D) + F.lane;
#pragma unroll
            for (int j = 0; j < 4; ++j) { int w = 0; w = __builtin_amdgcn_cvt_pk_fp8_f32(v[j].x * rstd * gv[j].x, v[j].y * rstd * gv[j].y, w, false); w = __builtin_amdgcn_cvt_pk_fp8_f32(v[j].z * rstd * gv[j].z, v[j].w * rstd * gv[j].w, w, true); o4[64 * j] = (unsigned)w; } }
    }
}
__device__ __forceinline__ void quant_wqk(const Frame& F) {
    const bf16_t* W = (const bf16_t*)(F.ws + WS_WQKP); unsigned char* Q8 = F.ws + WS_WQ8;
    const unsigned* CM = (const unsigned*)(F.ws + WS_CTL) + CW_COLMAX; float* WSCL = (float*)(F.ws + WS_CTL) + CW_WSCL;
    for (int r = F.gw; r < 4096; r += F.NGW) {
        const float cm = __builtin_bit_cast(float, __hip_atomic_load(CM + r, __ATOMIC_RELAXED, __HIP_MEMORY_SCOPE_AGENT));
        const float sc = cm > 0.f ? 127.0f / cm : 0.f;
        const u32x4* wp = (const u32x4*)(W + (size_t)r * 1024 + 16 * F.lane); const u32x4 a = wp[0], b = wp[1];
        const float v[16] = {bflo(a.x), bfhi(a.x), bflo(a.y), bfhi(a.y), bflo(a.z), bfhi(a.z), bflo(a.w), bfhi(a.w), bflo(b.x), bfhi(b.x), bflo(b.y), bfhi(b.y), bflo(b.z), bfhi(b.z), bflo(b.w), bfhi(b.w)};
        unsigned o[4];
#pragma unroll
        for (int j = 0; j < 4; ++j) { unsigned w = 0u;
#pragma unroll
            for (int e = 0; e < 4; ++e) { int q = (int)rintf(v[4 * j + e] * sc); q = q > 127 ? 127 : (q < -127 ? -127 : q); w |= ((unsigned)q & 255u) << (8 * e); }
            o[j] = w; }
        *(u32x4*)(Q8 + (size_t)r * 1024 + 16 * F.lane) = (u32x4){o[0], o[1], o[2], o[3]};
        if (F.lane == 0) WSCL[r] = cm * (1.0f / 127.0f);
    }
}
__device__ __forceinline__ void rmsnorm_rows_bf(const Frame& F, const bf16_t* src, const float* g, bf16_t* dst, unsigned char* dst8, unsigned char* dsti = nullptr, float* rowsc = nullptr) {
    const f32x4* gp = (const f32x4*)g + F.lane;
    f32x4 gv[4];
#pragma unroll
    for (int j = 0; j < 4; ++j) gv[j] = gp[64 * j];
    for (int m = F.gw; m < T; m += F.NGW) {
        const u32x2* xr = (const u32x2*)(src + (size_t)m * D) + F.lane;
        f32x4 v[4]; float s = 0.f;
#pragma unroll
        for (int j = 0; j < 4; ++j) { const u32x2 w = xr[64 * j]; v[j] = (f32x4){bflo(w.x), bfhi(w.x), bflo(w.y), bfhi(w.y)}; s += (v[j].x * v[j].x + v[j].y * v[j].y) + (v[j].z * v[j].z + v[j].w * v[j].w); }
        const float rstd = 1.0f / sqrtf(wave_sum(s) * (1.f / D) + 1e-6f);
        if (dst) { u32x2* o8 = (u32x2*)(dst + (size_t)m * D) + F.lane;
#pragma unroll
        for (int j = 0; j < 4; ++j) { u32x2 w; w.x = pk2(v[j].x * rstd * gv[j].x, v[j].y * rstd * gv[j].y); w.y = pk2(v[j].z * rstd * gv[j].z, v[j].w * rstd * gv[j].w); o8[64 * j] = w; } }
        if (dst8) { unsigned* o4 = (unsigned*)(dst8 + (size_t)m * D) + F.lane;
#pragma unroll
            for (int j = 0; j < 4; ++j) { int w = 0; w = __builtin_amdgcn_cvt_pk_fp8_f32(v[j].x * rstd * gv[j].x, v[j].y * rstd * gv[j].y, w, false); w = __builtin_amdgcn_cvt_pk_fp8_f32(v[j].z * rstd * gv[j].z, v[j].w * rstd * gv[j].w, w, true); o4[64 * j] = (unsigned)w; } }
        if (dsti) {
            f32x4 y[4]; float am = 0.f;
#pragma unroll
            for (int j = 0; j < 4; ++j) { y[j] = v[j] * rstd * gv[j]; am = fmaxf(am, fmaxf(fmaxf(fabsf(y[j].x), fabsf(y[j].y)), fmaxf(fabsf(y[j].z), fabsf(y[j].w)))); }
            am = wave_max(am);
            const float qs = am > 0.f ? 127.0f / am : 0.f;
            unsigned* oi = (unsigned*)(dsti + (size_t)m * D) + F.lane;
#pragma unroll
            for (int j = 0; j < 4; ++j) { const int q0 = (int)rintf(y[j].x * qs), q1 = (int)rintf(y[j].y * qs), q2 = (int)rintf(y[j].z * qs), q3 = (int)rintf(y[j].w * qs);
                oi[64 * j] = ((unsigned)q0 & 255u) | (((unsigned)q1 & 255u) << 8) | (((unsigned)q2 & 255u) << 16) | ((unsigned)q3 << 24); }
            if (F.lane == 0) rowsc[m] = am * (1.0f / 127.0f);
        }
    }
}
__device__ __forceinline__ void final_norm_bf(const Frame& F, const bf16_t* h, float* out, const float* g) {
    const f32x4* gp = (const f32x4*)g + F.lane;
    f32x4 gv[4];
#pragma unroll
    for (int j = 0; j < 4; ++j) gv[j] = gp[64 * j];
    for (int m = F.gw; m < T; m += F.NGW) {
        const u32x2* xr = (const u32x2*)(h + (size_t)m * D) + F.lane;
        f32x4 v[4]; float s = 0.f;
#pragma unroll
        for (int j = 0; j < 4; ++j) { const u32x2 w = xr[64 * j]; v[j] = (f32x4){bflo(w.x), bfhi(w.x), bflo(w.y), bfhi(w.y)}; s += (v[j].x * v[j].x + v[j].y * v[j].y) + (v[j].z * v[j].z + v[j].w * v[j].w); }
        const float rstd = 1.0f / sqrtf(wave_sum(s) * (1.f / D) + 1e-6f);
        f32x4* orow = (f32x4*)(out + (size_t)m * D) + F.lane;
#pragma unroll
        for (int j = 0; j < 4; ++j) orow[64 * j] = v[j] * rstd * gv[j];
    }
}
__device__ __forceinline__ void final_norm(const Frame& F, float* h, const float* g) {
    const f32x4* gp = (const f32x4*)g + F.lane;
    f32x4 gv[4];
#pragma unroll
    for (int j = 0; j < 4; ++j) gv[j] = gp[64 * j];
    for (int m = F.gw; m < T; m += F.NGW) {
        f32x4* xr = (f32x4*)(h + (size_t)m * D) + F.lane;
        f32x4 v[4]; float s = 0.f;
#pragma unroll
        for (int j = 0; j < 4; ++j) { v[j] = xr[64 * j]; s += (v[j].x * v[j].x + v[j].y * v[j].y) + (v[j].z * v[j].z + v[j].w * v[j].w); }
        const float rstd = 1.0f / sqrtf(wave_sum(s) * (1.f / D) + 1e-6f);
#pragma unroll
        for (int j = 0; j < 4; ++j) xr[64 * j] = v[j] * rstd * gv[j];
    }
}
__device__ __forceinline__ void cvt_fp4_rows(const Frame& F, const float* src, unsigned char* dst, float* inv) {
    for (int r = F.gw; r < 16384; r += F.NGW) {
        const f32x4* p = (const f32x4*)(src + (size_t)r * 1024 + 16 * F.lane);
        const f32x4 v0 = p[0], v1 = p[1], v2 = p[2], v3 = p[3];
        float m = fmaxf(fmaxf(fmaxf(fabsf(v0.x), fabsf(v0.y)), fmaxf(fabsf(v0.z), fabsf(v0.w))), fmaxf(fmaxf(fabsf(v1.x), fabsf(v1.y)), fmaxf(fabsf(v1.z), fabsf(v1.w))));
        m = fmaxf(m, fmaxf(fmaxf(fmaxf(fabsf(v2.x), fabsf(v2.y)), fmaxf(fabsf(v2.z), fabsf(v2.w))), fmaxf(fmaxf(fabsf(v3.x), fabsf(v3.y)), fmaxf(fabsf(v3.z), fabsf(v3.w)))));
        m = wave_max(m);
        const float sc = m > 0.f ? 6.0f / m : 1.0f;
        unsigned w0 = 0u, w1 = 0u;
        w0 = __builtin_amdgcn_cvt_scalef32_pk_fp4_f32(w0, v0.x * sc, v0.y * sc, 1.0f, 0); w0 = __builtin_amdgcn_cvt_scalef32_pk_fp4_f32(w0, v0.z * sc, v0.w * sc, 1.0f, 1);
        w0 = __builtin_amdgcn_cvt_scalef32_pk_fp4_f32(w0, v1.x * sc, v1.y * sc, 1.0f, 2); w0 = __builtin_amdgcn_cvt_scalef32_pk_fp4_f32(w0, v1.z * sc, v1.w * sc, 1.0f, 3);
        w1 = __builtin_amdgcn_cvt_scalef32_pk_fp4_f32(w1, v2.x * sc, v2.y * sc, 1.0f, 0); w1 = __builtin_amdgcn_cvt_scalef32_pk_fp4_f32(w1, v2.z * sc, v2.w * sc, 1.0f, 1);
        w1 = __builtin_amdgcn_cvt_scalef32_pk_fp4_f32(w1, v3.x * sc, v3.y * sc, 1.0f, 2); w1 = __builtin_amdgcn_cvt_scalef32_pk_fp4_f32(w1, v3.z * sc, v3.w * sc, 1.0f, 3);
        *(u32x2*)(dst + (size_t)(F.lane >> 4) * (2 * MiB) + (size_t)r * 128 + 8 * (F.lane & 15)) = (u32x2){w0, w1};
        if (F.lane == 0) inv[2 * r] = m > 0.f ? m * (1.0f / 6.0f) : 1.0f;
    }
}
__device__ __forceinline__ void l1tab_load(const Frame& F, int R, f32x4 (&v)[4]) {
    const int tb = R >> 14, r = R & 16383;
    const f32x4* p = (const f32x4*)(((tb & 1) ? F.in[16] : F.in[15]) + ((size_t)(tb >> 1) * 16384 + r) * 1024 + 16 * F.lane);
    v[0] = p[0]; v[1] = p[1]; v[2] = p[2]; v[3] = p[3];
}
__device__ __forceinline__ void l1tab_finish(const Frame& F, int R, const f32x4 (&v)[4]) {
    const int tb = R >> 14, r = R & 16383;
    const f32x4 v0 = v[0], v1 = v[1], v2 = v[2], v3 = v[3];
    float m = fmaxf(fmaxf(fmaxf(fabsf(v0.x), fabsf(v0.y)), fmaxf(fabsf(v0.z), fabsf(v0.w))), fmaxf(fmaxf(fabsf(v1.x), fabsf(v1.y)), fmaxf(fabsf(v1.z), fabsf(v1.w))));
    m = fmaxf(m, fmaxf(fmaxf(fmaxf(fabsf(v2.x), fabsf(v2.y)), fmaxf(fabsf(v2.z), fabsf(v2.w))), fmaxf(fmaxf(fabsf(v3.x), fabsf(v3.y)), fmaxf(fabsf(v3.z), fabsf(v3.w)))));
    m = wave_max(m);
    const float sc = m > 0.f ? 6.0f / m : 1.0f;
    unsigned w0 = 0u, w1 = 0u;
    w0 = __builtin_amdgcn_cvt_scalef32_pk_fp4_f32(w0, v0.x * sc, v0.y * sc, 1.0f, 0); w0 = __builtin_amdgcn_cvt_scalef32_pk_fp4_f32(w0, v0.z * sc, v0.w * sc, 1.0f, 1);
    w0 = __builtin_amdgcn_cvt_scalef32_pk_fp4_f32(w0, v1.x * sc, v1.y * sc, 1.0f, 2); w0 = __builtin_amdgcn_cvt_scalef32_pk_fp4_f32(w0, v1.z * sc, v1.w * sc, 1.0f, 3);
    w1 = __builtin_amdgcn_cvt_scalef32_pk_fp4_f32(w1, v2.x * sc, v2.y * sc, 1.0f, 0); w1 = __builtin_amdgcn_cvt_scalef32_pk_fp4_f32(w1, v2.z * sc, v2.w * sc, 1.0f, 1);
    w1 = __builtin_amdgcn_cvt_scalef32_pk_fp4_f32(w1, v3.x * sc, v3.y * sc, 1.0f, 2); w1 = __builtin_amdgcn_cvt_scalef32_pk_fp4_f32(w1, v3.z * sc, v3.w * sc, 1.0f, 3);
    *(u32x2*)(F.ws + WS_TAB + (size_t)tb * 16 * MiB + (size_t)(F.lane >> 4) * (2 * MiB) + (size_t)r * 128 + 8 * (F.lane & 15)) = (u32x2){w0, w1};
    if (F.lane == 0) ((float*)(F.ws + WS_SCL))[(tb >> 1) * 32768 + (tb & 1) + 2 * r] = m > 0.f ? m * (1.0f / 6.0f) : 1.0f;
}
__device__ __forceinline__ int t5_bucket(int rel) {
    const int ret = rel > 0 ? 16 : 0; const int n = rel < 0 ? -rel : rel;
    int v;
    if (n < 8) v = n; else if (n < 12) v = 8; else if (n < 16) v = 9; else if (n < 23) v = 10; else if (n < 32) v = 11;
    else if (n < 46) v = 12; else if (n < 64) v = 13; else if (n < 91) v = 14; else v = 15;
    return ret + v;
}

__device__ __forceinline__ void p0_prologue(const Frame& F) {
    LAS float* scr = (LAS float*)(F.lds + F.wave * 16384);
    bf16_t* WQK = (bf16_t*)(F.ws + WS_WQK); bf16_t* WV = (bf16_t*)(F.ws + WS_WV); bf16_t* WO = (bf16_t*)(F.ws + WS_WO);
    bf16_t* WSGV = (bf16_t*)(F.ws + WS_WSGV); bf16_t* WSGU = (bf16_t*)(F.ws + WS_WSGU); bf16_t* WSGO = (bf16_t*)(F.ws + WS_WSGO);
    constexpr int I_QK = 16 * 40, I_V = 16 * 8, I_O = 16 * 32, I_SG = 16 * 96, I_SGO = 48 * 32;
    constexpr int NITEMS = I_QK + I_V + I_O + 2 * I_SG + I_SGO;
    for (int it = F.gw; it < NITEMS; it += F.NGW) {
        int r = it;
        if (r < I_QK) { const int nb = r % 40; transpose_item(F.in[3], 1536, 0, WQK, 1024, 40, (nb < 32 ? 0.125f * 1.4426950408889634f : 1.0f) * W8_SCALE, scr, r, F.lane, true); continue; } r -= I_QK;
        if (r < I_V) { transpose_item(F.in[3], 1536, 1280, WV, 1024, 8, W8_SCALE, scr, r, F.lane, true); continue; } r -= I_V;
        if (r < I_O) { transpose_item(F.in[4], 1024, 0, WO, 1024, 32, W8_SCALE, scr, r, F.lane, true); continue; } r -= I_O;
        if (r < I_SG) { transpose_item(F.in[6], 6144, 0, WSGU, 1024, 96, W8_SCALE, scr, r, F.lane, true, F.in[2] + D); continue; } r -= I_SG;
        if (r < I_SG) { transpose_item(F.in[6], 6144, 3072, WSGV, 1024, 96, W8_SCALE, scr, r, F.lane, true, F.in[2] + D); continue; } r -= I_SG;
        transpose_item(F.in[11], 1024, 0, WSGO, 3072, 32, W8_SCALE, scr, r, F.lane, true);
    }
    {
        bf16_t* WQKP = (bf16_t*)(F.ws + WS_WQKP);
        const int fr = F.lane & 15, fq = F.lane >> 4;
        for (int task = F.gw; task < 2 * 16 * 64; task += F.NGW) {
            const int l = task >> 10, hc = (task >> 6) & 15, k0 = (task & 63) * 16;
            const f32x4* ap = (const f32x4*)(F.in[13] + ((size_t)l * 1024 + k0 + fr) * 2048 + hc * 128 + 32 * fq);
            f32x4 av[8];
#pragma unroll
            for (int i = 0; i < 8; ++i) av[i] = ap[i];
#pragma unroll 1
            for (int nt = 0; nt < 8; ++nt) {
                const f32x4* bp = (const f32x4*)(F.in[14] + ((size_t)(l * 16 + hc) * 128 + nt * 16 + fr) * 128 + 32 * fq);
                f32x4 bv[8];
#pragma unroll
                for (int i = 0; i < 8; ++i) bv[i] = bp[i];
                f32x4 acc = {0.f, 0.f, 0.f, 0.f};
#pragma unroll
                for (int i = 0; i < 8; ++i)
#pragma unroll
                    for (int j = 0; j < 4; ++j) acc = __builtin_amdgcn_mfma_f32_16x16x4f32(av[i][j], bv[i][j], acc, 0, 0, 0);
                *(u32x2*)(WQKP + ((size_t)l * 2048 + hc * 128 + nt * 16 + fr) * 1024 + k0 + 4 * fq) = (u32x2){pk2(acc[0], acc[1]), pk2(acc[2], acc[3])};
                { float mx = fmaxf(fmaxf(fabsf(acc[0]), fabsf(acc[1])), fmaxf(fabsf(acc[2]), fabsf(acc[3])));
                  mx = fmaxf(mx, __shfl_xor(mx, 16)); mx = fmaxf(mx, __shfl_xor(mx, 32));
                  if (fq == 0) atomicMax((unsigned*)(F.ws + WS_CTL) + CW_COLMAX + l * 2048 + hc * 128 + nt * 16 + fr, __builtin_bit_cast(unsigned, mx)); }
            }
        }
    }
    if (blockIdx.x == 0) {
        float* bt = (float*)(F.ws + WS_BIAS);
        for (int i = F.tid; i < 16 * 257; i += 512) { const int hq = i / 257, r = i % 257 - 128; bt[hq * 260 + r + 128] = F.in[1][t5_bucket(r) * 16 + hq] * 1.4426950408889634f; }
    }
    rmsnorm_rows(F, F.in[0], F.in[2], nullptr, nullptr, F.ws + WS_HN8B);
}

typedef float f32x16 __attribute__((ext_vector_type(16)));
constexpr int AT_K = 0, AT_KS = 144, AT_V = 384 * AT_KS, AT_VS = 792, AT_B = AT_V + 64 * AT_VS;
__device__ __forceinline__ void attn_phase_v2(const Frame& F) {
    const bf16_t* Q = (const bf16_t*)(F.ws + WS_Q); const bf16_t* Kb = (const bf16_t*)(F.ws + WS_K); const bf16_t* Vt = (const bf16_t*)(F.ws + WS_VT);
    bf16_t* AO = (bf16_t*)(F.ws + WS_AO); const float* bias = (const float*)(F.ws + WS_BIAS); const float* sinkp = F.in[5];
    const int lane = F.lane, tid = F.tid, h5 = lane >> 5, c31 = lane & 31, g = F.wave >> 1, qh = F.wave & 1;
    LAS float* bl = (LAS float*)(F.lds + AT_B) + g * 260;
    int jrow = 0;
    for (int unit = blockIdx.x; unit < 1024; unit += F.G) {
        const int hkv = unit & 3, qb = (unit >> 2) & 15, b = unit >> 6;
        const int tok0 = b * 2048 + qb * 128, kbase = tok0 - 128;
        __syncthreads();
#pragma unroll 2
        for (int it = 0; it < 6; ++it) { const int id = it * 512 + tid, row = id >> 3, ch = id & 7, pos = qb * 128 - 128 + row;
            u32x4 v = (u32x4){0u, 0u, 0u, 0u};
            if (pos >= 0 && pos < 2048) v = *(const u32x4*)(Kb + (size_t)(kbase + row) * 256 + hkv * 64 + ch * 8);
            *(LAS u32x4*)(F.lds + AT_K + row * AT_KS + ch * 16) = v; }
#pragma unroll 2
        for (int it = 0; it < 6; ++it) { const int id = it * 512 + tid, d = id / 48, ch = id % 48, pos0 = qb * 128 - 128 + ch * 8;
            u32x4 v = (u32x4){0u, 0u, 0u, 0u};
            if (pos0 >= 0 && pos0 < 2048) v = *(const u32x4*)(Vt + (size_t)(hkv * 64 + d) * T + kbase + ch * 8);
            *(LAS u32x2*)(F.lds + AT_V + d * AT_VS + ch * 16) = (u32x2){v.x, v.y}; *(LAS u32x2*)(F.lds + AT_V + d * AT_VS + ch * 16 + 8) = (u32x2){v.z, v.w}; }
        for (int i = tid; i < 4 * 260; i += 512) ((LAS float*)(F.lds + AT_B))[i] = bias[hkv * 4 * 260 + i];
        __syncthreads();
        const int hq = hkv * 4 + g; const float sinkv = sinkp[hq] * 1.4426950408889634f;
#pragma unroll 1
        for (int qt = 0; qt < 2; ++qt) {
            const int R0 = F.gw + jrow * F.NGW, R1 = R0 + F.NGW, R2 = R1 + F.NGW, R3 = R2 + F.NGW; jrow += 4;
            f32x4 tr0[4], tr1[4], tr2[4], tr3[4];
            l1tab_load(F, R0 < 65536 ? R0 : 65535, tr0); l1tab_load(F, R1 < 65536 ? R1 : 65535, tr1); l1tab_load(F, R2 < 65536 ? R2 : 65535, tr2); l1tab_load(F, R3 < 65536 ? R3 : 65535, tr3);
            __builtin_amdgcn_sched_barrier(0);
            const int q0 = 64 * qh + 32 * qt;
            const bf16_t* qrow = Q + (size_t)(tok0 + q0 + c31) * 1024 + hq * 64 + 8 * h5;
            bf16x8 qf[4];
#pragma unroll
            for (int s2 = 0; s2 < 4; ++s2) qf[s2] = *(const bf16x8*)(qrow + 16 * s2);
            const int kt0 = q0 >> 5; int kt_lo = kt0, kt_hi = kt0 + 8;
            if (qb == 0 && kt_lo < 4) kt_lo = 4;
            if (qb == 15 && kt_hi > 7) kt_hi = 7;
            const int qi = q0 + c31;
            float mx = sinkv, lsum = h5 == 0 ? 1.0f : 0.f;
            f32x16 o0 = {0.f, 0.f, 0.f, 0.f, 0.f, 0.f, 0.f, 0.f, 0.f, 0.f, 0.f, 0.f, 0.f, 0.f, 0.f, 0.f}, o1 = o0;
#pragma unroll 1
            for (int kt = kt_lo; kt <= kt_hi; ++kt) {
                f32x16 sa = {0.f, 0.f, 0.f, 0.f, 0.f, 0.f, 0.f, 0.f, 0.f, 0.f, 0.f, 0.f, 0.f, 0.f, 0.f, 0.f};
#pragma unroll
                for (int s2 = 0; s2 < 4; ++s2) { const bf16x8 kf = *(const LAS bf16x8*)(F.lds + AT_K + (kt * 32 + c31) * AT_KS + s2 * 32 + h5 * 16); sa = __builtin_amdgcn_mfma_f32_32x32x16_bf16(kf, qf[s2], sa, 0, 0, 0); }
                float sv[16]; float tmax = -INFINITY;
                if (kt > kt0 && kt < kt0 + 8) {
                    const LAS float* bp = bl + (kt * 32 + 4 * h5 - qi);
#pragma unroll
                    for (int r = 0; r < 16; ++r) { sv[r] = sa[r] + bp[(r & 3) + 8 * (r >> 2)]; tmax = fmaxf(tmax, sv[r]); }
                } else {
#pragma unroll
                    for (int r = 0; r < 16; ++r) { const int key = kt * 32 + (r & 3) + 8 * (r >> 2) + 4 * h5, rel = key - 128 - qi; const bool ok = rel >= -128 && rel <= 128;
                        const int bi = rel < -128 ? 0 : (rel > 128 ? 256 : rel + 128);
                        sv[r] = ok ? sa[r] + bl[bi] : -INFINITY; tmax = fmaxf(tmax, sv[r]); }
                }
                tmax = fmaxf(tmax, __shfl_xor(tmax, 32));
                if (__any(tmax > mx)) {
                    const float mn = fmaxf(mx, tmax), scl = __builtin_amdgcn_exp2f(mx - mn); mx = mn; lsum *= scl;
#pragma unroll
                    for (int r = 0; r < 16; ++r) { o0[r] *= scl; o1[r] *= scl; }
                }
                float pr[16];
#pragma unroll
                for (int r = 0; r < 16; ++r) { pr[r] = __builtin_amdgcn_exp2f(sv[r] - mx); lsum += pr[r]; }
#pragma unroll
                for (int s2 = 0; s2 < 2; ++s2) {
                    u32x4 pw; pw.x = pk2(pr[8 * s2 + 0], pr[8 * s2 + 1]); pw.y = pk2(pr[8 * s2 + 2], pr[8 * s2 + 3]); pw.z = pk2(pr[8 * s2 + 4], pr[8 * s2 + 5]); pw.w = pk2(pr[8 * s2 + 6], pr[8 * s2 + 7]);
                    const bf16x8 pb = __builtin_bit_cast(bf16x8, pw);
                    const int koff = (kt * 32 + 16 * s2 + 4 * h5) * 2;
                    { const LAS unsigned char* vb = F.lds + AT_V + c31 * AT_VS + koff; const u32x2 lo = *(const LAS u32x2*)vb, hi = *(const LAS u32x2*)(vb + 16);
                      const bf16x8 vf = __builtin_bit_cast(bf16x8, (u32x4){lo.x, lo.y, hi.x, hi.y}); o0 = __builtin_amdgcn_mfma_f32_32x32x16_bf16(vf, pb, o0, 0, 0, 0); }
                    { const LAS unsigned char* vb = F.lds + AT_V + (32 + c31) * AT_VS + koff; const u32x2 lo = *(const LAS u32x2*)vb, hi = *(const LAS u32x2*)(vb + 16);
                      const bf16x8 vf = __builtin_bit_cast(bf16x8, (u32x4){lo.x, lo.y, hi.x, hi.y}); o1 = __builtin_amdgcn_mfma_f32_32x32x16_bf16(vf, pb, o1, 0, 0, 0); }
                }
            }
            lsum += __shfl_xor(lsum, 32);
            const float linv = 1.0f / lsum;
            unsigned char* op = (unsigned char*)AO + (size_t)(tok0 + qi) * 1024 + hq * 64 + 4 * h5;
            const float ls = linv * AO8_SCALE;
#pragma unroll
            for (int gq = 0; gq < 4; ++gq) {
                int w0 = 0, w1 = 0;
                w0 = __builtin_amdgcn_cvt_pk_fp8_f32(o0[4 * gq] * ls, o0[4 * gq + 1] * ls, w0, false); w0 = __builtin_amdgcn_cvt_pk_fp8_f32(o0[4 * gq + 2] * ls, o0[4 * gq + 3] * ls, w0, true);
                w1 = __builtin_amdgcn_cvt_pk_fp8_f32(o1[4 * gq] * ls, o1[4 * gq + 1] * ls, w1, false); w1 = __builtin_amdgcn_cvt_pk_fp8_f32(o1[4 * gq + 2] * ls, o1[4 * gq + 3] * ls, w1, true);
                *(unsigned*)(op + 8 * gq) = (unsigned)w0; *(unsigned*)(op + 32 + 8 * gq) = (unsigned)w1; }
            if (R0 < 65536) l1tab_finish(F, R0, tr0);
            if (R1 < 65536) l1tab_finish(F, R1, tr1);
            if (R2 < 65536) l1tab_finish(F, R2, tr2);
            if (R3 < 65536) l1tab_finish(F, R3, tr3);
        }
    }
    for (int R = F.gw + jrow * F.NGW; R < 65536; R += F.NGW) { f32x4 tr[4]; l1tab_load(F, R, tr); l1tab_finish(F, R, tr); }
}

__device__ __forceinline__ unsigned enc_key(float f, unsigned tag, unsigned mask) { unsigned u = __builtin_bit_cast(unsigned, f); u = (u & ~mask) | tag; return (u & 0x80000000u) ? ~u : (u | 0x80000000u); }
__device__ __forceinline__ unsigned dec_key(unsigned m) { return (m & 0x80000000u) ? (m & 0x7fffffffu) : ~m; }
__device__ __forceinline__ unsigned umax(unsigned a, unsigned b) { return a > b ? a : b; }
__device__ __forceinline__ unsigned umin(unsigned a, unsigned b) { return a < b ? a : b; }
#define SORT_CE(i, j) do { const unsigned hi_ = umax(a[i], a[j]), lo_ = umin(a[i], a[j]); a[i] = hi_; a[j] = lo_; } while (0)
__device__ __forceinline__ void sort16_desc(unsigned (&a)[16]) {
    SORT_CE(0, 13); SORT_CE(1, 12); SORT_CE(2, 15); SORT_CE(3, 14); SORT_CE(4, 8); SORT_CE(5, 6); SORT_CE(7, 11); SORT_CE(9, 10);
    SORT_CE(0, 5); SORT_CE(1, 7); SORT_CE(2, 9); SORT_CE(3, 4); SORT_CE(6, 13); SORT_CE(8, 14); SORT_CE(10, 15); SORT_CE(11, 12);
    SORT_CE(0, 1); SORT_CE(2, 3); SORT_CE(4, 5); SORT_CE(6, 8); SORT_CE(7, 9); SORT_CE(10, 11); SORT_CE(12, 13); SORT_CE(14, 15);
    SORT_CE(0, 2); SORT_CE(1, 3); SORT_CE(4, 10); SORT_CE(5, 11); SORT_CE(6, 7); SORT_CE(8, 9); SORT_CE(12, 14); SORT_CE(13, 15);
    SORT_CE(1, 2); SORT_CE(3, 12); SORT_CE(4, 6); SORT_CE(5, 7); SORT_CE(8, 10); SORT_CE(9, 11); SORT_CE(13, 14);
    SORT_CE(1, 4); SORT_CE(2, 6); SORT_CE(5, 8); SORT_CE(7, 10); SORT_CE(9, 13); SORT_CE(11, 14);
    SORT_CE(2, 4); SORT_CE(3, 6); SORT_CE(9, 12); SORT_CE(11, 13);
    SORT_CE(3, 5); SORT_CE(6, 8); SORT_CE(7, 9); SORT_CE(10, 12);
    SORT_CE(3, 4); SORT_CE(5, 6); SORT_CE(7, 8); SORT_CE(9, 10); SORT_CE(11, 12);
    SORT_CE(6, 7); SORT_CE(8, 9);
}
#undef SORT_CE
__device__ __forceinline__ void merge16_desc(unsigned (&a)[16]) {
#pragma unroll
    for (int jj = 3; jj >= 0; --jj)
#pragma unroll
        for (int i = 0; i < 16; ++i) { const int j = 1 << jj, l = i ^ j; if (l > i) { const unsigned hi = umax(a[i], a[l]), lo = umin(a[i], a[l]); a[i] = hi; a[l] = lo; } }
}
template <int CTRL> __device__ __forceinline__ void xmerge16(unsigned (&a)[16]) {
    unsigned p[16];
#pragma unroll
    for (int i = 0; i < 16; ++i) p[i] = (unsigned)__builtin_amdgcn_update_dpp(0, (int)a[i], CTRL, 0xf, 0xf, true);
#pragma unroll
    for (int i = 0; i < 16; ++i) a[i] = umax(a[i], p[15 - i]);
    merge16_desc(a);
}
template <int CTRL> __device__ __forceinline__ unsigned dpp_u(unsigned v) { return (unsigned)__builtin_amdgcn_update_dpp(0, (int)v, CTRL, 0xf, 0xf, true); }
__device__ __forceinline__ void topk_phase_v3(const Frame& F) {
    const bf16_t* S = (const bf16_t*)(F.ws + WS_S); int* IDX = (int*)(F.ws + WS_IDX); float* GATE = (float*)(F.ws + WS_GATE);
    LAS unsigned* L = (LAS unsigned*)F.lds + F.wave * 1024;
    const int lane = F.lane, tk = lane >> 4, hc = lane & 15, h = hc >> 1, c = hc & 1;
    auto step = [&](const u32x4 (&cur)[16], const int tb) __attribute__((always_inline)) {
        const int t = tb + tk;
        unsigned top[16];
#pragma unroll
        for (int ck = 0; ck < 8; ++ck) {
            const u32x4 v = cur[2 * ck], w = cur[2 * ck + 1];
            const float fv[16] = {hlo(v.x), hhi(v.x), hlo(v.y), hhi(v.y), hlo(v.z), hhi(v.z), hlo(v.w), hhi(v.w), hlo(w.x), hhi(w.x), hlo(w.y), hhi(w.y), hlo(w.z), hhi(w.z), hlo(w.w), hhi(w.w)};
            unsigned nw[16];
#pragma unroll
            for (int j = 0; j < 16; ++j) nw[j] = enc_key(fv[j], (unsigned)(16 * ck + j), 127u);
            sort16_desc(nw);
            if (ck == 0) {
#pragma unroll
                for (int j = 0; j < 16; ++j) top[j] = nw[j];
            } else {
#pragma unroll
                for (int j = 0; j < 16; ++j) top[j] = umax(top[j], nw[15 - j]);
                merge16_desc(top);
            }
        }
#pragma unroll
        for (int i = 0; i < 16; ++i) L[lane * 16 + i] = top[i];
        float f1[16], f2[16];
#pragma unroll
        for (int i = 0; i < 16; ++i) { const unsigned o = dpp_u<0xB1>(top[i]); const unsigned u1 = dec_key(c ? o : top[i]) & ~127u, u2 = dec_key(c ? top[i] : o) & ~127u;
            f1[i] = __builtin_bit_cast(float, u1); f2[i] = __builtin_bit_cast(float, u2); }
        unsigned ca[16], cb[16];
#pragma unroll
        for (int i = 0; i < 16; ++i) { ca[i] = 0u; cb[i] = 0u; }
        { int n = 0;
#pragma unroll
          for (int i = 0; i < 16; ++i)
#pragma unroll
            for (int j = 0; j < 16; ++j) if ((i + 1) * (j + 1) <= 16) { const unsigned key = enc_key(f1[i] + f2[j], (unsigned)((i << 4) | j), 255u); const int slot = n >> 1, who = n & 1;
                if (slot < 16) ca[slot] = (c == who) ? key : ca[slot]; else cb[slot - 16] = (c == who) ? key : cb[slot - 16]; ++n; } }
        sort16_desc(ca); sort16_desc(cb);
#pragma unroll
        for (int i = 0; i < 16; ++i) ca[i] = umax(ca[i], cb[15 - i]);
        merge16_desc(ca);
        xmerge16<0xB1>(ca);
        float sc[8]; unsigned ex[8];
#pragma unroll
        for (int k = 0; k < 8; ++k) { unsigned wlo = ca[k], whi = ca[8 + k]; asm volatile("" : "+v"(wlo), "+v"(whi));
            const unsigned w = c ? whi : wlo;
            const unsigned tag = dec_key(w) & 255u; const unsigned u1 = dec_key(L[(lane & ~1) * 16 + (tag >> 4)]), u2 = dec_key(L[(lane | 1) * 16 + (tag & 15u)]);
            sc[k] = __builtin_bit_cast(float, u1 & ~127u) + __builtin_bit_cast(float, u2 & ~127u); ex[k] = ((u1 & 127u) << 7) | (u2 & 127u); }
        const float smax = __builtin_bit_cast(float, __builtin_amdgcn_update_dpp(0, __builtin_bit_cast(int, sc[0]), 0xA0, 0xf, 0xf, true));
        float e[8]; float sum = 0.f;
#pragma unroll
        for (int k = 0; k < 8; ++k) { e[k] = __expf(sc[k] - smax); sum += e[k]; }
        sum += __builtin_bit_cast(float, __builtin_amdgcn_update_dpp(0, __builtin_bit_cast(int, sum), 0xB1, 0xf, 0xf, true));
        const float inv = 1.0f / sum;
        unsigned* ip = (unsigned*)IDX + (size_t)t * 64 + h * 8 + 4 * c; unsigned* gp = (unsigned*)GATE + (size_t)t * 64 + h * 8 + 4 * c;
        *(u32x4*)ip = (u32x4){ex[0] | (ex[1] << 16), ex[2] | (ex[3] << 16), ex[4] | (ex[5] << 16), ex[6] | (ex[7] << 16)};
        *(u32x4*)gp = (u32x4){pkh2(e[0] * inv, e[1] * inv), pkh2(e[2] * inv, e[3] * inv), pkh2(e[4] * inv, e[5] * inv), pkh2(e[6] * inv, e[7] * inv)};
    };
#define TK_LD1(dst, ptr, OFF) asm volatile("global_load_dwordx4 %0, %1, off offset:" #OFF : "=v"(dst) : "v"(ptr) : "memory")
#define TK_LOAD(buf, tb_) do { const u32x4* sp_ = (const u32x4*)(S + (size_t)((tb_) + tk) * 2048 + hc * 128); \
        TK_LD1(buf[0], sp_, 0); TK_LD1(buf[1], sp_, 16); TK_LD1(buf[2], sp_, 32); TK_LD1(buf[3], sp_, 48); TK_LD1(buf[4], sp_, 64); TK_LD1(buf[5], sp_, 80); TK_LD1(buf[6], sp_, 96); TK_LD1(buf[7], sp_, 112); \
        TK_LD1(buf[8], sp_, 128); TK_LD1(buf[9], sp_, 144); TK_LD1(buf[10], sp_, 160); TK_LD1(buf[11], sp_, 176); TK_LD1(buf[12], sp_, 192); TK_LD1(buf[13], sp_, 208); TK_LD1(buf[14], sp_, 224); TK_LD1(buf[15], sp_, 240); } while (0)
#define TK_WAIT(buf, N) asm volatile("s_waitcnt vmcnt(" #N ")" : "+v"(buf[0]), "+v"(buf[1]), "+v"(buf[2]), "+v"(buf[3]), "+v"(buf[4]), "+v"(buf[5]), "+v"(buf[6]), "+v"(buf[7]), \
        "+v"(buf[8]), "+v"(buf[9]), "+v"(buf[10]), "+v"(buf[11]), "+v"(buf[12]), "+v"(buf[13]), "+v"(buf[14]), "+v"(buf[15]) :: "memory")
    const int dstep = 4 * F.NGW; int tb = 4 * F.gw;
    u32x4 bufa[16], bufb[16];
    if (tb >= T) return;
    TK_LOAD(bufa, tb);
    for (;;) {
        const int t1 = tb + dstep; TK_LOAD(bufb, t1 < T ? t1 : tb);
        TK_WAIT(bufa, 16);
        step(bufa, tb);
        if (t1 >= T) break;
        const int t2 = t1 + dstep; TK_LOAD(bufa, t2 < T ? t2 : t1);
        TK_WAIT(bufb, 16);
        step(bufb, t1);
        if (t2 >= T) break;
        tb = t2;
    }
    asm volatile("s_waitcnt vmcnt(0)" ::: "memory");
#undef TK_LOAD
#undef TK_LD1
#undef TK_WAIT
}

template <int S> __device__ __forceinline__ void reduce_scatter16(const float (&v)[16], int lane, float& z0, float& z1) {
    const bool b2 = (lane & (4 * S)) != 0, b1 = (lane & (2 * S)) != 0, b0 = (lane & S) != 0;
    float u[8], w[4];
#pragma unroll
    for (int k = 0; k < 8; ++k) { const float keep = b2 ? v[8 + k] : v[k], send = b2 ? v[k] : v[8 + k]; u[k] = keep + __shfl_xor(send, 4 * S); }
#pragma unroll
    for (int k = 0; k < 4; ++k) { const float keep = b1 ? u[4 + k] : u[k], send = b1 ? u[k] : u[4 + k]; w[k] = keep + __shfl_xor(send, 2 * S); }
    { const float keep = b0 ? w[2] : w[0], send = b0 ? w[0] : w[2]; z0 = keep + __shfl_xor(send, S); }
    { const float keep = b0 ? w[3] : w[1], send = b0 ? w[1] : w[3]; z1 = keep + __shfl_xor(send, S); }
}
__device__ __forceinline__ void ld_off16(const int* IDX, int t, int g, unsigned off, unsigned (&e)[16]) {
    const u32x4* ip = (const u32x4*)((const char*)IDX + (unsigned)(t * 512 + 64 * g)); const u32x4 i0 = ip[0], i1 = ip[1], i2 = ip[2], i3 = ip[3];
    e[0] = i0.x * 128u + off; e[1] = i0.y * 128u + off; e[2] = i0.z * 128u + off; e[3] = i0.w * 128u + off; e[4] = i1.x * 128u + off; e[5] = i1.y * 128u + off; e[6] = i1.z * 128u + off; e[7] = i1.w * 128u + off;
    e[8] = i2.x * 128u + off; e[9] = i2.y * 128u + off; e[10] = i2.z * 128u + off; e[11] = i2.w * 128u + off; e[12] = i3.x * 128u + off; e[13] = i3.y * 128u + off; e[14] = i3.z * 128u + off; e[15] = i3.w * 128u + off;
}
__device__ __forceinline__ void gather16(const unsigned char* tab, const unsigned (&e)[16], u32x4 (&wv)[16]) {
#pragma unroll
    for (int i = 0; i < 16; ++i) wv[i] = *(const u32x4*)(tab + e[i]);
}
#define FP4X32(W_, o) do { const u32x4 _w = (W_); \
    o[0] = __builtin_amdgcn_cvt_scalef32_pk_f32_fp4(_w.x, 1.0f, 0); o[1] = __builtin_amdgcn_cvt_scalef32_pk_f32_fp4(_w.x, 1.0f, 1); o[2] = __builtin_amdgcn_cvt_scalef32_pk_f32_fp4(_w.x, 1.0f, 2); o[3] = __builtin_amdgcn_cvt_scalef32_pk_f32_fp4(_w.x, 1.0f, 3); \
    o[4] = __builtin_amdgcn_cvt_scalef32_pk_f32_fp4(_w.y, 1.0f, 0); o[5] = __builtin_amdgcn_cvt_scalef32_pk_f32_fp4(_w.y, 1.0f, 1); o[6] = __builtin_amdgcn_cvt_scalef32_pk_f32_fp4(_w.y, 1.0f, 2); o[7] = __builtin_amdgcn_cvt_scalef32_pk_f32_fp4(_w.y, 1.0f, 3); \
    o[8] = __builtin_amdgcn_cvt_scalef32_pk_f32_fp4(_w.z, 1.0f, 0); o[9] = __builtin_amdgcn_cvt_scalef32_pk_f32_fp4(_w.z, 1.0f, 1); o[10] = __builtin_amdgcn_cvt_scalef32_pk_f32_fp4(_w.z, 1.0f, 2); o[11] = __builtin_amdgcn_cvt_scalef32_pk_f32_fp4(_w.z, 1.0f, 3); \
    o[12] = __builtin_amdgcn_cvt_scalef32_pk_f32_fp4(_w.w, 1.0f, 0); o[13] = __builtin_amdgcn_cvt_scalef32_pk_f32_fp4(_w.w, 1.0f, 1); o[14] = __builtin_amdgcn_cvt_scalef32_pk_f32_fp4(_w.w, 1.0f, 2); o[15] = __builtin_amdgcn_cvt_scalef32_pk_f32_fp4(_w.w, 1.0f, 3); } while (0)
__device__ __forceinline__ void peer_down_phase4(const Frame& F, int layer) {
    const int bx = blockIdx.x, p4 = bx & 3, par = (bx >> 2) & 1;
    const unsigned char* TD = F.ws + WS_TAB + (size_t)(2 * layer) * 16 * MiB + (size_t)p4 * (2 * MiB); const char* HNb = (const char*)(F.ws + WS_HN);
    const int* IDX = (const int*)(F.ws + WS_IDX); bf16_t* PART = (bf16_t*)(F.ws + WS_PART);
    const int nwp = (F.G - (bx & 7) + 7) >> 3, ww = (bx >> 3) * 8 + F.wave, stride = 2 * nwp * 8, tfirst = 2 * ww + par;
    const int lane = F.lane, r = lane & 7, g = lane >> 3, off = 256 * p4 + 32 * r;
    if (tfirst >= T) return;
    unsigned e1[16]; u32x4 wv[16];
    const unsigned toff = 16u * r;
    ld_off16(IDX, tfirst, g, toff, e1); gather16(TD, e1, wv);
    u32x4 xc[4];
#pragma unroll
    for (int k = 0; k < 4; ++k) xc[k] = *(const u32x4*)(HNb + (unsigned)(tfirst * 2048 + 2 * off + 16 * k));
    { const int t1 = tfirst + stride < T ? tfirst + stride : tfirst; ld_off16(IDX, t1, g, toff, e1); }
    for (int t0 = tfirst; t0 < T; t0 += stride) {
        const int t1 = t0 + stride < T ? t0 + stride : t0, t2 = t0 + 2 * stride < T ? t0 + 2 * stride : t0;
        unsigned e2[16]; ld_off16(IDX, t2, g, toff, e2);
        u32x4 xn[4];
#pragma unroll
        for (int k = 0; k < 4; ++k) xn[k] = *(const u32x4*)(HNb + (unsigned)(t1 * 2048 + 2 * off + 16 * k));
        const unsigned xw[16] = {xc[0].x, xc[0].y, xc[0].z, xc[0].w, xc[1].x, xc[1].y, xc[1].z, xc[1].w, xc[2].x, xc[2].y, xc[2].z, xc[2].w, xc[3].x, xc[3].y, xc[3].z, xc[3].w};
        float acc[16];
#pragma unroll
        for (int i = 0; i < 16; ++i) { const u32x4 w = wv[i]; wv[i] = *(const u32x4*)(TD + e1[i]);
            const unsigned ww4[4] = {w.x, w.y, w.z, w.w}; float sv = 0.f;
#pragma unroll
            for (int k = 0; k < 4; ++k) {
                sv = __builtin_amdgcn_fdot2_f32_bf16(__builtin_amdgcn_cvt_scalef32_pk_bf16_fp4(ww4[k], 1.0f, 0), __builtin_bit_cast(bfx2, xw[4 * k]), sv, false);
                sv = __builtin_amdgcn_fdot2_f32_bf16(__builtin_amdgcn_cvt_scalef32_pk_bf16_fp4(ww4[k], 1.0f, 1), __builtin_bit_cast(bfx2, xw[4 * k + 1]), sv, false);
                sv = __builtin_amdgcn_fdot2_f32_bf16(__builtin_amdgcn_cvt_scalef32_pk_bf16_fp4(ww4[k], 1.0f, 2), __builtin_bit_cast(bfx2, xw[4 * k + 2]), sv, false);
                sv = __builtin_amdgcn_fdot2_f32_bf16(__builtin_amdgcn_cvt_scalef32_pk_bf16_fp4(ww4[k], 1.0f, 3), __builtin_bit_cast(bfx2, xw[4 * k + 3]), sv, false); }
            acc[i] = sv; }
        float z0, z1; reduce_scatter16<1>(acc, lane, z0, z1);
        *(unsigned*)((char*)(PART + (size_t)p4 * T * 128) + (unsigned)(t0 * 256 + 32 * g + 4 * r)) = pk2(z0, z1);
#pragma unroll
        for (int k = 0; k < 4; ++k) xc[k] = xn[k];
#pragma unroll
        for (int i = 0; i < 16; ++i) e1[i] = e2[i];
    }
}
constexpr int D5_AUX = 131072;
#define D5_K(d) (4 * ((d) >> 3) + (((d) >> 1) & 3))
#define D5_EL(iv, d) ((D5_K(d) & 1) ? ((iv)[(d) & 1][D5_K(d) >> 1] >> 16) : ((iv)[(d) & 1][D5_K(d) >> 1] & 0xffffu))
#define D5_DMA(iv, d) __builtin_amdgcn_global_load_lds((const unsigned*)(TD + (D5_EL(iv, d) * 128u + (((d) & 1) ? sw1 : sw0))), (LAS unsigned*)(wl + (d) * 1024), 16, 0, 0)
#define D5_DMA_IDX(t, slot) __builtin_amdgcn_global_load_lds((const unsigned*)(IDX + (unsigned)((t) * 256) + l4), (LAS unsigned*)(xl + (slot) * 512), 4, 0, 0)
#define D5_DMA_H(t, slot) __builtin_amdgcn_global_load_lds((const unsigned*)(H8 + (unsigned)((t) * 1024) + l4), (LAS unsigned*)(xl + 1024 + (slot) * 256), 4, 0, 0)
#define D5_B(h, c) ((i32x8){(int)h[2 * (c)].x, (int)h[2 * (c)].y, (int)h[2 * (c)].z, (int)h[2 * (c)].w, (int)h[2 * (c) + 1].x, (int)h[2 * (c) + 1].y, (int)h[2 * (c) + 1].z, (int)h[2 * (c) + 1].w})
#define D5_A(a) ((i32x8){(int)(a).x, (int)(a).y, (int)(a).z, (int)(a).w, 0, 0, 0, 0})
__device__ __forceinline__ void peer_down_phase5(const Frame& F, int layer) {
    const int bx = blockIdx.x, p4 = bx & 3, par = (bx >> 2) & 1;
    const unsigned char* TD = F.ws + WS_TAB + (size_t)(2 * layer) * 16 * MiB + (size_t)p4 * (2 * MiB);
    const char* H8 = (const char*)(F.ws + WS_HNI8) + 256 * p4; const char* IDX = (const char*)(F.ws + WS_IDX); char* PART = (char*)(F.ws + WS_PART) + (size_t)p4 * T * 256;
    const int nwp = (F.G - (bx & 7) + 7) >> 3, ww = (bx >> 3) * 8 + F.wave, stride = 2 * nwp * 8, tfirst = 2 * ww + par;
    if (tfirst >= T) return;
    const int lane = F.lane, rs = lane >> 3, sg = lane & 7, m = lane & 15, kg = lane >> 4;
    LAS unsigned char* wl = F.lds + F.wave * 16384; LAS unsigned char* xl = F.lds + D5_AUX + F.wave * 1536;
    const unsigned sw0 = (unsigned)((sg ^ kg) * 16), sw1 = (unsigned)((sg ^ (4 + kg)) * 16);
    const unsigned rd0 = (unsigned)(m * 128 + (kg ^ (m >> 1)) * 16), rd1 = (unsigned)(m * 128 + ((4 + kg) ^ (m >> 1)) * 16);
    const unsigned l4 = 4u * lane, ioff = 16u * rs, hoff = 16u * kg;
    { const u32x4* ip = (const u32x4*)(IDX + (unsigned)(tfirst * 256) + ioff); u32x4 i0[2]; i0[0] = ip[0]; i0[1] = ip[8];
      asm volatile("" : "+v"(i0[0]), "+v"(i0[1]) :: "memory");
      { const int t1 = tfirst + stride < T ? tfirst + stride : tfirst; D5_DMA_IDX(t1, 1); D5_DMA_H(tfirst, 0); }
      asm volatile("" ::: "memory");
#pragma unroll
      for (int d = 0; d < 16; ++d) D5_DMA(i0, d); }
    int sl = 0;
    for (int t0 = tfirst; t0 < T; t0 += stride, sl ^= 1) {
        const int t1 = t0 + stride < T ? t0 + stride : t0, t2 = t0 + 2 * stride < T ? t0 + 2 * stride : t0;
        D5_DMA_IDX(t2, sl); D5_DMA_H(t1, sl ^ 1);
        u32x4 i1[2], hb[4];
        f32x4 acc[8];
#pragma unroll
        for (int q = 0; q < 4; ++q) {
            asm volatile("s_waitcnt vmcnt(14)" ::: "memory");
            u32x4 a00 = *(const LAS u32x4*)(wl + (2 * q) * 2048 + rd0), a01 = *(const LAS u32x4*)(wl + (2 * q) * 2048 + rd1);
            u32x4 a10 = *(const LAS u32x4*)(wl + (2 * q + 1) * 2048 + rd0), a11 = *(const LAS u32x4*)(wl + (2 * q + 1) * 2048 + rd1);
            if (q == 0) {
                const LAS u32x4* ip = (const LAS u32x4*)(xl + (sl ^ 1) * 512 + ioff); i1[0] = ip[0]; i1[1] = ip[8];
                { LAS unsigned* cp = (LAS unsigned*)(xl + 1024 + sl * 256 + l4); const unsigned wq = *cp;
                  int o8 = 0; o8 = __builtin_amdgcn_cvt_pk_fp8_f32((float)(int)(signed char)(wq & 255u), (float)(int)(signed char)((wq >> 8) & 255u), o8, false);
                  o8 = __builtin_amdgcn_cvt_pk_fp8_f32((float)(int)(signed char)((wq >> 16) & 255u), (float)((int)wq >> 24), o8, true);
                  *cp = (unsigned)o8; }
                asm volatile("" ::: "memory");
                const LAS u32x4* hp = (const LAS u32x4*)(xl + 1024 + sl * 256 + hoff); hb[0] = hp[0]; hb[1] = hp[4]; hb[2] = hp[8]; hb[3] = hp[12];
                asm volatile("s_waitcnt lgkmcnt(0)" : "+v"(i1[0]), "+v"(i1[1]), "+v"(hb[0]), "+v"(hb[1]), "+v"(hb[2]), "+v"(hb[3]) :: "memory");
            }
            asm volatile("s_waitcnt lgkmcnt(0)" : "+v"(a00), "+v"(a01), "+v"(a10), "+v"(a11) :: "memory");
            D5_DMA(i1, 4 * q); D5_DMA(i1, 4 * q + 1); D5_DMA(i1, 4 * q + 2); D5_DMA(i1, 4 * q + 3);
            asm volatile("" ::: "memory");
            const i32x8 b0 = D5_B(hb, 0), b1 = D5_B(hb, 1);
            const f32x4 z = {0.f, 0.f, 0.f, 0.f};
            acc[2 * q] = __builtin_amdgcn_mfma_scale_f32_16x16x128_f8f6f4(D5_A(a00), b0, z, 4, 0, 0, 0, 0, 0);
            acc[2 * q + 1] = __builtin_amdgcn_mfma_scale_f32_16x16x128_f8f6f4(D5_A(a10), b0, z, 4, 0, 0, 0, 0, 0);
            acc[2 * q] = __builtin_amdgcn_mfma_scale_f32_16x16x128_f8f6f4(D5_A(a01), b1, acc[2 * q], 4, 0, 0, 0, 0, 0);
            acc[2 * q + 1] = __builtin_amdgcn_mfma_scale_f32_16x16x128_f8f6f4(D5_A(a11), b1, acc[2 * q + 1], 4, 0, 0, 0, 0, 0);
        }
        if (m < 4) {
            float v[8];
#pragma unroll
            for (int j = 0; j < 8; ++j) v[j] = m == 0 ? acc[j].x : m == 1 ? acc[j].y : m == 2 ? acc[j].z : acc[j].w;
            *(u32x4*)(PART + (unsigned)(t0 * 256 + 16 * (4 * kg + m))) = (u32x4){pk2(v[0], v[1]), pk2(v[2], v[3]), pk2(v[4], v[5]), pk2(v[6], v[7])};
        }
    }
    asm volatile("s_waitcnt vmcnt(0)" ::: "memory");
}
template <int NS> __device__ __forceinline__ void peer_reduce_phase(const Frame& F, int layer) {
    const u32x2* PART = (const u32x2*)(F.ws + WS_PART); const int* IDX = (const int*)(F.ws + WS_IDX); const float* GATE = (const float*)(F.ws + WS_GATE);
    bf16_t* AB = (bf16_t*)(F.ws + WS_AB);
    const f32x2* scl = (const f32x2*)(F.ws + WS_SCL) + (size_t)layer * 16384;
    const size_t n4 = (size_t)T * 128 / 4, stride = (size_t)F.G * 512;
    for (size_t i = (size_t)blockIdx.x * 512 + F.tid; i < n4; i += stride) {
        u32x2 pw[NS];
#pragma unroll
        for (int p = 0; p < NS; ++p) pw[p] = PART[(size_t)p * T * 32 + i];
        const u32x4 e = ((const u32x4*)IDX)[i]; const f32x4 gt = ((const f32x4*)GATE)[i];
        const f32x2 c0 = scl[e.x], c1 = scl[e.y], c2 = scl[e.z], c3 = scl[e.w];
        f32x4 s = {0.f, 0.f, 0.f, 0.f};
#pragma unroll
        for (int p = 0; p < NS; ++p) { s.x += bflo(pw[p].x); s.y += bfhi(pw[p].x); s.z += bflo(pw[p].y); s.w += bfhi(pw[p].y); }
        f32x4 o;
        o.x = gelu_tanh(s.x * c0.x) * gt.x * c0.y; o.y = gelu_tanh(s.y * c1.x) * gt.y * c1.y;
        o.z = gelu_tanh(s.z * c2.x) * gt.z * c2.y; o.w = gelu_tanh(s.w * c3.x) * gt.w * c3.y;
        ((u32x2*)AB)[i] = (u32x2){pk2(o.x, o.y), pk2(o.z, o.w)};
    }
}
__device__ __forceinline__ void peer_reduce_phase8(const Frame& F, int layer) {
    const u32x2* PART = (const u32x2*)(F.ws + WS_PART); const int* IDX = (const int*)(F.ws + WS_IDX); const float* GATE = (const float*)(F.ws + WS_GATE);
    unsigned char* AB8 = F.ws + WS_AB;
    const f32x2* scl = (const f32x2*)(F.ws + WS_SCL) + (size_t)layer * 16384;
    const size_t n4 = (size_t)T * 128 / 4, stride = (size_t)F.G * 512;
    for (size_t i = (size_t)blockIdx.x * 512 + F.tid; i < n4; i += stride) {
        u32x2 pw[4];
#pragma unroll
        for (int p = 0; p < 4; ++p) pw[p] = PART[(size_t)p * T * 32 + i];
        const u32x2 e2 = ((const u32x2*)IDX)[i]; const u32x4 e = {e2.x & 0xffffu, e2.x >> 16, e2.y & 0xffffu, e2.y >> 16}; const u32x2 gh = ((const u32x2*)GATE)[i]; const f32x4 gt = {hlo(gh.x), hhi(gh.x), hlo(gh.y), hhi(gh.y)};
        const f32x2 c0 = scl[e.x], c1 = scl[e.y], c2 = scl[e.z], c3 = scl[e.w];
        const float hs = ((const float*)(F.ws + WS_HSC))[i >> 5];
        f32x4 s = {0.f, 0.f, 0.f, 0.f};
#pragma unroll
        for (int p = 0; p < 4; ++p) { s.x += bflo(pw[p].x); s.y += bfhi(pw[p].x); s.z += bflo(pw[p].y); s.w += bfhi(pw[p].y); }
        s = s * hs;
        f32x4 o;
        o.x = gelu_tanh(s.x * c0.x) * gt.x * c0.y; o.y = gelu_tanh(s.y * c1.x) * gt.y * c1.y;
        o.z = gelu_tanh(s.z * c2.x) * gt.z * c2.y; o.w = gelu_tanh(s.w * c3.x) * gt.w * c3.y;
        float am = fmaxf(fmaxf(fabsf(o.x), fabsf(o.y)), fmaxf(fabsf(o.z), fabsf(o.w)));
#pragma unroll
        for (int d = 1; d < 32; d <<= 1) am = fmaxf(am, __shfl_xor(am, d));
        const float S = am > 0.f ? 256.0f / am : 1.0f;
        int w = 0; w = __builtin_amdgcn_cvt_pk_fp8_f32(o.x * S, o.y * S, w, false); w = __builtin_amdgcn_cvt_pk_fp8_f32(o.z * S, o.w * S, w, true);
        const size_t t = i >> 5; const unsigned j = (unsigned)i & 31u;
        *(unsigned*)(AB8 + t * 256 + 4 * j) = (unsigned)w;
        if (j == 0) *(float*)(AB8 + t * 256 + 128) = am * (1.0f / 256.0f);
    }
}
__device__ __forceinline__ unsigned hadd2(unsigned a, unsigned b) { const h16x2 r = __builtin_bit_cast(h16x2, a) + __builtin_bit_cast(h16x2, b); return __builtin_bit_cast(unsigned, r); }
__device__ __forceinline__ f32x4 reduce_scatter32h_g(const unsigned (&v)[16], int lane) {
    const bool b2 = (lane & 32) != 0, b1 = (lane & 16) != 0, b0 = (lane & 8) != 0;
    unsigned u[8], w[4], z[2];
#pragma unroll
    for (int k = 0; k < 8; ++k) { const unsigned keep = b2 ? v[8 + k] : v[k], send = b2 ? v[k] : v[8 + k]; u[k] = hadd2(keep, (unsigned)__shfl_xor((int)send, 32)); }
#pragma unroll
    for (int k = 0; k < 4; ++k) { const unsigned keep = b1 ? u[4 + k] : u[k], send = b1 ? u[k] : u[4 + k]; w[k] = hadd2(keep, (unsigned)__shfl_xor((int)send, 16)); }
#pragma unroll
    for (int k = 0; k < 2; ++k) { const unsigned keep = b0 ? w[2 + k] : w[k], send = b0 ? w[k] : w[2 + k]; z[k] = hadd2(keep, (unsigned)__shfl_xor((int)send, 8)); }
    return (f32x4){hlo(z[0]), hhi(z[0]), hlo(z[1]), hhi(z[1])};
}
__device__ __forceinline__ void peer_up_phase4(const Frame& F, int layer) {
    const int bx = blockIdx.x, p4 = bx & 3, par = (bx >> 2) & 1;
    const unsigned char* TU = F.ws + WS_TAB + (size_t)(2 * layer + 1) * 16 * MiB + (size_t)p4 * (2 * MiB);
    const int* IDX = (const int*)(F.ws + WS_IDX); const char* AB = (const char*)(F.ws + WS_AB);
    const int nwp = (F.G - (bx & 7) + 7) >> 3, ww = (bx >> 3) * 8 + F.wave, stride = 2 * nwp * 8, tfirst = 2 * ww + par;
    const int lane = F.lane, r = lane & 7, g = lane >> 3, hoff = 256 * p4 + 32 * r + 4 * g;
    if (tfirst >= T) return;
    unsigned e1[16]; u32x4 wv[16];
    const unsigned toff = 16u * r;
    ld_off16(IDX, tfirst, g, toff, e1); gather16(TU, e1, wv);
    u32x4 a0a = *(const u32x4*)(AB + (unsigned)(tfirst * 256 + 32 * g)), a0b = *(const u32x4*)(AB + (unsigned)(tfirst * 256 + 32 * g + 16));
    { const int t1 = tfirst + stride < T ? tfirst + stride : tfirst; ld_off16(IDX, t1, g, toff, e1); }
    for (int t0 = tfirst; t0 < T; t0 += stride) {
        const int t1 = t0 + stride < T ? t0 + stride : t0, t2 = t0 + 2 * stride < T ? t0 + 2 * stride : t0;
        unsigned e2[16]; ld_off16(IDX, t2, g, toff, e2);
        const u32x4 a1a = *(const u32x4*)(AB + (unsigned)(t1 * 256 + 32 * g)), a1b = *(const u32x4*)(AB + (unsigned)(t1 * 256 + 32 * g + 16));
        f32x4* hp = (f32x4*)((char*)F.out + (unsigned)(t0 * 4096 + 4 * hoff)); const f32x4 h0 = *hp;
        const unsigned aw[8] = {a0a.x, a0a.y, a0a.z, a0a.w, a0b.x, a0b.y, a0b.z, a0b.w};
        unsigned y2[16];
#pragma unroll
        for (int k = 0; k < 16; ++k) y2[k] = 0u;
#pragma unroll
        for (int i = 0; i < 16; ++i) { u32x4 w = wv[i]; wv[i] = *(const u32x4*)(TU + e1[i]);
            if (i > 0) asm volatile("" : "+v"(w.x), "+v"(w.y), "+v"(w.z), "+v"(w.w) : "v"(y2[0]), "v"(y2[15]));
            const float ai = (i & 1) ? bfhi(aw[i >> 1]) : bflo(aw[i >> 1]); const h16x2 av = {(_Float16)ai, (_Float16)ai};
            const unsigned ww4[4] = {w.x, w.y, w.z, w.w};
#pragma unroll
            for (int k = 0; k < 4; ++k) {
                { const h16x2 r = av * __builtin_amdgcn_cvt_scalef32_pk_f16_fp4(ww4[k], 1.0f, 0) + __builtin_bit_cast(h16x2, y2[4 * k]); y2[4 * k] = __builtin_bit_cast(unsigned, r); }
                { const h16x2 r = av * __builtin_amdgcn_cvt_scalef32_pk_f16_fp4(ww4[k], 1.0f, 1) + __builtin_bit_cast(h16x2, y2[4 * k + 1]); y2[4 * k + 1] = __builtin_bit_cast(unsigned, r); }
                { const h16x2 r = av * __builtin_amdgcn_cvt_scalef32_pk_f16_fp4(ww4[k], 1.0f, 2) + __builtin_bit_cast(h16x2, y2[4 * k + 2]); y2[4 * k + 2] = __builtin_bit_cast(unsigned, r); }
                { const h16x2 r = av * __builtin_amdgcn_cvt_scalef32_pk_f16_fp4(ww4[k], 1.0f, 3) + __builtin_bit_cast(h16x2, y2[4 * k + 3]); y2[4 * k + 3] = __builtin_bit_cast(unsigned, r); } } }
        const f32x4 z = reduce_scatter32h_g(y2, lane);
        *hp = h0 + z;
        a0a = a1a; a0b = a1b;
#pragma unroll
        for (int i = 0; i < 16; ++i) e1[i] = e2[i];
    }
}

constexpr int U5_AUX = 131072;
__device__ __forceinline__ void peer_up_phase5(const Frame& F, int layer) {
    const int bx = blockIdx.x, p4 = bx & 3, par = (bx >> 2) & 1;
    const unsigned char* TU = F.ws + WS_TAB + (size_t)(2 * layer + 1) * 16 * MiB + (size_t)p4 * (2 * MiB);
    const char* IDX = (const char*)(F.ws + WS_IDX); const char* AB8 = (const char*)(F.ws + WS_AB);
    char* H8 = (char*)(F.ws + WS_H8) + 256 * p4; float* HSQ = (float*)(F.ws + WS_HSQ);
    const char* HIN = (const char*)F.out + 512 * p4; char* OUT = (layer == 1 ? (char*)(F.ws + WS_H2) : (char*)F.out) + 512 * p4;
    const int nwp = (F.G - (bx & 7) + 7) >> 3, ww = (bx >> 3) * 8 + F.wave, stride = 2 * nwp * 8, tfirst = 2 * ww + par;
    if (tfirst >= T) return;
    const int lane = F.lane, rs = lane >> 3, sg = lane & 7, m = lane & 15, kg = lane >> 4;
    LAS unsigned char* wl = F.lds + F.wave * 16384; LAS unsigned char* xl = F.lds + U5_AUX + F.wave * 3584;
    const unsigned sw0 = (unsigned)((sg ^ kg) * 16), sw1 = (unsigned)((sg ^ (4 + kg)) * 16);
    const unsigned l4 = 4u * lane, l16 = 16u * lane;
    unsigned tb[8];
#pragma unroll
    for (int sgm = 0; sgm < 8; ++sgm) tb[sgm] = (unsigned)((32 * kg + m) * 128 + ((sgm ^ (m >> 1)) * 16));
    const int psrc = 4 * ((lane >> 2) + 16 * (lane & 3));
    const unsigned hrd = (unsigned)(32 * m + 8 * kg);
#define U5_PIECE(ixv, d) __builtin_amdgcn_global_load_lds((const unsigned*)(TU + ((ixv)[d] * 128u + (((d) & 1) ? sw1 : sw0))), (LAS unsigned*)(wl + (d) * 1024), 16, 0, 0)
#define U5_DMA_IDX(t, slot) __builtin_amdgcn_global_load_lds((const unsigned*)(IDX + (unsigned)((t) * 256) + l4), (LAS unsigned*)(xl + (slot) * 512), 4, 0, 0)
#define U5_DMA_AB(t, slot) __builtin_amdgcn_global_load_lds((const unsigned*)(AB8 + (unsigned)((t) * 256) + l4), (LAS unsigned*)(xl + 1024 + (slot) * 256), 4, 0, 0)
#define U5_DMA_H(t, slot) do { __builtin_amdgcn_global_load_lds((const unsigned*)(HIN + (unsigned)((t) * 2048) + l4), (LAS unsigned*)(xl + 1536 + (slot) * 1024), 4, 0, 0); \
                               __builtin_amdgcn_global_load_lds((const unsigned*)(HIN + (unsigned)((t) * 2048) + 256u + l4), (LAS unsigned*)(xl + 1536 + (slot) * 1024 + 256), 4, 0, 0); } while (0)
    { unsigned i0[16];
#pragma unroll
      for (int d = 0; d < 16; ++d) i0[d] = *(const unsigned short*)(IDX + (unsigned)(tfirst * 256) + (unsigned)(2 * rs + 16 * d));
#pragma unroll
      for (int d = 0; d < 16; ++d) asm volatile("" : "+v"(i0[d]) :: "memory");
      { const int t1 = tfirst + stride < T ? tfirst + stride : tfirst; U5_DMA_IDX(t1, 1); U5_DMA_AB(tfirst, 0); U5_DMA_H(tfirst, 0); }
      asm volatile("" ::: "memory");
#pragma unroll
      for (int d = 0; d < 16; ++d) U5_PIECE(i0, d); }
    int sl = 0, tprev = -1; f32x4 pend = {0.f, 0.f, 0.f, 0.f};
    for (int t0 = tfirst; t0 < T; t0 += stride, sl ^= 1) {
        const int t1 = t0 + stride < T ? t0 + stride : t0, t2 = t0 + 2 * stride < T ? t0 + 2 * stride : t0;
        asm volatile("s_waitcnt vmcnt(0)" ::: "memory");
        unsigned ix[16];
        { const LAS unsigned short* ip = (const LAS unsigned short*)(xl + (sl ^ 1) * 512 + 2 * rs);
#pragma unroll
          for (int d = 0; d < 16; ++d) ix[d] = ip[8 * d]; }
        const LAS u32x4* bp = (const LAS u32x4*)(xl + 1024 + sl * 256 + 16 * kg); u32x4 bl = bp[0], bh = bp[4];
        float inv = *(const LAS float*)(xl + 1024 + sl * 256 + 128);
        u32x2 hw = *(const LAS u32x2*)(xl + 1536 + sl * 1024 + hrd);
        i32x2 a0[16], a1[16];
#pragma unroll
        for (int cb = 0; cb < 16; ++cb) {
            a0[cb] = __builtin_amdgcn_ds_read_tr4_b64_v2i32((LAS i32x2*)(wl + tb[cb >> 1] + (cb & 1) * 8));
            a1[cb] = __builtin_amdgcn_ds_read_tr4_b64_v2i32((LAS i32x2*)(wl + tb[cb >> 1] + (cb & 1) * 8 + 2048)); }
        asm volatile("s_waitcnt lgkmcnt(0)" : "+v"(bl), "+v"(bh), "+v"(inv), "+v"(hw) :: "memory");
#pragma unroll
        for (int d = 0; d < 16; ++d) asm volatile("" : "+v"(ix[d]), "+v"(a0[d]), "+v"(a1[d]) :: "memory");
        if (tprev >= 0) { *(u32x2*)(OUT + (unsigned)(tprev * 2048) + 8u * lane) = (u32x2){(unsigned)__builtin_amdgcn_ds_bpermute(psrc, (int)pk2(pend.x, pend.y)), (unsigned)__builtin_amdgcn_ds_bpermute(psrc, (int)pk2(pend.z, pend.w))};
            if (layer == 0) { int w8 = 0; w8 = __builtin_amdgcn_cvt_pk_fp8_f32(pend.x, pend.y, w8, false); w8 = __builtin_amdgcn_cvt_pk_fp8_f32(pend.z, pend.w, w8, true);
                *(unsigned*)(H8 + (unsigned)(tprev * 1024) + l4) = (unsigned)__builtin_amdgcn_ds_bpermute(psrc, w8);
                const float sq = wave_sum((pend.x * pend.x + pend.y * pend.y) + (pend.z * pend.z + pend.w * pend.w));
                if (lane == 0) HSQ[tprev * 4 + p4] = sq; } }
        asm volatile("" ::: "memory");
        U5_DMA_IDX(t2, sl); U5_DMA_AB(t1, sl ^ 1); U5_DMA_H(t1, sl ^ 1);
#pragma unroll
        for (int d = 0; d < 16; ++d) U5_PIECE(ix, d);
        asm volatile("" ::: "memory");
        const i32x8 b = {(int)bl.x, (int)bl.y, (int)bl.z, (int)bl.w, (int)bh.x, (int)bh.y, (int)bh.z, (int)bh.w};
        const f32x4 z = {0.f, 0.f, 0.f, 0.f};
        f32x4 v = z;
#pragma unroll
        for (int cb = 0; cb < 16; ++cb) {
            const i32x8 a = {a0[cb].x, a0[cb].y, a1[cb].x, a1[cb].y, 0, 0, 0, 0};
            const f32x4 r = __builtin_amdgcn_mfma_scale_f32_16x16x128_f8f6f4(a, b, z, 4, 0, 0, 0, 0, 0);
            v = (m == cb) ? r : v; }
        pend = (f32x4){bflo(hw.x), bfhi(hw.x), bflo(hw.y), bfhi(hw.y)} + v * inv; tprev = t0;
    }
    asm volatile("s_waitcnt vmcnt(0)" ::: "memory");
    *(u32x2*)(OUT + (unsigned)(tprev * 2048) + 8u * lane) = (u32x2){(unsigned)__builtin_amdgcn_ds_bpermute(psrc, (int)pk2(pend.x, pend.y)), (unsigned)__builtin_amdgcn_ds_bpermute(psrc, (int)pk2(pend.z, pend.w))};
    if (layer == 0) { int w8 = 0; w8 = __builtin_amdgcn_cvt_pk_fp8_f32(pend.x, pend.y, w8, false); w8 = __builtin_amdgcn_cvt_pk_fp8_f32(pend.z, pend.w, w8, true);
        *(unsigned*)(H8 + (unsigned)(tprev * 1024) + l4) = (unsigned)__builtin_amdgcn_ds_bpermute(psrc, w8);
        const float sq = wave_sum((pend.x * pend.x + pend.y * pend.y) + (pend.z * pend.z + pend.w * pend.w));
        if (lane == 0) HSQ[tprev * 4 + p4] = sq; }
#undef U5_PIECE
#undef U5_DMA_IDX
#undef U5_DMA_AB
#undef U5_DMA_H
}

constexpr int SGM_VT = 0, SGM_WL = 384 * 272, SGM_STAT = SGM_WL + 128 * 272;
#define LDS_BARRIER() do { asm volatile("s_waitcnt lgkmcnt(0)" ::: "memory"); __builtin_amdgcn_s_barrier(); asm volatile("" ::: "memory"); } while (0)
__device__ __forceinline__ void sg_mix_phase(const Frame& F) {
    const unsigned char* V8 = F.ws + WS_SG; unsigned char* MX8 = F.ws + WS_MX8;
    const float* lng = F.in[7]; const float* lnb = F.in[8]; const float* wsp = F.in[9]; const float* bsp = F.in[10];
    LAS unsigned* VT32 = (LAS unsigned*)(F.lds + SGM_VT); LAS bf16_t* VT = (LAS bf16_t*)(F.lds + SGM_VT); LAS bf16_t* WL = (LAS bf16_t*)(F.lds + SGM_WL);
    LAS float* stat = (LAS float*)(F.lds + SGM_STAT); LAS float* lnl = (LAS float*)(F.lds + SGM_STAT + 1024);
    const int lane = F.lane, tid = F.tid, fr = lane & 15, fq = lane >> 4;
    for (int c = blockIdx.x; c < 256; c += F.G) {
#pragma unroll 1
        for (int r4 = 0; r4 < 16; r4 += 4) {
            u32x4 w[4][3];
#pragma unroll
            for (int rr = 0; rr < 4; ++rr) { const u32x4* row = (const u32x4*)(V8 + (size_t)(c * 128 + F.wave * 16 + r4 + rr) * DG);
#pragma unroll
                for (int i = 0; i < 3; ++i) w[rr][i] = row[lane + 64 * i]; }
#pragma unroll
            for (int rr = 0; rr < 4; ++rr) { const int q = F.wave * 16 + r4 + rr;
                float v[48]; float s = 0.f;
#pragma unroll
                for (int i = 0; i < 3; ++i) { const u32x4 x = w[rr][i]; const unsigned xw[4] = {x.x, x.y, x.z, x.w};
#pragma unroll
                    for (int k = 0; k < 4; ++k) { const f32x2 lo = __builtin_amdgcn_cvt_pk_f32_fp8((int)xw[k], false), hi = __builtin_amdgcn_cvt_pk_f32_fp8((int)xw[k], true);
                        v[16 * i + 4 * k + 0] = lo.x; v[16 * i + 4 * k + 1] = lo.y; v[16 * i + 4 * k + 2] = hi.x; v[16 * i + 4 * k + 3] = hi.y; } }
#pragma unroll
                for (int i = 0; i < 48; ++i) s += v[i];
                const float mean = wave_sum(s) * (1.f / DG); float s2 = 0.f;
#pragma unroll
                for (int i = 0; i < 48; ++i) { const float d = v[i] - mean; s2 += d * d; }
                const float rstd = 1.0f / sqrtf(wave_sum(s2) * (1.f / DG) + 1e-5f);
                if (lane == 0) { stat[2 * q] = mean; stat[2 * q + 1] = rstd; } }
        }
        __syncthreads();
        u32x2 x0[6], x1[6]; f32x4 lnr = {0.f, 0.f, 0.f, 0.f}; f32x4 wa[4], wb[4];
#define MIX_LOADS(g_, tid) do { \
            _Pragma("unroll") for (int it = 0; it < 6; ++it) { const int item = it * 512 + tid, qp = (item >> 3) & 63, dc = (item >> 9) * 8 + (item & 7); const int q0 = 2 * qp, col = (g_) * 384 + 8 * dc; \
                x0[it] = *(const u32x2*)(V8 + (size_t)(c * 128 + q0) * DG + col); x1[it] = *(const u32x2*)(V8 + (size_t)(c * 128 + q0 + 1) * DG + col); } \
            _Pragma("unroll") for (int it = 0; it < 4; ++it) { const int item = it * 512 + tid, p = item >> 4, q8 = (item & 15) * 8; const f32x4* wp = (const f32x4*)(wsp + ((size_t)(g_) * 128 + p) * 128 + q8); wa[it] = wp[0]; wb[it] = wp[1]; } \
            { const int t2 = tid < 192 ? tid : 0; lnr = *(const f32x4*)((t2 < 96 ? lng : lnb) + (g_) * 384 + 4 * (t2 < 96 ? t2 : t2 - 96)); } } while (0)
        MIX_LOADS(0, tid);
#pragma unroll 1
        for (int g = 0; g < 8; ++g) {
            int tidg = tid; asm volatile("" : "+v"(tidg));
            {
#pragma unroll
              for (int it = 0; it < 4; ++it) { const int item = it * 512 + tidg, p = item >> 4, q8 = (item & 15) * 8; const f32x4 a = wa[it], b = wb[it];
                u32x4 w; w.x = pk2(a.x, a.y); w.y = pk2(a.z, a.w); w.z = pk2(b.x, b.y); w.w = pk2(b.z, b.w);
                *(LAS u32x4*)(WL + p * 136 + q8) = w; } }
            if (tidg < 192) *(LAS f32x4*)(lnl + (tidg < 96 ? 4 * tidg : 384 + 4 * (tidg - 96))) = lnr;
            LDS_BARRIER();
#pragma unroll
            for (int it = 0; it < 6; ++it) { const int item = it * 512 + tidg, qp = (item >> 3) & 63, dc = (item >> 9) * 8 + (item & 7); const int q0 = 2 * qp, qsw = qp ^ (8 * (dc & 7));
                const u32x2 w0 = x0[it], w1 = x1[it];
                const float mu0 = stat[2 * q0], rs0 = stat[2 * q0 + 1], mu1 = stat[2 * q0 + 2], rs1 = stat[2 * q0 + 3];
                const f32x4 ga = *(const LAS f32x4*)(lnl + 8 * dc), gb = *(const LAS f32x4*)(lnl + 8 * dc + 4), ba = *(const LAS f32x4*)(lnl + 384 + 8 * dc), bb = *(const LAS f32x4*)(lnl + 384 + 8 * dc + 4);
                const float gm[8] = {ga.x, ga.y, ga.z, ga.w, gb.x, gb.y, gb.z, gb.w}, bt[8] = {ba.x, ba.y, ba.z, ba.w, bb.x, bb.y, bb.z, bb.w};
                const f32x2 p00 = __builtin_amdgcn_cvt_pk_f32_fp8((int)w0.x, false), p01 = __builtin_amdgcn_cvt_pk_f32_fp8((int)w0.x, true), p02 = __builtin_amdgcn_cvt_pk_f32_fp8((int)w0.y, false), p03 = __builtin_amdgcn_cvt_pk_f32_fp8((int)w0.y, true);
                const f32x2 p10 = __builtin_amdgcn_cvt_pk_f32_fp8((int)w1.x, false), p11 = __builtin_amdgcn_cvt_pk_f32_fp8((int)w1.x, true), p12 = __builtin_amdgcn_cvt_pk_f32_fp8((int)w1.y, false), p13 = __builtin_amdgcn_cvt_pk_f32_fp8((int)w1.y, true);
                const float a0[8] = {p00.x, p00.y, p01.x, p01.y, p02.x, p02.y, p03.x, p03.y};
                const float a1[8] = {p10.x, p10.y, p11.x, p11.y, p12.x, p12.y, p13.x, p13.y};
#pragma unroll
                for (int i = 0; i < 8; ++i) VT32[(8 * dc + i) * 68 + qsw] = pk2((a0[i] - mu0) * rs0 * gm[i] + bt[i], (a1[i] - mu1) * rs1 * gm[i] + bt[i]); }
            LDS_BARRIER();
            { const int gn = g + 1 < 8 ? g + 1 : g; MIX_LOADS(gn, tidg); }
            __builtin_amdgcn_sched_barrier(0);
            f32x4 acc[3][8];
#pragma unroll
            for (int a = 0; a < 3; ++a)
#pragma unroll
                for (int n = 0; n < 8; ++n) acc[a][n] = (f32x4){0.f, 0.f, 0.f, 0.f};
#pragma unroll 1
            for (int ks = 0; ks < 4; ++ks) { const int k0 = 32 * ks + 8 * fq;
                bf16x8 af[3];
#pragma unroll
                for (int a = 0; a < 3; ++a) { const int d = 16 * (3 * F.wave + a) + fr; af[a] = *(const LAS bf16x8*)(VT + d * 136 + 2 * ((k0 >> 1) ^ (8 * ((d >> 3) & 7)))); }
#pragma unroll
                for (int n2 = 0; n2 < 8; n2 += 2) {
                    const bf16x8 b0 = *(const LAS bf16x8*)(WL + (16 * n2 + fr) * 136 + k0), b1 = *(const LAS bf16x8*)(WL + (16 * (n2 + 1) + fr) * 136 + k0);
#pragma unroll
                    for (int a = 0; a < 3; ++a) { acc[a][n2] = __builtin_amdgcn_mfma_f32_16x16x32_bf16(af[a], b0, acc[a][n2], 0, 0, 0); acc[a][n2 + 1] = __builtin_amdgcn_mfma_f32_16x16x32_bf16(af[a], b1, acc[a][n2 + 1], 0, 0, 0); }
                    __builtin_amdgcn_sched_barrier(0); } }
            LDS_BARRIER();
#pragma unroll
            for (int n = 0; n < 8; ++n) { const int p = 16 * n + fr; const float bs = bsp[g * 128 + p];
#pragma unroll
                for (int a = 0; a < 3; ++a) { const int d0 = 16 * (3 * F.wave + a) + 4 * fq;
                    int w = 0; w = __builtin_amdgcn_cvt_pk_fp8_f32(acc[a][n][0] + bs, acc[a][n][1] + bs, w, false); w = __builtin_amdgcn_cvt_pk_fp8_f32(acc[a][n][2] + bs, acc[a][n][3] + bs, w, true);
                    *(LAS unsigned*)(F.lds + SGM_VT + p * 400 + d0) = (unsigned)w; } }
            LDS_BARRIER();
#pragma unroll
            for (int ps = 0; ps < 6; ++ps) { const int idx = ps * 512 + tidg, row = idx / 24, ch = idx - row * 24;
                *(u32x4*)(MX8 + (size_t)(c * 128 + row) * DG + g * 384 + ch * 16) = *(const LAS u32x4*)(F.lds + SGM_VT + row * 400 + ch * 16); }
            LDS_BARRIER();
        }
    }
}

#undef MIX_LOADS
__global__ void __launch_bounds__(512, 2) fwd(Args args) {
    extern __shared__ __attribute__((aligned(16))) unsigned char lds_raw[];
    Frame F;
    F.lds = (LAS unsigned char*)lds_raw;
    F.tid = threadIdx.x; F.lane = F.tid & 63; F.wave = __builtin_amdgcn_readfirstlane(F.tid >> 6);
    F.G = gridDim.x; F.gw = blockIdx.x * 8 + F.wave; F.NGW = F.G * 8;
    F.in = args.in; F.out = args.out; F.ws = args.ws;
    volatile LAS unsigned* MISC = (volatile LAS unsigned*)(F.lds + MISC_OFF);
    if (F.tid < 64) MISC[F.tid] = 0u;
    __syncthreads();
    const int lo = args.ph_lo, hi = args.ph_hi;
    unsigned* barw = (unsigned*)(F.ws + WS_CTL) + CW_BAR;
    XcdBarrier bar; bar.bar = barw; bar.x = 0; bar.st = MISC + 8;
    if (hi - lo > 1) bar = xcd_barrier_post(barw, MISC + 8);
#define IN(k) (lo <= (k) && (k) < hi)
#define SEAM(k) do { if (IN(k) && IN((k) + 1)) xcd_barrier(bar); } while (0)
    const int G = F.G, bx = blockIdx.x;
    bf16_t* HN = (bf16_t*)(F.ws + WS_HN); bf16_t* HB = (bf16_t*)F.out;

    if (IN(0)) { p0_prologue(F); } SEAM(0);
    if (IN(1)) {
        const bf16_t* HN8 = (const bf16_t*)(F.ws + WS_HN8B);
        { pg8::Gemm g{HN8, (const bf16_t*)(F.ws + WS_WQK), T, NQK, D / 2}; pg8::StaticOrder S; S.init(T, NQK, G, bx);
          pg8::EpiBf<3> E{(bf16_t*)(F.ws + WS_Q), 1024, (bf16_t*)(F.ws + WS_K), 1.0f / W8_SCALE};
          pg8::gemm_phase<1>(F.lds, g, S, E); }
        __syncthreads();
        { pg8::Gemm g{(const bf16_t*)(F.ws + WS_WV), HN8, 256, T, D / 2}; pg8::StaticOrder S; S.init(256, T, G, (bx + G / 2) % G);
          pg8::EpiBf<0> E{(bf16_t*)(F.ws + WS_VT), T, nullptr, 1.0f / W8_SCALE};
          pg8::gemm_phase<1>(F.lds, g, S, E); }
    } SEAM(1);
    if (IN(2)) { attn_phase_v2(F); } SEAM(2);
    if (IN(3)) {
        pg8::Gemm g{(const bf16_t*)(F.ws + WS_AO), (const bf16_t*)(F.ws + WS_WO), T, D, D / 2}; pg8::StaticOrder S; S.init(T, D, G, bx);
        pg8::EpiBf<6> E{HB, D, (bf16_t*)F.in[0], 1.0f / (W8_SCALE * AO8_SCALE)};
        pg8::gemm_phase<1>(F.lds, g, S, E);
    } SEAM(3);
    if (IN(4)) { quant_wqk(F); rmsnorm_rows_bf(F, HB, F.in[12], nullptr, nullptr, F.ws + WS_HNI8, (float*)(F.ws + WS_HSC)); } SEAM(4);
    if (IN(5)) {
        pg8::Gemm g{(const bf16_t*)(F.ws + WS_HNI8), (const bf16_t*)(F.ws + WS_WQ8), T, 2048, D / 2}; pg8::StaticOrder S; S.init(T, 2048, G, bx);
        pg8::EpiBf<8> E{(bf16_t*)(F.ws + WS_S), 2048, (bf16_t*)(F.ws + WS_HSC), 1.0f, (const float*)(F.ws + WS_CTL) + CW_WSCL};
        pg8::gemm_phase<2>(F.lds, g, S, E);
    } SEAM(5);
    if (IN(6)) { topk_phase_v3(F); } SEAM(6);
    if (IN(7)) { peer_down_phase5(F, 0); } SEAM(7);
    if (IN(8)) { peer_reduce_phase8(F, 0); } SEAM(8);
    if (IN(9)) { peer_up_phase5(F, 0); } SEAM(9);
    if (IN(11)) {
        pg8::Gemm g{(const bf16_t*)(F.ws + WS_H8), (const bf16_t*)(F.ws + WS_WSGV), T, DG, D / 2}; pg8::StaticOrder S; S.init(T, DG, G, bx);
        pg8::EpiBf<9, true> E{nullptr, DG, (bf16_t*)(F.ws + WS_SG), 1.0f / W8_SCALE, nullptr, (const float*)(F.ws + WS_HSQ)};
        pg8::gemm_phase<1>(F.lds, g, S, E);
    } SEAM(11);
    if (IN(12)) { sg_mix_phase(F); } SEAM(12);
    if (IN(13)) {
        pg8::Gemm g{(const bf16_t*)(F.ws + WS_H8), (const bf16_t*)(F.ws + WS_WSGU), T, DG, D / 2}; pg8::StaticOrder S; S.init(T, DG, G, bx);
        pg8::EpiBf<5, true> E{(bf16_t*)(F.ws + WS_MX8), DG, (bf16_t*)(F.ws + WS_SG8), 1.0f / W8_SCALE, nullptr, (const float*)(F.ws + WS_HSQ)};
        pg8::gemm_phase<1>(F.lds, g, S, E);
    } SEAM(13);
    if (IN(14)) {
        pg8::Gemm g{(const bf16_t*)(F.ws + WS_SG8), (const bf16_t*)(F.ws + WS_WSGO), T, D, DG / 2}; pg8::StaticOrder S; S.init(T, D, G, bx);
        pg8::EpiBf<7> E{HB, D, nullptr, 1.0f / W8_SCALE};
        pg8::gemm_phase<1>(F.lds, g, S, E);
    } SEAM(14);
    if (IN(15)) { rmsnorm_rows_bf(F, HB, F.in[12] + D, nullptr, nullptr, F.ws + WS_HNI8, (float*)(F.ws + WS_HSC)); } SEAM(15);
    if (IN(16)) {
        pg8::Gemm g{(const bf16_t*)(F.ws + WS_HNI8), (const bf16_t*)(F.ws + WS_WQ8 + (size_t)2048 * 1024), T, 2048, D / 2}; pg8::StaticOrder S; S.init(T, 2048, G, bx);
        pg8::EpiBf<8> E{(bf16_t*)(F.ws + WS_S), 2048, (bf16_t*)(F.ws + WS_HSC), 1.0f, (const float*)(F.ws + WS_CTL) + CW_WSCL + 2048};
        pg8::gemm_phase<2>(F.lds, g, S, E);
    } SEAM(16);
    if (IN(17)) { topk_phase_v3(F); } SEAM(17);
    if (IN(18)) { peer_down_phase5(F, 1); } SEAM(18);
    if (IN(19)) { peer_reduce_phase8(F, 1); } SEAM(19);
    if (IN(20)) { peer_up_phase5(F, 1); } SEAM(20);
    if (IN(21)) { final_norm_bf(F, (const bf16_t*)(F.ws + WS_H2), F.out, F.in[17]); }
#undef IN
#undef SEAM
}

extern "C" void kernel_launch(void* const* d_in, const int* in_sizes, int n_in, void* d_out, int out_size, void* d_ws, size_t ws_size, hipStream_t stream) {
    static int grid = 0;
    if (grid == 0) {
        if (n_in != 18 || out_size != T * D || ws_size < WS_END) { fprintf(stderr, "kernel_launch: unexpected problem (n_in %d, out %d, ws %zu)\n", n_in, out_size, ws_size); grid = -1; return; }
        int dev = 0, cus = 0, per_cu = 0;
        if (hipGetDevice(&dev) != hipSuccess || hipDeviceGetAttribute(&cus, hipDeviceAttributeMultiprocessorCount, dev) != hipSuccess) { grid = -1; return; }
        if (hipFuncSetAttribute((const void*)fwd, hipFuncAttributeMaxDynamicSharedMemorySize, LDS_BYTES) != hipSuccess) { fprintf(stderr, "kernel_launch: hipFuncSetAttribute failed\n"); grid = -1; return; }
        if (hipOccupancyMaxActiveBlocksPerMultiprocessor(&per_cu, (const void*)fwd, 512, LDS_BYTES) != hipSuccess || per_cu < 1) fprintf(stderr, "kernel_launch: occupancy query says %d\n", per_cu);
        (void)hipGetLastError();
        grid = cus;
    }
    if (grid < 0) return;
    (void)hipMemsetAsync((char*)d_ws + WS_CTL, 0, CTL_ZERO_BYTES, stream);
    Args a{};
    for (int i = 0; i < 18; ++i) a.in[i] = (const float*)d_in[i];
    a.out = (float*)d_out; a.ws = (unsigned char*)d_ws;
#if MK_ONE_LAUNCH
    a.ph_lo = 0; a.ph_hi = NPH;
    hipLaunchKernelGGL(fwd, dim3(grid), dim3(512), LDS_BYTES, stream, a);
#else
    for (int ph = 0; ph < NPH; ++ph) {
        a.ph_lo = ph; a.ph_hi = ph + 1;
        hipLaunchKernelGGL(fwd, dim3(grid), dim3(512), LDS_BYTES, stream, a);
    }
#endif
}
```
